# Optimizing an MI355X kernel written in HIP

```python
import jax, jax.numpy as jnp
from jax import lax
import numpy as np

D_MODEL = 1024
BATCH = 16
SEQ = 256
DEPTH = 1
DEC_BATCH = 4
DEC_SEQ = 4096
PAST_LEN = 256

GRID_W = 64
D_MIX = D_MODEL
D_CONV = D_MIX // 2
D_MLSTM = D_MIX - D_CONV
N_HEADS = 4
HEAD_DIM = D_MLSTM // N_HEADS
N_GATES = 4 * N_HEADS
D_IN = 3 * D_CONV + 4 * D_MLSTM + N_GATES
D_FF = ((8 * D_MODEL // 3 + 127) // 128) * 128
CHUNK = 128
EPS = 1e-6

kernel_name = 'hymba_conv_mlstm_diffusion_step'


def rmsnorm(x, g):
    xf = x.astype(jnp.float32)
    y = xf * lax.rsqrt(jnp.mean(xf * xf, axis=-1, keepdims=True) + EPS)
    return (y * g.astype(jnp.float32)).astype(x.dtype)


def conv3(x4, w, b, axis):
    n = x4.shape[axis]
    pad = [(0, 0)] * 4
    pad[axis] = (1, 1)
    xp = jnp.pad(x4, pad)
    prev = lax.slice_in_dim(xp, 0, n, axis=axis)
    nxt = lax.slice_in_dim(xp, 2, n + 2, axis=axis)
    return w[0] * prev + w[1] * x4 + w[2] * nxt + b


def mlstm_scan(q, k, v, log_i, log_f, C0, n0, m0):
    B, T, H, Dh = q.shape
    nc = T // CHUNK
    f32 = jnp.float32

    def blocks(a):
        a = a.astype(f32).reshape((B, nc, CHUNK) + a.shape[2:])
        return jnp.moveaxis(a, (1, 3), (0, 2))

    qb = blocks(q) * (Dh ** -0.5)
    kb, vb, ib, fb = blocks(k), blocks(v), blocks(log_i), blocks(log_f)
    mask = jnp.tril(jnp.ones((CHUNK, CHUNK), dtype=bool))

    def step(carry, inp):
        C, n, m = carry
        qc, kc, vc, ic, fc = inp
        b = jnp.cumsum(fc, axis=-1)
        dlog = b[..., :, None] - b[..., None, :] + ic[..., None, :]
        dlog = jnp.where(mask, dlog, -jnp.inf)
        inter = b + m[..., None]
        m_t = jnp.maximum(inter, jnp.max(dlog, axis=-1))
        w_intra = jnp.exp(dlog - m_t[..., None])
        w_inter = jnp.exp(inter - m_t)
        s = jnp.einsum('bhtd,bhsd->bhts', qc, kc) * w_intra
        num = jnp.einsum('bhts,bhsd->bhtd', s, vc) + w_inter[..., None] * jnp.einsum('bhvk,bhtk->bhtv', C, qc)
        den = jnp.sum(s, axis=-1) + w_inter * jnp.einsum('bhk,bhtk->bht', n, qc)
        h = num / jnp.maximum(jnp.abs(den), jnp.exp(-m_t))[..., None]
        bl = b[..., -1]
        g = bl[..., None] - b + ic
        m_new = jnp.maximum(bl + m, jnp.max(g, axis=-1))
        wg = jnp.exp(g - m_new[..., None])
        decay = jnp.exp(bl + m - m_new)
        C_new = decay[..., None, None] * C + jnp.einsum('bhs,bhsv,bhsk->bhvk', wg, vc, kc)
        n_new = decay[..., None] * n + jnp.einsum('bhs,bhsk->bhk', wg, kc)
        return (C_new, n_new, m_new), h

    (C, n, m), hb = lax.scan(step, (C0.astype(f32), n0.astype(f32), m0.astype(f32)), (qb, kb, vb, ib, fb))
    h = jnp.moveaxis(hb, (0, 2), (1, 3)).reshape(B, T, H, Dh)
    return h, C, n, m


def mlstm_bidir(q, k, v, gates, C0, n0, m0):
    flip = lambda a: a[:, ::-1]
    h_f, Cf, nf, mf = mlstm_scan(q, k, v, gates[:, :, 0], jax.nn.log_sigmoid(gates[:, :, 1]),
                                 C0[:, 0], n0[:, 0], m0[:, 0])
    h_b, Cb, nb, mb = mlstm_scan(flip(q), flip(k), flip(v), flip(gates[:, :, 2]),
                                 flip(jax.nn.log_sigmoid(gates[:, :, 3])), C0[:, 1], n0[:, 1], m0[:, 1])
    return h_f + flip(h_b), jnp.stack([Cf, Cb], 1), jnp.stack([nf, nb], 1), jnp.stack([mf, mb], 1)


def trunk_layer(x, mod, row_len, ffn_axis, C0, n0, m0, norm1, w_in, b_gate, conv_sc_w, conv_sc_b,
                mh_norm, w_out, norm2, w_up, conv_ffn_w, conv_ffn_b, w_down):
    B, T, _ = x.shape
    rows = T // row_len
    shift1, scale1, gate1, shift2, scale2, gate2 = jnp.split(mod, 6, axis=-1)
    h = rmsnorm(x, norm1) * (1 + scale1) + shift1
    z = h @ w_in
    idx = [D_CONV, 2 * D_CONV, 3 * D_CONV, 3 * D_CONV + D_MLSTM, 3 * D_CONV + 2 * D_MLSTM,
           3 * D_CONV + 3 * D_MLSTM, 3 * D_CONV + 4 * D_MLSTM]
    sc_b, sc_c, sc_x, q, k, v, o, g = jnp.split(z, idx, axis=-1)
    u = (sc_c * sc_x).reshape(B, rows, row_len, D_CONV)
    y_sc = sc_b * conv3(u, conv_sc_w, conv_sc_b, axis=2).reshape(B, T, D_CONV)
    heads = lambda a: a.reshape(B, T, N_HEADS, HEAD_DIM)
    gates = g.astype(jnp.float32).reshape(B, T, 4, N_HEADS) + b_gate.astype(jnp.float32)
    h_m, C, n, m = mlstm_bidir(heads(q), heads(k), heads(v), gates, C0, n0, m0)
    h_m = h_m * lax.rsqrt(jnp.mean(h_m * h_m, axis=-1, keepdims=True) + EPS)
    h_m = h_m * mh_norm.reshape(N_HEADS, HEAD_DIM).astype(jnp.float32)
    h_m = h_m.reshape(B, T, D_MLSTM).astype(x.dtype) * jax.nn.sigmoid(o)
    x = x + gate1 * (jnp.concatenate([y_sc, h_m], axis=-1) @ w_out)
    h2 = rmsnorm(x, norm2) * (1 + scale2) + shift2
    up = (h2 @ w_up).reshape(B, rows, row_len, 2 * D_FF)
    up = conv3(up, conv_ffn_w, conv_ffn_b, axis=ffn_axis).reshape(B, T, 2 * D_FF)
    a, gg = jnp.split(up, 2, axis=-1)
    x = x + gate2 * ((jax.nn.silu(gg) * a) @ w_down)
    return x, C, n, m


def setup_inputs(seed: int = 0) -> dict:
    key = jax.random.key(seed)
    ks = jax.random.split(key, 24)
    nrm = lambda k, shape, scale: scale * jax.random.normal(k, shape, jnp.float32)
    forget_bias = jnp.linspace(3.0, 6.0, N_HEADS)
    gate_offset = jnp.zeros((4, N_HEADS), jnp.float32).at[1].set(forget_bias).at[3].set(forget_bias)
    return {
        'x_prompt': nrm(ks[0], (BATCH, SEQ, D_MODEL), 1.0),
        'x_sample': nrm(ks[1], (DEC_BATCH, DEC_SEQ, D_MODEL), 1.0),
        'state_C': nrm(ks[2], (DEC_BATCH, DEPTH, 2, N_HEADS, HEAD_DIM, HEAD_DIM), 0.5),
        'state_n': nrm(ks[3], (DEC_BATCH, DEPTH, 2, N_HEADS, HEAD_DIM), 0.5),
        'state_m': nrm(ks[4], (DEC_BATCH, DEPTH, 2, N_HEADS), 1.0),
        'c': nrm(ks[5], (DEC_BATCH, D_MODEL), 1.0),
        'c_ctx': nrm(ks[6], (D_MODEL,), 1.0),
        'w_mod': nrm(ks[7], (DEPTH, D_MODEL, 6 * D_MODEL), D_MODEL ** -0.5),
        'b_mod': nrm(ks[8], (DEPTH, 6 * D_MODEL), 0.02),
        'norm1': 1.0 + nrm(ks[9], (DEPTH, D_MODEL), 0.02),
        'w_in': nrm(ks[10], (DEPTH, D_MODEL, D_IN), D_MODEL ** -0.5),
        'b_gate': gate_offset + nrm(ks[11], (DEPTH, 4, N_HEADS), 0.1),
        'conv_sc_w': nrm(ks[12], (DEPTH, 3, D_CONV), 3 ** -0.5),
        'conv_sc_b': nrm(ks[13], (DEPTH, D_CONV), 0.02),
        'mh_norm': 1.0 + nrm(ks[14], (DEPTH, D_MLSTM), 0.02),
        'w_out': nrm(ks[15], (DEPTH, D_MIX, D_MODEL), D_MIX ** -0.5),
        'norm2': 1.0 + nrm(ks[16], (DEPTH, D_MODEL), 0.02),
        'w_up': nrm(ks[17], (DEPTH, D_MODEL, 2 * D_FF), D_MODEL ** -0.5),
        'conv_ffn_w': nrm(ks[18], (DEPTH, 3, 2 * D_FF), 3 ** -0.5),
        'conv_ffn_b': nrm(ks[19], (DEPTH, 2 * D_FF), 0.02),
        'w_down': nrm(ks[20], (DEPTH, D_FF, D_MODEL), D_FF ** -0.5),
        'final_norm': 1.0 + nrm(ks[21], (D_MODEL,), 0.02),
    }


def reference(x_prompt, x_sample, state_C, state_n, state_m, c, c_ctx, w_mod, b_mod, norm1, w_in, b_gate,
              conv_sc_w, conv_sc_b, mh_norm, w_out, norm2, w_up, conv_ffn_w, conv_ffn_b, w_down, final_norm):
    B, S, _ = x_prompt.shape
    f32 = jnp.float32
    zC = jnp.zeros((B, 2, N_HEADS, HEAD_DIM, HEAD_DIM), f32)
    zn = jnp.zeros((B, 2, N_HEADS, HEAD_DIM), f32)
    zm = jnp.zeros((B, 2, N_HEADS), f32)
    xp, xs = x_prompt, x_sample
    new_C, new_n, new_m = [], [], []
    for l in range(DEPTH):
        mod_ctx = (jax.nn.silu(c_ctx) @ w_mod[l] + b_mod[l])[None, None, :]
        mod_lat = (jax.nn.silu(c) @ w_mod[l] + b_mod[l])[:, None, :]
        lw = (norm1[l], w_in[l], b_gate[l], conv_sc_w[l], conv_sc_b[l], mh_norm[l], w_out[l],
              norm2[l], w_up[l], conv_ffn_w[l], conv_ffn_b[l], w_down[l])
        xp, Cc, ncc, mc = trunk_layer(xp, mod_ctx, S, 2, zC, zn, zm, *lw)
        xs, _, _, _ = trunk_layer(xs, mod_lat, GRID_W, 1, state_C[:, l], state_n[:, l], state_m[:, l], *lw)
        new_C.append(Cc.astype(x_prompt.dtype))
        new_n.append(ncc.astype(x_prompt.dtype))
        new_m.append(mc.astype(x_prompt.dtype))
    y_prompt = rmsnorm(xp, final_norm)
    y_sample = rmsnorm(xs, final_norm)
    return (y_prompt, y_sample, jnp.stack(new_C, 1), jnp.stack(new_n, 1), jnp.stack(new_m, 1))
```

```cpp
#include <hip/hip_runtime.h>
#include <hip/hip_cooperative_groups.h>
#include <cstdio>
namespace cg = cooperative_groups;

#define LAS __attribute__((address_space(3)))
typedef unsigned short bf16_t;
typedef short bf16x8 __attribute__((ext_vector_type(8)));
typedef float f32x4 __attribute__((ext_vector_type(4)));
typedef unsigned u32x2 __attribute__((ext_vector_type(2)));
typedef unsigned u32x4 __attribute__((ext_vector_type(4)));

constexpr int DM = 1024, NTOK = 20480, NCTXT = 4096, DIN = 3600, NZ = 3584, DFF = 2816, NUP = 5632, NMOD = 6144;
constexpr float EPS = 1e-6f;
constexpr size_t WS_MOD = 0, WS_SB = 122880, WS_RSS1 = 235520, WS_RSS2 = 317440, WS_ZERO_BYTES = 399360;
constexpr size_t WS_GATES = 399360, WS_STAT = 1710080, WS_MST = 1720320;
constexpr size_t WS_WIN = 2097152, WS_WOUT = 9437184, WS_WUP = 11534336, WS_WDN = 23068672;
constexpr size_t WS_H = 28835840;
constexpr size_t WS_UCAT = 71106560;
constexpr size_t WS_Z = 113049600;
constexpr int OUT_TAIL = 20971520;
constexpr int LDS_BYTES = 131072 + 8192;

struct Params {
  const float *x_prompt, *x_sample, *state_C, *state_n, *state_m, *c, *c_ctx, *w_mod, *b_mod, *norm1, *w_in, *b_gate,
      *conv_sc_w, *conv_sc_b, *mh_norm, *w_out, *norm2, *w_up, *conv_ffn_w, *conv_ffn_b, *w_down, *final_norm;
  float* out; unsigned char* ws;
};

typedef __bf16 bf16x2_n __attribute__((ext_vector_type(2)));
typedef float f32x2_n __attribute__((ext_vector_type(2)));
__device__ __forceinline__ unsigned cvt_pk_bf16_c(float lo, float hi) { const f32x2_n v = {lo, hi}; return __builtin_bit_cast(unsigned, __builtin_convertvector(v, bf16x2_n)); }
__device__ __forceinline__ unsigned cvt_pk_bf16(float lo, float hi) { unsigned r; asm("v_cvt_pk_bf16_f32 %0, %1, %2" : "=v"(r) : "v"(lo), "v"(hi)); return r; }
__device__ __forceinline__ bf16_t f2bf_c(float f) { return (bf16_t)(cvt_pk_bf16_c(f, 0.f) & 0xffffu); }
__device__ __forceinline__ bf16_t f2bf(float f) { return (bf16_t)(cvt_pk_bf16(f, 0.f) & 0xffffu); }
__device__ __forceinline__ float bf2f(bf16_t b) { return __uint_as_float(((unsigned)b) << 16); }
__device__ __forceinline__ float bflo(unsigned u) { return __uint_as_float(u << 16); }
__device__ __forceinline__ float bfhi(unsigned u) { return __uint_as_float(u & 0xffff0000u); }
__device__ __forceinline__ int permtok(int T) { if (T < NCTXT) return T; const int q = T - NCTXT; return NCTXT + (q & ~4095) + ((q & 63) << 6) + ((q >> 6) & 63); }
template <int CTRL> __device__ __forceinline__ float dppf(float x) { return __builtin_bit_cast(float, __builtin_amdgcn_mov_dpp(__builtin_bit_cast(int, x), CTRL, 0xf, 0xf, true)); }
__device__ __forceinline__ float fast_sigmoid(float x) { return __builtin_amdgcn_rcpf(1.0f + __expf(-x)); }

constexpr int BM = 256, BK = 64, HALF = 128, HTB = HALF * BK * 2, NXCD = 8, WGM = 8;
__device__ __forceinline__ int lds_byte(int r, int c) { const int st = (r >> 4) * 2 + (c >> 5), rr = r & 15, cc = c & 31, ob = rr * 64 + cc * 2; return st * 1024 + (ob ^ (((ob >> 9) & 1) << 5)); }
__device__ __forceinline__ void stage_rc(int b, int& R, int& C) { const int st = b / 1024, sb = b % 1024, swz = sb ^ (((sb >> 9) & 1) << 5); R = (st >> 1) * 16 + swz / 64; C = (st & 1) * 32 + (swz % 64) / 2; }

struct Order {
  int nM, nN, nwg, G, c;
  __device__ __forceinline__ void init(int M, int N) { nM = M / BM; nN = N / BM; nwg = nM * nN; G = gridDim.x; c = blockIdx.x; }
  __device__ __forceinline__ bool next(int i, int& pm, int& pn) const {
    const long L = (long)i * G + c; if (L >= nwg) return false;
    int wgid = (int)L; { const int q = nwg / NXCD, r = nwg % NXCD, xcd = wgid % NXCD, off = wgid / NXCD; wgid = (xcd < r ? xcd * (q + 1) : r * (q + 1) + (xcd - r) * q) + off; }
    const int nig = WGM * nN, gid = wgid / nig, fm = gid * WGM, gsz = (nM - fm) < WGM ? (nM - fm) : WGM;
    pm = fm + ((wgid % nig) % gsz); pn = (wgid % nig) / gsz; return true;
  }
};

template <class Epi>
__device__ __forceinline__ void gemm_phase(LAS unsigned char* lds, const bf16_t* gA, const bf16_t* gBt, int M, int N, int K, const Epi& E) {
  const int tid = threadIdx.x, wid = __builtin_amdgcn_readfirstlane(tid >> 6), lane = tid & 63, wr = wid >> 2, wc = wid & 3, fr = lane & 15, fq = lane >> 4;
  const int nt = K / BK;
  Order S; S.init(M, N);
  unsigned voffA[2];
#pragma unroll
  for (int i = 0; i < 2; ++i) { int R, C; stage_rc(tid * 16 + i * 8192, R, C); voffA[i] = (unsigned)(R * K + C) * 2u; }
  const size_t kstep = (size_t)(BK * 2);
  const size_t hstep = (size_t)HALF * K * 2;
  const size_t tstep = 2 * hstep;
  const unsigned ldsw = (unsigned)wid * 1024u;
  const int aoff = lds_byte(wr * 64 + fr, fq * 8), boff = lds_byte(wc * 32 + fr, fq * 8);
#define G_SA(b, h) (((b) * 2 + (h)) * HTB)
#define G_SB(b, h) ((4 + (b) * 2 + (h)) * HTB)
#define G_STAGE(bufoff, gbase) do { _Pragma("unroll") for (int _i = 0; _i < 2; ++_i) \
    __builtin_amdgcn_global_load_lds((const unsigned*)((const char*)(gbase) + voffA[_i]), (LAS unsigned*)(lds + (bufoff) + ldsw + _i * 8192), 16, 0, 0); } while (0)
#define G_LDA(dst, b, h) do { _Pragma("unroll") for (int m = 0; m < 4; ++m) _Pragma("unroll") for (int k = 0; k < 2; ++k) dst[m][k] = *(const LAS bf16x8*)(lds + G_SA(b, h) + aoff + m * 2048 + k * 1024); } while (0)
#define G_LDB(dst, b, h) do { _Pragma("unroll") for (int n = 0; n < 2; ++n) _Pragma("unroll") for (int k = 0; k < 2; ++k) dst[n][k] = *(const LAS bf16x8*)(lds + G_SB(b, h) + boff + n * 2048 + k * 1024); } while (0)
#define G_MMA(ai, bj, At, Bt) do { __builtin_amdgcn_s_setprio(1); _Pragma("unroll") for (int m = 0; m < 4; ++m) _Pragma("unroll") for (int n = 0; n < 2; ++n) _Pragma("unroll") for (int k = 0; k < 2; ++k) \
    acc[ai][bj][m][n] = __builtin_amdgcn_mfma_f32_16x16x32_bf16(Bt[n][k], At[m][k], acc[ai][bj][m][n], 0, 0, 0); __builtin_amdgcn_s_setprio(0); } while (0)
#define G_WAIT_V(n) asm volatile("s_waitcnt vmcnt(" #n ")" ::: "memory")
#define G_WAIT_L(n) asm volatile("s_waitcnt lgkmcnt(" #n ")" ::: "memory")
#define G_BAR __builtin_amdgcn_s_barrier()
#define G_SCHED __builtin_amdgcn_sched_barrier(0)
  int cpm, cpn, npm = 0, npn = 0, ui = 0;
  if (!S.next(0, cpm, cpn)) return;
  f32x4 acc[2][2][4][2];
#pragma unroll
  for (int a = 0; a < 2; ++a)
#pragma unroll
    for (int b = 0; b < 2; ++b)
#pragma unroll
      for (int m = 0; m < 4; ++m)
#pragma unroll
        for (int n = 0; n < 2; ++n) acc[a][b][m][n] = (f32x4){0.f, 0.f, 0.f, 0.f};
  bf16x8 At[4][2], B0[2][2], B1[2][2];
  const char* cA = (const char*)gA + (size_t)cpm * tstep; const char* cB = (const char*)gBt + (size_t)cpn * tstep;
  G_STAGE(G_SB(0, 0), cB); G_STAGE(G_SA(0, 0), cA); G_STAGE(G_SB(0, 1), cB + hstep); G_STAGE(G_SA(0, 1), cA + hstep);
  if (wr == 1) G_BAR;
  G_WAIT_V(4); G_BAR;
  G_STAGE(G_SB(1, 0), cB + kstep); G_STAGE(G_SA(1, 0), cA + kstep); G_STAGE(G_SB(1, 1), cB + hstep + kstep);
  G_WAIT_V(6); G_BAR;
  for (;;) {
    const bool has_next = S.next(ui + 1, npm, npn);
    const char* nA = has_next ? (const char*)gA + (size_t)npm * tstep : cA; const char* nB = has_next ? (const char*)gBt + (size_t)npn * tstep : cB;
    for (int t = 0; t < nt; t += 2) {
      const bool last = (t == nt - 2);
      const char* a1 = cA + (size_t)(t + 1) * kstep;
      const char* a2 = last ? nA : cA + (size_t)(t + 2) * kstep; const char* b2 = last ? nB : cB + (size_t)(t + 2) * kstep;
      const char* a3 = a2 + kstep; const char* b3 = b2 + kstep;
      G_LDB(B0, 0, 0); G_SCHED; G_LDA(At, 0, 0); G_STAGE(G_SA(1, 1), a1 + hstep);
      G_WAIT_L(8); G_BAR; G_WAIT_L(0); G_MMA(0, 0, At, B0); G_BAR; G_SCHED;
      G_LDB(B1, 0, 1); G_STAGE(G_SB(0, 0), b2);
      G_BAR; G_WAIT_L(0); G_MMA(0, 1, At, B1); G_BAR;
      G_LDA(At, 0, 1); G_STAGE(G_SA(0, 0), a2);
      G_BAR; G_WAIT_L(0); G_MMA(1, 0, At, B0); G_BAR; G_SCHED;
      G_STAGE(G_SB(0, 1), b2 + hstep);
      G_WAIT_V(6); G_BAR; G_MMA(1, 1, At, B1); G_BAR;
      G_LDB(B0, 1, 0); G_SCHED; G_LDA(At, 1, 0); G_STAGE(G_SA(0, 1), a2 + hstep);
      G_WAIT_L(8); G_BAR; G_WAIT_L(0); G_MMA(0, 0, At, B0); G_BAR; G_SCHED;
      G_LDB(B1, 1, 1); G_STAGE(G_SB(1, 0), b3);
      G_BAR; G_WAIT_L(0); G_MMA(0, 1, At, B1); G_BAR;
      G_LDA(At, 1, 1); G_STAGE(G_SA(1, 0), a3);
      G_BAR; G_WAIT_L(0); G_MMA(1, 0, At, B0); G_BAR; G_SCHED;
      G_STAGE(G_SB(1, 1), b3 + hstep);
      G_WAIT_V(6); G_BAR; G_MMA(1, 1, At, B1); G_BAR;
    }
    asm volatile("s_nop 15\n\ts_nop 15" ::: "memory");
    E(acc, cpm, cpn, wr, wc, fr, fq, lds);
    if (!has_next) break;
#pragma unroll
    for (int a = 0; a < 2; ++a)
#pragma unroll
      for (int b = 0; b < 2; ++b)
#pragma unroll
        for (int m = 0; m < 4; ++m)
#pragma unroll
          for (int n = 0; n < 2; ++n) acc[a][b][m][n] = (f32x4){0.f, 0.f, 0.f, 0.f};
    cpm = npm; cpn = npn; cA = nA; cB = nB; ++ui;
  }
  G_WAIT_V(0);
  if (wr == 0) G_BAR;
  G_BAR;
}

struct EpiZ {
  bf16_t* Z;
  __device__ __forceinline__ void operator()(f32x4 (&acc)[2][2][4][2], int pm, int pn, int wr, int wc, int fr, int fq, LAS unsigned char*) const {
    const int row0 = pm * BM + wr * 64 + fr, col0 = pn * BM + wc * 32 + 4 * fq;
#pragma unroll
    for (int ai = 0; ai < 2; ++ai)
#pragma unroll
      for (int m = 0; m < 4; ++m) {
        bf16_t* rowp = Z + (size_t)(row0 + ai * HALF + m * 16) * NZ + col0;
#pragma unroll
        for (int bj = 0; bj < 2; ++bj)
#pragma unroll
          for (int n = 0; n < 2; ++n) { const f32x4 v = acc[ai][bj][m][n]; u32x2 o; o.x = cvt_pk_bf16(v[0], v[1]); o.y = cvt_pk_bf16(v[2], v[3]); *(u32x2*)(rowp + bj * HALF + n * 16) = o; }
      }
  }
};

struct EpiX1 {
  const float* xp; const float* xs; const float* mod; const float* norm2; float* x1out; bf16_t* x1g; float* rowss;
  __device__ __forceinline__ void operator()(f32x4 (&acc)[2][2][4][2], int pm, int pn, int wr, int wc, int fr, int fq, LAS unsigned char*) const {
    const int g = pm < 16 ? 4 : ((pm - 16) >> 4);
    const float* modg = mod + g * NMOD;
    const int col0 = pn * BM + wc * 32 + 4 * fq;
    f32x4 g1[2][2], g2[2][2];
#pragma unroll
    for (int bj = 0; bj < 2; ++bj)
#pragma unroll
      for (int n = 0; n < 2; ++n) { const int c = col0 + bj * HALF + n * 16; g1[bj][n] = *(const f32x4*)(modg + 2048 + c); const f32x4 s2 = *(const f32x4*)(modg + 4096 + c); const f32x4 nv = *(const f32x4*)(norm2 + c); g2[bj][n] = nv * (s2 + 1.0f); }
#pragma unroll
    for (int ai = 0; ai < 2; ++ai)
#pragma unroll
      for (int m = 0; m < 4; ++m) {
        const int T = pm * BM + ai * HALF + wr * 64 + m * 16 + fr;
        const float* xrow = (T < NCTXT) ? xp + (size_t)T * DM : xs + (size_t)(T - NCTXT) * DM;
        const int p = permtok(T);
        float ss = 0.f;
#pragma unroll
        for (int bj = 0; bj < 2; ++bj)
#pragma unroll
          for (int n = 0; n < 2; ++n) {
            const int c = col0 + bj * HALF + n * 16;
            const f32x4 xv = *(const f32x4*)(xrow + c);
            const f32x4 v = xv + g1[bj][n] * acc[ai][bj][m][n];
            *(f32x4*)(x1out + (size_t)T * DM + c) = v;
            ss += v[0] * v[0] + v[1] * v[1] + v[2] * v[2] + v[3] * v[3];
            const f32x4 w = v * g2[bj][n];
            u32x2 o; o.x = cvt_pk_bf16(w[0], w[1]); o.y = cvt_pk_bf16(w[2], w[3]);
            *(u32x2*)(x1g + (size_t)p * DM + c) = o;
          }
        ss += __shfl_xor(ss, 16); ss += __shfl_xor(ss, 32);
        if (fq == 0) __hip_atomic_fetch_add(rowss + p, ss, __ATOMIC_RELAXED, __HIP_MEMORY_SCOPE_AGENT);
      }
  }
};

struct EpiDown {
  const float* mod; float* out; float* rowss2;
  __device__ __forceinline__ void operator()(f32x4 (&acc)[2][2][4][2], int pm, int pn, int wr, int wc, int fr, int fq, LAS unsigned char*) const {
    const int g = pm < 16 ? 4 : ((pm - 16) >> 4);
    const float* modg = mod + g * NMOD;
    const int col0 = pn * BM + wc * 32 + 4 * fq;
    f32x4 g2[2][2];
#pragma unroll
    for (int bj = 0; bj < 2; ++bj)
#pragma unroll
      for (int n = 0; n < 2; ++n) g2[bj][n] = *(const f32x4*)(modg + 5120 + col0 + bj * HALF + n * 16);
#pragma unroll
    for (int ai = 0; ai < 2; ++ai)
#pragma unroll
      for (int m = 0; m < 4; ++m) {
        const int p = pm * BM + ai * HALF + wr * 64 + m * 16 + fr;
        const int T = permtok(p);
        float* orow = out + (size_t)T * DM;
        float ss = 0.f;
#pragma unroll
        for (int bj = 0; bj < 2; ++bj)
#pragma unroll
          for (int n = 0; n < 2; ++n) {
            const int c = col0 + bj * HALF + n * 16;
            const f32x4 xv = *(const f32x4*)(orow + c);
            const f32x4 v = xv + g2[bj][n] * acc[ai][bj][m][n];
            *(f32x4*)(orow + c) = v;
            ss += v[0] * v[0] + v[1] * v[1] + v[2] * v[2] + v[3] * v[3];
          }
        ss += __shfl_xor(ss, 16); ss += __shfl_xor(ss, 32);
        if (fq == 0) __hip_atomic_fetch_add(rowss2 + T, ss, __ATOMIC_RELAXED, __HIP_MEMORY_SCOPE_AGENT);
      }
  }
};

struct EpiUp {
  const float* rowss1; const float* sb; const float* cw; const float* cb; bf16_t* act;
  __device__ __forceinline__ void operator()(f32x4 (&acc)[2][2][4][2], int pm, int pn, int wr, int wc, int fr, int fq, LAS unsigned char* lds) const {
    asm volatile("" : "+v"(fr), "+v"(fq));
    const bool ctx = pm < 16;
    const int g = ctx ? 4 : ((pm - 16) >> 4);
    const float* sbg = sb + g * NUP;
    LAS float* halo = (LAS float*)(lds + 131072);
    const int prow0 = pm * BM + wr * 64 + fr;
    {
      float rs[2][4];
#pragma unroll
      for (int ai = 0; ai < 2; ++ai)
#pragma unroll
        for (int m = 0; m < 4; ++m) rs[ai][m] = __builtin_amdgcn_rsqf(rowss1[prow0 + ai * HALF + m * 16] * (1.0f / 1024.0f) + EPS);
#pragma unroll
      for (int bj = 0; bj < 2; ++bj)
#pragma unroll
        for (int n = 0; n < 2; ++n) {
          asm volatile("" ::: "memory"); __builtin_amdgcn_sched_barrier(0);
          const f32x4 sv = *(const f32x4*)(sbg + bj * DFF + pn * HALF + wc * 32 + n * 16 + 4 * fq);
#pragma unroll
          for (int ai = 0; ai < 2; ++ai)
#pragma unroll
            for (int m = 0; m < 4; ++m) { acc[ai][bj][m][n] = acc[ai][bj][m][n] * rs[ai][m] + sv; asm volatile("" : "+v"(acc[ai][bj][m][n])); }
        }
    }
    if (ctx) {
#pragma unroll
      for (int ai = 0; ai < 2; ++ai)
#pragma unroll
        for (int bj = 0; bj < 2; ++bj)
#pragma unroll
          for (int n = 0; n < 2; ++n) {
            const int rb = 2 * ai + wr, colt = bj * HALF + wc * 32 + n * 16 + 4 * fq;
            if (fr == 0) *(LAS f32x4*)(halo + (rb * 2 + 0) * 256 + colt) = acc[ai][bj][0][n];
            if (fr == 15) *(LAS f32x4*)(halo + (rb * 2 + 1) * 256 + colt) = acc[ai][bj][3][n];
          }
      asm volatile("s_waitcnt lgkmcnt(0)" ::: "memory");
      __builtin_amdgcn_s_barrier();
      __builtin_amdgcn_s_barrier();
      asm volatile("" ::: "memory");
    }
#pragma unroll
    for (int n = 0; n < 2; ++n)
#pragma unroll
      for (int ai = 0; ai < 2; ++ai) {
        f32x4 ya[4];
        const int rb = 2 * ai + wr;
#pragma unroll
        for (int bj = 0; bj < 2; ++bj) {
          asm volatile("" ::: "memory"); __builtin_amdgcn_sched_barrier(0);
          const int cnat = bj * DFF + pn * HALF + wc * 32 + n * 16 + 4 * fq, colt = bj * HALF + wc * 32 + n * 16 + 4 * fq;
          const f32x4 w0 = *(const f32x4*)(cw + cnat), w1 = *(const f32x4*)(cw + NUP + cnat), w2 = *(const f32x4*)(cw + 2 * NUP + cnat), bb = *(const f32x4*)(cb + cnat);
          f32x4 hp = (f32x4){0.f, 0.f, 0.f, 0.f}, hn = hp;
          if (ctx) {
            if (rb > 0) hp = *(const LAS f32x4*)(halo + ((rb - 1) * 2 + 1) * 256 + colt);
            if (rb < 3) hn = *(const LAS f32x4*)(halo + ((rb + 1) * 2 + 0) * 256 + colt);
          }
#pragma unroll
          for (int m = 0; m < 4; ++m) {
            const f32x4 cur = acc[ai][bj][m][n];
            f32x4 prev, next;
#pragma unroll
            for (int e = 0; e < 4; ++e) {
              if (m > 0) { const float snd = (fr == 15) ? acc[ai][bj][m > 0 ? m - 1 : 0][n][e] : cur[e]; prev[e] = dppf<0x121>(snd); }
              else { const float rcv = dppf<0x121>(cur[e]); prev[e] = (fr == 0) ? hp[e] : rcv; }
              if (m < 3) { const float snd = (fr == 0) ? acc[ai][bj][m < 3 ? m + 1 : 3][n][e] : cur[e]; next[e] = dppf<0x12F>(snd); }
              else { const float rcv = dppf<0x12F>(cur[e]); next[e] = (fr == 15) ? hn[e] : rcv; }
            }
            const f32x4 y = w0 * prev + w1 * cur + w2 * next + bb;
            if (bj == 0) ya[m] = y;
            else {
              float o[4];
#pragma unroll
              for (int e = 0; e < 4; ++e) o[e] = y[e] * fast_sigmoid(y[e]) * ya[m][e];
              u32x2 ov; ov.x = cvt_pk_bf16(o[0], o[1]); ov.y = cvt_pk_bf16(o[2], o[3]);
              *(u32x2*)(act + (size_t)(prow0 + ai * HALF + m * 16) * DFF + pn * HALF + wc * 32 + n * 16 + 4 * fq) = ov;
            }
          }
        }
      }
  }
};

template <bool SILU>
__device__ __forceinline__ void gemv5_unit(const Params& P, int unit, int ncb, const float* W, int ldw, float* outp, int ldo, const float* bias, const float* modv, float* sm) {
  const int tid = threadIdx.x;
  const int cb = unit % ncb, ks = unit / ncb, n0 = cb * 256, k0 = ks * 128;
  float* sv = sm; float* red = sm + 640;
  for (int i = tid; i < 640; i += 512) {
    const int g = i >> 7, k = k0 + (i & 127);
    float v;
    if (SILU) { v = (g < 4) ? P.c[g * DM + k] : P.c_ctx[k]; v = v / (1.0f + __expf(-v)); }
    else v = modv[g * NMOD + 3072 + k];
    sv[i] = v;
  }
  __syncthreads();
  const int col = tid & 255, kh = tid >> 8;
  float a0 = 0.f, a1 = 0.f, a2 = 0.f, a3 = 0.f, a4 = 0.f;
  const float* wp = W + (size_t)(k0 + kh * 64) * ldw + n0 + col;
#pragma unroll 8
  for (int kk = 0; kk < 64; ++kk) {
    const float w = wp[(size_t)kk * ldw];
    const int ki = kh * 64 + kk;
    a0 += sv[ki] * w; a1 += sv[128 + ki] * w; a2 += sv[256 + ki] * w; a3 += sv[384 + ki] * w; a4 += sv[512 + ki] * w;
  }
  if (kh == 1) { red[col] = a0; red[256 + col] = a1; red[512 + col] = a2; red[768 + col] = a3; red[1024 + col] = a4; }
  __syncthreads();
  if (kh == 0) {
    const float bv = (bias != nullptr && ks == 0) ? bias[n0 + col] : 0.f;
    a0 += red[col] + bv; a1 += red[256 + col] + bv; a2 += red[512 + col] + bv; a3 += red[768 + col] + bv; a4 += red[1024 + col] + bv;
    float* o = outp + n0 + col;
    __hip_atomic_fetch_add(o, a0, __ATOMIC_RELAXED, __HIP_MEMORY_SCOPE_AGENT);
    __hip_atomic_fetch_add(o + ldo, a1, __ATOMIC_RELAXED, __HIP_MEMORY_SCOPE_AGENT);
    __hip_atomic_fetch_add(o + 2 * ldo, a2, __ATOMIC_RELAXED, __HIP_MEMORY_SCOPE_AGENT);
    __hip_atomic_fetch_add(o + 3 * ldo, a3, __ATOMIC_RELAXED, __HIP_MEMORY_SCOPE_AGENT);
    __hip_atomic_fetch_add(o + 4 * ldo, a4, __ATOMIC_RELAXED, __HIP_MEMORY_SCOPE_AGENT);
  }
  __syncthreads();
}

__device__ __forceinline__ void transpose_unit(const float* W, int ldw, int k0, int n0, bf16_t* dst, int ldd, int drow0, float* tile) {
  const int tid = threadIdx.x;
  { const int r = tid >> 4, c4 = (tid & 15) * 4;
#pragma unroll
    for (int i = 0; i < 2; ++i) { const f32x4 v = *(const f32x4*)(W + (size_t)(k0 + r + 32 * i) * ldw + n0 + c4); float* t = tile + (r + 32 * i) * 65 + c4; t[0] = v[0]; t[1] = v[1]; t[2] = v[2]; t[3] = v[3]; } }
  __syncthreads();
  { const int nn = tid >> 3, kk8 = (tid & 7) * 8; float v[8];
#pragma unroll
    for (int j = 0; j < 8; ++j) v[j] = tile[(kk8 + j) * 65 + nn];
    u32x4 o; o.x = cvt_pk_bf16(v[0], v[1]); o.y = cvt_pk_bf16(v[2], v[3]); o.z = cvt_pk_bf16(v[4], v[5]); o.w = cvt_pk_bf16(v[6], v[7]);
    *(u32x4*)(dst + (size_t)(drow0 + nn) * ldd + k0 + kk8) = o; }
  __syncthreads();
}

__device__ void phase0a(const Params& P, float* sm) {
  float* mod = (float*)(P.ws + WS_MOD);
  bf16_t* WinT = (bf16_t*)(P.ws + WS_WIN); bf16_t* WoutT = (bf16_t*)(P.ws + WS_WOUT); bf16_t* WupT = (bf16_t*)(P.ws + WS_WUP); bf16_t* WdnT = (bf16_t*)(P.ws + WS_WDN);
  constexpr int NG = 24 * 8, N1 = NG + 896, N2 = N1 + 256, N3 = N2 + 1408, N4 = N3 + 704;
  for (int u = blockIdx.x; u < N4; u += gridDim.x) {
    if (u < NG) gemv5_unit<true>(P, u, 24, P.w_mod, NMOD, mod, NMOD, P.b_mod, nullptr, sm);
    else if (u < N1) { const int v = u - NG, kt = v / 56, ntl = v % 56; transpose_unit(P.w_in, DIN, kt * 64, ntl * 64, WinT, DM, ntl * 64, sm); }
    else if (u < N2) { const int v = u - N1, kt = v >> 4, ntl = v & 15; transpose_unit(P.w_out, DM, kt * 64, ntl * 64, WoutT, DM, ntl * 64, sm); }
    else if (u < N3) { const int v = u - N2, kt = v / 88, ntl = v % 88; const int n0 = ntl * 64, half = n0 / DFF, r = n0 % DFF, pn = r >> 7, cc = r & 127;
      transpose_unit(P.w_up, NUP, kt * 64, n0, WupT, DM, pn * 256 + half * 128 + cc, sm); }
    else { const int v = u - N3, kt = v >> 4, ntl = v & 15; transpose_unit(P.w_down, DM, kt * 64, ntl * 64, WdnT, DFF, ntl * 64, sm); }
  }
}

__device__ void phase0b(const Params& P, float* sm) {
  const int tid = threadIdx.x, wid = tid >> 6, lane = tid & 63;
  const float* mod = (const float*)(P.ws + WS_MOD);
  float* sbv = (float*)(P.ws + WS_SB);
  float* gates = (float*)(P.ws + WS_GATES);
  bf16_t* H = (bf16_t*)(P.ws + WS_H);
  for (int u = blockIdx.x; u < 22 * 8; u += gridDim.x) gemv5_unit<false>(P, u, 22, P.w_up, NUP, sbv, NUP, nullptr, mod, sm + 16384);
  for (int idx = tid; idx < 16384; idx += 512) { const int k = idx >> 4, g = idx & 15; sm[g * 1024 + k] = P.w_in[(size_t)k * DIN + NZ + g]; }
  __syncthreads();
  for (int T = blockIdx.x * 8 + wid; T < NTOK; T += gridDim.x * 8) {
    const int g = T < NCTXT ? 4 : ((T - NCTXT) >> 12);
    const float* xrow = (T < NCTXT) ? P.x_prompt + (size_t)T * DM : P.x_sample + (size_t)(T - NCTXT) * DM;
    const float* modg = mod + g * NMOD;
    f32x4 xv[4]; float ss = 0.f;
#pragma unroll
    for (int i = 0; i < 4; ++i) { xv[i] = *(const f32x4*)(xrow + i * 256 + lane * 4); ss += xv[i][0] * xv[i][0] + xv[i][1] * xv[i][1] + xv[i][2] * xv[i][2] + xv[i][3] * xv[i][3]; }
#pragma unroll
    for (int o = 1; o < 64; o <<= 1) ss += __shfl_xor(ss, o);
    const float rstd = rsqrtf(ss * (1.0f / 1024.0f) + EPS);
    f32x4 hv[4];
#pragma unroll
    for (int i = 0; i < 4; ++i) {
      const int c = i * 256 + lane * 4;
      const f32x4 nv = *(const f32x4*)(P.norm1 + c), sc = *(const f32x4*)(modg + 1024 + c), sh = *(const f32x4*)(modg + c);
      hv[i] = xv[i] * rstd * nv * (sc + 1.0f) + sh;
      u32x2 o; o.x = cvt_pk_bf16(hv[i][0], hv[i][1]); o.y = cvt_pk_bf16(hv[i][2], hv[i][3]);
      *(u32x2*)(H + (size_t)T * DM + c) = o;
    }
    float v[16];
#pragma unroll
    for (int gi = 0; gi < 16; ++gi) {
      float a = 0.f;
#pragma unroll
      for (int i = 0; i < 4; ++i) { const f32x4 w = *(const f32x4*)(sm + gi * 1024 + i * 256 + lane * 4); a += hv[i][0] * w[0] + hv[i][1] * w[1] + hv[i][2] * w[2] + hv[i][3] * w[3]; }
      v[gi] = a;
    }
#pragma unroll
    for (int j = 0; j < 8; ++j) { const bool hi = lane & 32; const float keep = hi ? v[j + 8] : v[j], send = hi ? v[j] : v[j + 8]; v[j] = keep + __shfl_xor(send, 32); }
#pragma unroll
    for (int j = 0; j < 4; ++j) { const bool hi = lane & 16; const float keep = hi ? v[j + 4] : v[j], send = hi ? v[j] : v[j + 4]; v[j] = keep + __shfl_xor(send, 16); }
#pragma unroll
    for (int j = 0; j < 2; ++j) { const bool hi = lane & 8; const float keep = hi ? v[j + 2] : v[j], send = hi ? v[j] : v[j + 2]; v[j] = keep + __shfl_xor(send, 8); }
    { const bool hi = lane & 4; const float keep = hi ? v[1] : v[0], send = hi ? v[0] : v[1]; v[0] = keep + __shfl_xor(send, 4); }
    v[0] += __shfl_xor(v[0], 2); v[0] += __shfl_xor(v[0], 1);
    if ((lane & 3) == 0) {
      const int gi = ((lane >> 5) & 1) * 8 + ((lane >> 4) & 1) * 4 + ((lane >> 3) & 1) * 2 + ((lane >> 2) & 1);
      float val = v[0] + P.b_gate[gi];
      if ((gi >> 2) & 1) val = fminf(val, 0.f) - log1pf(__expf(-fabsf(val)));
      gates[(size_t)T * 16 + gi] = val;
    }
  }
  __syncthreads();
}

__device__ __forceinline__ void unit_info(int u, int& T0, int& nc, int& b, int& h, int& c) {
  if (u < 128) { nc = 2; b = u >> 3; h = (u >> 1) & 3; c = u & 1; T0 = b * 256 + c * 128; }
  else { const int v = u - 128; nc = 32; b = v >> 7; h = (v >> 5) & 3; c = v & 31; T0 = NCTXT + b * 4096 + c * 128; }
}
struct ScanOut { float beta0, beta1, cf0, cf1, pm0, pm1, bl, cmax; int t0, t1; };
__device__ __forceinline__ void chunk_scan(const float* gates, int T0, int h, int d, int lane, ScanOut& o) {
  const int t0 = d ? 127 - 2 * lane : 2 * lane, t1 = d ? t0 - 1 : t0 + 1;
  const float* g0 = gates + (size_t)(T0 + t0) * 16 + d * 8 + h; const float* g1 = gates + (size_t)(T0 + t1) * 16 + d * 8 + h;
  const float i0 = g0[0], f0 = g0[4], i1 = g1[0], f1 = g1[4];
  const float s = f0 + f1;
  float x = s;
#pragma unroll
  for (int off = 1; off < 64; off <<= 1) { const float y = __shfl_up(x, off); if (lane >= off) x += y; }
  const float excl = x - s;
  o.beta0 = excl + f0; o.beta1 = x;
  o.cf0 = i0 - o.beta0; o.cf1 = i1 - o.beta1;
  float mx = fmaxf(o.cf0, o.cf1);
#pragma unroll
  for (int off = 1; off < 64; off <<= 1) { const float y = __shfl_up(mx, off); if (lane >= off) mx = fmaxf(mx, y); }
  const float mex = __shfl_up(mx, 1);
  o.pm0 = lane ? fmaxf(mex, o.cf0) : o.cf0; o.pm1 = mx;
  o.bl = __shfl(x, 63); o.cmax = __shfl(mx, 63);
  o.t0 = t0; o.t1 = t1;
}

constexpr int LROW = 136;
constexpr int CST_ELEMS = 129 * 128;

__device__ void shortconv_items(const Params& P) {
  const bf16_t* Z = (const bf16_t*)(P.ws + WS_Z);
  bf16_t* ucat = (bf16_t*)(P.ws + WS_UCAT);
  for (int idx = blockIdx.x * 512 + threadIdx.x; idx < NTOK * 64; idx += gridDim.x * 512) {
    const int T = idx >> 6, cgp = (idx & 63) * 8;
    bool hasp, hasn;
    if (T < NCTXT) { const int pos = T & 255; hasp = pos != 0; hasn = pos != 255; } else { const int pos = (T - NCTXT) & 63; hasp = pos != 0; hasn = pos != 63; }
    const bf16_t* zr = Z + (size_t)T * NZ + cgp;
    const u32x4 sbq = *(const u32x4*)(zr);
    const u32x4 c1 = *(const u32x4*)(zr + 512), x1 = *(const u32x4*)(zr + 1024);
    u32x4 c0 = (u32x4){0, 0, 0, 0}, x0 = c0, c2 = c0, x2 = c0;
    if (hasp) { c0 = *(const u32x4*)(zr - NZ + 512); x0 = *(const u32x4*)(zr - NZ + 1024); }
    if (hasn) { c2 = *(const u32x4*)(zr + NZ + 512); x2 = *(const u32x4*)(zr + NZ + 1024); }
    float w0[8], w1[8], w2[8], bb[8];
#pragma unroll
    for (int q = 0; q < 2; ++q) {
      const f32x4 a = *(const f32x4*)(P.conv_sc_w + cgp + q * 4), b = *(const f32x4*)(P.conv_sc_w + 512 + cgp + q * 4), cc = *(const f32x4*)(P.conv_sc_w + 1024 + cgp + q * 4), d = *(const f32x4*)(P.conv_sc_b + cgp + q * 4);
#pragma unroll
      for (int e = 0; e < 4; ++e) { w0[q * 4 + e] = a[e]; w1[q * 4 + e] = b[e]; w2[q * 4 + e] = cc[e]; bb[q * 4 + e] = d[e]; }
    }
    float o[8];
#pragma unroll
    for (int q = 0; q < 4; ++q) {
      const float up0 = bflo(c0[q]) * bflo(x0[q]), up1 = bfhi(c0[q]) * bfhi(x0[q]);
      const float uc0 = bflo(c1[q]) * bflo(x1[q]), uc1 = bfhi(c1[q]) * bfhi(x1[q]);
      const float un0 = bflo(c2[q]) * bflo(x2[q]), un1 = bfhi(c2[q]) * bfhi(x2[q]);
      o[2 * q] = bflo(sbq[q]) * (w0[2 * q] * up0 + w1[2 * q] * uc0 + w2[2 * q] * un0 + bb[2 * q]);
      o[2 * q + 1] = bfhi(sbq[q]) * (w0[2 * q + 1] * up1 + w1[2 * q + 1] * uc1 + w2[2 * q + 1] * un1 + bb[2 * q + 1]);
    }
    u32x4 ov; ov.x = cvt_pk_bf16(o[0], o[1]); ov.y = cvt_pk_bf16(o[2], o[3]); ov.z = cvt_pk_bf16(o[4], o[5]); ov.w = cvt_pk_bf16(o[6], o[7]);
    *(u32x4*)(ucat + (size_t)T * DM + cgp) = ov;
  }
}

__device__ void phaseM1(const Params& P, LAS unsigned char* lds) {
  const int tid = threadIdx.x, wid = tid >> 6, lane = tid & 63, fr = lane & 15, fq = lane >> 4;
  const bf16_t* Z = (const bf16_t*)(P.ws + WS_Z);
  const float* gates = (const float*)(P.ws + WS_GATES);
  float* stat = (float*)(P.ws + WS_STAT);
  bf16_t* dC = (bf16_t*)P.out;
  LAS bf16_t* KT = (LAS bf16_t*)lds;
  LAS bf16_t* VT0 = (LAS bf16_t*)(lds + 34816);
  LAS bf16_t* VT1 = (LAS bf16_t*)(lds + 34816 + 36992);
  LAS float* ecs = (LAS float*)(lds + 34816 + 2 * 36992 + 4096);
  for (int u = blockIdx.x; u < 640; u += gridDim.x) {
    int T0, nc, b, h, c; unit_info(u, T0, nc, b, h, c);
    if (wid < 2) {
      ScanOut so; chunk_scan(gates, T0, h, wid, lane, so);
      ecs[wid * 128 + so.t0] = __expf(so.cf0 - so.cmax); ecs[wid * 128 + so.t1] = __expf(so.cf1 - so.cmax);
      if (lane == 0) { stat[(u * 2 + wid) * 2] = so.bl; stat[(u * 2 + wid) * 2 + 1] = so.cmax; }
    }
    __syncthreads();
    {
      const int kg = tid & 15;
#pragma unroll
      for (int i = 0; i < 2; ++i) {
        const int s = 2 * ((tid >> 4) + 32 * i);
        const bf16_t* zr = Z + (size_t)(T0 + s) * NZ + h * 128 + kg * 8;
        const u32x4 ka = *(const u32x4*)(zr + 2048), va = *(const u32x4*)(zr + 2560);
        const u32x4 kb = *(const u32x4*)(zr + NZ + 2048), vb = *(const u32x4*)(zr + NZ + 2560);
        const float e0a = ecs[s], e0b = ecs[s + 1], e1a = ecs[128 + s], e1b = ecs[128 + s + 1];
#pragma unroll
        for (int q = 0; q < 4; ++q) {
          const int r0 = (kg * 8 + 2 * q) * LROW + s, r1 = r0 + LROW;
          *(LAS unsigned*)(KT + r0) = (ka[q] & 0xffffu) | (kb[q] << 16);
          *(LAS unsigned*)(KT + r1) = (ka[q] >> 16) | (kb[q] & 0xffff0000u);
          const float al = bflo(va[q]), ah = bfhi(va[q]), bl_ = bflo(vb[q]), bh = bfhi(vb[q]);
          *(LAS unsigned*)(VT0 + r0) = cvt_pk_bf16_c(al * e0a, bl_ * e0b);
          *(LAS unsigned*)(VT0 + r1) = cvt_pk_bf16_c(ah * e0a, bh * e0b);
          *(LAS unsigned*)(VT1 + r0) = cvt_pk_bf16_c(al * e1a, bl_ * e1b);
          *(LAS unsigned*)(VT1 + r1) = cvt_pk_bf16_c(ah * e1a, bh * e1b);
        }
      }
      if (tid < 64) { *(LAS unsigned*)(VT0 + 128 * LROW + 2 * tid) = cvt_pk_bf16_c(ecs[2 * tid], ecs[2 * tid + 1]); *(LAS unsigned*)(VT1 + 128 * LROW + 2 * tid) = cvt_pk_bf16_c(ecs[128 + 2 * tid], ecs[128 + 2 * tid + 1]); }
    }
    __syncthreads();
    {
      bf16x8 Kf[4];
#pragma unroll
      for (int ks = 0; ks < 4; ++ks) Kf[ks] = *(const LAS bf16x8*)(KT + (16 * wid + fr) * LROW + 32 * ks + 8 * fq);
#pragma unroll
      for (int d = 0; d < 2; ++d) {
        LAS bf16_t* VT = d ? VT1 : VT0;
        bf16_t* dst = dC + (size_t)(u * 2 + d) * CST_ELEMS;
#pragma unroll
        for (int mt = 0; mt < 9; ++mt) {
          f32x4 a = (f32x4){0.f, 0.f, 0.f, 0.f};
#pragma unroll
          for (int ks = 0; ks < 4; ++ks) { const bf16x8 Vf = *(const LAS bf16x8*)(VT + (16 * mt + fr) * LROW + 32 * ks + 8 * fq); a = __builtin_amdgcn_mfma_f32_16x16x32_bf16(Kf[ks], Vf, a, 0, 0, 0); }
          if (mt < 8 || fr == 0) { u32x2 o; o.x = cvt_pk_bf16_c(a[0], a[1]); o.y = cvt_pk_bf16_c(a[2], a[3]); *(u32x2*)(dst + (16 * mt + fr) * 128 + 16 * wid + 4 * fq) = o; }
        }
      }
    }
    __syncthreads();
  }
}

__device__ void phaseM2(const Params& P) {
  const int tid = threadIdx.x;
  const bf16_t* dC = (const bf16_t*)P.out;
  bf16_t* Cst = (bf16_t*)(P.ws + WS_H);
  const float* stat = (const float*)(P.ws + WS_STAT);
  float* mst = (float*)(P.ws + WS_MST);
  for (int unit = blockIdx.x; unit < 1280; unit += gridDim.x) {
    const bool lat = unit < 256;
    const int v = lat ? unit : unit - 256;
    const int sq = v >> 3, slice = v & 7;
    const int b = sq >> 3, h = (sq >> 1) & 3, d = sq & 1;
    const int nc = lat ? 32 : 2;
    const int ubase = lat ? 128 + (b * 4 + h) * 32 : (b * 4 + h) * 2;
    const int e = slice * 2048 + tid * 4;
    const bool hasn = (slice == 0) && (tid < 32);
    const int kn = tid * 4;
    f32x4 C4 = (f32x4){0.f, 0.f, 0.f, 0.f}, n4 = C4; float m = 0.f;
    if (lat) {
      const int sidx = (b * 2 + d) * 4 + h;
      C4 = *(const f32x4*)(P.state_C + (size_t)sidx * 16384 + e);
      if (hasn) n4 = *(const f32x4*)(P.state_n + sidx * 128 + kn);
      m = P.state_m[sidx];
    }
    for (int j = 0; j < nc; ++j) {
      const int c = d ? nc - 1 - j : j;
      const int idx = (ubase + c) * 2 + d;
      bf16_t* cs = Cst + (size_t)idx * CST_ELEMS;
      { u32x2 o; o.x = cvt_pk_bf16(C4[0], C4[1]); o.y = cvt_pk_bf16(C4[2], C4[3]); *(u32x2*)(cs + e) = o; }
      if (hasn) { u32x2 o; o.x = cvt_pk_bf16(n4[0], n4[1]); o.y = cvt_pk_bf16(n4[2], n4[3]); *(u32x2*)(cs + 16384 + kn) = o; }
      if (slice == 0 && tid == 0) mst[idx] = m;
      const float bl = stat[idx * 2], cmax = stat[idx * 2 + 1];
      const float mn = bl + fmaxf(m, cmax);
      const float decay = __expf(bl + m - mn), scale = __expf(bl + cmax - mn);
      const bf16_t* dp = dC + (size_t)idx * CST_ELEMS;
      const u32x2 dv = *(const u32x2*)(dp + e);
      C4[0] = decay * C4[0] + scale * bflo(dv.x); C4[1] = decay * C4[1] + scale * bfhi(dv.x); C4[2] = decay * C4[2] + scale * bflo(dv.y); C4[3] = decay * C4[3] + scale * bfhi(dv.y);
      if (hasn) { const u32x2 nv = *(const u32x2*)(dp + 16384 + kn);
        n4[0] = decay * n4[0] + scale * bflo(nv.x); n4[1] = decay * n4[1] + scale * bfhi(nv.x); n4[2] = decay * n4[2] + scale * bflo(nv.y); n4[3] = decay * n4[3] + scale * bfhi(nv.y); }
      m = mn;
    }
    if (!lat) {
      const int sidx = (b * 2 + d) * 4 + h;
      *(f32x4*)(P.out + OUT_TAIL + (size_t)sidx * 16384 + e) = C4;
      if (hasn) *(f32x4*)(P.out + OUT_TAIL + 2097152 + sidx * 128 + kn) = n4;
      if (slice == 0 && tid == 0) P.out[OUT_TAIL + 2097152 + 16384 + sidx] = m;
    }
  }
}

__device__ __forceinline__ bf16x8 scale_frag(bf16x8 q, float s) {
  const u32x4 a = __builtin_bit_cast(u32x4, q); u32x4 r;
  r.x = cvt_pk_bf16_c(bflo(a.x) * s, bfhi(a.x) * s); r.y = cvt_pk_bf16_c(bflo(a.y) * s, bfhi(a.y) * s);
  r.z = cvt_pk_bf16_c(bflo(a.z) * s, bfhi(a.z) * s); r.w = cvt_pk_bf16_c(bflo(a.w) * s, bfhi(a.w) * s);
  return __builtin_bit_cast(bf16x8, r);
}

__device__ void phaseM3(const Params& P, LAS unsigned char* lds) {
  const int tid = threadIdx.x, wid = tid >> 6, lane = tid & 63, fr = lane & 15, fq = lane >> 4;
  const bf16_t* Z = (const bf16_t*)(P.ws + WS_Z);
  const float* gates = (const float*)(P.ws + WS_GATES);
  const bf16_t* Cst = (const bf16_t*)(P.ws + WS_H);
  const float* mst = (const float*)(P.ws + WS_MST);
  bf16_t* ucat = (bf16_t*)(P.ws + WS_UCAT);
  LAS bf16_t* Ks = (LAS bf16_t*)lds;
  LAS bf16_t* VT = (LAS bf16_t*)(lds + 34816);
  LAS bf16_t* Sb = (LAS bf16_t*)(lds + 34816 + 36992);
  LAS float* arr = (LAS float*)(lds + 34816 + 36992 + 34816);
  LAS float* ecA = arr; LAS float* erA = arr + 256; LAS float* wiA = arr + 512; LAS float* flA = arr + 768;
  const float qs = 0.08838834764831845f;
  for (int u = blockIdx.x; u < 640; u += gridDim.x) {
    int T0, nc, b, h, c; unit_info(u, T0, nc, b, h, c);
    if (wid < 2) {
      const int d = wid;
      ScanOut so; chunk_scan(gates, T0, h, d, lane, so);
      const float mc = mst[u * 2 + d];
      const float mx0 = fmaxf(mc, so.pm0), mx1 = fmaxf(mc, so.pm1);
      ecA[d * 128 + so.t0] = __expf(so.cf0 - so.cmax); ecA[d * 128 + so.t1] = __expf(so.cf1 - so.cmax);
      erA[d * 128 + so.t0] = __expf(so.cmax - mx0) * qs; erA[d * 128 + so.t1] = __expf(so.cmax - mx1) * qs;
      wiA[d * 128 + so.t0] = __expf(mc - mx0) * qs; wiA[d * 128 + so.t1] = __expf(mc - mx1) * qs;
      flA[d * 128 + so.t0] = __expf(-(so.beta0 + mx0)); flA[d * 128 + so.t1] = __expf(-(so.beta1 + mx1));
    }
    {
      const int kg = tid & 15;
#pragma unroll
      for (int i = 0; i < 2; ++i) {
        const int s = 2 * ((tid >> 4) + 32 * i);
        const bf16_t* zr = Z + (size_t)(T0 + s) * NZ + h * 128 + kg * 8;
        const u32x4 ka = *(const u32x4*)(zr + 2048), va = *(const u32x4*)(zr + 2560);
        const u32x4 kb = *(const u32x4*)(zr + NZ + 2048), vb = *(const u32x4*)(zr + NZ + 2560);
        *(LAS u32x4*)(Ks + s * LROW + kg * 8) = ka;
        *(LAS u32x4*)(Ks + (s + 1) * LROW + kg * 8) = kb;
#pragma unroll
        for (int q = 0; q < 4; ++q) {
          const int r0 = (kg * 8 + 2 * q) * LROW + s, r1 = r0 + LROW;
          *(LAS unsigned*)(VT + r0) = (va[q] & 0xffffu) | (vb[q] << 16);
          *(LAS unsigned*)(VT + r1) = (va[q] >> 16) | (vb[q] & 0xffff0000u);
        }
      }
      if (tid < 64) *(LAS unsigned*)(VT + 128 * LROW + 2 * tid) = 0x3F803F80u;
    }
    __syncthreads();
    {
      const int w = wid;
      bf16x8 Qf[4];
      { const bf16_t* qr = Z + (size_t)(T0 + 16 * w + fr) * NZ + 1536 + h * 128 + 8 * fq;
#pragma unroll
        for (int ks = 0; ks < 4; ++ks) Qf[ks] = *(const bf16x8*)(qr + 32 * ks); }
      f32x4 hsum[8];
#pragma unroll
      for (int vt = 0; vt < 8; ++vt) hsum[vt] = (f32x4){0.f, 0.f, 0.f, 0.f};
      LAS bf16_t* Sw = Sb + w * 16 * LROW;
#pragma unroll
      for (int d = 0; d < 2; ++d) {
        const int lo = d ? w : 0, hi = d ? 7 : w;
        const int ks_lo = lo >> 1, ks_hi = hi >> 1;
        float er4[4];
#pragma unroll
        for (int j = 0; j < 4; ++j) er4[j] = erA[d * 128 + 16 * w + 4 * fq + j];
#pragma unroll
        for (int nt = 0; nt < 8; ++nt) {
          if (nt >= 2 * ks_lo && nt <= 2 * ks_hi + 1) {
            f32x4 a = (f32x4){0.f, 0.f, 0.f, 0.f};
            if (nt >= lo && nt <= hi) {
#pragma unroll
              for (int ks = 0; ks < 4; ++ks) { const bf16x8 Kf = *(const LAS bf16x8*)(Ks + (16 * nt + fr) * LROW + 32 * ks + 8 * fq); a = __builtin_amdgcn_mfma_f32_16x16x32_bf16(Qf[ks], Kf, a, 0, 0, 0); }
              const float ecv = ecA[d * 128 + 16 * nt + fr];
#pragma unroll
              for (int j = 0; j < 4; ++j) {
                float val = a[j] * er4[j] * ecv;
                if (nt == w) { const int tl = 4 * fq + j; const bool ok = d ? (fr >= tl) : (fr <= tl); val = ok ? val : 0.f; }
                a[j] = val;
              }
            }
#pragma unroll
            for (int j = 0; j < 4; ++j) { const float nb = dppf<0x12F>(a[j]); if ((fr & 1) == 0) *(LAS unsigned*)(Sw + (4 * fq + j) * LROW + 16 * nt + fr) = cvt_pk_bf16_c(a[j], nb); }
          }
        }
        asm volatile("s_waitcnt lgkmcnt(0)" ::: "memory");
        f32x4 ao[9];
#pragma unroll
        for (int vt = 0; vt < 9; ++vt) ao[vt] = (f32x4){0.f, 0.f, 0.f, 0.f};
        const bf16x8 zf = (bf16x8){0, 0, 0, 0, 0, 0, 0, 0};
#pragma unroll
        for (int ks = 0; ks < 4; ++ks) {
          if (ks >= ks_lo && ks <= ks_hi) {
            const bf16x8 Sf = *(const LAS bf16x8*)(Sw + fr * LROW + 32 * ks + 8 * fq);
#pragma unroll
            for (int vt = 0; vt < 9; ++vt) {
              bf16x8 Vf = *(const LAS bf16x8*)(VT + (vt < 8 ? 16 * vt + fr : 128) * LROW + 32 * ks + 8 * fq);
              if (vt == 8 && fr != 0) Vf = zf;
              ao[vt] = __builtin_amdgcn_mfma_f32_16x16x32_bf16(Sf, Vf, ao[vt], 0, 0, 0);
            }
          }
        }
        {
          const float wv = wiA[d * 128 + 16 * w + fr];
          const bf16_t* cs = Cst + (size_t)(u * 2 + d) * CST_ELEMS;
#pragma unroll
          for (int ks = 0; ks < 4; ++ks) {
            const bf16x8 Qs = scale_frag(Qf[ks], wv);
#pragma unroll
            for (int vt = 0; vt < 9; ++vt) {
              bf16x8 Cf = *(const bf16x8*)(cs + (vt < 8 ? 16 * vt + fr : 128) * 128 + 32 * ks + 8 * fq);
              if (vt == 8 && fr != 0) Cf = zf;
              ao[vt] = __builtin_amdgcn_mfma_f32_16x16x32_bf16(Qs, Cf, ao[vt], 0, 0, 0);
            }
          }
        }
#pragma unroll
        for (int j = 0; j < 4; ++j) {
          const float den = __shfl(ao[8][j], lane & 48);
          const float fl = flA[d * 128 + 16 * w + 4 * fq + j];
          const float inv = 1.0f / fmaxf(fabsf(den), fl);
#pragma unroll
          for (int vt = 0; vt < 8; ++vt) hsum[vt][j] += ao[vt][j] * inv;
        }
        asm volatile("" ::: "memory");
      }
#pragma unroll
      for (int j = 0; j < 4; ++j) {
        float ms = 0.f;
#pragma unroll
        for (int vt = 0; vt < 8; ++vt) ms += hsum[vt][j] * hsum[vt][j];
        ms += __shfl_xor(ms, 1); ms += __shfl_xor(ms, 2); ms += __shfl_xor(ms, 4); ms += __shfl_xor(ms, 8);
        const float r = rsqrtf(ms * (1.0f / 128.0f) + EPS);
        const int T = T0 + 16 * w + 4 * fq + j;
#pragma unroll
        for (int vt = 0; vt < 8; ++vt) {
          const int col = h * 128 + 16 * vt + fr;
          const float og = bf2f(Z[(size_t)T * NZ + 3072 + col]);
          const float val = hsum[vt][j] * r * P.mh_norm[col] * fast_sigmoid(og);
          ucat[(size_t)T * DM + 512 + col] = f2bf_c(val);
        }
      }
    }
    __syncthreads();
  }
}

__device__ void phase7(const Params& P) {
  const int wid = threadIdx.x >> 6, lane = threadIdx.x & 63;
  const float* rss2 = (const float*)(P.ws + WS_RSS2);
  for (int T = blockIdx.x * 8 + wid; T < NTOK; T += gridDim.x * 8) {
    const float r = rsqrtf(rss2[T] * (1.0f / 1024.0f) + EPS);
    float* row = P.out + (size_t)T * DM;
#pragma unroll
    for (int i = 0; i < 4; ++i) { const int c = i * 256 + lane * 4; const f32x4 v = *(const f32x4*)(row + c); const f32x4 fn = *(const f32x4*)(P.final_norm + c); *(f32x4*)(row + c) = v * r * fn; }
  }
}

#define GSYNC() do { asm volatile("s_waitcnt vmcnt(0) lgkmcnt(0)" ::: "memory"); __builtin_amdgcn_fence(__ATOMIC_RELEASE, "agent"); asm volatile("s_waitcnt vmcnt(0)" ::: "memory"); grid.sync(); } while (0)
__global__ void __launch_bounds__(512, 2) fwd_megakernel(Params P) {
  extern __shared__ __attribute__((aligned(16))) unsigned char shm[];
  cg::grid_group grid = cg::this_grid();
  LAS unsigned char* lds = (LAS unsigned char*)shm;
  float* smf = (float*)shm;
  phase0a(P, smf);
  GSYNC();
  phase0b(P, smf);
  GSYNC();
#if DBG_STOP == 1
  { const bf16_t* Hb = (const bf16_t*)(P.ws + WS_H); const float* gt = (const float*)(P.ws + WS_GATES); const float* md = (const float*)(P.ws + WS_MOD);
    for (size_t i = (size_t)blockIdx.x * 512 + threadIdx.x; i < (size_t)NTOK * DM; i += (size_t)gridDim.x * 512) P.out[i] = bf2f(Hb[i]);
    for (size_t i = (size_t)blockIdx.x * 512 + threadIdx.x; i < (size_t)NTOK * 16; i += (size_t)gridDim.x * 512) P.out[OUT_TAIL + i] = gt[i];
    for (size_t i = (size_t)blockIdx.x * 512 + threadIdx.x; i < (size_t)(5 * NMOD + 5 * NUP); i += (size_t)gridDim.x * 512) P.out[OUT_TAIL + NTOK * 16 + i] = md[i]; }
  return;
#endif
  { EpiZ E; E.Z = (bf16_t*)(P.ws + WS_Z);
    gemm_phase<EpiZ>(lds, (const bf16_t*)(P.ws + WS_H), (const bf16_t*)(P.ws + WS_WIN), NTOK, NZ, DM, E); }
  GSYNC();
#if DBG_STOP == 2
  { const bf16_t* Zb = (const bf16_t*)(P.ws + WS_Z);
    for (size_t i = (size_t)blockIdx.x * 512 + threadIdx.x; i < (size_t)NTOK * DM; i += (size_t)gridDim.x * 512) P.out[i] = bf2f(Zb[(i >> 10) * NZ + 1536 + (i & 1023)]); }
  return;
#endif
  phaseM1(P, lds);
  shortconv_items(P);
  GSYNC();
#if DBG_STOP == 3
  { const float* st = (const float*)(P.ws + WS_STAT);
    for (size_t i = (size_t)1280 * CST_ELEMS / 2 + (size_t)blockIdx.x * 512 + threadIdx.x; i < (size_t)NTOK * DM; i += (size_t)gridDim.x * 512) P.out[i] = 0.f;
    for (size_t i = (size_t)blockIdx.x * 512 + threadIdx.x; i < (size_t)2560; i += (size_t)gridDim.x * 512) P.out[OUT_TAIL + i] = st[i];
  }
  return;
#endif
  phaseM2(P);
  GSYNC();
#if DBG_STOP == 4
  { const bf16_t* Cb = (const bf16_t*)(P.ws + WS_H); const float* ms = (const float*)(P.ws + WS_MST); const float* st = (const float*)(P.ws + WS_STAT);
    for (size_t i = (size_t)blockIdx.x * 512 + threadIdx.x; i < (size_t)NTOK * DM; i += (size_t)gridDim.x * 512) P.out[i] = bf2f(Cb[i]);
    for (size_t i = (size_t)blockIdx.x * 512 + threadIdx.x; i < (size_t)1280; i += (size_t)gridDim.x * 512) P.out[OUT_TAIL + 2097152 + 16384 + 128 - 1280*3 + i] = ms[i];
  }
  return;
#endif
  phaseM3(P, lds);
  GSYNC();
#if DBG_STOP == 6
  { const bf16_t* ucat = (const bf16_t*)(P.ws + WS_UCAT);
    for (size_t i = (size_t)blockIdx.x * 512 + threadIdx.x; i < (size_t)NTOK * DM; i += (size_t)gridDim.x * 512) P.out[i] = bf2f(ucat[i]); }
  return;
#endif
  { EpiX1 E; E.xp = P.x_prompt; E.xs = P.x_sample; E.mod = (const float*)(P.ws + WS_MOD); E.norm2 = P.norm2; E.x1out = P.out; E.x1g = (bf16_t*)(P.ws + WS_H); E.rowss = (float*)(P.ws + WS_RSS1);
    gemm_phase<EpiX1>(lds, (const bf16_t*)(P.ws + WS_UCAT), (const bf16_t*)(P.ws + WS_WOUT), NTOK, DM, DM, E); }
  GSYNC();
  { EpiUp E; E.rowss1 = (const float*)(P.ws + WS_RSS1); E.sb = (const float*)(P.ws + WS_SB); E.cw = P.conv_ffn_w; E.cb = P.conv_ffn_b; E.act = (bf16_t*)(P.ws + WS_Z);
    gemm_phase<EpiUp>(lds, (const bf16_t*)(P.ws + WS_H), (const bf16_t*)(P.ws + WS_WUP), NTOK, NUP, DM, E); }
  GSYNC();
  { EpiDown E; E.mod = (const float*)(P.ws + WS_MOD); E.out = P.out; E.rowss2 = (float*)(P.ws + WS_RSS2);
    gemm_phase<EpiDown>(lds, (const bf16_t*)(P.ws + WS_Z), (const bf16_t*)(P.ws + WS_WDN), NTOK, DM, DFF, E); }
  GSYNC();
  phase7(P);
}

extern "C" void kernel_launch(void* const* d_in, const int* in_sizes, int n_in, void* d_out, int out_size, void* d_ws, size_t ws_size, hipStream_t stream) {
  static int grid_blocks = 0;
  if (!grid_blocks) {
    int dev = 0, cus = 0, per_cu = 0;
    hipGetDevice(&dev);
    hipDeviceGetAttribute(&cus, hipDeviceAttributeMultiprocessorCount, dev);
    hipFuncSetAttribute((const void*)fwd_megakernel, hipFuncAttributeMaxDynamicSharedMemorySize, LDS_BYTES);
    hipOccupancyMaxActiveBlocksPerMultiprocessor(&per_cu, (const void*)fwd_megakernel, 512, LDS_BYTES);
    (void)hipGetLastError();
    if (per_cu < 1) per_cu = 1;
    if (per_cu > 1) per_cu = 1;
    grid_blocks = cus * per_cu;
  }
  hipMemsetAsync(d_ws, 0, WS_ZERO_BYTES, stream);
  Params p{};
  const float** pp = (const float**)&p;
  for (int i = 0; i < 22; ++i) pp[i] = (const float*)d_in[i];
  p.out = (float*)d_out; p.ws = (unsigned char*)d_ws;
  void* args[] = {&p};
  hipError_t e = hipLaunchCooperativeKernel((const void*)fwd_megakernel, dim3(grid_blocks), dim3(512), args, LDS_BYTES, stream);
  if (e != hipSuccess) fprintf(stderr, "cooperative launch failed: %s (grid %d)\n", hipGetErrorString(e), grid_blocks);
}
```

```cpp
#include <hip/hip_runtime.h>
#include <hip/hip_cooperative_groups.h>
#include <cstdio>
namespace cg = cooperative_groups;

#ifndef DUP
#define DUP 0
#endif
#define LAS __attribute__((address_space(3)))
typedef unsigned short bf16_t;
typedef short bf16x8 __attribute__((ext_vector_type(8)));
typedef float f32x4 __attribute__((ext_vector_type(4)));
typedef unsigned u32x2 __attribute__((ext_vector_type(2)));
typedef unsigned u32x4 __attribute__((ext_vector_type(4)));

constexpr int DM = 1024, NTOK = 20480, NCTXT = 4096, DIN = 3600, NZ = 3584, DFF = 2816, NUP = 5632, NMOD = 6144;
constexpr float EPS = 1e-6f;
constexpr size_t WS_MOD = 0, WS_SB = 122880, WS_RSS1 = 235520, WS_RSS2 = 317440, WS_ZERO_BYTES = 399360;
constexpr size_t WS_GATES = 399360, WS_STAT = 1710080, WS_MST = 1720320;
constexpr size_t WS_WIN = 2097152, WS_WOUT = 9437184, WS_WUP = 11534336, WS_WDN = 23068672;
constexpr size_t WS_H = 28835840;
constexpr size_t WS_UCAT = 71106560;
constexpr size_t WS_Z = 113049600;
constexpr int OUT_TAIL = 20971520;
constexpr int LDS_BYTES = 146432;

struct Params {
  const float *x_prompt, *x_sample, *state_C, *state_n, *state_m, *c, *c_ctx, *w_mod, *b_mod, *norm1, *w_in, *b_gate,
      *conv_sc_w, *conv_sc_b, *mh_norm, *w_out, *norm2, *w_up, *conv_ffn_w, *conv_ffn_b, *w_down, *final_norm;
  float* out; unsigned char* ws;
};

typedef __bf16 bf16x2_n __attribute__((ext_vector_type(2)));
typedef float f32x2_n __attribute__((ext_vector_type(2)));
__device__ __forceinline__ unsigned cvt_pk_bf16_c(float lo, float hi) { const f32x2_n v = {lo, hi}; return __builtin_bit_cast(unsigned, __builtin_convertvector(v, bf16x2_n)); }
__device__ __forceinline__ unsigned cvt_pk_bf16(float lo, float hi) { unsigned r; asm("v_cvt_pk_bf16_f32 %0, %1, %2" : "=v"(r) : "v"(lo), "v"(hi)); return r; }
__device__ __forceinline__ bf16_t f2bf_c(float f) { return (bf16_t)(cvt_pk_bf16_c(f, 0.f) & 0xffffu); }
__device__ __forceinline__ bf16_t f2bf(float f) { return (bf16_t)(cvt_pk_bf16(f, 0.f) & 0xffffu); }
__device__ __forceinline__ float bf2f(bf16_t b) { return __uint_as_float(((unsigned)b) << 16); }
__device__ __forceinline__ float bflo(unsigned u) { return __uint_as_float(u << 16); }
__device__ __forceinline__ float bfhi(unsigned u) { return __uint_as_float(u & 0xffff0000u); }
__device__ __forceinline__ int permtok(int T) { if (T < NCTXT) return T; const int q = T - NCTXT; return NCTXT + (q & ~4095) + ((q & 63) << 6) + ((q >> 6) & 63); }
template <int CTRL> __device__ __forceinline__ float dppf(float x) { return __builtin_bit_cast(float, __builtin_amdgcn_mov_dpp(__builtin_bit_cast(int, x), CTRL, 0xf, 0xf, true)); }
__device__ __forceinline__ float fast_sigmoid(float x) { return __builtin_amdgcn_rcpf(1.0f + __expf(-x)); }

__device__ __forceinline__ int opaque_tid() { int t = threadIdx.x; asm volatile("" : "+v"(t)); return t; }

constexpr int BM = 256, BK = 64, HALF = 128, HTB = HALF * BK * 2, NXCD = 8, WGM = 8;
__device__ __forceinline__ int lds_byte(int r, int c) { const int st = (r >> 4) * 2 + (c >> 5), rr = r & 15, cc = c & 31, ob = rr * 64 + cc * 2; return st * 1024 + (ob ^ (((ob >> 9) & 1) << 5)); }
__device__ __forceinline__ void stage_rc(int b, int& R, int& C) { const int st = b / 1024, sb = b % 1024, swz = sb ^ (((sb >> 9) & 1) << 5); R = (st >> 1) * 16 + swz / 64; C = (st & 1) * 32 + (swz % 64) / 2; }

struct Order {
  int nM, nN, nwg, G, c;
  __device__ __forceinline__ void init(int M, int N) { nM = M / BM; nN = N / BM; nwg = nM * nN; G = gridDim.x; c = blockIdx.x; }
  __device__ __forceinline__ bool next(int i, int& pm, int& pn) const {
    const long L = (long)i * G + c; if (L >= nwg) return false;
    int wgid = (int)L; { const int q = nwg / NXCD, r = nwg % NXCD, xcd = wgid % NXCD, off = wgid / NXCD; wgid = (xcd < r ? xcd * (q + 1) : r * (q + 1) + (xcd - r) * q) + off; }
    const int nig = WGM * nN, gid = wgid / nig, fm = gid * WGM, gsz = (nM - fm) < WGM ? (nM - fm) : WGM;
    pm = fm + ((wgid % nig) % gsz); pn = (wgid % nig) / gsz; return true;
  }
};

template <class Epi>
__device__ __forceinline__ void gemm_phase(LAS unsigned char* lds, const bf16_t* gA, const bf16_t* gBt, int M, int N, int K, const Epi& E) {
  const int tid = opaque_tid(), wid = __builtin_amdgcn_readfirstlane(tid >> 6), lane = tid & 63, wr = wid >> 2, wc = wid & 3, fr = lane & 15, fq = lane >> 4;
  const int nt = K / BK;
  Order S; S.init(M, N);
  unsigned voffA[2];
#pragma unroll
  for (int i = 0; i < 2; ++i) { int R, C; stage_rc(tid * 16 + i * 8192, R, C); voffA[i] = (unsigned)(R * K + C) * 2u; }
  const size_t kstep = (size_t)(BK * 2);
  const size_t hstep = (size_t)HALF * K * 2;
  const size_t tstep = 2 * hstep;
  const unsigned ldsw = (unsigned)wid * 1024u;
  const int aoff = lds_byte(wr * 64 + fr, fq * 8), boff = lds_byte(wc * 32 + fr, fq * 8);
#define G_SA(b, h) (((b) * 2 + (h)) * HTB)
#define G_SB(b, h) ((4 + (b) * 2 + (h)) * HTB)
#define G_STAGE(bufoff, gbase) do { _Pragma("unroll") for (int _i = 0; _i < 2; ++_i) \
    __builtin_amdgcn_global_load_lds((const unsigned*)((const char*)(gbase) + voffA[_i]), (LAS unsigned*)(lds + (bufoff) + ldsw + _i * 8192), 16, 0, 0); } while (0)
#define G_LDA(dst, b, h) do { _Pragma("unroll") for (int m = 0; m < 4; ++m) _Pragma("unroll") for (int k = 0; k < 2; ++k) dst[m][k] = *(const LAS bf16x8*)(lds + G_SA(b, h) + aoff + m * 2048 + k * 1024); } while (0)
#define G_LDB(dst, b, h) do { _Pragma("unroll") for (int n = 0; n < 2; ++n) _Pragma("unroll") for (int k = 0; k < 2; ++k) dst[n][k] = *(const LAS bf16x8*)(lds + G_SB(b, h) + boff + n * 2048 + k * 1024); } while (0)
#define G_MMA(ai, bj, At, Bt) do { __builtin_amdgcn_s_setprio(1); _Pragma("unroll") for (int m = 0; m < 4; ++m) _Pragma("unroll") for (int n = 0; n < 2; ++n) _Pragma("unroll") for (int k = 0; k < 2; ++k) \
    acc[ai][bj][m][n] = __builtin_amdgcn_mfma_f32_16x16x32_bf16(Bt[n][k], At[m][k], acc[ai][bj][m][n], 0, 0, 0); __builtin_amdgcn_s_setprio(0); } while (0)
#define G_WAIT_V(n) asm volatile("s_waitcnt vmcnt(" #n ")" ::: "memory")
#define G_WAIT_L(n) asm volatile("s_waitcnt lgkmcnt(" #n ")" ::: "memory")
#define G_BAR __builtin_amdgcn_s_barrier()
#define G_SCHED __builtin_amdgcn_sched_barrier(0)
  int cpm, cpn, npm = 0, npn = 0, ui = 0;
  if (!S.next(0, cpm, cpn)) return;
  f32x4 acc[2][2][4][2];
#pragma unroll
  for (int a = 0; a < 2; ++a)
#pragma unroll
    for (int b = 0; b < 2; ++b)
#pragma unroll
      for (int m = 0; m < 4; ++m)
#pragma unroll
        for (int n = 0; n < 2; ++n) acc[a][b][m][n] = (f32x4){0.f, 0.f, 0.f, 0.f};
  bf16x8 At[4][2], B0[2][2], B1[2][2];
  const char* cA = (const char*)gA + (size_t)cpm * tstep; const char* cB = (const char*)gBt + (size_t)cpn * tstep;
  G_STAGE(G_SB(0, 0), cB); G_STAGE(G_SA(0, 0), cA); G_STAGE(G_SB(0, 1), cB + hstep); G_STAGE(G_SA(0, 1), cA + hstep);
  if (wr == 1) G_BAR;
  G_WAIT_V(4); G_BAR;
  G_STAGE(G_SB(1, 0), cB + kstep); G_STAGE(G_SA(1, 0), cA + kstep); G_STAGE(G_SB(1, 1), cB + hstep + kstep);
  G_WAIT_V(6); G_BAR;
  for (;;) {
    const bool has_next = S.next(ui + 1, npm, npn);
    const char* nA = has_next ? (const char*)gA + (size_t)npm * tstep : cA; const char* nB = has_next ? (const char*)gBt + (size_t)npn * tstep : cB;
    for (int t = 0; t < nt; t += 2) {
      const bool last = (t == nt - 2);
      const char* a1 = cA + (size_t)(t + 1) * kstep;
      const char* a2 = last ? nA : cA + (size_t)(t + 2) * kstep; const char* b2 = last ? nB : cB + (size_t)(t + 2) * kstep;
      const char* a3 = a2 + kstep; const char* b3 = b2 + kstep;
      G_LDB(B0, 0, 0); G_SCHED; G_LDA(At, 0, 0); G_STAGE(G_SA(1, 1), a1 + hstep);
      G_WAIT_L(8); G_BAR; G_WAIT_L(0); G_MMA(0, 0, At, B0); G_BAR; G_SCHED;
      G_LDB(B1, 0, 1); G_STAGE(G_SB(0, 0), b2);
      G_BAR; G_WAIT_L(0); G_MMA(0, 1, At, B1); G_BAR;
      G_LDA(At, 0, 1); G_STAGE(G_SA(0, 0), a2);
      G_BAR; G_WAIT_L(0); G_MMA(1, 0, At, B0); G_BAR; G_SCHED;
      G_STAGE(G_SB(0, 1), b2 + hstep);
      G_WAIT_V(6); G_BAR; G_MMA(1, 1, At, B1); G_BAR;
      G_LDB(B0, 1, 0); G_SCHED; G_LDA(At, 1, 0); G_STAGE(G_SA(0, 1), a2 + hstep);
      G_WAIT_L(8); G_BAR; G_WAIT_L(0); G_MMA(0, 0, At, B0); G_BAR; G_SCHED;
      G_LDB(B1, 1, 1); G_STAGE(G_SB(1, 0), b3);
      G_BAR; G_WAIT_L(0); G_MMA(0, 1, At, B1); G_BAR;
      G_LDA(At, 1, 1); G_STAGE(G_SA(1, 0), a3);
      G_BAR; G_WAIT_L(0); G_MMA(1, 0, At, B0); G_BAR; G_SCHED;
      G_STAGE(G_SB(1, 1), b3 + hstep);
      G_WAIT_V(6); G_BAR; G_MMA(1, 1, At, B1); G_BAR;
    }
    asm volatile("s_nop 15\n\ts_nop 15" ::: "memory");
    E(acc, cpm, cpn, wr, wc, fr, fq, lds);
    if (!has_next) break;
#pragma unroll
    for (int a = 0; a < 2; ++a)
#pragma unroll
      for (int b = 0; b < 2; ++b)
#pragma unroll
        for (int m = 0; m < 4; ++m)
#pragma unroll
          for (int n = 0; n < 2; ++n) acc[a][b][m][n] = (f32x4){0.f, 0.f, 0.f, 0.f};
    cpm = npm; cpn = npn; cA = nA; cB = nB; ++ui;
  }
  G_WAIT_V(0);
  if (wr == 0) G_BAR;
  G_BAR;
}

struct EpiZ {
  bf16_t* Z;
  __device__ __forceinline__ void operator()(f32x4 (&acc)[2][2][4][2], int pm, int pn, int wr, int wc, int fr, int fq, LAS unsigned char*) const {
    const int row0 = pm * BM + wr * 64 + fr, col0 = pn * BM + wc * 32 + 4 * fq;
#pragma unroll
    for (int ai = 0; ai < 2; ++ai)
#pragma unroll
      for (int m = 0; m < 4; ++m) {
        bf16_t* rowp = Z + (size_t)(row0 + ai * HALF + m * 16) * NZ + col0;
#pragma unroll
        for (int bj = 0; bj < 2; ++bj)
#pragma unroll
          for (int n = 0; n < 2; ++n) { const f32x4 v = acc[ai][bj][m][n]; u32x2 o; o.x = cvt_pk_bf16(v[0], v[1]); o.y = cvt_pk_bf16(v[2], v[3]); *(u32x2*)(rowp + bj * HALF + n * 16) = o; }
      }
  }
};

struct EpiNone {
  bf16_t* Z;
  __device__ __forceinline__ void operator()(f32x4 (&acc)[2][2][4][2], int pm, int pn, int wr, int wc, int fr, int fq, LAS unsigned char*) const {
    f32x4 s = (f32x4){0.f, 0.f, 0.f, 0.f};
#pragma unroll
    for (int ai = 0; ai < 2; ++ai)
#pragma unroll
      for (int bj = 0; bj < 2; ++bj)
#pragma unroll
        for (int m = 0; m < 4; ++m)
#pragma unroll
          for (int n = 0; n < 2; ++n) s += acc[ai][bj][m][n];
    if (s[0] + s[1] + s[2] + s[3] == 12345.678f) Z[pm + pn] = 1;
  }
};

struct EpiX1 {
  const float* xp; const float* xs; const float* mod; const float* norm2; float* x1out; bf16_t* x1g; float* rowss;
  __device__ __forceinline__ void operator()(f32x4 (&acc)[2][2][4][2], int pm, int pn, int wr, int wc, int fr, int fq, LAS unsigned char*) const {
    const int g = pm < 16 ? 4 : ((pm - 16) >> 4);
    const float* modg = mod + g * NMOD;
    const int col0 = pn * BM + wc * 32 + 4 * fq;
    f32x4 g1[2][2], g2[2][2];
#pragma unroll
    for (int bj = 0; bj < 2; ++bj)
#pragma unroll
      for (int n = 0; n < 2; ++n) { const int c = col0 + bj * HALF + n * 16; g1[bj][n] = *(const f32x4*)(modg + 2048 + c); const f32x4 s2 = *(const f32x4*)(modg + 4096 + c); const f32x4 nv = *(const f32x4*)(norm2 + c); g2[bj][n] = nv * (s2 + 1.0f); }
#pragma unroll
    for (int ai = 0; ai < 2; ++ai)
#pragma unroll
      for (int m = 0; m < 4; ++m) {
        const int T = pm * BM + ai * HALF + wr * 64 + m * 16 + fr;
        const float* xrow = (T < NCTXT) ? xp + (size_t)T * DM : xs + (size_t)(T - NCTXT) * DM;
        const int p = permtok(T);
        float ss = 0.f;
#pragma unroll
        for (int bj = 0; bj < 2; ++bj)
#pragma unroll
          for (int n = 0; n < 2; ++n) {
            const int c = col0 + bj * HALF + n * 16;
            const f32x4 xv = *(const f32x4*)(xrow + c);
            const f32x4 v = xv + g1[bj][n] * acc[ai][bj][m][n];
            *(f32x4*)(x1out + (size_t)T * DM + c) = v;
            ss += v[0] * v[0] + v[1] * v[1] + v[2] * v[2] + v[3] * v[3];
            const f32x4 w = v * g2[bj][n];
            u32x2 o; o.x = cvt_pk_bf16(w[0], w[1]); o.y = cvt_pk_bf16(w[2], w[3]);
            *(u32x2*)(x1g + (size_t)p * DM + c) = o;
          }
        ss += __shfl_xor(ss, 16); ss += __shfl_xor(ss, 32);
        if (fq == 0) __hip_atomic_fetch_add(rowss + p, ss, __ATOMIC_RELAXED, __HIP_MEMORY_SCOPE_AGENT);
      }
  }
};

struct EpiDown {
  const float* mod; float* out; float* rowss2;
  __device__ __forceinline__ void operator()(f32x4 (&acc)[2][2][4][2], int pm, int pn, int wr, int wc, int fr, int fq, LAS unsigned char*) const {
    const int g = pm < 16 ? 4 : ((pm - 16) >> 4);
    const float* modg = mod + g * NMOD;
    const int col0 = pn * BM + wc * 32 + 4 * fq;
    f32x4 g2[2][2];
#pragma unroll
    for (int bj = 0; bj < 2; ++bj)
#pragma unroll
      for (int n = 0; n < 2; ++n) g2[bj][n] = *(const f32x4*)(modg + 5120 + col0 + bj * HALF + n * 16);
#pragma unroll
    for (int ai = 0; ai < 2; ++ai)
#pragma unroll
      for (int m = 0; m < 4; ++m) {
        const int p = pm * BM + ai * HALF + wr * 64 + m * 16 + fr;
        const int T = permtok(p);
        float* orow = out + (size_t)T * DM;
        float ss = 0.f;
#pragma unroll
        for (int bj = 0; bj < 2; ++bj)
#pragma unroll
          for (int n = 0; n < 2; ++n) {
            const int c = col0 + bj * HALF + n * 16;
            const f32x4 xv = *(const f32x4*)(orow + c);
            const f32x4 v = xv + g2[bj][n] * acc[ai][bj][m][n];
            *(f32x4*)(orow + c) = v;
            ss += v[0] * v[0] + v[1] * v[1] + v[2] * v[2] + v[3] * v[3];
          }
        ss += __shfl_xor(ss, 16); ss += __shfl_xor(ss, 32);
        if (fq == 0) __hip_atomic_fetch_add(rowss2 + T, ss, __ATOMIC_RELAXED, __HIP_MEMORY_SCOPE_AGENT);
      }
  }
};

struct EpiUp {
  const float* rowss1; const float* sb; const float* cw; const float* cb; bf16_t* act;
  __device__ __forceinline__ void operator()(f32x4 (&acc)[2][2][4][2], int pm, int pn, int wr, int wc, int fr, int fq, LAS unsigned char* lds) const {
    asm volatile("" : "+v"(fr), "+v"(fq));
    const bool ctx = pm < 16;
    const int g = ctx ? 4 : ((pm - 16) >> 4);
    const float* sbg = sb + g * NUP;
    LAS float* halo = (LAS float*)(lds + 131072);
    const int prow0 = pm * BM + wr * 64 + fr;
    {
      float rs[2][4];
#pragma unroll
      for (int ai = 0; ai < 2; ++ai)
#pragma unroll
        for (int m = 0; m < 4; ++m) rs[ai][m] = __builtin_amdgcn_rsqf(rowss1[prow0 + ai * HALF + m * 16] * (1.0f / 1024.0f) + EPS);
#pragma unroll
      for (int bj = 0; bj < 2; ++bj)
#pragma unroll
        for (int n = 0; n < 2; ++n) {
          asm volatile("" ::: "memory"); __builtin_amdgcn_sched_barrier(0);
          const f32x4 sv = *(const f32x4*)(sbg + bj * DFF + pn * HALF + wc * 32 + n * 16 + 4 * fq);
#pragma unroll
          for (int ai = 0; ai < 2; ++ai)
#pragma unroll
            for (int m = 0; m < 4; ++m) { acc[ai][bj][m][n] = acc[ai][bj][m][n] * rs[ai][m] + sv; asm volatile("" : "+v"(acc[ai][bj][m][n])); }
        }
    }
    if (ctx) {
#pragma unroll
      for (int ai = 0; ai < 2; ++ai)
#pragma unroll
        for (int bj = 0; bj < 2; ++bj)
#pragma unroll
          for (int n = 0; n < 2; ++n) {
            const int rb = 2 * ai + wr, colt = bj * HALF + wc * 32 + n * 16 + 4 * fq;
            if (fr == 0) *(LAS f32x4*)(halo + (rb * 2 + 0) * 256 + colt) = acc[ai][bj][0][n];
            if (fr == 15) *(LAS f32x4*)(halo + (rb * 2 + 1) * 256 + colt) = acc[ai][bj][3][n];
          }
      asm volatile("s_waitcnt lgkmcnt(0)" ::: "memory");
      __builtin_amdgcn_s_barrier();
      __builtin_amdgcn_s_barrier();
      asm volatile("" ::: "memory");
    }
#pragma unroll
    for (int n = 0; n < 2; ++n)
#pragma unroll
      for (int ai = 0; ai < 2; ++ai) {
        f32x4 ya[4];
        const int rb = 2 * ai + wr;
#pragma unroll
        for (int bj = 0; bj < 2; ++bj) {
          asm volatile("" ::: "memory"); __builtin_amdgcn_sched_barrier(0);
          const int cnat = bj * DFF + pn * HALF + wc * 32 + n * 16 + 4 * fq, colt = bj * HALF + wc * 32 + n * 16 + 4 * fq;
          const f32x4 w0 = *(const f32x4*)(cw + cnat), w1 = *(const f32x4*)(cw + NUP + cnat), w2 = *(const f32x4*)(cw + 2 * NUP + cnat), bb = *(const f32x4*)(cb + cnat);
          f32x4 hp = (f32x4){0.f, 0.f, 0.f, 0.f}, hn = hp;
          if (ctx) {
            if (rb > 0) hp = *(const LAS f32x4*)(halo + ((rb - 1) * 2 + 1) * 256 + colt);
            if (rb < 3) hn = *(const LAS f32x4*)(halo + ((rb + 1) * 2 + 0) * 256 + colt);
          }
#pragma unroll
          for (int m = 0; m < 4; ++m) {
            const f32x4 cur = acc[ai][bj][m][n];
            f32x4 prev, next;
#pragma unroll
            for (int e = 0; e < 4; ++e) {
              if (m > 0) { const float snd = (fr == 15) ? acc[ai][bj][m > 0 ? m - 1 : 0][n][e] : cur[e]; prev[e] = dppf<0x121>(snd); }
              else { const float rcv = dppf<0x121>(cur[e]); prev[e] = (fr == 0) ? hp[e] : rcv; }
              if (m < 3) { const float snd = (fr == 0) ? acc[ai][bj][m < 3 ? m + 1 : 3][n][e] : cur[e]; next[e] = dppf<0x12F>(snd); }
              else { const float rcv = dppf<0x12F>(cur[e]); next[e] = (fr == 15) ? hn[e] : rcv; }
            }
            const f32x4 y = w0 * prev + w1 * cur + w2 * next + bb;
            if (bj == 0) ya[m] = y;
            else {
              float o[4];
#pragma unroll
              for (int e = 0; e < 4; ++e) o[e] = y[e] * fast_sigmoid(y[e]) * ya[m][e];
              u32x2 ov; ov.x = cvt_pk_bf16(o[0], o[1]); ov.y = cvt_pk_bf16(o[2], o[3]);
              *(u32x2*)(act + (size_t)(prow0 + ai * HALF + m * 16) * DFF + pn * HALF + wc * 32 + n * 16 + 4 * fq) = ov;
            }
          }
        }
      }
  }
};

template <bool SILU>
__device__ __forceinline__ void gemv5_unit(const Params& P, int unit, int ncb, const float* W, int ldw, float* outp, int ldo, const float* bias, const float* modv, float* sm) {
  const int tid = opaque_tid();
  const int cb = unit % ncb, ks = unit / ncb, n0 = cb * 256, k0 = ks * 128;
  float* sv = sm; float* red = sm + 640;
  for (int i = tid; i < 640; i += 512) {
    const int g = i >> 7, k = k0 + (i & 127);
    float v;
    if (SILU) { v = (g < 4) ? P.c[g * DM + k] : P.c_ctx[k]; v = v / (1.0f + __expf(-v)); }
    else v = modv[g * NMOD + 3072 + k];
    sv[i] = v;
  }
  __syncthreads();
  const int col = tid & 255, kh = tid >> 8;
  float a0 = 0.f, a1 = 0.f, a2 = 0.f, a3 = 0.f, a4 = 0.f;
  const float* wp = W + (size_t)(k0 + kh * 64) * ldw + n0 + col;
#pragma unroll 8
  for (int kk = 0; kk < 64; ++kk) {
    const float w = wp[(size_t)kk * ldw];
    const int ki = kh * 64 + kk;
    a0 += sv[ki] * w; a1 += sv[128 + ki] * w; a2 += sv[256 + ki] * w; a3 += sv[384 + ki] * w; a4 += sv[512 + ki] * w;
  }
  if (kh == 1) { red[col] = a0; red[256 + col] = a1; red[512 + col] = a2; red[768 + col] = a3; red[1024 + col] = a4; }
  __syncthreads();
  if (kh == 0) {
    const float bv = (bias != nullptr && ks == 0) ? bias[n0 + col] : 0.f;
    a0 += red[col] + bv; a1 += red[256 + col] + bv; a2 += red[512 + col] + bv; a3 += red[768 + col] + bv; a4 += red[1024 + col] + bv;
    float* o = outp + n0 + col;
    __hip_atomic_fetch_add(o, a0, __ATOMIC_RELAXED, __HIP_MEMORY_SCOPE_AGENT);
    __hip_atomic_fetch_add(o + ldo, a1, __ATOMIC_RELAXED, __HIP_MEMORY_SCOPE_AGENT);
    __hip_atomic_fetch_add(o + 2 * ldo, a2, __ATOMIC_RELAXED, __HIP_MEMORY_SCOPE_AGENT);
    __hip_atomic_fetch_add(o + 3 * ldo, a3, __ATOMIC_RELAXED, __HIP_MEMORY_SCOPE_AGENT);
    __hip_atomic_fetch_add(o + 4 * ldo, a4, __ATOMIC_RELAXED, __HIP_MEMORY_SCOPE_AGENT);
  }
  __syncthreads();
}

__device__ __forceinline__ void transpose_unit(const float* W, int ldw, int k0, int n0, bf16_t* dst, int ldd, int drow0, float* tile) {
  const int tid = opaque_tid();
  { const int r = tid >> 4, c4 = (tid & 15) * 4;
#pragma unroll
    for (int i = 0; i < 2; ++i) { const f32x4 v = *(const f32x4*)(W + (size_t)(k0 + r + 32 * i) * ldw + n0 + c4); float* t = tile + (r + 32 * i) * 65 + c4; t[0] = v[0]; t[1] = v[1]; t[2] = v[2]; t[3] = v[3]; } }
  __syncthreads();
  { const int nn = tid >> 3, kk8 = (tid & 7) * 8; float v[8];
#pragma unroll
    for (int j = 0; j < 8; ++j) v[j] = tile[(kk8 + j) * 65 + nn];
    u32x4 o; o.x = cvt_pk_bf16(v[0], v[1]); o.y = cvt_pk_bf16(v[2], v[3]); o.z = cvt_pk_bf16(v[4], v[5]); o.w = cvt_pk_bf16(v[6], v[7]);
    *(u32x4*)(dst + (size_t)(drow0 + nn) * ldd + k0 + kk8) = o; }
  __syncthreads();
}

__device__ void phase0a(const Params& P, float* sm) {
  float* mod = (float*)(P.ws + WS_MOD);
  bf16_t* WinT = (bf16_t*)(P.ws + WS_WIN); bf16_t* WoutT = (bf16_t*)(P.ws + WS_WOUT); bf16_t* WupT = (bf16_t*)(P.ws + WS_WUP); bf16_t* WdnT = (bf16_t*)(P.ws + WS_WDN);
  constexpr int NG = 24 * 8, N1 = NG + 896, N2 = N1 + 256, N3 = N2 + 1408, N4 = N3 + 704;
  for (int u = blockIdx.x; u < N4; u += gridDim.x) {
    if (u < NG) gemv5_unit<true>(P, u, 24, P.w_mod, NMOD, mod, NMOD, P.b_mod, nullptr, sm);
    else if (u < N1) { const int v = u - NG, kt = v / 56, ntl = v % 56; transpose_unit(P.w_in, DIN, kt * 64, ntl * 64, WinT, DM, ntl * 64, sm); }
    else if (u < N2) { const int v = u - N1, kt = v >> 4, ntl = v & 15; transpose_unit(P.w_out, DM, kt * 64, ntl * 64, WoutT, DM, ntl * 64, sm); }
    else if (u < N3) { const int v = u - N2, kt = v / 88, ntl = v % 88; const int n0 = ntl * 64, half = n0 / DFF, r = n0 % DFF, pn = r >> 7, cc = r & 127;
      transpose_unit(P.w_up, NUP, kt * 64, n0, WupT, DM, pn * 256 + half * 128 + cc, sm); }
    else { const int v = u - N3, kt = v >> 4, ntl = v & 15; transpose_unit(P.w_down, DM, kt * 64, ntl * 64, WdnT, DFF, ntl * 64, sm); }
  }
}

__device__ void phase0b(const Params& P, float* sm) {
  const int tid = opaque_tid(), wid = tid >> 6, lane = tid & 63;
  const float* mod = (const float*)(P.ws + WS_MOD);
  float* sbv = (float*)(P.ws + WS_SB);
  float* gates = (float*)(P.ws + WS_GATES);
  bf16_t* H = (bf16_t*)(P.ws + WS_H);
  for (int u = blockIdx.x; u < 22 * 8; u += gridDim.x) gemv5_unit<false>(P, u, 22, P.w_up, NUP, sbv, NUP, nullptr, mod, sm + 16384);
  for (int idx = tid; idx < 16384; idx += 512) { const int k = idx >> 4, g = idx & 15; sm[g * 1024 + k] = P.w_in[(size_t)k * DIN + NZ + g]; }
  __syncthreads();
  for (int T = blockIdx.x * 8 + wid; T < NTOK; T += gridDim.x * 8) {
    const int g = T < NCTXT ? 4 : ((T - NCTXT) >> 12);
    const float* xrow = (T < NCTXT) ? P.x_prompt + (size_t)T * DM : P.x_sample + (size_t)(T - NCTXT) * DM;
    const float* modg = mod + g * NMOD;
    f32x4 xv[4]; float ss = 0.f;
#pragma unroll
    for (int i = 0; i < 4; ++i) { xv[i] = *(const f32x4*)(xrow + i * 256 + lane * 4); ss += xv[i][0] * xv[i][0] + xv[i][1] * xv[i][1] + xv[i][2] * xv[i][2] + xv[i][3] * xv[i][3]; }
#pragma unroll
    for (int o = 1; o < 64; o <<= 1) ss += __shfl_xor(ss, o);
    const float rstd = rsqrtf(ss * (1.0f / 1024.0f) + EPS);
    f32x4 hv[4];
#pragma unroll
    for (int i = 0; i < 4; ++i) {
      const int c = i * 256 + lane * 4;
      const f32x4 nv = *(const f32x4*)(P.norm1 + c), sc = *(const f32x4*)(modg + 1024 + c), sh = *(const f32x4*)(modg + c);
      hv[i] = xv[i] * rstd * nv * (sc + 1.0f) + sh;
      u32x2 o; o.x = cvt_pk_bf16(hv[i][0], hv[i][1]); o.y = cvt_pk_bf16(hv[i][2], hv[i][3]);
      *(u32x2*)(H + (size_t)T * DM + c) = o;
    }
    float v[16];
#pragma unroll
    for (int gi = 0; gi < 16; ++gi) {
      float a = 0.f;
#pragma unroll
      for (int i = 0; i < 4; ++i) { const f32x4 w = *(const f32x4*)(sm + gi * 1024 + i * 256 + lane * 4); a += hv[i][0] * w[0] + hv[i][1] * w[1] + hv[i][2] * w[2] + hv[i][3] * w[3]; }
      v[gi] = a;
    }
#pragma unroll
    for (int j = 0; j < 8; ++j) { const bool hi = lane & 32; const float keep = hi ? v[j + 8] : v[j], send = hi ? v[j] : v[j + 8]; v[j] = keep + __shfl_xor(send, 32); }
#pragma unroll
    for (int j = 0; j < 4; ++j) { const bool hi = lane & 16; const float keep = hi ? v[j + 4] : v[j], send = hi ? v[j] : v[j + 4]; v[j] = keep + __shfl_xor(send, 16); }
#pragma unroll
    for (int j = 0; j < 2; ++j) { const bool hi = lane & 8; const float keep = hi ? v[j + 2] : v[j], send = hi ? v[j] : v[j + 2]; v[j] = keep + __shfl_xor(send, 8); }
    { const bool hi = lane & 4; const float keep = hi ? v[1] : v[0], send = hi ? v[0] : v[1]; v[0] = keep + __shfl_xor(send, 4); }
    v[0] += __shfl_xor(v[0], 2); v[0] += __shfl_xor(v[0], 1);
    if ((lane & 3) == 0) {
      const int gi = ((lane >> 5) & 1) * 8 + ((lane >> 4) & 1) * 4 + ((lane >> 3) & 1) * 2 + ((lane >> 2) & 1);
      float val = v[0] + P.b_gate[gi];
      if ((gi >> 2) & 1) val = fminf(val, 0.f) - log1pf(__expf(-fabsf(val)));
      gates[(size_t)T * 16 + gi] = val;
    }
  }
  __syncthreads();
}

__device__ __forceinline__ void unit_info(int u, int& T0, int& nc, int& b, int& h, int& c) {
  if (u < 128) { nc = 2; b = u >> 3; h = (u >> 1) & 3; c = u & 1; T0 = b * 256 + c * 128; }
  else { const int v = u - 128; nc = 32; b = v >> 7; h = (v >> 5) & 3; c = v & 31; T0 = NCTXT + b * 4096 + c * 128; }
}
struct ScanOut { float beta0, beta1, cf0, cf1, pm0, pm1, bl, cmax; int t0, t1; };
__device__ __forceinline__ void chunk_scan(const float* gates, int T0, int h, int d, int lane, ScanOut& o) {
  const int t0 = d ? 127 - 2 * lane : 2 * lane, t1 = d ? t0 - 1 : t0 + 1;
  const float* g0 = gates + (size_t)(T0 + t0) * 16 + d * 8 + h; const float* g1 = gates + (size_t)(T0 + t1) * 16 + d * 8 + h;
  const float i0 = g0[0], f0 = g0[4], i1 = g1[0], f1 = g1[4];
  const float s = f0 + f1;
  float x = s;
#pragma unroll
  for (int off = 1; off < 64; off <<= 1) { const float y = __shfl_up(x, off); if (lane >= off) x += y; }
  const float excl = x - s;
  o.beta0 = excl + f0; o.beta1 = x;
  o.cf0 = i0 - o.beta0; o.cf1 = i1 - o.beta1;
  float mx = fmaxf(o.cf0, o.cf1);
#pragma unroll
  for (int off = 1; off < 64; off <<= 1) { const float y = __shfl_up(mx, off); if (lane >= off) mx = fmaxf(mx, y); }
  const float mex = __shfl_up(mx, 1);
  o.pm0 = lane ? fmaxf(mex, o.cf0) : o.cf0; o.pm1 = mx;
  o.bl = __shfl(x, 63); o.cmax = __shfl(mx, 63);
  o.t0 = t0; o.t1 = t1;
}

constexpr int LROW = 136;
constexpr int CST_ELEMS = 129 * 128;

__device__ void shortconv_items(const Params& P) {
  const bf16_t* Z = (const bf16_t*)(P.ws + WS_Z);
  bf16_t* ucat = (bf16_t*)(P.ws + WS_UCAT);
  const int tid = opaque_tid(), wid = tid >> 6, lane = tid & 63, cgp = lane * 8;
  float w0[8], w1[8], w2[8], bb[8];
#pragma unroll
  for (int q = 0; q < 2; ++q) {
    const f32x4 a = *(const f32x4*)(P.conv_sc_w + cgp + q * 4), b = *(const f32x4*)(P.conv_sc_w + 512 + cgp + q * 4), cc = *(const f32x4*)(P.conv_sc_w + 1024 + cgp + q * 4), d = *(const f32x4*)(P.conv_sc_b + cgp + q * 4);
#pragma unroll
    for (int e = 0; e < 4; ++e) { w0[q * 4 + e] = a[e]; w1[q * 4 + e] = b[e]; w2[q * 4 + e] = cc[e]; bb[q * 4 + e] = d[e]; }
  }
  const int nwaves = gridDim.x * 8, gw = blockIdx.x * 8 + wid;
  const int per = (NTOK + nwaves - 1) / nwaves;
  const int Tb = gw * per, Te = (Tb + per < NTOK) ? Tb + per : NTOK;
  if (Tb >= Te) return;
  auto loadu = [&](int T, float (&u)[8]) {
    const int Tc = T < 0 ? 0 : (T >= NTOK ? NTOK - 1 : T);
    const bf16_t* zr = Z + (size_t)Tc * NZ + cgp;
    const u32x4 c = *(const u32x4*)(zr + 512), x = *(const u32x4*)(zr + 1024);
#pragma unroll
    for (int q = 0; q < 4; ++q) { u[2 * q] = bflo(c[q]) * bflo(x[q]); u[2 * q + 1] = bfhi(c[q]) * bfhi(x[q]); }
  };
  float up[8], uc[8], un[8];
  loadu(Tb - 1, up); loadu(Tb, uc);
  for (int T = Tb; T < Te; ++T) {
    loadu(T + 1, un);
    const u32x4 sbq = *(const u32x4*)(Z + (size_t)T * NZ + cgp);
    const int pos = (T < NCTXT) ? (T & 255) : ((T - NCTXT) & 63), lastp = (T < NCTXT) ? 255 : 63;
    const float mp = pos != 0 ? 1.f : 0.f, mn = pos != lastp ? 1.f : 0.f;
    float o[8];
#pragma unroll
    for (int q = 0; q < 4; ++q) {
      o[2 * q] = bflo(sbq[q]) * (w0[2 * q] * (mp * up[2 * q]) + w1[2 * q] * uc[2 * q] + w2[2 * q] * (mn * un[2 * q]) + bb[2 * q]);
      o[2 * q + 1] = bfhi(sbq[q]) * (w0[2 * q + 1] * (mp * up[2 * q + 1]) + w1[2 * q + 1] * uc[2 * q + 1] + w2[2 * q + 1] * (mn * un[2 * q + 1]) + bb[2 * q + 1]);
    }
    u32x4 ov; ov.x = cvt_pk_bf16(o[0], o[1]); ov.y = cvt_pk_bf16(o[2], o[3]); ov.z = cvt_pk_bf16(o[4], o[5]); ov.w = cvt_pk_bf16(o[6], o[7]);
    *(u32x4*)(ucat + (size_t)T * DM + cgp) = ov;
#pragma unroll
    for (int e = 0; e < 8; ++e) { up[e] = uc[e]; uc[e] = un[e]; }
  }
}

__device__ void phaseM1(const Params& P, LAS unsigned char* lds) {
  const int tid = opaque_tid(), wid = tid >> 6, lane = tid & 63, fr = lane & 15, fq = lane >> 4;
  const bf16_t* Z = (const bf16_t*)(P.ws + WS_Z);
  const float* gates = (const float*)(P.ws + WS_GATES);
  float* stat = (float*)(P.ws + WS_STAT);
  bf16_t* dC = (bf16_t*)P.out;
  LAS bf16_t* KT = (LAS bf16_t*)lds;
  LAS bf16_t* VT0 = (LAS bf16_t*)(lds + 34816);
  LAS bf16_t* VT1 = (LAS bf16_t*)(lds + 34816 + 36992);
  LAS float* ecs = (LAS float*)(lds + 34816 + 2 * 36992 + 4096);
  for (int u = blockIdx.x; u < 640; u += gridDim.x) {
    int T0, nc, b, h, c; unit_info(u, T0, nc, b, h, c);
    if (wid < 2) {
      ScanOut so; chunk_scan(gates, T0, h, wid, lane, so);
      ecs[wid * 128 + so.t0] = __expf(so.cf0 - so.cmax); ecs[wid * 128 + so.t1] = __expf(so.cf1 - so.cmax);
      if (lane == 0) { stat[(u * 2 + wid) * 2] = so.bl; stat[(u * 2 + wid) * 2 + 1] = so.cmax; }
    }
    __syncthreads();
    {
      const int kg = tid & 15;
#pragma unroll
      for (int i = 0; i < 2; ++i) {
        const int s = 2 * ((tid >> 4) + 32 * i);
        const bf16_t* zr = Z + (size_t)(T0 + s) * NZ + h * 128 + kg * 8;
        const u32x4 ka = *(const u32x4*)(zr + 2048), va = *(const u32x4*)(zr + 2560);
        const u32x4 kb = *(const u32x4*)(zr + NZ + 2048), vb = *(const u32x4*)(zr + NZ + 2560);
        const float e0a = ecs[s], e0b = ecs[s + 1], e1a = ecs[128 + s], e1b = ecs[128 + s + 1];
#pragma unroll
        for (int q = 0; q < 4; ++q) {
          const int r0 = (kg * 8 + 2 * q) * LROW + s, r1 = r0 + LROW;
          *(LAS unsigned*)(KT + r0) = (ka[q] & 0xffffu) | (kb[q] << 16);
          *(LAS unsigned*)(KT + r1) = (ka[q] >> 16) | (kb[q] & 0xffff0000u);
          const float al = bflo(va[q]), ah = bfhi(va[q]), bl_ = bflo(vb[q]), bh = bfhi(vb[q]);
          *(LAS unsigned*)(VT0 + r0) = cvt_pk_bf16_c(al * e0a, bl_ * e0b);
          *(LAS unsigned*)(VT0 + r1) = cvt_pk_bf16_c(ah * e0a, bh * e0b);
          *(LAS unsigned*)(VT1 + r0) = cvt_pk_bf16_c(al * e1a, bl_ * e1b);
          *(LAS unsigned*)(VT1 + r1) = cvt_pk_bf16_c(ah * e1a, bh * e1b);
        }
      }
      if (tid < 64) { *(LAS unsigned*)(VT0 + 128 * LROW + 2 * tid) = cvt_pk_bf16_c(ecs[2 * tid], ecs[2 * tid + 1]); *(LAS unsigned*)(VT1 + 128 * LROW + 2 * tid) = cvt_pk_bf16_c(ecs[128 + 2 * tid], ecs[128 + 2 * tid + 1]); }
    }
    __syncthreads();
    {
      bf16x8 Kf[4];
#pragma unroll
      for (int ks = 0; ks < 4; ++ks) Kf[ks] = *(const LAS bf16x8*)(KT + (16 * wid + fr) * LROW + 32 * ks + 8 * fq);
#pragma unroll
      for (int d = 0; d < 2; ++d) {
        LAS bf16_t* VT = d ? VT1 : VT0;
        bf16_t* dst = dC + (size_t)(u * 2 + d) * CST_ELEMS;
#pragma unroll
        for (int mt = 0; mt < 9; ++mt) {
          f32x4 a = (f32x4){0.f, 0.f, 0.f, 0.f};
#pragma unroll
          for (int ks = 0; ks < 4; ++ks) { const bf16x8 Vf = *(const LAS bf16x8*)(VT + (16 * mt + fr) * LROW + 32 * ks + 8 * fq); a = __builtin_amdgcn_mfma_f32_16x16x32_bf16(Kf[ks], Vf, a, 0, 0, 0); }
          if (mt < 8 || fr == 0) { u32x2 o; o.x = cvt_pk_bf16_c(a[0], a[1]); o.y = cvt_pk_bf16_c(a[2], a[3]); *(u32x2*)(dst + (16 * mt + fr) * 128 + 16 * wid + 4 * fq) = o; }
        }
      }
    }
    __syncthreads();
  }
}

template <int NC, int BLK, bool HASN>
__device__ __forceinline__ void m2_loop(const bf16_t* dC, bf16_t* Cst, float* mst, const float* sm, int ubase, int d, int e, int kn, bool wm, f32x4& C4, f32x4& n4, float& m) {
#pragma unroll 1
  for (int jb = 0; jb < NC; jb += BLK) {
    u32x2 dv[BLK], nv[BLK];
#pragma unroll
    for (int jj = 0; jj < BLK; ++jj) {
      const int j = jb + jj, c = d ? NC - 1 - j : j;
      const bf16_t* dp = dC + (size_t)((ubase + c) * 2 + d) * CST_ELEMS;
      dv[jj] = *(const u32x2*)(dp + e);
      if (HASN) nv[jj] = *(const u32x2*)(dp + 16384 + kn);
    }
#pragma unroll
    for (int jj = 0; jj < BLK; ++jj) {
      const int j = jb + jj, c = d ? NC - 1 - j : j;
      const int idx = (ubase + c) * 2 + d;
      bf16_t* cs = Cst + (size_t)idx * CST_ELEMS;
      { u32x2 o; o.x = cvt_pk_bf16(C4[0], C4[1]); o.y = cvt_pk_bf16(C4[2], C4[3]); *(u32x2*)(cs + e) = o; }
      if (HASN) { u32x2 o; o.x = cvt_pk_bf16(n4[0], n4[1]); o.y = cvt_pk_bf16(n4[2], n4[3]); *(u32x2*)(cs + 16384 + kn) = o; if (wm) mst[idx] = m; }
      const float bl = sm[2 * j], cmax = sm[2 * j + 1];
      const float mn = bl + fmaxf(m, cmax);
      const float decay = __expf(bl + m - mn), scale = __expf(bl + cmax - mn);
      const u32x2 dvv = dv[jj];
      C4[0] = decay * C4[0] + scale * bflo(dvv.x); C4[1] = decay * C4[1] + scale * bfhi(dvv.x); C4[2] = decay * C4[2] + scale * bflo(dvv.y); C4[3] = decay * C4[3] + scale * bfhi(dvv.y);
      if (HASN) { const u32x2 nvv = nv[jj];
        n4[0] = decay * n4[0] + scale * bflo(nvv.x); n4[1] = decay * n4[1] + scale * bfhi(nvv.x); n4[2] = decay * n4[2] + scale * bflo(nvv.y); n4[3] = decay * n4[3] + scale * bfhi(nvv.y); }
      m = mn;
    }
  }
}
template <int NC, int BLK>
__device__ __forceinline__ void m2_unit(const Params& P, bool lat, int sq, int slice, float* sm) {
  const int tid = opaque_tid();
  const bf16_t* dC = (const bf16_t*)P.out;
  bf16_t* Cst = (bf16_t*)(P.ws + WS_H);
  const float* stat = (const float*)(P.ws + WS_STAT);
  float* mst = (float*)(P.ws + WS_MST);
  const int b = sq >> 3, h = (sq >> 1) & 3, d = sq & 1;
  const int ubase = lat ? 128 + (b * 4 + h) * 32 : (b * 4 + h) * 2;
  const int e = slice * 2048 + tid * 4;
  const bool hasn = (slice == 0) && (tid < 64);
  const int kn = (tid & 31) * 4;
  if (tid < NC) { const int c = d ? NC - 1 - tid : tid; const int idx = (ubase + c) * 2 + d; sm[2 * tid] = stat[idx * 2]; sm[2 * tid + 1] = stat[idx * 2 + 1]; }
  f32x4 C4 = (f32x4){0.f, 0.f, 0.f, 0.f}, n4 = C4; float m = 0.f;
  const int sidx = (b * 2 + d) * 4 + h;
  if (lat) {
    C4 = *(const f32x4*)(P.state_C + (size_t)sidx * 16384 + e);
    n4 = *(const f32x4*)(P.state_n + sidx * 128 + kn);
    m = P.state_m[sidx];
  }
  __syncthreads();
  if (hasn) m2_loop<NC, BLK, true>(dC, Cst, mst, sm, ubase, d, e, kn, tid == 0, C4, n4, m);
  else m2_loop<NC, BLK, false>(dC, Cst, mst, sm, ubase, d, e, kn, false, C4, n4, m);
  if (!lat) {
    *(f32x4*)(P.out + OUT_TAIL + (size_t)sidx * 16384 + e) = C4;
    if (hasn) { *(f32x4*)(P.out + OUT_TAIL + 2097152 + sidx * 128 + kn) = n4; if (tid == 0) P.out[OUT_TAIL + 2097152 + 16384 + sidx] = m; }
  }
  __syncthreads();
}
__device__ void phaseM2(const Params& P, float* sm) {
  for (int unit = blockIdx.x; unit < 1280; unit += gridDim.x) {
    if (unit < 256) m2_unit<32, 16>(P, true, unit >> 3, unit & 7, sm);
    else { const int v = unit - 256; m2_unit<2, 2>(P, false, v >> 3, v & 7, sm); }
  }
}

__device__ __forceinline__ bf16x8 scale_frag(bf16x8 q, float s) {
  const u32x4 a = __builtin_bit_cast(u32x4, q); u32x4 r;
  r.x = cvt_pk_bf16_c(bflo(a.x) * s, bfhi(a.x) * s); r.y = cvt_pk_bf16_c(bflo(a.y) * s, bfhi(a.y) * s);
  r.z = cvt_pk_bf16_c(bflo(a.z) * s, bfhi(a.z) * s); r.w = cvt_pk_bf16_c(bflo(a.w) * s, bfhi(a.w) * s);
  return __builtin_bit_cast(bf16x8, r);
}

__device__ void phaseM3(const Params& P, LAS unsigned char* lds) {
  const int tid = opaque_tid(), wid = tid >> 6, lane = tid & 63, fr = lane & 15, fq = lane >> 4;
  const bf16_t* Z = (const bf16_t*)(P.ws + WS_Z);
  const float* gates = (const float*)(P.ws + WS_GATES);
  const bf16_t* Cst = (const bf16_t*)(P.ws + WS_H);
  const float* mst = (const float*)(P.ws + WS_MST);
  bf16_t* ucat = (bf16_t*)(P.ws + WS_UCAT);
  LAS bf16_t* Ks = (LAS bf16_t*)lds;
  LAS bf16_t* VT = (LAS bf16_t*)(lds + 34816);
  LAS bf16_t* Sb = (LAS bf16_t*)(lds + 34816 + 36992);
  LAS float* arr = (LAS float*)(lds + 34816 + 36992 + 34816);
  LAS float* ecA = arr; LAS float* erA = arr + 256; LAS float* wiA = arr + 512; LAS float* flA = arr + 768;
  LAS bf16_t* Cb = (LAS bf16_t*)(lds + 34816 + 36992 + 34816 + 4096);
  const float qs = 0.08838834764831845f;
  for (int u = blockIdx.x; u < 640; u += gridDim.x) {
    int T0, nc, b, h, c; unit_info(u, T0, nc, b, h, c);
    if (wid < 2) {
      const int d = wid;
      ScanOut so; chunk_scan(gates, T0, h, d, lane, so);
      const float mc = mst[u * 2 + d];
      const float mx0 = fmaxf(mc, so.pm0), mx1 = fmaxf(mc, so.pm1);
      ecA[d * 128 + so.t0] = __expf(so.cf0 - so.cmax); ecA[d * 128 + so.t1] = __expf(so.cf1 - so.cmax);
      erA[d * 128 + so.t0] = __expf(so.cmax - mx0) * qs; erA[d * 128 + so.t1] = __expf(so.cmax - mx1) * qs;
      wiA[d * 128 + so.t0] = __expf(mc - mx0) * qs; wiA[d * 128 + so.t1] = __expf(mc - mx1) * qs;
      flA[d * 128 + so.t0] = __expf(-(so.beta0 + mx0)); flA[d * 128 + so.t1] = __expf(-(so.beta1 + mx1));
    }
    {
      const int kg = tid & 15;
#pragma unroll
      for (int i = 0; i < 2; ++i) {
        const int s = 2 * ((tid >> 4) + 32 * i);
        const bf16_t* zr = Z + (size_t)(T0 + s) * NZ + h * 128 + kg * 8;
        const u32x4 ka = *(const u32x4*)(zr + 2048), va = *(const u32x4*)(zr + 2560);
        const u32x4 kb = *(const u32x4*)(zr + NZ + 2048), vb = *(const u32x4*)(zr + NZ + 2560);
        *(LAS u32x4*)(Ks + s * LROW + kg * 8) = ka;
        *(LAS u32x4*)(Ks + (s + 1) * LROW + kg * 8) = kb;
#pragma unroll
        for (int q = 0; q < 4; ++q) {
          const int r0 = (kg * 8 + 2 * q) * LROW + s, r1 = r0 + LROW;
          *(LAS unsigned*)(VT + r0) = (va[q] & 0xffffu) | (vb[q] << 16);
          *(LAS unsigned*)(VT + r1) = (va[q] >> 16) | (vb[q] & 0xffff0000u);
        }
      }
      if (tid < 64) *(LAS unsigned*)(VT + 128 * LROW + 2 * tid) = 0x3F803F80u;
    }
    u32x4 creg[5];
    {
      const bf16_t* cs0 = Cst + (size_t)(u * 2) * CST_ELEMS;
#pragma unroll
      for (int i = 0; i < 4; ++i) creg[i] = *(const u32x4*)(cs0 + (tid + 512 * i) * 8);
      creg[4] = *(const u32x4*)(cs0 + 16384 + (tid & 15) * 8);
#pragma unroll
      for (int i = 0; i < 4; ++i) { const int ci = tid + 512 * i; *(LAS u32x4*)(Cb + (ci >> 4) * LROW + (ci & 15) * 8) = creg[i]; }
      if (tid < 16) *(LAS u32x4*)(Cb + 128 * LROW + tid * 8) = creg[4];
    }
    __syncthreads();
    {
      const bf16_t* cs1 = Cst + (size_t)(u * 2 + 1) * CST_ELEMS;
#pragma unroll
      for (int i = 0; i < 4; ++i) creg[i] = *(const u32x4*)(cs1 + (tid + 512 * i) * 8);
      creg[4] = *(const u32x4*)(cs1 + 16384 + (tid & 15) * 8);
    }
    {
      const int w = wid;
      bf16x8 Qf[4];
      { const bf16_t* qr = Z + (size_t)(T0 + 16 * w + fr) * NZ + 1536 + h * 128 + 8 * fq;
#pragma unroll
        for (int ks = 0; ks < 4; ++ks) Qf[ks] = *(const bf16x8*)(qr + 32 * ks); }
      f32x4 hsum[8];
#pragma unroll
      for (int vt = 0; vt < 8; ++vt) hsum[vt] = (f32x4){0.f, 0.f, 0.f, 0.f};
      LAS bf16_t* Sw = Sb + w * 16 * LROW;
#pragma unroll
      for (int d = 0; d < 2; ++d) {
        if (d == 1) {
          __syncthreads();
#pragma unroll
          for (int i = 0; i < 4; ++i) { const int ci = tid + 512 * i; *(LAS u32x4*)(Cb + (ci >> 4) * LROW + (ci & 15) * 8) = creg[i]; }
          if (tid < 16) *(LAS u32x4*)(Cb + 128 * LROW + tid * 8) = creg[4];
          __syncthreads();
        }
        const int lo = d ? w : 0, hi = d ? 7 : w;
        const int ks_lo = lo >> 1, ks_hi = hi >> 1;
        float er4[4];
#pragma unroll
        for (int j = 0; j < 4; ++j) er4[j] = erA[d * 128 + 16 * w + 4 * fq + j];
#pragma unroll
        for (int nt = 0; nt < 8; ++nt) {
          if (nt >= 2 * ks_lo && nt <= 2 * ks_hi + 1) {
            f32x4 a = (f32x4){0.f, 0.f, 0.f, 0.f};
            if (nt >= lo && nt <= hi) {
#pragma unroll
              for (int ks = 0; ks < 4; ++ks) { const bf16x8 Kf = *(const LAS bf16x8*)(Ks + (16 * nt + fr) * LROW + 32 * ks + 8 * fq); a = __builtin_amdgcn_mfma_f32_16x16x32_bf16(Qf[ks], Kf, a, 0, 0, 0); }
              const float ecv = ecA[d * 128 + 16 * nt + fr];
#pragma unroll
              for (int j = 0; j < 4; ++j) {
                float val = a[j] * er4[j] * ecv;
                if (nt == w) { const int tl = 4 * fq + j; const bool ok = d ? (fr >= tl) : (fr <= tl); val = ok ? val : 0.f; }
                a[j] = val;
              }
            }
#pragma unroll
            for (int j = 0; j < 4; ++j) { const float nb = dppf<0x12F>(a[j]); if ((fr & 1) == 0) *(LAS unsigned*)(Sw + (4 * fq + j) * LROW + 16 * nt + fr) = cvt_pk_bf16_c(a[j], nb); }
          }
        }
        asm volatile("s_waitcnt lgkmcnt(0)" ::: "memory");
        f32x4 ao[9];
#pragma unroll
        for (int vt = 0; vt < 9; ++vt) ao[vt] = (f32x4){0.f, 0.f, 0.f, 0.f};
        const bf16x8 zf = (bf16x8){0, 0, 0, 0, 0, 0, 0, 0};
#pragma unroll
        for (int ks = 0; ks < 4; ++ks) {
          if (ks >= ks_lo && ks <= ks_hi) {
            const bf16x8 Sf = *(const LAS bf16x8*)(Sw + fr * LROW + 32 * ks + 8 * fq);
#pragma unroll
            for (int vt = 0; vt < 9; ++vt) {
              bf16x8 Vf = *(const LAS bf16x8*)(VT + (vt < 8 ? 16 * vt + fr : 128) * LROW + 32 * ks + 8 * fq);
              if (vt == 8 && fr != 0) Vf = zf;
              ao[vt] = __builtin_amdgcn_mfma_f32_16x16x32_bf16(Sf, Vf, ao[vt], 0, 0, 0);
            }
          }
        }
        {
          const float wv = wiA[d * 128 + 16 * w + fr];
#pragma unroll
          for (int ks = 0; ks < 4; ++ks) {
            const bf16x8 Qs = scale_frag(Qf[ks], wv);
#pragma unroll
            for (int vt = 0; vt < 9; ++vt) {
              bf16x8 Cf = *(const LAS bf16x8*)(Cb + (vt < 8 ? 16 * vt + fr : 128) * LROW + 32 * ks + 8 * fq);
              if (vt == 8 && fr != 0) Cf = zf;
              ao[vt] = __builtin_amdgcn_mfma_f32_16x16x32_bf16(Qs, Cf, ao[vt], 0, 0, 0);
            }
          }
        }
#pragma unroll
        for (int j = 0; j < 4; ++j) {
          const float den = __shfl(ao[8][j], lane & 48);
          const float fl = flA[d * 128 + 16 * w + 4 * fq + j];
          const float inv = 1.0f / fmaxf(fabsf(den), fl);
#pragma unroll
          for (int vt = 0; vt < 8; ++vt) hsum[vt][j] += ao[vt][j] * inv;
        }
        asm volatile("" ::: "memory");
      }
#pragma unroll
      for (int j = 0; j < 4; ++j) {
        float ms = 0.f;
#pragma unroll
        for (int vt = 0; vt < 8; ++vt) ms += hsum[vt][j] * hsum[vt][j];
        ms += __shfl_xor(ms, 1); ms += __shfl_xor(ms, 2); ms += __shfl_xor(ms, 4); ms += __shfl_xor(ms, 8);
        const float r = rsqrtf(ms * (1.0f / 128.0f) + EPS);
        const int T = T0 + 16 * w + 4 * fq + j;
#pragma unroll
        for (int vt = 0; vt < 8; ++vt) {
          const int col = h * 128 + 16 * vt + fr;
          const float og = bf2f(Z[(size_t)T * NZ + 3072 + col]);
          const float val = hsum[vt][j] * r * P.mh_norm[col] * fast_sigmoid(og);
          ucat[(size_t)T * DM + 512 + col] = f2bf_c(val);
        }
      }
    }
    __syncthreads();
  }
}

__device__ void phase7(const Params& P) {
  const int tid7 = opaque_tid(); const int wid = tid7 >> 6, lane = tid7 & 63;
  const float* rss2 = (const float*)(P.ws + WS_RSS2);
  for (int T = blockIdx.x * 8 + wid; T < NTOK; T += gridDim.x * 8) {
    const float r = rsqrtf(rss2[T] * (1.0f / 1024.0f) + EPS);
    float* row = P.out + (size_t)T * DM;
#pragma unroll
    for (int i = 0; i < 4; ++i) { const int c = i * 256 + lane * 4; const f32x4 v = *(const f32x4*)(row + c); const f32x4 fn = *(const f32x4*)(P.final_norm + c); *(f32x4*)(row + c) = v * r * fn; }
  }
}

#define GSYNC() do { asm volatile("s_waitcnt vmcnt(0) lgkmcnt(0)" ::: "memory"); grid.sync(); } while (0)
__global__ void __launch_bounds__(512, 2) fwd_megakernel(Params P) {
  extern __shared__ __attribute__((aligned(16))) unsigned char shm[];
  cg::grid_group grid = cg::this_grid();
  LAS unsigned char* lds = (LAS unsigned char*)shm;
  float* smf = (float*)shm;
#define RUN_P2() { EpiZ E; E.Z = (bf16_t*)(P.ws + WS_Z); \
    gemm_phase<EpiZ>(lds, (const bf16_t*)(P.ws + WS_H), (const bf16_t*)(P.ws + WS_WIN), NTOK, NZ, DM, E); } GSYNC();
#define RUN_M() phaseM1(P, lds); shortconv_items(P); GSYNC(); phaseM2(P, smf); GSYNC(); phaseM3(P, lds); GSYNC();
#define RUN_P5() { EpiUp E; E.rowss1 = (const float*)(P.ws + WS_RSS1); E.sb = (const float*)(P.ws + WS_SB); E.cw = P.conv_ffn_w; E.cb = P.conv_ffn_b; E.act = (bf16_t*)(P.ws + WS_Z); \
    gemm_phase<EpiUp>(lds, (const bf16_t*)(P.ws + WS_H), (const bf16_t*)(P.ws + WS_WUP), NTOK, NUP, DM, E); } GSYNC();
  phase0a(P, smf);
  GSYNC();
  phase0b(P, smf);
  GSYNC();
  RUN_P2()
#if DUP == 2
  RUN_P2()
#endif
#if DUP == 21
  { EpiNone E; E.Z = (bf16_t*)(P.ws + WS_UCAT);
    gemm_phase<EpiNone>(lds, (const bf16_t*)(P.ws + WS_H), (const bf16_t*)(P.ws + WS_WIN), NTOK, NZ, DM, E); } GSYNC();
#endif
  RUN_M()
#if DUP == 3
  RUN_M()
#endif
#if DUP == 31
  phaseM1(P, lds); GSYNC();
#endif
#if DUP == 32
  phaseM2(P, smf); GSYNC();
#endif
#if DUP == 33
  phaseM3(P, lds); GSYNC();
#endif
#if DUP == 34
  shortconv_items(P); GSYNC();
#endif
#if DUP == 6
  RUN_P5()
#endif
  { EpiX1 E; E.xp = P.x_prompt; E.xs = P.x_sample; E.mod = (const float*)(P.ws + WS_MOD); E.norm2 = P.norm2; E.x1out = P.out; E.x1g = (bf16_t*)(P.ws + WS_H); E.rowss = (float*)(P.ws + WS_RSS1);
    gemm_phase<EpiX1>(lds, (const bf16_t*)(P.ws + WS_UCAT), (const bf16_t*)(P.ws + WS_WOUT), NTOK, DM, DM, E); }
  GSYNC();
  RUN_P5()
#if DUP == 5
  RUN_P5()
#endif
  { EpiDown E; E.mod = (const float*)(P.ws + WS_MOD); E.out = P.out; E.rowss2 = (float*)(P.ws + WS_RSS2);
    gemm_phase<EpiDown>(lds, (const bf16_t*)(P.ws + WS_Z), (const bf16_t*)(P.ws + WS_WDN), NTOK, DM, DFF, E); }
  GSYNC();
  phase7(P);
}

extern "C" void kernel_launch(void* const* d_in, const int* in_sizes, int n_in, void* d_out, int out_size, void* d_ws, size_t ws_size, hipStream_t stream) {
  static int grid_blocks = 0;
  if (!grid_blocks) {
    int dev = 0, cus = 0, per_cu = 0;
    hipGetDevice(&dev);
    hipDeviceGetAttribute(&cus, hipDeviceAttributeMultiprocessorCount, dev);
    hipFuncSetAttribute((const void*)fwd_megakernel, hipFuncAttributeMaxDynamicSharedMemorySize, LDS_BYTES);
    hipOccupancyMaxActiveBlocksPerMultiprocessor(&per_cu, (const void*)fwd_megakernel, 512, LDS_BYTES);
    (void)hipGetLastError();
    if (per_cu < 1) per_cu = 1;
    if (per_cu > 1) per_cu = 1;
    grid_blocks = cus * per_cu;
  }
  hipMemsetAsync(d_ws, 0, WS_ZERO_BYTES, stream);
  Params p{};
  const float** pp = (const float**)&p;
  for (int i = 0; i < 22; ++i) pp[i] = (const float*)d_in[i];
  p.out = (float*)d_out; p.ws = (unsigned char*)d_ws;
  void* args[] = {&p};
  hipError_t e = hipLaunchCooperativeKernel((const void*)fwd_megakernel, dim3(grid_blocks), dim3(512), args, LDS_BYTES, stream);
  if (e != hipSuccess) fprintf(stderr, "cooperative launch failed: %s (grid %d)\n", hipGetErrorString(e), grid_blocks);
}
```

```cpp
#include <hip/hip_runtime.h>
#include <hip/hip_cooperative_groups.h>
#include <cstdio>
namespace cg = cooperative_groups;

#ifndef DUP
#define DUP 0
#endif
#define LAS __attribute__((address_space(3)))
typedef unsigned short bf16_t;
typedef short bf16x8 __attribute__((ext_vector_type(8)));
typedef float f32x4 __attribute__((ext_vector_type(4)));
typedef unsigned u32x2 __attribute__((ext_vector_type(2)));
typedef unsigned u32x4 __attribute__((ext_vector_type(4)));

constexpr int DM = 1024, NTOK = 20480, NCTXT = 4096, DIN = 3600, NZ = 3584, DFF = 2816, NUP = 5632, NMOD = 6144;
constexpr float EPS = 1e-6f;
constexpr size_t WS_MOD = 0, WS_SB = 122880, WS_RSS1 = 235520, WS_RSS2 = 317440, WS_ZERO_BYTES = 399360;
constexpr size_t WS_GATES = 399360, WS_STAT = 1710080, WS_MST = 1720320;
constexpr size_t WS_WIN = 2097152, WS_WOUT = 9437184, WS_WUP = 11534336, WS_WDN = 23068672;
constexpr size_t WS_H = 28835840;
constexpr size_t WS_UCAT = 71106560;
constexpr size_t WS_Z = 113049600;
constexpr int OUT_TAIL = 20971520;
constexpr int LDS_BYTES = 146432;

struct Params {
  const float *x_prompt, *x_sample, *state_C, *state_n, *state_m, *c, *c_ctx, *w_mod, *b_mod, *norm1, *w_in, *b_gate,
      *conv_sc_w, *conv_sc_b, *mh_norm, *w_out, *norm2, *w_up, *conv_ffn_w, *conv_ffn_b, *w_down, *final_norm;
  float* out; unsigned char* ws;
};

typedef __bf16 bf16x2_n __attribute__((ext_vector_type(2)));
typedef float f32x2_n __attribute__((ext_vector_type(2)));
__device__ __forceinline__ unsigned cvt_pk_bf16_c(float lo, float hi) { const f32x2_n v = {lo, hi}; return __builtin_bit_cast(unsigned, __builtin_convertvector(v, bf16x2_n)); }
__device__ __forceinline__ unsigned cvt_pk_bf16(float lo, float hi) { unsigned r; asm("v_cvt_pk_bf16_f32 %0, %1, %2" : "=v"(r) : "v"(lo), "v"(hi)); return r; }
__device__ __forceinline__ bf16_t f2bf_c(float f) { return (bf16_t)(cvt_pk_bf16_c(f, 0.f) & 0xffffu); }
__device__ __forceinline__ bf16_t f2bf(float f) { return (bf16_t)(cvt_pk_bf16(f, 0.f) & 0xffffu); }
__device__ __forceinline__ float bf2f(bf16_t b) { return __uint_as_float(((unsigned)b) << 16); }
__device__ __forceinline__ float bflo(unsigned u) { return __uint_as_float(u << 16); }
__device__ __forceinline__ float bfhi(unsigned u) { return __uint_as_float(u & 0xffff0000u); }
__device__ __forceinline__ int permtok(int T) { if (T < NCTXT) return T; const int q = T - NCTXT; return NCTXT + (q & ~4095) + ((q & 63) << 6) + ((q >> 6) & 63); }
template <int CTRL> __device__ __forceinline__ float dppf(float x) { return __builtin_bit_cast(float, __builtin_amdgcn_mov_dpp(__builtin_bit_cast(int, x), CTRL, 0xf, 0xf, true)); }
__device__ __forceinline__ float fast_sigmoid(float x) { return __builtin_amdgcn_rcpf(1.0f + __expf(-x)); }

__device__ __forceinline__ int opaque_tid() { int t = threadIdx.x; asm volatile("" : "+v"(t)); return t; }

constexpr int BM = 256, BK = 64, HALF = 128, HTB = HALF * BK * 2, NXCD = 8, WGM = 8;
__device__ __forceinline__ int lds_byte(int r, int c) { const int st = (r >> 4) * 2 + (c >> 5), rr = r & 15, cc = c & 31, ob = rr * 64 + cc * 2; return st * 1024 + (ob ^ (((ob >> 9) & 1) << 5)); }
__device__ __forceinline__ void stage_rc(int b, int& R, int& C) { const int st = b / 1024, sb = b % 1024, swz = sb ^ (((sb >> 9) & 1) << 5); R = (st >> 1) * 16 + swz / 64; C = (st & 1) * 32 + (swz % 64) / 2; }

struct Order {
  int nM, nN, nwg, G, c;
  __device__ __forceinline__ void init(int M, int N) { nM = M / BM; nN = N / BM; nwg = nM * nN; G = gridDim.x; c = blockIdx.x; }
  __device__ __forceinline__ bool next(int i, int& pm, int& pn) const {
    const long L = (long)i * G + c; if (L >= nwg) return false;
    int wgid = (int)L; { const int q = nwg / NXCD, r = nwg % NXCD, xcd = wgid % NXCD, off = wgid / NXCD; wgid = (xcd < r ? xcd * (q + 1) : r * (q + 1) + (xcd - r) * q) + off; }
    const int nig = WGM * nN, gid = wgid / nig, fm = gid * WGM, gsz = (nM - fm) < WGM ? (nM - fm) : WGM;
    pm = fm + ((wgid % nig) % gsz); pn = (wgid % nig) / gsz; return true;
  }
};

template <class Epi>
__device__ __forceinline__ void gemm_phase(LAS unsigned char* lds, const bf16_t* gA, const bf16_t* gBt, int M, int N, int K, const Epi& E) {
  const int tid = opaque_tid(), wid = __builtin_amdgcn_readfirstlane(tid >> 6), lane = tid & 63, wr = wid >> 2, wc = wid & 3, fr = lane & 15, fq = lane >> 4;
  const int nt = K / BK;
  Order S; S.init(M, N);
  unsigned voffA[2];
#pragma unroll
  for (int i = 0; i < 2; ++i) { int R, C; stage_rc(tid * 16 + i * 8192, R, C); voffA[i] = (unsigned)(R * K + C) * 2u; }
  const size_t kstep = (size_t)(BK * 2);
  const size_t hstep = (size_t)HALF * K * 2;
  const size_t tstep = 2 * hstep;
  const unsigned ldsw = (unsigned)wid * 1024u;
  const int aoff = lds_byte(wr * 64 + fr, fq * 8), boff = lds_byte(wc * 32 + fr, fq * 8);
#define G_SA(b, h) (((b) * 2 + (h)) * HTB)
#define G_SB(b, h) ((4 + (b) * 2 + (h)) * HTB)
#define G_STAGE(bufoff, gbase) do { _Pragma("unroll") for (int _i = 0; _i < 2; ++_i) \
    __builtin_amdgcn_global_load_lds((const unsigned*)((const char*)(gbase) + voffA[_i]), (LAS unsigned*)(lds + (bufoff) + ldsw + _i * 8192), 16, 0, 0); } while (0)
#define G_LDA(dst, b, h) do { _Pragma("unroll") for (int m = 0; m < 4; ++m) _Pragma("unroll") for (int k = 0; k < 2; ++k) dst[m][k] = *(const LAS bf16x8*)(lds + G_SA(b, h) + aoff + m * 2048 + k * 1024); } while (0)
#define G_LDB(dst, b, h) do { _Pragma("unroll") for (int n = 0; n < 2; ++n) _Pragma("unroll") for (int k = 0; k < 2; ++k) dst[n][k] = *(const LAS bf16x8*)(lds + G_SB(b, h) + boff + n * 2048 + k * 1024); } while (0)
#define G_MMA(ai, bj, At, Bt) do { __builtin_amdgcn_s_setprio(1); _Pragma("unroll") for (int m = 0; m < 4; ++m) _Pragma("unroll") for (int n = 0; n < 2; ++n) _Pragma("unroll") for (int k = 0; k < 2; ++k) \
    acc[ai][bj][m][n] = __builtin_amdgcn_mfma_f32_16x16x32_bf16(Bt[n][k], At[m][k], acc[ai][bj][m][n], 0, 0, 0); __builtin_amdgcn_s_setprio(0); } while (0)
#define G_WAIT_V(n) asm volatile("s_waitcnt vmcnt(" #n ")" ::: "memory")
#define G_WAIT_L(n) asm volatile("s_waitcnt lgkmcnt(" #n ")" ::: "memory")
#define G_BAR __builtin_amdgcn_s_barrier()
#define G_SCHED __builtin_amdgcn_sched_barrier(0)
  int cpm, cpn, npm = 0, npn = 0, ui = 0;
  if (!S.next(0, cpm, cpn)) return;
  f32x4 acc[2][2][4][2];
#pragma unroll
  for (int a = 0; a < 2; ++a)
#pragma unroll
    for (int b = 0; b < 2; ++b)
#pragma unroll
      for (int m = 0; m < 4; ++m)
#pragma unroll
        for (int n = 0; n < 2; ++n) acc[a][b][m][n] = (f32x4){0.f, 0.f, 0.f, 0.f};
  bf16x8 At[4][2], B0[2][2], B1[2][2];
  const char* cA = (const char*)gA + (size_t)cpm * tstep; const char* cB = (const char*)gBt + (size_t)cpn * tstep;
  G_STAGE(G_SB(0, 0), cB); G_STAGE(G_SA(0, 0), cA); G_STAGE(G_SB(0, 1), cB + hstep); G_STAGE(G_SA(0, 1), cA + hstep);
  if (wr == 1) G_BAR;
  G_WAIT_V(4); G_BAR;
  G_STAGE(G_SB(1, 0), cB + kstep); G_STAGE(G_SA(1, 0), cA + kstep); G_STAGE(G_SB(1, 1), cB + hstep + kstep);
  G_WAIT_V(6); G_BAR;
  for (;;) {
    const bool has_next = S.next(ui + 1, npm, npn);
    const char* nA = has_next ? (const char*)gA + (size_t)npm * tstep : cA; const char* nB = has_next ? (const char*)gBt + (size_t)npn * tstep : cB;
    for (int t = 0; t < nt; t += 2) {
      const bool last = (t == nt - 2);
      const char* a1 = cA + (size_t)(t + 1) * kstep;
      const char* a2 = last ? nA : cA + (size_t)(t + 2) * kstep; const char* b2 = last ? nB : cB + (size_t)(t + 2) * kstep;
      const char* a3 = a2 + kstep; const char* b3 = b2 + kstep;
      G_LDB(B0, 0, 0); G_SCHED; G_LDA(At, 0, 0); G_STAGE(G_SA(1, 1), a1 + hstep);
      G_WAIT_L(8); G_BAR; G_WAIT_L(0); G_MMA(0, 0, At, B0); G_BAR; G_SCHED;
      G_LDB(B1, 0, 1); G_STAGE(G_SB(0, 0), b2);
      G_BAR; G_WAIT_L(0); G_MMA(0, 1, At, B1); G_BAR;
      G_LDA(At, 0, 1); G_STAGE(G_SA(0, 0), a2);
      G_BAR; G_WAIT_L(0); G_MMA(1, 0, At, B0); G_BAR; G_SCHED;
      G_STAGE(G_SB(0, 1), b2 + hstep);
      G_WAIT_V(6); G_BAR; G_MMA(1, 1, At, B1); G_BAR;
      G_LDB(B0, 1, 0); G_SCHED; G_LDA(At, 1, 0); G_STAGE(G_SA(0, 1), a2 + hstep);
      G_WAIT_L(8); G_BAR; G_WAIT_L(0); G_MMA(0, 0, At, B0); G_BAR; G_SCHED;
      G_LDB(B1, 1, 1); G_STAGE(G_SB(1, 0), b3);
      G_BAR; G_WAIT_L(0); G_MMA(0, 1, At, B1); G_BAR;
      G_LDA(At, 1, 1); G_STAGE(G_SA(1, 0), a3);
      G_BAR; G_WAIT_L(0); G_MMA(1, 0, At, B0); G_BAR; G_SCHED;
      G_STAGE(G_SB(1, 1), b3 + hstep);
      G_WAIT_V(6); G_BAR; G_MMA(1, 1, At, B1); G_BAR;
    }
    asm volatile("s_nop 15\n\ts_nop 15" ::: "memory");
    E(acc, cpm, cpn, wr, wc, fr, fq, lds);
    if (!has_next) break;
#pragma unroll
    for (int a = 0; a < 2; ++a)
#pragma unroll
      for (int b = 0; b < 2; ++b)
#pragma unroll
        for (int m = 0; m < 4; ++m)
#pragma unroll
          for (int n = 0; n < 2; ++n) acc[a][b][m][n] = (f32x4){0.f, 0.f, 0.f, 0.f};
    cpm = npm; cpn = npn; cA = nA; cB = nB; ++ui;
  }
  G_WAIT_V(0);
  if (wr == 0) G_BAR;
  G_BAR;
}

struct EpiZ {
  bf16_t* Z;
  __device__ __forceinline__ void operator()(f32x4 (&acc)[2][2][4][2], int pm, int pn, int wr, int wc, int fr, int fq, LAS unsigned char*) const {
    const int row0 = pm * BM + wr * 64 + fr, col0 = pn * BM + wc * 32 + 8 * fq;
#pragma unroll
    for (int ai = 0; ai < 2; ++ai)
#pragma unroll
      for (int m = 0; m < 4; ++m) {
        bf16_t* rowp = Z + (size_t)(row0 + ai * HALF + m * 16) * NZ + col0;
#pragma unroll
        for (int bj = 0; bj < 2; ++bj) { const f32x4 v0 = acc[ai][bj][m][0], v1 = acc[ai][bj][m][1];
          u32x4 o; o.x = cvt_pk_bf16(v0[0], v0[1]); o.y = cvt_pk_bf16(v0[2], v0[3]); o.z = cvt_pk_bf16(v1[0], v1[1]); o.w = cvt_pk_bf16(v1[2], v1[3]);
          *(u32x4*)(rowp + bj * HALF) = o; }
      }
  }
};

struct EpiNone {
  bf16_t* Z;
  __device__ __forceinline__ void operator()(f32x4 (&acc)[2][2][4][2], int pm, int pn, int wr, int wc, int fr, int fq, LAS unsigned char*) const {
    f32x4 s = (f32x4){0.f, 0.f, 0.f, 0.f};
#pragma unroll
    for (int ai = 0; ai < 2; ++ai)
#pragma unroll
      for (int bj = 0; bj < 2; ++bj)
#pragma unroll
        for (int m = 0; m < 4; ++m)
#pragma unroll
          for (int n = 0; n < 2; ++n) s += acc[ai][bj][m][n];
    if (s[0] + s[1] + s[2] + s[3] == 12345.678f) Z[pm + pn] = 1;
  }
};

struct EpiX1 {
  const float* xp; const float* xs; const float* mod; const float* norm2; float* x1out; bf16_t* x1g; float* rowss;
  __device__ __forceinline__ void operator()(f32x4 (&acc)[2][2][4][2], int pm, int pn, int wr, int wc, int fr, int fq, LAS unsigned char*) const {
    const int g = pm < 16 ? 4 : ((pm - 16) >> 4);
    const float* modg = mod + g * NMOD;
    const int col0 = pn * BM + wc * 32 + 4 * fq;
    f32x4 g1[2][2], g2[2][2];
#pragma unroll
    for (int bj = 0; bj < 2; ++bj)
#pragma unroll
      for (int n = 0; n < 2; ++n) { const int c = col0 + bj * HALF + n * 16; g1[bj][n] = *(const f32x4*)(modg + 2048 + c); const f32x4 s2 = *(const f32x4*)(modg + 4096 + c); const f32x4 nv = *(const f32x4*)(norm2 + c); g2[bj][n] = nv * (s2 + 1.0f); }
#pragma unroll
    for (int ai = 0; ai < 2; ++ai)
#pragma unroll
      for (int m = 0; m < 4; ++m) {
        const int T = pm * BM + ai * HALF + wr * 64 + m * 16 + fr;
        const float* xrow = (T < NCTXT) ? xp + (size_t)T * DM : xs + (size_t)(T - NCTXT) * DM;
        const int p = permtok(T);
        float ss = 0.f;
#pragma unroll
        for (int bj = 0; bj < 2; ++bj)
#pragma unroll
          for (int n = 0; n < 2; ++n) {
            const int c = col0 + bj * HALF + n * 16;
            const f32x4 xv = *(const f32x4*)(xrow + c);
            const f32x4 v = xv + g1[bj][n] * acc[ai][bj][m][n];
            *(f32x4*)(x1out + (size_t)T * DM + c) = v;
            ss += v[0] * v[0] + v[1] * v[1] + v[2] * v[2] + v[3] * v[3];
            const f32x4 w = v * g2[bj][n];
            u32x2 o; o.x = cvt_pk_bf16(w[0], w[1]); o.y = cvt_pk_bf16(w[2], w[3]);
            *(u32x2*)(x1g + (size_t)p * DM + c) = o;
          }
        ss += __shfl_xor(ss, 16); ss += __shfl_xor(ss, 32);
        if (fq == 0) __hip_atomic_fetch_add(rowss + p, ss, __ATOMIC_RELAXED, __HIP_MEMORY_SCOPE_AGENT);
      }
  }
};

struct EpiDown {
  const float* mod; float* out; float* rowss2;
  __device__ __forceinline__ void operator()(f32x4 (&acc)[2][2][4][2], int pm, int pn, int wr, int wc, int fr, int fq, LAS unsigned char*) const {
    const int g = pm < 16 ? 4 : ((pm - 16) >> 4);
    const float* modg = mod + g * NMOD;
    const int col0 = pn * BM + wc * 32 + 4 * fq;
    f32x4 g2[2][2];
#pragma unroll
    for (int bj = 0; bj < 2; ++bj)
#pragma unroll
      for (int n = 0; n < 2; ++n) g2[bj][n] = *(const f32x4*)(modg + 5120 + col0 + bj * HALF + n * 16);
#pragma unroll
    for (int ai = 0; ai < 2; ++ai)
#pragma unroll
      for (int m = 0; m < 4; ++m) {
        const int p = pm * BM + ai * HALF + wr * 64 + m * 16 + fr;
        const int T = permtok(p);
        float* orow = out + (size_t)T * DM;
        float ss = 0.f;
#pragma unroll
        for (int bj = 0; bj < 2; ++bj)
#pragma unroll
          for (int n = 0; n < 2; ++n) {
            const int c = col0 + bj * HALF + n * 16;
            const f32x4 xv = *(const f32x4*)(orow + c);
            const f32x4 v = xv + g2[bj][n] * acc[ai][bj][m][n];
            *(f32x4*)(orow + c) = v;
            ss += v[0] * v[0] + v[1] * v[1] + v[2] * v[2] + v[3] * v[3];
          }
        ss += __shfl_xor(ss, 16); ss += __shfl_xor(ss, 32);
        if (fq == 0) __hip_atomic_fetch_add(rowss2 + T, ss, __ATOMIC_RELAXED, __HIP_MEMORY_SCOPE_AGENT);
      }
  }
};

struct EpiUp {
  const float* rowss1; const float* sb; const float* cw; const float* cb; bf16_t* act;
  __device__ __forceinline__ void operator()(f32x4 (&acc)[2][2][4][2], int pm, int pn, int wr, int wc, int fr, int fq, LAS unsigned char* lds) const {
    asm volatile("" : "+v"(fr), "+v"(fq));
    const bool ctx = pm < 16;
    const int g = ctx ? 4 : ((pm - 16) >> 4);
    const float* sbg = sb + g * NUP;
    LAS float* halo = (LAS float*)(lds + 131072);
    const int prow0 = pm * BM + wr * 64 + fr;
    {
      float rs[2][4];
#pragma unroll
      for (int ai = 0; ai < 2; ++ai)
#pragma unroll
        for (int m = 0; m < 4; ++m) rs[ai][m] = __builtin_amdgcn_rsqf(rowss1[prow0 + ai * HALF + m * 16] * (1.0f / 1024.0f) + EPS);
#pragma unroll
      for (int bj = 0; bj < 2; ++bj)
#pragma unroll
        for (int n = 0; n < 2; ++n) {
          asm volatile("" ::: "memory"); __builtin_amdgcn_sched_barrier(0);
          const f32x4 sv = *(const f32x4*)(sbg + bj * DFF + pn * HALF + wc * 32 + 8 * fq + 4 * n);
#pragma unroll
          for (int ai = 0; ai < 2; ++ai)
#pragma unroll
            for (int m = 0; m < 4; ++m) { acc[ai][bj][m][n] = acc[ai][bj][m][n] * rs[ai][m] + sv; asm volatile("" : "+v"(acc[ai][bj][m][n])); }
        }
    }
    if (ctx) {
#pragma unroll
      for (int ai = 0; ai < 2; ++ai)
#pragma unroll
        for (int bj = 0; bj < 2; ++bj)
#pragma unroll
          for (int n = 0; n < 2; ++n) {
            const int rb = 2 * ai + wr, colt = bj * HALF + wc * 32 + 8 * fq + 4 * n;
            if (fr == 0) *(LAS f32x4*)(halo + (rb * 2 + 0) * 256 + colt) = acc[ai][bj][0][n];
            if (fr == 15) *(LAS f32x4*)(halo + (rb * 2 + 1) * 256 + colt) = acc[ai][bj][3][n];
          }
      asm volatile("s_waitcnt lgkmcnt(0)" ::: "memory");
      __builtin_amdgcn_s_barrier();
      __builtin_amdgcn_s_barrier();
      asm volatile("" ::: "memory");
    }
#pragma unroll
    for (int ai = 0; ai < 2; ++ai) {
      u32x2 st[4];
#pragma unroll
      for (int n = 0; n < 2; ++n) {
        f32x4 ya[4];
        const int rb = 2 * ai + wr;
#pragma unroll
        for (int bj = 0; bj < 2; ++bj) {
          asm volatile("" ::: "memory"); __builtin_amdgcn_sched_barrier(0);
          const int cnat = bj * DFF + pn * HALF + wc * 32 + 8 * fq + 4 * n, colt = bj * HALF + wc * 32 + 8 * fq + 4 * n;
          const f32x4 w0 = *(const f32x4*)(cw + cnat), w1 = *(const f32x4*)(cw + NUP + cnat), w2 = *(const f32x4*)(cw + 2 * NUP + cnat), bb = *(const f32x4*)(cb + cnat);
          f32x4 hp = (f32x4){0.f, 0.f, 0.f, 0.f}, hn = hp;
          if (ctx) {
            if (rb > 0) hp = *(const LAS f32x4*)(halo + ((rb - 1) * 2 + 1) * 256 + colt);
            if (rb < 3) hn = *(const LAS f32x4*)(halo + ((rb + 1) * 2 + 0) * 256 + colt);
          }
#pragma unroll
          for (int m = 0; m < 4; ++m) {
            const f32x4 cur = acc[ai][bj][m][n];
            f32x4 prev, next;
#pragma unroll
            for (int e = 0; e < 4; ++e) {
              if (m > 0) { const float snd = (fr == 15) ? acc[ai][bj][m > 0 ? m - 1 : 0][n][e] : cur[e]; prev[e] = dppf<0x121>(snd); }
              else { const float rcv = dppf<0x121>(cur[e]); prev[e] = (fr == 0) ? hp[e] : rcv; }
              if (m < 3) { const float snd = (fr == 0) ? acc[ai][bj][m < 3 ? m + 1 : 3][n][e] : cur[e]; next[e] = dppf<0x12F>(snd); }
              else { const float rcv = dppf<0x12F>(cur[e]); next[e] = (fr == 15) ? hn[e] : rcv; }
            }
            const f32x4 y = w0 * prev + w1 * cur + w2 * next + bb;
            if (bj == 0) ya[m] = y;
            else {
              float o[4];
#pragma unroll
              for (int e = 0; e < 4; ++e) o[e] = y[e] * fast_sigmoid(y[e]) * ya[m][e];
              u32x2 ov; ov.x = cvt_pk_bf16(o[0], o[1]); ov.y = cvt_pk_bf16(o[2], o[3]);
              if (n == 0) st[m] = ov;
              else { u32x4 o4; o4.x = st[m].x; o4.y = st[m].y; o4.z = ov.x; o4.w = ov.y;
                *(u32x4*)(act + (size_t)(prow0 + ai * HALF + m * 16) * DFF + pn * HALF + wc * 32 + 8 * fq) = o4; }
            }
          }
        }
      }
    }
  }
};

template <bool SILU>
__device__ __forceinline__ void gemv5_unit(const Params& P, int unit, int ncb, const float* W, int ldw, float* outp, int ldo, const float* bias, const float* modv, float* sm) {
  const int tid = opaque_tid();
  const int cb = unit % ncb, ks = unit / ncb, n0 = cb * 256, k0 = ks * 128;
  float* sv = sm; float* red = sm + 640;
  for (int i = tid; i < 640; i += 512) {
    const int g = i >> 7, k = k0 + (i & 127);
    float v;
    if (SILU) { v = (g < 4) ? P.c[g * DM + k] : P.c_ctx[k]; v = v / (1.0f + __expf(-v)); }
    else v = modv[g * NMOD + 3072 + k];
    sv[i] = v;
  }
  __syncthreads();
  const int col = tid & 255, kh = tid >> 8;
  float a0 = 0.f, a1 = 0.f, a2 = 0.f, a3 = 0.f, a4 = 0.f;
  const float* wp = W + (size_t)(k0 + kh * 64) * ldw + n0 + col;
#pragma unroll 8
  for (int kk = 0; kk < 64; ++kk) {
    const float w = wp[(size_t)kk * ldw];
    const int ki = kh * 64 + kk;
    a0 += sv[ki] * w; a1 += sv[128 + ki] * w; a2 += sv[256 + ki] * w; a3 += sv[384 + ki] * w; a4 += sv[512 + ki] * w;
  }
  if (kh == 1) { red[col] = a0; red[256 + col] = a1; red[512 + col] = a2; red[768 + col] = a3; red[1024 + col] = a4; }
  __syncthreads();
  if (kh == 0) {
    const float bv = (bias != nullptr && ks == 0) ? bias[n0 + col] : 0.f;
    a0 += red[col] + bv; a1 += red[256 + col] + bv; a2 += red[512 + col] + bv; a3 += red[768 + col] + bv; a4 += red[1024 + col] + bv;
    float* o = outp + n0 + col;
    __hip_atomic_fetch_add(o, a0, __ATOMIC_RELAXED, __HIP_MEMORY_SCOPE_AGENT);
    __hip_atomic_fetch_add(o + ldo, a1, __ATOMIC_RELAXED, __HIP_MEMORY_SCOPE_AGENT);
    __hip_atomic_fetch_add(o + 2 * ldo, a2, __ATOMIC_RELAXED, __HIP_MEMORY_SCOPE_AGENT);
    __hip_atomic_fetch_add(o + 3 * ldo, a3, __ATOMIC_RELAXED, __HIP_MEMORY_SCOPE_AGENT);
    __hip_atomic_fetch_add(o + 4 * ldo, a4, __ATOMIC_RELAXED, __HIP_MEMORY_SCOPE_AGENT);
  }
  __syncthreads();
}

struct TrUnit { const float* src; bf16_t* dst; int ldw, ldd, perm; };
__device__ __forceinline__ void tr_decode(const Params& P, int v, TrUnit& t) {
  bf16_t* WinT = (bf16_t*)(P.ws + WS_WIN); bf16_t* WoutT = (bf16_t*)(P.ws + WS_WOUT); bf16_t* WupT = (bf16_t*)(P.ws + WS_WUP); bf16_t* WdnT = (bf16_t*)(P.ws + WS_WDN);
  if (v < 896) { const int kt = v / 56, ntl = v % 56; t.src = P.w_in + (size_t)(kt * 64) * DIN + ntl * 64; t.ldw = DIN; t.dst = WinT + (size_t)(ntl * 64) * DM + kt * 64; t.ldd = DM; t.perm = 1; }
  else if (v < 1152) { const int w = v - 896, kt = w >> 4, ntl = w & 15; t.src = P.w_out + (size_t)(kt * 64) * DM + ntl * 64; t.ldw = DM; t.dst = WoutT + (size_t)(ntl * 64) * DM + kt * 64; t.ldd = DM; t.perm = 0; }
  else if (v < 2560) { const int w = v - 1152, kt = w / 88, ntl = w % 88; const int n0 = ntl * 64, half = n0 / DFF, r = n0 % DFF, pn = r >> 7, cc = r & 127;
    t.src = P.w_up + (size_t)(kt * 64) * NUP + n0; t.ldw = NUP; t.dst = WupT + (size_t)(pn * 256 + half * 128 + cc) * DM + kt * 64; t.ldd = DM; t.perm = 1; }
  else { const int w = v - 2560, kt = w >> 4, ntl = w & 15; t.src = P.w_down + (size_t)(kt * 64) * DM + ntl * 64; t.ldw = DM; t.dst = WdnT + (size_t)(ntl * 64) * DFF + kt * 64; t.ldd = DFF; t.perm = 0; }
}
__device__ void phase0a(const Params& P, float* sm) {
  const int tid = opaque_tid();
  float* mod = (float*)(P.ws + WS_MOD);
  for (int u = blockIdx.x; u < 24 * 8; u += gridDim.x) gemv5_unit<true>(P, u, 24, P.w_mod, NMOD, mod, NMOD, P.b_mod, nullptr, sm);
  constexpr int NTR = 896 + 256 + 1408 + 704;
  const int r = tid >> 4, c4 = (tid & 15) * 4, nn = tid >> 3, kk8 = (tid & 7) * 8;
  float* tile = sm;
  int v = gridDim.x - 1 - blockIdx.x;
  f32x4 p0 = (f32x4){0.f, 0.f, 0.f, 0.f}, p1 = p0; TrUnit cur;
  if (v < NTR) { tr_decode(P, v, cur); p0 = *(const f32x4*)(cur.src + (size_t)r * cur.ldw + c4); p1 = *(const f32x4*)(cur.src + (size_t)(r + 32) * cur.ldw + c4); }
  while (v < NTR) {
    { float* t = tile + r * 65 + c4; t[0] = p0[0]; t[1] = p0[1]; t[2] = p0[2]; t[3] = p0[3]; t += 32 * 65; t[0] = p1[0]; t[1] = p1[1]; t[2] = p1[2]; t[3] = p1[3]; }
    const int vn = v + gridDim.x; TrUnit nxt = cur;
    if (vn < NTR) tr_decode(P, vn, nxt);
    p0 = *(const f32x4*)(nxt.src + (size_t)r * nxt.ldw + c4); p1 = *(const f32x4*)(nxt.src + (size_t)(r + 32) * nxt.ldw + c4);
    __syncthreads();
    { float vv[8];
#pragma unroll
      for (int j = 0; j < 8; ++j) vv[j] = tile[(kk8 + j) * 65 + nn];
      u32x4 o; o.x = cvt_pk_bf16(vv[0], vv[1]); o.y = cvt_pk_bf16(vv[2], vv[3]); o.z = cvt_pk_bf16(vv[4], vv[5]); o.w = cvt_pk_bf16(vv[6], vv[7]);
      const int c5 = nn & 31, nnp = cur.perm ? ((nn & 32) + ((c5 >> 2) & 1) * 16 + (c5 >> 3) * 4 + (c5 & 3)) : nn;
      *(u32x4*)(cur.dst + (size_t)nnp * cur.ldd + kk8) = o; }
    __syncthreads();
    cur = nxt; v = vn;
  }
}

__device__ void phase0b(const Params& P, float* sm) {
  const int tid = opaque_tid(), wid = tid >> 6, lane = tid & 63;
  const float* mod = (const float*)(P.ws + WS_MOD);
  float* sbv = (float*)(P.ws + WS_SB);
  float* gates = (float*)(P.ws + WS_GATES);
  bf16_t* H = (bf16_t*)(P.ws + WS_H);
  for (int u = blockIdx.x; u < 22 * 8; u += gridDim.x) gemv5_unit<false>(P, u, 22, P.w_up, NUP, sbv, NUP, nullptr, mod, sm + 16384);
  for (int i0 = 0; i0 < 32; i0 += 8) {
    float wv[8];
#pragma unroll
    for (int i = 0; i < 8; ++i) { const int idx = tid + 512 * (i0 + i); wv[i] = P.w_in[(size_t)(idx >> 4) * DIN + NZ + (idx & 15)]; }
#pragma unroll
    for (int i = 0; i < 8; ++i) { const int idx = tid + 512 * (i0 + i); sm[(idx & 15) * 1024 + (idx >> 4)] = wv[i]; }
  }
  __syncthreads();
  f32x4 xnext[4];
  { const int Tn = blockIdx.x * 8 + wid; const float* xr = (Tn < NCTXT) ? P.x_prompt + (size_t)Tn * DM : P.x_sample + (size_t)(Tn - NCTXT) * DM;
#pragma unroll
    for (int i = 0; i < 4; ++i) xnext[i] = *(const f32x4*)(xr + i * 256 + lane * 4); }
  for (int T = blockIdx.x * 8 + wid; T < NTOK; T += gridDim.x * 8) {
    const int g = T < NCTXT ? 4 : ((T - NCTXT) >> 12);
    const float* modg = mod + g * NMOD;
    f32x4 xv[4]; float ss = 0.f;
#pragma unroll
    for (int i = 0; i < 4; ++i) xv[i] = xnext[i];
    { int Tn = T + gridDim.x * 8; Tn = Tn < NTOK ? Tn : T;
      const float* xr = (Tn < NCTXT) ? P.x_prompt + (size_t)Tn * DM : P.x_sample + (size_t)(Tn - NCTXT) * DM;
#pragma unroll
      for (int i = 0; i < 4; ++i) xnext[i] = *(const f32x4*)(xr + i * 256 + lane * 4); }
#pragma unroll
    for (int i = 0; i < 4; ++i) ss += xv[i][0] * xv[i][0] + xv[i][1] * xv[i][1] + xv[i][2] * xv[i][2] + xv[i][3] * xv[i][3];
#pragma unroll
    for (int o = 1; o < 64; o <<= 1) ss += __shfl_xor(ss, o);
    const float rstd = rsqrtf(ss * (1.0f / 1024.0f) + EPS);
    f32x4 hv[4];
#pragma unroll
    for (int i = 0; i < 4; ++i) {
      const int c = i * 256 + lane * 4;
      const f32x4 nv = *(const f32x4*)(P.norm1 + c), sc = *(const f32x4*)(modg + 1024 + c), sh = *(const f32x4*)(modg + c);
      hv[i] = xv[i] * rstd * nv * (sc + 1.0f) + sh;
      u32x2 o; o.x = cvt_pk_bf16(hv[i][0], hv[i][1]); o.y = cvt_pk_bf16(hv[i][2], hv[i][3]);
      *(u32x2*)(H + (size_t)T * DM + c) = o;
    }
    float v[16];
#pragma unroll
    for (int gi = 0; gi < 16; ++gi) {
      float a = 0.f;
#pragma unroll
      for (int i = 0; i < 4; ++i) { const f32x4 w = *(const f32x4*)(sm + gi * 1024 + i * 256 + lane * 4); a += hv[i][0] * w[0] + hv[i][1] * w[1] + hv[i][2] * w[2] + hv[i][3] * w[3]; }
      v[gi] = a;
    }
#pragma unroll
    for (int j = 0; j < 8; ++j) { const bool hi = lane & 32; const float keep = hi ? v[j + 8] : v[j], send = hi ? v[j] : v[j + 8]; v[j] = keep + __shfl_xor(send, 32); }
#pragma unroll
    for (int j = 0; j < 4; ++j) { const bool hi = lane & 16; const float keep = hi ? v[j + 4] : v[j], send = hi ? v[j] : v[j + 4]; v[j] = keep + __shfl_xor(send, 16); }
#pragma unroll
    for (int j = 0; j < 2; ++j) { const bool hi = lane & 8; const float keep = hi ? v[j + 2] : v[j], send = hi ? v[j] : v[j + 2]; v[j] = keep + __shfl_xor(send, 8); }
    { const bool hi = lane & 4; const float keep = hi ? v[1] : v[0], send = hi ? v[0] : v[1]; v[0] = keep + __shfl_xor(send, 4); }
    v[0] += __shfl_xor(v[0], 2); v[0] += __shfl_xor(v[0], 1);
    if ((lane & 3) == 0) {
      const int gi = ((lane >> 5) & 1) * 8 + ((lane >> 4) & 1) * 4 + ((lane >> 3) & 1) * 2 + ((lane >> 2) & 1);
      float val = v[0] + P.b_gate[gi];
      if ((gi >> 2) & 1) val = fminf(val, 0.f) - log1pf(__expf(-fabsf(val)));
      gates[(size_t)T * 16 + gi] = val;
    }
  }
  __syncthreads();
}

__device__ __forceinline__ void unit_info(int u, int& T0, int& nc, int& b, int& h, int& c) {
  if (u < 128) { nc = 2; b = u >> 3; h = (u >> 1) & 3; c = u & 1; T0 = b * 256 + c * 128; }
  else { const int v = u - 128; nc = 32; b = v >> 7; h = (v >> 5) & 3; c = v & 31; T0 = NCTXT + b * 4096 + c * 128; }
}
struct ScanOut { float beta0, beta1, cf0, cf1, pm0, pm1, bl, cmax; int t0, t1; };
__device__ __forceinline__ void chunk_scan(const float* gates, int T0, int h, int d, int lane, ScanOut& o) {
  const int t0 = d ? 127 - 2 * lane : 2 * lane, t1 = d ? t0 - 1 : t0 + 1;
  const float* g0 = gates + (size_t)(T0 + t0) * 16 + d * 8 + h; const float* g1 = gates + (size_t)(T0 + t1) * 16 + d * 8 + h;
  const float i0 = g0[0], f0 = g0[4], i1 = g1[0], f1 = g1[4];
  const float s = f0 + f1;
  float x = s;
#pragma unroll
  for (int off = 1; off < 64; off <<= 1) { const float y = __shfl_up(x, off); if (lane >= off) x += y; }
  const float excl = x - s;
  o.beta0 = excl + f0; o.beta1 = x;
  o.cf0 = i0 - o.beta0; o.cf1 = i1 - o.beta1;
  float mx = fmaxf(o.cf0, o.cf1);
#pragma unroll
  for (int off = 1; off < 64; off <<= 1) { const float y = __shfl_up(mx, off); if (lane >= off) mx = fmaxf(mx, y); }
  const float mex = __shfl_up(mx, 1);
  o.pm0 = lane ? fmaxf(mex, o.cf0) : o.cf0; o.pm1 = mx;
  o.bl = __shfl(x, 63); o.cmax = __shfl(mx, 63);
  o.t0 = t0; o.t1 = t1;
}

constexpr int LROW = 136;
constexpr int CST_ELEMS = 129 * 128;

__device__ void shortconv_items(const Params& P) {
  const bf16_t* Z = (const bf16_t*)(P.ws + WS_Z);
  bf16_t* ucat = (bf16_t*)(P.ws + WS_UCAT);
  const int tid = opaque_tid(), wid = tid >> 6, lane = tid & 63, cgp = lane * 8;
  float w0[8], w1[8], w2[8], bb[8];
#pragma unroll
  for (int q = 0; q < 2; ++q) {
    const f32x4 a = *(const f32x4*)(P.conv_sc_w + cgp + q * 4), b = *(const f32x4*)(P.conv_sc_w + 512 + cgp + q * 4), cc = *(const f32x4*)(P.conv_sc_w + 1024 + cgp + q * 4), d = *(const f32x4*)(P.conv_sc_b + cgp + q * 4);
#pragma unroll
    for (int e = 0; e < 4; ++e) { w0[q * 4 + e] = a[e]; w1[q * 4 + e] = b[e]; w2[q * 4 + e] = cc[e]; bb[q * 4 + e] = d[e]; }
  }
  const int nwaves = gridDim.x * 8, gw = blockIdx.x * 8 + wid;
  const int per = (NTOK + nwaves - 1) / nwaves;
  const int Tb = gw * per, Te = (Tb + per < NTOK) ? Tb + per : NTOK;
  if (Tb >= Te) return;
  auto loadu = [&](int T, float (&u)[8]) {
    const int Tc = T < 0 ? 0 : (T >= NTOK ? NTOK - 1 : T);
    const bf16_t* zr = Z + (size_t)Tc * NZ + cgp;
    const u32x4 c = *(const u32x4*)(zr + 512), x = *(const u32x4*)(zr + 1024);
#pragma unroll
    for (int q = 0; q < 4; ++q) { u[2 * q] = bflo(c[q]) * bflo(x[q]); u[2 * q + 1] = bfhi(c[q]) * bfhi(x[q]); }
  };
  float up[8], uc[8], un[8];
  loadu(Tb - 1, up); loadu(Tb, uc);
  for (int T = Tb; T < Te; ++T) {
    loadu(T + 1, un);
    const u32x4 sbq = *(const u32x4*)(Z + (size_t)T * NZ + cgp);
    const int pos = (T < NCTXT) ? (T & 255) : ((T - NCTXT) & 63), lastp = (T < NCTXT) ? 255 : 63;
    const float mp = pos != 0 ? 1.f : 0.f, mn = pos != lastp ? 1.f : 0.f;
    float o[8];
#pragma unroll
    for (int q = 0; q < 4; ++q) {
      o[2 * q] = bflo(sbq[q]) * (w0[2 * q] * (mp * up[2 * q]) + w1[2 * q] * uc[2 * q] + w2[2 * q] * (mn * un[2 * q]) + bb[2 * q]);
      o[2 * q + 1] = bfhi(sbq[q]) * (w0[2 * q + 1] * (mp * up[2 * q + 1]) + w1[2 * q + 1] * uc[2 * q + 1] + w2[2 * q + 1] * (mn * un[2 * q + 1]) + bb[2 * q + 1]);
    }
    u32x4 ov; ov.x = cvt_pk_bf16(o[0], o[1]); ov.y = cvt_pk_bf16(o[2], o[3]); ov.z = cvt_pk_bf16(o[4], o[5]); ov.w = cvt_pk_bf16(o[6], o[7]);
    *(u32x4*)(ucat + (size_t)T * DM + cgp) = ov;
#pragma unroll
    for (int e = 0; e < 8; ++e) { up[e] = uc[e]; uc[e] = un[e]; }
  }
}

__device__ void phaseM1(const Params& P, LAS unsigned char* lds) {
  const int tid = opaque_tid(), wid = tid >> 6, lane = tid & 63, fr = lane & 15, fq = lane >> 4;
  const bf16_t* Z = (const bf16_t*)(P.ws + WS_Z);
  const float* gates = (const float*)(P.ws + WS_GATES);
  float* stat = (float*)(P.ws + WS_STAT);
  bf16_t* dC = (bf16_t*)P.out;
  LAS bf16_t* KT = (LAS bf16_t*)lds;
  LAS bf16_t* VT0 = (LAS bf16_t*)(lds + 34816);
  LAS bf16_t* VT1 = (LAS bf16_t*)(lds + 34816 + 36992);
  LAS float* ecs = (LAS float*)(lds + 34816 + 2 * 36992 + 4096);
  for (int u = blockIdx.x; u < 640; u += gridDim.x) {
    int T0, nc, b, h, c; unit_info(u, T0, nc, b, h, c);
    if (wid < 2) {
      ScanOut so; chunk_scan(gates, T0, h, wid, lane, so);
      ecs[wid * 128 + so.t0] = __expf(so.cf0 - so.cmax); ecs[wid * 128 + so.t1] = __expf(so.cf1 - so.cmax);
      if (lane == 0) { stat[(u * 2 + wid) * 2] = so.bl; stat[(u * 2 + wid) * 2 + 1] = so.cmax; }
    }
    __syncthreads();
    {
      const int s = 2 * (tid & 63);
#pragma unroll
      for (int i = 0; i < 2; ++i) {
        const int kg = (tid >> 6) + 8 * i;
        const bf16_t* zr = Z + (size_t)(T0 + s) * NZ + h * 128 + kg * 8;
        const u32x4 ka = *(const u32x4*)(zr + 2048), va = *(const u32x4*)(zr + 2560);
        const u32x4 kb = *(const u32x4*)(zr + NZ + 2048), vb = *(const u32x4*)(zr + NZ + 2560);
        const float e0a = ecs[s], e0b = ecs[s + 1], e1a = ecs[128 + s], e1b = ecs[128 + s + 1];
#pragma unroll
        for (int q = 0; q < 4; ++q) {
          const int r0 = (kg * 8 + 2 * q) * LROW + s, r1 = r0 + LROW;
          *(LAS unsigned*)(KT + r0) = (ka[q] & 0xffffu) | (kb[q] << 16);
          *(LAS unsigned*)(KT + r1) = (ka[q] >> 16) | (kb[q] & 0xffff0000u);
          const float al = bflo(va[q]), ah = bfhi(va[q]), bl_ = bflo(vb[q]), bh = bfhi(vb[q]);
          *(LAS unsigned*)(VT0 + r0) = cvt_pk_bf16_c(al * e0a, bl_ * e0b);
          *(LAS unsigned*)(VT0 + r1) = cvt_pk_bf16_c(ah * e0a, bh * e0b);
          *(LAS unsigned*)(VT1 + r0) = cvt_pk_bf16_c(al * e1a, bl_ * e1b);
          *(LAS unsigned*)(VT1 + r1) = cvt_pk_bf16_c(ah * e1a, bh * e1b);
        }
      }
      if (tid < 64) { *(LAS unsigned*)(VT0 + 128 * LROW + 2 * tid) = cvt_pk_bf16_c(ecs[2 * tid], ecs[2 * tid + 1]); *(LAS unsigned*)(VT1 + 128 * LROW + 2 * tid) = cvt_pk_bf16_c(ecs[128 + 2 * tid], ecs[128 + 2 * tid + 1]); }
    }
    __syncthreads();
    {
      bf16x8 Kf[4];
#pragma unroll
      for (int ks = 0; ks < 4; ++ks) Kf[ks] = *(const LAS bf16x8*)(KT + (16 * wid + fr) * LROW + 32 * ks + 8 * fq);
#pragma unroll
      for (int d = 0; d < 2; ++d) {
        LAS bf16_t* VT = d ? VT1 : VT0;
        bf16_t* dst = dC + (size_t)(u * 2 + d) * CST_ELEMS;
#pragma unroll
        for (int mt = 0; mt < 9; ++mt) {
          f32x4 a = (f32x4){0.f, 0.f, 0.f, 0.f};
#pragma unroll
          for (int ks = 0; ks < 4; ++ks) { const bf16x8 Vf = *(const LAS bf16x8*)(VT + (16 * mt + fr) * LROW + 32 * ks + 8 * fq); a = __builtin_amdgcn_mfma_f32_16x16x32_bf16(Kf[ks], Vf, a, 0, 0, 0); }
          if (mt < 8 || fr == 0) { u32x2 o; o.x = cvt_pk_bf16_c(a[0], a[1]); o.y = cvt_pk_bf16_c(a[2], a[3]); *(u32x2*)(dst + (16 * mt + fr) * 128 + 16 * wid + 4 * fq) = o; }
        }
      }
    }
    __syncthreads();
  }
}

template <int NC, int BLK, bool HASN>
__device__ __forceinline__ void m2_loop(const bf16_t* dC, bf16_t* Cst, float* mst, const float* sm, int ubase, int d, int e, int kn, bool wm, f32x4& C4, f32x4& n4, float& m) {
#pragma unroll 1
  for (int jb = 0; jb < NC; jb += BLK) {
    u32x2 dv[BLK], nv[BLK];
#pragma unroll
    for (int jj = 0; jj < BLK; ++jj) {
      const int j = jb + jj, c = d ? NC - 1 - j : j;
      const bf16_t* dp = dC + (size_t)((ubase + c) * 2 + d) * CST_ELEMS;
      dv[jj] = *(const u32x2*)(dp + e);
      if (HASN) nv[jj] = *(const u32x2*)(dp + 16384 + kn);
    }
#pragma unroll
    for (int jj = 0; jj < BLK; ++jj) {
      const int j = jb + jj, c = d ? NC - 1 - j : j;
      const int idx = (ubase + c) * 2 + d;
      bf16_t* cs = Cst + (size_t)idx * CST_ELEMS;
      { u32x2 o; o.x = cvt_pk_bf16(C4[0], C4[1]); o.y = cvt_pk_bf16(C4[2], C4[3]); *(u32x2*)(cs + e) = o; }
      if (HASN) { u32x2 o; o.x = cvt_pk_bf16(n4[0], n4[1]); o.y = cvt_pk_bf16(n4[2], n4[3]); *(u32x2*)(cs + 16384 + kn) = o; if (wm) mst[idx] = m; }
      const float bl = sm[2 * j], cmax = sm[2 * j + 1];
      const float mn = bl + fmaxf(m, cmax);
      const float decay = __expf(bl + m - mn), scale = __expf(bl + cmax - mn);
      const u32x2 dvv = dv[jj];
      C4[0] = decay * C4[0] + scale * bflo(dvv.x); C4[1] = decay * C4[1] + scale * bfhi(dvv.x); C4[2] = decay * C4[2] + scale * bflo(dvv.y); C4[3] = decay * C4[3] + scale * bfhi(dvv.y);
      if (HASN) { const u32x2 nvv = nv[jj];
        n4[0] = decay * n4[0] + scale * bflo(nvv.x); n4[1] = decay * n4[1] + scale * bfhi(nvv.x); n4[2] = decay * n4[2] + scale * bflo(nvv.y); n4[3] = decay * n4[3] + scale * bfhi(nvv.y); }
      m = mn;
    }
  }
}
template <int NC, int BLK>
__device__ __forceinline__ void m2_unit(const Params& P, bool lat, int sq, int slice, float* sm) {
  const int tid = opaque_tid();
  const bf16_t* dC = (const bf16_t*)P.out;
  bf16_t* Cst = (bf16_t*)(P.ws + WS_H);
  const float* stat = (const float*)(P.ws + WS_STAT);
  float* mst = (float*)(P.ws + WS_MST);
  const int b = sq >> 3, h = (sq >> 1) & 3, d = sq & 1;
  const int ubase = lat ? 128 + (b * 4 + h) * 32 : (b * 4 + h) * 2;
  const int e = slice * 2048 + tid * 4;
  const bool hasn = (slice == 0) && (tid < 64);
  const int kn = (tid & 31) * 4;
  if (tid < NC) { const int c = d ? NC - 1 - tid : tid; const int idx = (ubase + c) * 2 + d; sm[2 * tid] = stat[idx * 2]; sm[2 * tid + 1] = stat[idx * 2 + 1]; }
  f32x4 C4 = (f32x4){0.f, 0.f, 0.f, 0.f}, n4 = C4; float m = 0.f;
  const int sidx = (b * 2 + d) * 4 + h;
  if (lat) {
    C4 = *(const f32x4*)(P.state_C + (size_t)sidx * 16384 + e);
    n4 = *(const f32x4*)(P.state_n + sidx * 128 + kn);
    m = P.state_m[sidx];
  }
  __syncthreads();
  if (hasn) m2_loop<NC, BLK, true>(dC, Cst, mst, sm, ubase, d, e, kn, tid == 0, C4, n4, m);
  else m2_loop<NC, BLK, false>(dC, Cst, mst, sm, ubase, d, e, kn, false, C4, n4, m);
  if (!lat) {
    *(f32x4*)(P.out + OUT_TAIL + (size_t)sidx * 16384 + e) = C4;
    if (hasn) { *(f32x4*)(P.out + OUT_TAIL + 2097152 + sidx * 128 + kn) = n4; if (tid == 0) P.out[OUT_TAIL + 2097152 + 16384 + sidx] = m; }
  }
  __syncthreads();
}
__device__ void phaseM2(const Params& P, float* sm) {
  for (int unit = blockIdx.x; unit < 1280; unit += gridDim.x) {
    if (unit < 256) m2_unit<32, 16>(P, true, unit >> 3, unit & 7, sm);
    else { const int v = unit - 256; m2_unit<2, 2>(P, false, v >> 3, v & 7, sm); }
  }
}

__device__ __forceinline__ bf16x8 scale_frag(bf16x8 q, float s) {
  const u32x4 a = __builtin_bit_cast(u32x4, q); u32x4 r;
  r.x = cvt_pk_bf16_c(bflo(a.x) * s, bfhi(a.x) * s); r.y = cvt_pk_bf16_c(bflo(a.y) * s, bfhi(a.y) * s);
  r.z = cvt_pk_bf16_c(bflo(a.z) * s, bfhi(a.z) * s); r.w = cvt_pk_bf16_c(bflo(a.w) * s, bfhi(a.w) * s);
  return __builtin_bit_cast(bf16x8, r);
}

__device__ void phaseM3(const Params& P, LAS unsigned char* lds) {
  const int tid = opaque_tid(), wid = tid >> 6, lane = tid & 63, fr = lane & 15, fq = lane >> 4;
  const bf16_t* Z = (const bf16_t*)(P.ws + WS_Z);
  const float* gates = (const float*)(P.ws + WS_GATES);
  const bf16_t* Cst = (const bf16_t*)(P.ws + WS_H);
  const float* mst = (const float*)(P.ws + WS_MST);
  bf16_t* ucat = (bf16_t*)(P.ws + WS_UCAT);
  LAS bf16_t* Ks = (LAS bf16_t*)lds;
  LAS bf16_t* VT = (LAS bf16_t*)(lds + 34816);
  LAS bf16_t* Sb = (LAS bf16_t*)(lds + 34816 + 36992);
  LAS float* arr = (LAS float*)(lds + 34816 + 36992 + 34816);
  LAS float* ecA = arr; LAS float* erA = arr + 256; LAS float* wiA = arr + 512; LAS float* flA = arr + 768;
  LAS bf16_t* Cb = (LAS bf16_t*)(lds + 34816 + 36992 + 34816 + 4096);
  const float qs = 0.08838834764831845f;
  for (int u = blockIdx.x; u < 640; u += gridDim.x) {
    int T0, nc, b, h, c; unit_info(u, T0, nc, b, h, c);
    if (wid < 2) {
      const int d = wid;
      ScanOut so; chunk_scan(gates, T0, h, d, lane, so);
      const float mc = mst[u * 2 + d];
      const float mx0 = fmaxf(mc, so.pm0), mx1 = fmaxf(mc, so.pm1);
      ecA[d * 128 + so.t0] = __expf(so.cf0 - so.cmax); ecA[d * 128 + so.t1] = __expf(so.cf1 - so.cmax);
      erA[d * 128 + so.t0] = __expf(so.cmax - mx0) * qs; erA[d * 128 + so.t1] = __expf(so.cmax - mx1) * qs;
      wiA[d * 128 + so.t0] = __expf(mc - mx0) * qs; wiA[d * 128 + so.t1] = __expf(mc - mx1) * qs;
      flA[d * 128 + so.t0] = __expf(-(so.beta0 + mx0)); flA[d * 128 + so.t1] = __expf(-(so.beta1 + mx1));
    }
    {
      const int s = 2 * (tid & 63);
#pragma unroll
      for (int i = 0; i < 2; ++i) {
        const int kg = (tid >> 6) + 8 * i;
        const bf16_t* zr = Z + (size_t)(T0 + s) * NZ + h * 128 + kg * 8;
        const u32x4 ka = *(const u32x4*)(zr + 2048), va = *(const u32x4*)(zr + 2560);
        const u32x4 kb = *(const u32x4*)(zr + NZ + 2048), vb = *(const u32x4*)(zr + NZ + 2560);
        *(LAS u32x4*)(Ks + s * LROW + kg * 8) = ka;
        *(LAS u32x4*)(Ks + (s + 1) * LROW + kg * 8) = kb;
#pragma unroll
        for (int q = 0; q < 4; ++q) {
          const int r0 = (kg * 8 + 2 * q) * LROW + s, r1 = r0 + LROW;
          *(LAS unsigned*)(VT + r0) = (va[q] & 0xffffu) | (vb[q] << 16);
          *(LAS unsigned*)(VT + r1) = (va[q] >> 16) | (vb[q] & 0xffff0000u);
        }
      }
      if (tid < 64) *(LAS unsigned*)(VT + 128 * LROW + 2 * tid) = 0x3F803F80u;
    }
    u32x4 creg[5];
    {
      const bf16_t* cs0 = Cst + (size_t)(u * 2) * CST_ELEMS;
#pragma unroll
      for (int i = 0; i < 4; ++i) creg[i] = *(const u32x4*)(cs0 + (tid + 512 * i) * 8);
      creg[4] = *(const u32x4*)(cs0 + 16384 + (tid & 15) * 8);
#pragma unroll
      for (int i = 0; i < 4; ++i) { const int ci = tid + 512 * i; *(LAS u32x4*)(Cb + (ci >> 4) * LROW + (ci & 15) * 8) = creg[i]; }
      if (tid < 16) *(LAS u32x4*)(Cb + 128 * LROW + tid * 8) = creg[4];
    }
    __syncthreads();
    {
      const bf16_t* cs1 = Cst + (size_t)(u * 2 + 1) * CST_ELEMS;
#pragma unroll
      for (int i = 0; i < 4; ++i) creg[i] = *(const u32x4*)(cs1 + (tid + 512 * i) * 8);
      creg[4] = *(const u32x4*)(cs1 + 16384 + (tid & 15) * 8);
    }
    {
      const int w = wid;
      bf16x8 Qf[4];
      { const bf16_t* qr = Z + (size_t)(T0 + 16 * w + fr) * NZ + 1536 + h * 128 + 8 * fq;
#pragma unroll
        for (int ks = 0; ks < 4; ++ks) Qf[ks] = *(const bf16x8*)(qr + 32 * ks); }
      f32x4 hsum[8];
#pragma unroll
      for (int vt = 0; vt < 8; ++vt) hsum[vt] = (f32x4){0.f, 0.f, 0.f, 0.f};
      LAS bf16_t* Sw = Sb + w * 16 * LROW;
#pragma unroll
      for (int d = 0; d < 2; ++d) {
        if (d == 1) {
          __syncthreads();
#pragma unroll
          for (int i = 0; i < 4; ++i) { const int ci = tid + 512 * i; *(LAS u32x4*)(Cb + (ci >> 4) * LROW + (ci & 15) * 8) = creg[i]; }
          if (tid < 16) *(LAS u32x4*)(Cb + 128 * LROW + tid * 8) = creg[4];
          __syncthreads();
        }
        const int lo = d ? w : 0, hi = d ? 7 : w;
        const int ks_lo = lo >> 1, ks_hi = hi >> 1;
        float er4[4];
#pragma unroll
        for (int j = 0; j < 4; ++j) er4[j] = erA[d * 128 + 16 * w + 4 * fq + j];
#pragma unroll
        for (int nt = 0; nt < 8; ++nt) {
          if (nt >= 2 * ks_lo && nt <= 2 * ks_hi + 1) {
            f32x4 a = (f32x4){0.f, 0.f, 0.f, 0.f};
            if (nt >= lo && nt <= hi) {
#pragma unroll
              for (int ks = 0; ks < 4; ++ks) { const bf16x8 Kf = *(const LAS bf16x8*)(Ks + (16 * nt + fr) * LROW + 32 * ks + 8 * fq); a = __builtin_amdgcn_mfma_f32_16x16x32_bf16(Qf[ks], Kf, a, 0, 0, 0); }
              const float ecv = ecA[d * 128 + 16 * nt + fr];
#pragma unroll
              for (int j = 0; j < 4; ++j) {
                float val = a[j] * er4[j] * ecv;
                if (nt == w) { const int tl = 4 * fq + j; const bool ok = d ? (fr >= tl) : (fr <= tl); val = ok ? val : 0.f; }
                a[j] = val;
              }
            }
#pragma unroll
            for (int j = 0; j < 4; ++j) { const float nb = dppf<0x12F>(a[j]); if ((fr & 1) == 0) *(LAS unsigned*)(Sw + (4 * fq + j) * LROW + 16 * nt + fr) = cvt_pk_bf16_c(a[j], nb); }
          }
        }
        asm volatile("s_waitcnt lgkmcnt(0)" ::: "memory");
        f32x4 ao[9];
#pragma unroll
        for (int vt = 0; vt < 9; ++vt) ao[vt] = (f32x4){0.f, 0.f, 0.f, 0.f};
        const bf16x8 zf = (bf16x8){0, 0, 0, 0, 0, 0, 0, 0};
#pragma unroll
        for (int ks = 0; ks < 4; ++ks) {
          if (ks >= ks_lo && ks <= ks_hi) {
            const bf16x8 Sf = *(const LAS bf16x8*)(Sw + fr * LROW + 32 * ks + 8 * fq);
#pragma unroll
            for (int vt = 0; vt < 9; ++vt) {
              bf16x8 Vf = *(const LAS bf16x8*)(VT + (vt < 8 ? 16 * vt + fr : 128) * LROW + 32 * ks + 8 * fq);
              if (vt == 8 && fr != 0) Vf = zf;
              ao[vt] = __builtin_amdgcn_mfma_f32_16x16x32_bf16(Sf, Vf, ao[vt], 0, 0, 0);
            }
          }
        }
        {
          const float wv = wiA[d * 128 + 16 * w + fr];
#pragma unroll
          for (int ks = 0; ks < 4; ++ks) {
            const bf16x8 Qs = scale_frag(Qf[ks], wv);
#pragma unroll
            for (int vt = 0; vt < 9; ++vt) {
              bf16x8 Cf = *(const LAS bf16x8*)(Cb + (vt < 8 ? 16 * vt + fr : 128) * LROW + 32 * ks + 8 * fq);
              if (vt == 8 && fr != 0) Cf = zf;
              ao[vt] = __builtin_amdgcn_mfma_f32_16x16x32_bf16(Qs, Cf, ao[vt], 0, 0, 0);
            }
          }
        }
#pragma unroll
        for (int j = 0; j < 4; ++j) {
          const float den = __shfl(ao[8][j], lane & 48);
          const float fl = flA[d * 128 + 16 * w + 4 * fq + j];
          const float inv = 1.0f / fmaxf(fabsf(den), fl);
#pragma unroll
          for (int vt = 0; vt < 8; ++vt) hsum[vt][j] += ao[vt][j] * inv;
        }
        asm volatile("" ::: "memory");
      }
#pragma unroll
      for (int j = 0; j < 4; ++j) {
        float ms = 0.f;
#pragma unroll
        for (int vt = 0; vt < 8; ++vt) ms += hsum[vt][j] * hsum[vt][j];
        ms += __shfl_xor(ms, 1); ms += __shfl_xor(ms, 2); ms += __shfl_xor(ms, 4); ms += __shfl_xor(ms, 8);
        const float r = rsqrtf(ms * (1.0f / 128.0f) + EPS);
        const int T = T0 + 16 * w + 4 * fq + j;
#pragma unroll
        for (int vt = 0; vt < 8; ++vt) {
          const int col = h * 128 + 16 * vt + fr;
          const float og = bf2f(Z[(size_t)T * NZ + 3072 + col]);
          const float val = hsum[vt][j] * r * P.mh_norm[col] * fast_sigmoid(og);
          ucat[(size_t)T * DM + 512 + col] = f2bf_c(val);
        }
      }
    }
    __syncthreads();
  }
}

__device__ void phase7(const Params& P) {
  const int tid7 = opaque_tid(); const int wid = tid7 >> 6, lane = tid7 & 63;
  const float* rss2 = (const float*)(P.ws + WS_RSS2);
  f32x4 fn[4];
#pragma unroll
  for (int i = 0; i < 4; ++i) fn[i] = *(const f32x4*)(P.final_norm + i * 256 + lane * 4);
  const int stride = gridDim.x * 8;
  for (int T0 = blockIdx.x * 8 + wid; T0 < NTOK; T0 += 5 * stride) {
    f32x4 v[5][4]; float r[5];
#pragma unroll
    for (int q = 0; q < 5; ++q) {
      int T = T0 + q * stride; T = T < NTOK ? T : NTOK - 1;
      r[q] = rss2[T];
#pragma unroll
      for (int i = 0; i < 4; ++i) v[q][i] = *(const f32x4*)(P.out + (size_t)T * DM + i * 256 + lane * 4);
    }
#pragma unroll
    for (int q = 0; q < 5; ++q) {
      const int T = T0 + q * stride;
      if (T < NTOK) {
        const float rr = rsqrtf(r[q] * (1.0f / 1024.0f) + EPS);
#pragma unroll
        for (int i = 0; i < 4; ++i) *(f32x4*)(P.out + (size_t)T * DM + i * 256 + lane * 4) = v[q][i] * rr * fn[i];
      }
    }
  }
}

#define GSYNC() do { asm volatile("s_waitcnt vmcnt(0) lgkmcnt(0)" ::: "memory"); grid.sync(); } while (0)
__global__ void __launch_bounds__(512, 2) fwd_megakernel(Params P) {
  extern __shared__ __attribute__((aligned(16))) unsigned char shm[];
  cg::grid_group grid = cg::this_grid();
  LAS unsigned char* lds = (LAS unsigned char*)shm;
  float* smf = (float*)shm;
#define RUN_P2() { EpiZ E; E.Z = (bf16_t*)(P.ws + WS_Z); \
    gemm_phase<EpiZ>(lds, (const bf16_t*)(P.ws + WS_H), (const bf16_t*)(P.ws + WS_WIN), NTOK, NZ, DM, E); } GSYNC();
#define RUN_M() phaseM1(P, lds); shortconv_items(P); GSYNC(); phaseM2(P, smf); GSYNC(); phaseM3(P, lds); GSYNC();
#define RUN_P5() { EpiUp E; E.rowss1 = (const float*)(P.ws + WS_RSS1); E.sb = (const float*)(P.ws + WS_SB); E.cw = P.conv_ffn_w; E.cb = P.conv_ffn_b; E.act = (bf16_t*)(P.ws + WS_Z); \
    gemm_phase<EpiUp>(lds, (const bf16_t*)(P.ws + WS_H), (const bf16_t*)(P.ws + WS_WUP), NTOK, NUP, DM, E); } GSYNC();
  phase0a(P, smf);
  GSYNC();
  phase0b(P, smf);
  GSYNC();
  RUN_P2()
#if DUP == 2
  RUN_P2()
#endif
#if DUP == 21
  { EpiNone E; E.Z = (bf16_t*)(P.ws + WS_UCAT);
    gemm_phase<EpiNone>(lds, (const bf16_t*)(P.ws + WS_H), (const bf16_t*)(P.ws + WS_WIN), NTOK, NZ, DM, E); } GSYNC();
#endif
  RUN_M()
#if DUP == 3
  RUN_M()
#endif
#if DUP == 31
  phaseM1(P, lds); GSYNC();
#endif
#if DUP == 32
  phaseM2(P, smf); GSYNC();
#endif
#if DUP == 33
  phaseM3(P, lds); GSYNC();
#endif
#if DUP == 34
  shortconv_items(P); GSYNC();
#endif
#if DUP == 6
  RUN_P5()
#endif
  { EpiX1 E; E.xp = P.x_prompt; E.xs = P.x_sample; E.mod = (const float*)(P.ws + WS_MOD); E.norm2 = P.norm2; E.x1out = P.out; E.x1g = (bf16_t*)(P.ws + WS_H); E.rowss = (float*)(P.ws + WS_RSS1);
    gemm_phase<EpiX1>(lds, (const bf16_t*)(P.ws + WS_UCAT), (const bf16_t*)(P.ws + WS_WOUT), NTOK, DM, DM, E); }
  GSYNC();
  RUN_P5()
#if DUP == 5
  RUN_P5()
#endif
  { EpiDown E; E.mod = (const float*)(P.ws + WS_MOD); E.out = P.out; E.rowss2 = (float*)(P.ws + WS_RSS2);
    gemm_phase<EpiDown>(lds, (const bf16_t*)(P.ws + WS_Z), (const bf16_t*)(P.ws + WS_WDN), NTOK, DM, DFF, E); }
  GSYNC();
  phase7(P);
}

extern "C" void kernel_launch(void* const* d_in, const int* in_sizes, int n_in, void* d_out, int out_size, void* d_ws, size_t ws_size, hipStream_t stream) {
  static int grid_blocks = 0;
  if (!grid_blocks) {
    int dev = 0, cus = 0, per_cu = 0;
    hipGetDevice(&dev);
    hipDeviceGetAttribute(&cus, hipDeviceAttributeMultiprocessorCount, dev);
    hipFuncSetAttribute((const void*)fwd_megakernel, hipFuncAttributeMaxDynamicSharedMemorySize, LDS_BYTES);
    hipOccupancyMaxActiveBlocksPerMultiprocessor(&per_cu, (const void*)fwd_megakernel, 512, LDS_BYTES);
    (void)hipGetLastError();
    if (per_cu < 1) per_cu = 1;
    if (per_cu > 1) per_cu = 1;
    grid_blocks = cus * per_cu;
  }
  hipMemsetAsync(d_ws, 0, WS_ZERO_BYTES, stream);
  Params p{};
  const float** pp = (const float**)&p;
  for (int i = 0; i < 22; ++i) pp[i] = (const float*)d_in[i];
  p.out = (float*)d_out; p.ws = (unsigned char*)d_ws;
  void* args[] = {&p};
  hipError_t e = hipLaunchCooperativeKernel((const void*)fwd_megakernel, dim3(grid_blocks), dim3(512), args, LDS_BYTES, stream);
  if (e != hipSuccess) fprintf(stderr, "cooperative launch failed: %s (grid %d)\n", hipGetErrorString(e), grid_blocks);
}
```

```cpp
#include <hip/hip_runtime.h>
#include <hip/hip_cooperative_groups.h>
#include <cstdio>
namespace cg = cooperative_groups;

#ifndef DUP
#define DUP 0
#endif
#define LAS __attribute__((address_space(3)))
typedef unsigned short bf16_t;
typedef short bf16x8 __attribute__((ext_vector_type(8)));
typedef float f32x4 __attribute__((ext_vector_type(4)));
typedef unsigned u32x2 __attribute__((ext_vector_type(2)));
typedef unsigned u32x4 __attribute__((ext_vector_type(4)));

constexpr int DM = 1024, NTOK = 20480, NCTXT = 4096, DIN = 3600, NZ = 3584, DFF = 2816, NUP = 5632, NMOD = 6144;
constexpr float EPS = 1e-6f;
constexpr size_t WS_MOD = 0, WS_SB = 122880, WS_RSS1 = 235520, WS_RSS2 = 317440, WS_ZERO_BYTES = 399360;
constexpr size_t WS_GATES = 399360, WS_STAT = 1710080, WS_MST = 1720320;
constexpr size_t WS_WIN = 2097152, WS_WOUT = 9437184, WS_WUP = 11534336, WS_WDN = 23068672;
constexpr size_t WS_H = 28835840;
constexpr size_t WS_UCAT = 71106560;
constexpr size_t WS_Z = 113049600;
constexpr int OUT_TAIL = 20971520;
constexpr int LDS_BYTES = 146432;

struct Params {
  const float *x_prompt, *x_sample, *state_C, *state_n, *state_m, *c, *c_ctx, *w_mod, *b_mod, *norm1, *w_in, *b_gate,
      *conv_sc_w, *conv_sc_b, *mh_norm, *w_out, *norm2, *w_up, *conv_ffn_w, *conv_ffn_b, *w_down, *final_norm;
  float* out; unsigned char* ws;
};

typedef __bf16 bf16x2_n __attribute__((ext_vector_type(2)));
typedef float f32x2_n __attribute__((ext_vector_type(2)));
__device__ __forceinline__ unsigned cvt_pk_bf16_c(float lo, float hi) { const f32x2_n v = {lo, hi}; return __builtin_bit_cast(unsigned, __builtin_convertvector(v, bf16x2_n)); }
__device__ __forceinline__ unsigned cvt_pk_bf16(float lo, float hi) { unsigned r; asm("v_cvt_pk_bf16_f32 %0, %1, %2" : "=v"(r) : "v"(lo), "v"(hi)); return r; }
__device__ __forceinline__ bf16_t f2bf_c(float f) { return (bf16_t)(cvt_pk_bf16_c(f, 0.f) & 0xffffu); }
__device__ __forceinline__ bf16_t f2bf(float f) { return (bf16_t)(cvt_pk_bf16(f, 0.f) & 0xffffu); }
__device__ __forceinline__ float bf2f(bf16_t b) { return __uint_as_float(((unsigned)b) << 16); }
__device__ __forceinline__ float bflo(unsigned u) { return __uint_as_float(u << 16); }
__device__ __forceinline__ float bfhi(unsigned u) { return __uint_as_float(u & 0xffff0000u); }
__device__ __forceinline__ int permtok(int T) { if (T < NCTXT) return T; const int q = T - NCTXT; return NCTXT + (q & ~4095) + ((q & 63) << 6) + ((q >> 6) & 63); }
template <int CTRL> __device__ __forceinline__ float dppf(float x) { return __builtin_bit_cast(float, __builtin_amdgcn_mov_dpp(__builtin_bit_cast(int, x), CTRL, 0xf, 0xf, true)); }
__device__ __forceinline__ float fast_sigmoid(float x) { return __builtin_amdgcn_rcpf(1.0f + __expf(-x)); }

__device__ __forceinline__ int opaque_tid() { int t = threadIdx.x; asm volatile("" : "+v"(t)); return t; }

constexpr int BM = 256, BK = 64, HALF = 128, HTB = HALF * BK * 2, NXCD = 8, WGM = 8;
__device__ __forceinline__ int lds_byte(int r, int c) { const int st = (r >> 4) * 2 + (c >> 5), rr = r & 15, cc = c & 31, ob = rr * 64 + cc * 2; return st * 1024 + (ob ^ (((ob >> 9) & 1) << 5)); }
__device__ __forceinline__ void stage_rc(int b, int& R, int& C) { const int st = b / 1024, sb = b % 1024, swz = sb ^ (((sb >> 9) & 1) << 5); R = (st >> 1) * 16 + swz / 64; C = (st & 1) * 32 + (swz % 64) / 2; }

struct Order {
  int nM, nN, nwg, G, c;
  __device__ __forceinline__ void init(int M, int N) { nM = M / BM; nN = N / BM; nwg = nM * nN; G = gridDim.x; c = blockIdx.x; }
  __device__ __forceinline__ bool next(int i, int& pm, int& pn) const {
    const long L = (long)i * G + c; if (L >= nwg) return false;
    int wgid = (int)L; { const int q = nwg / NXCD, r = nwg % NXCD, xcd = wgid % NXCD, off = wgid / NXCD; wgid = (xcd < r ? xcd * (q + 1) : r * (q + 1) + (xcd - r) * q) + off; }
    const int nig = WGM * nN, gid = wgid / nig, fm = gid * WGM, gsz = (nM - fm) < WGM ? (nM - fm) : WGM;
    pm = fm + ((wgid % nig) % gsz); pn = (wgid % nig) / gsz; return true;
  }
};

template <class Epi>
__device__ __forceinline__ void gemm_phase(LAS unsigned char* lds, const bf16_t* gA, const bf16_t* gBt, int M, int N, int K, const Epi& E) {
  const int tid = opaque_tid(), wid = __builtin_amdgcn_readfirstlane(tid >> 6), lane = tid & 63, wr = wid >> 2, wc = wid & 3, fr = lane & 15, fq = lane >> 4;
  const int nt = K / BK;
  Order S; S.init(M, N);
  unsigned voffA[2];
#pragma unroll
  for (int i = 0; i < 2; ++i) { int R, C; stage_rc(tid * 16 + i * 8192, R, C); voffA[i] = (unsigned)(R * K + C) * 2u; }
  const size_t kstep = (size_t)(BK * 2);
  const size_t hstep = (size_t)HALF * K * 2;
  const size_t tstep = 2 * hstep;
  const unsigned ldsw = (unsigned)wid * 1024u;
  const int aoff = lds_byte(wr * 64 + fr, fq * 8), boff = lds_byte(wc * 32 + fr, fq * 8);
#define G_SA(b, h) (((b) * 2 + (h)) * HTB)
#define G_SB(b, h) ((4 + (b) * 2 + (h)) * HTB)
#define G_STAGE(bufoff, gbase) do { _Pragma("unroll") for (int _i = 0; _i < 2; ++_i) \
    __builtin_amdgcn_global_load_lds((const unsigned*)((const char*)(gbase) + voffA[_i]), (LAS unsigned*)(lds + (bufoff) + ldsw + _i * 8192), 16, 0, 0); } while (0)
#define G_LDA(dst, b, h) do { _Pragma("unroll") for (int m = 0; m < 4; ++m) _Pragma("unroll") for (int k = 0; k < 2; ++k) dst[m][k] = *(const LAS bf16x8*)(lds + G_SA(b, h) + aoff + m * 2048 + k * 1024); } while (0)
#define G_LDB(dst, b, h) do { _Pragma("unroll") for (int n = 0; n < 2; ++n) _Pragma("unroll") for (int k = 0; k < 2; ++k) dst[n][k] = *(const LAS bf16x8*)(lds + G_SB(b, h) + boff + n * 2048 + k * 1024); } while (0)
#define G_MMA(ai, bj, At, Bt) do { __builtin_amdgcn_s_setprio(1); _Pragma("unroll") for (int m = 0; m < 4; ++m) _Pragma("unroll") for (int n = 0; n < 2; ++n) _Pragma("unroll") for (int k = 0; k < 2; ++k) \
    acc[ai][bj][m][n] = __builtin_amdgcn_mfma_f32_16x16x32_bf16(Bt[n][k], At[m][k], acc[ai][bj][m][n], 0, 0, 0); __builtin_amdgcn_s_setprio(0); } while (0)
#define G_WAIT_V(n) asm volatile("s_waitcnt vmcnt(" #n ")" ::: "memory")
#define G_WAIT_L(n) asm volatile("s_waitcnt lgkmcnt(" #n ")" ::: "memory")
#define G_BAR __builtin_amdgcn_s_barrier()
#define G_SCHED __builtin_amdgcn_sched_barrier(0)
  int cpm, cpn, npm = 0, npn = 0, ui = 0;
  if (!S.next(0, cpm, cpn)) return;
  f32x4 acc[2][2][4][2];
#pragma unroll
  for (int a = 0; a < 2; ++a)
#pragma unroll
    for (int b = 0; b < 2; ++b)
#pragma unroll
      for (int m = 0; m < 4; ++m)
#pragma unroll
        for (int n = 0; n < 2; ++n) acc[a][b][m][n] = (f32x4){0.f, 0.f, 0.f, 0.f};
  bf16x8 At[4][2], B0[2][2], B1[2][2];
  const char* cA = (const char*)gA + (size_t)cpm * tstep; const char* cB = (const char*)gBt + (size_t)cpn * tstep;
  G_STAGE(G_SB(0, 0), cB); G_STAGE(G_SA(0, 0), cA); G_STAGE(G_SB(0, 1), cB + hstep); G_STAGE(G_SA(0, 1), cA + hstep);
  if (wr == 1) G_BAR;
  G_WAIT_V(4); G_BAR;
  G_STAGE(G_SB(1, 0), cB + kstep); G_STAGE(G_SA(1, 0), cA + kstep); G_STAGE(G_SB(1, 1), cB + hstep + kstep);
  G_WAIT_V(6); G_BAR;
  for (;;) {
    const bool has_next = S.next(ui + 1, npm, npn);
    const char* nA = has_next ? (const char*)gA + (size_t)npm * tstep : cA; const char* nB = has_next ? (const char*)gBt + (size_t)npn * tstep : cB;
    for (int t = 0; t < nt; t += 2) {
      const bool last = (t == nt - 2);
      const char* a1 = cA + (size_t)(t + 1) * kstep;
      const char* a2 = last ? nA : cA + (size_t)(t + 2) * kstep; const char* b2 = last ? nB : cB + (size_t)(t + 2) * kstep;
      const char* a3 = a2 + kstep; const char* b3 = b2 + kstep;
      G_LDB(B0, 0, 0); G_SCHED; G_LDA(At, 0, 0); G_STAGE(G_SA(1, 1), a1 + hstep);
      G_WAIT_L(8); G_BAR; G_WAIT_L(0); G_MMA(0, 0, At, B0); G_BAR; G_SCHED;
      G_LDB(B1, 0, 1); G_STAGE(G_SB(0, 0), b2);
      G_BAR; G_WAIT_L(0); G_MMA(0, 1, At, B1); G_BAR;
      G_LDA(At, 0, 1); G_STAGE(G_SA(0, 0), a2);
      G_BAR; G_WAIT_L(0); G_MMA(1, 0, At, B0); G_BAR; G_SCHED;
      G_STAGE(G_SB(0, 1), b2 + hstep);
      G_WAIT_V(6); G_BAR; G_MMA(1, 1, At, B1); G_BAR;
      G_LDB(B0, 1, 0); G_SCHED; G_LDA(At, 1, 0); G_STAGE(G_SA(0, 1), a2 + hstep);
      G_WAIT_L(8); G_BAR; G_WAIT_L(0); G_MMA(0, 0, At, B0); G_BAR; G_SCHED;
      G_LDB(B1, 1, 1); G_STAGE(G_SB(1, 0), b3);
      G_BAR; G_WAIT_L(0); G_MMA(0, 1, At, B1); G_BAR;
      G_LDA(At, 1, 1); G_STAGE(G_SA(1, 0), a3);
      G_BAR; G_WAIT_L(0); G_MMA(1, 0, At, B0); G_BAR; G_SCHED;
      G_STAGE(G_SB(1, 1), b3 + hstep);
      G_WAIT_V(6); G_BAR; G_MMA(1, 1, At, B1); G_BAR;
    }
    asm volatile("s_nop 15\n\ts_nop 15" ::: "memory");
    E(acc, cpm, cpn, wr, wc, fr, fq, lds);
    if (!has_next) break;
#pragma unroll
    for (int a = 0; a < 2; ++a)
#pragma unroll
      for (int b = 0; b < 2; ++b)
#pragma unroll
        for (int m = 0; m < 4; ++m)
#pragma unroll
          for (int n = 0; n < 2; ++n) acc[a][b][m][n] = (f32x4){0.f, 0.f, 0.f, 0.f};
    cpm = npm; cpn = npn; cA = nA; cB = nB; ++ui;
  }
  G_WAIT_V(0);
  if (wr == 0) G_BAR;
  G_BAR;
}

struct EpiZ {
  bf16_t* Z;
  __device__ __forceinline__ void operator()(f32x4 (&acc)[2][2][4][2], int pm, int pn, int wr, int wc, int fr, int fq, LAS unsigned char*) const {
    const int row0 = pm * BM + wr * 64 + fr, col0 = pn * BM + wc * 32 + 8 * fq;
#pragma unroll
    for (int ai = 0; ai < 2; ++ai)
#pragma unroll
      for (int m = 0; m < 4; ++m) {
        bf16_t* rowp = Z + (size_t)(row0 + ai * HALF + m * 16) * NZ + col0;
#pragma unroll
        for (int bj = 0; bj < 2; ++bj) { const f32x4 v0 = acc[ai][bj][m][0], v1 = acc[ai][bj][m][1];
          u32x4 o; o.x = cvt_pk_bf16(v0[0], v0[1]); o.y = cvt_pk_bf16(v0[2], v0[3]); o.z = cvt_pk_bf16(v1[0], v1[1]); o.w = cvt_pk_bf16(v1[2], v1[3]);
          *(u32x4*)(rowp + bj * HALF) = o; }
      }
  }
};

struct EpiNone {
  bf16_t* Z;
  __device__ __forceinline__ void operator()(f32x4 (&acc)[2][2][4][2], int pm, int pn, int wr, int wc, int fr, int fq, LAS unsigned char*) const {
    f32x4 s = (f32x4){0.f, 0.f, 0.f, 0.f};
#pragma unroll
    for (int ai = 0; ai < 2; ++ai)
#pragma unroll
      for (int bj = 0; bj < 2; ++bj)
#pragma unroll
        for (int m = 0; m < 4; ++m)
#pragma unroll
          for (int n = 0; n < 2; ++n) s += acc[ai][bj][m][n];
    if (s[0] + s[1] + s[2] + s[3] == 12345.678f) Z[pm + pn] = 1;
  }
};

struct EpiX1 {
  const float* xp; const float* xs; const float* mod; const float* norm2; float* x1out; bf16_t* x1g; float* rowss;
  __device__ __forceinline__ void operator()(f32x4 (&acc)[2][2][4][2], int pm, int pn, int wr, int wc, int fr, int fq, LAS unsigned char*) const {
    const int g = pm < 16 ? 4 : ((pm - 16) >> 4);
    const float* modg = mod + g * NMOD;
    const int col0 = pn * BM + wc * 32 + 4 * fq;
    f32x4 g1[2][2], g2[2][2];
#pragma unroll
    for (int bj = 0; bj < 2; ++bj)
#pragma unroll
      for (int n = 0; n < 2; ++n) { const int c = col0 + bj * HALF + n * 16; g1[bj][n] = *(const f32x4*)(modg + 2048 + c); const f32x4 s2 = *(const f32x4*)(modg + 4096 + c); const f32x4 nv = *(const f32x4*)(norm2 + c); g2[bj][n] = nv * (s2 + 1.0f); }
#pragma unroll
    for (int ai = 0; ai < 2; ++ai)
#pragma unroll
      for (int m = 0; m < 4; ++m) {
        const int T = pm * BM + ai * HALF + wr * 64 + m * 16 + fr;
        const float* xrow = (T < NCTXT) ? xp + (size_t)T * DM : xs + (size_t)(T - NCTXT) * DM;
        const int p = permtok(T);
        float ss = 0.f;
#pragma unroll
        for (int bj = 0; bj < 2; ++bj)
#pragma unroll
          for (int n = 0; n < 2; ++n) {
            const int c = col0 + bj * HALF + n * 16;
            const f32x4 xv = *(const f32x4*)(xrow + c);
            const f32x4 v = xv + g1[bj][n] * acc[ai][bj][m][n];
            *(f32x4*)(x1out + (size_t)T * DM + c) = v;
            ss += v[0] * v[0] + v[1] * v[1] + v[2] * v[2] + v[3] * v[3];
            const f32x4 w = v * g2[bj][n];
            u32x2 o; o.x = cvt_pk_bf16(w[0], w[1]); o.y = cvt_pk_bf16(w[2], w[3]);
            *(u32x2*)(x1g + (size_t)p * DM + c) = o;
          }
        ss += __shfl_xor(ss, 16); ss += __shfl_xor(ss, 32);
        if (fq == 0) __hip_atomic_fetch_add(rowss + p, ss, __ATOMIC_RELAXED, __HIP_MEMORY_SCOPE_AGENT);
      }
  }
};

struct EpiDown {
  const float* mod; float* out; float* rowss2;
  __device__ __forceinline__ void operator()(f32x4 (&acc)[2][2][4][2], int pm, int pn, int wr, int wc, int fr, int fq, LAS unsigned char*) const {
    const int g = pm < 16 ? 4 : ((pm - 16) >> 4);
    const float* modg = mod + g * NMOD;
    const int col0 = pn * BM + wc * 32 + 4 * fq;
    f32x4 g2[2][2];
#pragma unroll
    for (int bj = 0; bj < 2; ++bj)
#pragma unroll
      for (int n = 0; n < 2; ++n) g2[bj][n] = *(const f32x4*)(modg + 5120 + col0 + bj * HALF + n * 16);
#pragma unroll
    for (int ai = 0; ai < 2; ++ai)
#pragma unroll
      for (int m = 0; m < 4; ++m) {
        const int p = pm * BM + ai * HALF + wr * 64 + m * 16 + fr;
        const int T = permtok(p);
        float* orow = out + (size_t)T * DM;
        float ss = 0.f;
#pragma unroll
        for (int bj = 0; bj < 2; ++bj)
#pragma unroll
          for (int n = 0; n < 2; ++n) {
            const int c = col0 + bj * HALF + n * 16;
            const f32x4 xv = *(const f32x4*)(orow + c);
            const f32x4 v = xv + g2[bj][n] * acc[ai][bj][m][n];
            *(f32x4*)(orow + c) = v;
            ss += v[0] * v[0] + v[1] * v[1] + v[2] * v[2] + v[3] * v[3];
          }
        ss += __shfl_xor(ss, 16); ss += __shfl_xor(ss, 32);
        if (fq == 0) __hip_atomic_fetch_add(rowss2 + T, ss, __ATOMIC_RELAXED, __HIP_MEMORY_SCOPE_AGENT);
      }
  }
};

struct EpiUp {
  const float* rowss1; const float* sb; const float* cw; const float* cb; bf16_t* act;
  __device__ __forceinline__ void operator()(f32x4 (&acc)[2][2][4][2], int pm, int pn, int wr, int wc, int fr, int fq, LAS unsigned char* lds) const {
    asm volatile("" : "+v"(fr), "+v"(fq));
    const bool ctx = pm < 16;
    const int g = ctx ? 4 : ((pm - 16) >> 4);
    const float* sbg = sb + g * NUP;
    LAS float* halo = (LAS float*)(lds + 131072);
    const int prow0 = pm * BM + wr * 64 + fr;
    {
      float rs[2][4];
#pragma unroll
      for (int ai = 0; ai < 2; ++ai)
#pragma unroll
        for (int m = 0; m < 4; ++m) rs[ai][m] = __builtin_amdgcn_rsqf(rowss1[prow0 + ai * HALF + m * 16] * (1.0f / 1024.0f) + EPS);
#pragma unroll
      for (int bj = 0; bj < 2; ++bj)
#pragma unroll
        for (int n = 0; n < 2; ++n) {
          asm volatile("" ::: "memory"); __builtin_amdgcn_sched_barrier(0);
          const f32x4 sv = *(const f32x4*)(sbg + bj * DFF + pn * HALF + wc * 32 + 8 * fq + 4 * n);
#pragma unroll
          for (int ai = 0; ai < 2; ++ai)
#pragma unroll
            for (int m = 0; m < 4; ++m) { acc[ai][bj][m][n] = acc[ai][bj][m][n] * rs[ai][m] + sv; asm volatile("" : "+v"(acc[ai][bj][m][n])); }
        }
    }
    if (ctx) {
#pragma unroll
      for (int ai = 0; ai < 2; ++ai)
#pragma unroll
        for (int bj = 0; bj < 2; ++bj)
#pragma unroll
          for (int n = 0; n < 2; ++n) {
            const int rb = 2 * ai + wr, colt = bj * HALF + wc * 32 + 8 * fq + 4 * n;
            if (fr == 0) *(LAS f32x4*)(halo + (rb * 2 + 0) * 256 + colt) = acc[ai][bj][0][n];
            if (fr == 15) *(LAS f32x4*)(halo + (rb * 2 + 1) * 256 + colt) = acc[ai][bj][3][n];
          }
      asm volatile("s_waitcnt lgkmcnt(0)" ::: "memory");
      __builtin_amdgcn_s_barrier();
      __builtin_amdgcn_s_barrier();
      asm volatile("" ::: "memory");
    }
#pragma unroll
    for (int ai = 0; ai < 2; ++ai) {
      u32x2 st[4];
#pragma unroll
      for (int n = 0; n < 2; ++n) {
        f32x4 ya[4];
        const int rb = 2 * ai + wr;
#pragma unroll
        for (int bj = 0; bj < 2; ++bj) {
          const int cnat = bj * DFF + pn * HALF + wc * 32 + 8 * fq + 4 * n, colt = bj * HALF + wc * 32 + 8 * fq + 4 * n;
          const f32x4 w0 = *(const f32x4*)(cw + cnat), w1 = *(const f32x4*)(cw + NUP + cnat), w2 = *(const f32x4*)(cw + 2 * NUP + cnat), bb = *(const f32x4*)(cb + cnat);
          f32x4 hp = (f32x4){0.f, 0.f, 0.f, 0.f}, hn = hp;
          if (ctx) {
            if (rb > 0) hp = *(const LAS f32x4*)(halo + ((rb - 1) * 2 + 1) * 256 + colt);
            if (rb < 3) hn = *(const LAS f32x4*)(halo + ((rb + 1) * 2 + 0) * 256 + colt);
          }
#pragma unroll
          for (int m = 0; m < 4; ++m) {
            const f32x4 cur = acc[ai][bj][m][n];
            f32x4 prev, next;
#pragma unroll
            for (int e = 0; e < 4; ++e) {
              if (m > 0) { const float snd = (fr == 15) ? acc[ai][bj][m > 0 ? m - 1 : 0][n][e] : cur[e]; prev[e] = dppf<0x121>(snd); }
              else { const float rcv = dppf<0x121>(cur[e]); prev[e] = (fr == 0) ? hp[e] : rcv; }
              if (m < 3) { const float snd = (fr == 0) ? acc[ai][bj][m < 3 ? m + 1 : 3][n][e] : cur[e]; next[e] = dppf<0x12F>(snd); }
              else { const float rcv = dppf<0x12F>(cur[e]); next[e] = (fr == 15) ? hn[e] : rcv; }
            }
            const f32x4 y = w0 * prev + w1 * cur + w2 * next + bb;
            if (bj == 0) ya[m] = y;
            else {
              float o[4];
#pragma unroll
              for (int e = 0; e < 4; ++e) o[e] = y[e] * fast_sigmoid(y[e]) * ya[m][e];
              u32x2 ov; ov.x = cvt_pk_bf16(o[0], o[1]); ov.y = cvt_pk_bf16(o[2], o[3]);
              if (n == 0) st[m] = ov;
              else { u32x4 o4; o4.x = st[m].x; o4.y = st[m].y; o4.z = ov.x; o4.w = ov.y;
                *(u32x4*)(act + (size_t)(prow0 + ai * HALF + m * 16) * DFF + pn * HALF + wc * 32 + 8 * fq) = o4; }
            }
          }
        }
      }
    }
  }
};

template <bool SILU>
__device__ __forceinline__ void gemv5_unit(const Params& P, int unit, int ncb, const float* W, int ldw, float* outp, int ldo, const float* bias, const float* modv, float* sm) {
  const int tid = opaque_tid();
  const int cb = unit % ncb, ks = unit / ncb, n0 = cb * 256, k0 = ks * 128;
  float* sv = sm; float* red = sm + 640;
  for (int i = tid; i < 640; i += 512) {
    const int g = i >> 7, k = k0 + (i & 127);
    float v;
    if (SILU) { v = (g < 4) ? P.c[g * DM + k] : P.c_ctx[k]; v = v / (1.0f + __expf(-v)); }
    else v = modv[g * NMOD + 3072 + k];
    sv[i] = v;
  }
  __syncthreads();
  const int col = tid & 255, kh = tid >> 8;
  float a0 = 0.f, a1 = 0.f, a2 = 0.f, a3 = 0.f, a4 = 0.f;
  const float* wp = W + (size_t)(k0 + kh * 64) * ldw + n0 + col;
#pragma unroll 8
  for (int kk = 0; kk < 64; ++kk) {
    const float w = wp[(size_t)kk * ldw];
    const int ki = kh * 64 + kk;
    a0 += sv[ki] * w; a1 += sv[128 + ki] * w; a2 += sv[256 + ki] * w; a3 += sv[384 + ki] * w; a4 += sv[512 + ki] * w;
  }
  if (kh == 1) { red[col] = a0; red[256 + col] = a1; red[512 + col] = a2; red[768 + col] = a3; red[1024 + col] = a4; }
  __syncthreads();
  if (kh == 0) {
    const float bv = (bias != nullptr && ks == 0) ? bias[n0 + col] : 0.f;
    a0 += red[col] + bv; a1 += red[256 + col] + bv; a2 += red[512 + col] + bv; a3 += red[768 + col] + bv; a4 += red[1024 + col] + bv;
    float* o = outp + n0 + col;
    __hip_atomic_fetch_add(o, a0, __ATOMIC_RELAXED, __HIP_MEMORY_SCOPE_AGENT);
    __hip_atomic_fetch_add(o + ldo, a1, __ATOMIC_RELAXED, __HIP_MEMORY_SCOPE_AGENT);
    __hip_atomic_fetch_add(o + 2 * ldo, a2, __ATOMIC_RELAXED, __HIP_MEMORY_SCOPE_AGENT);
    __hip_atomic_fetch_add(o + 3 * ldo, a3, __ATOMIC_RELAXED, __HIP_MEMORY_SCOPE_AGENT);
    __hip_atomic_fetch_add(o + 4 * ldo, a4, __ATOMIC_RELAXED, __HIP_MEMORY_SCOPE_AGENT);
  }
  __syncthreads();
}

struct TrUnit { const float* src; bf16_t* dst; int ldw, ldd, perm; };
__device__ __forceinline__ void tr_decode(const Params& P, int v, TrUnit& t) {
  bf16_t* WinT = (bf16_t*)(P.ws + WS_WIN); bf16_t* WoutT = (bf16_t*)(P.ws + WS_WOUT); bf16_t* WupT = (bf16_t*)(P.ws + WS_WUP); bf16_t* WdnT = (bf16_t*)(P.ws + WS_WDN);
  if (v < 896) { const int kt = v / 56, ntl = v % 56; t.src = P.w_in + (size_t)(kt * 64) * DIN + ntl * 64; t.ldw = DIN; t.dst = WinT + (size_t)(ntl * 64) * DM + kt * 64; t.ldd = DM; t.perm = 1; }
  else if (v < 1152) { const int w = v - 896, kt = w >> 4, ntl = w & 15; t.src = P.w_out + (size_t)(kt * 64) * DM + ntl * 64; t.ldw = DM; t.dst = WoutT + (size_t)(ntl * 64) * DM + kt * 64; t.ldd = DM; t.perm = 0; }
  else if (v < 2560) { const int w = v - 1152, kt = w / 88, ntl = w % 88; const int n0 = ntl * 64, half = n0 / DFF, r = n0 % DFF, pn = r >> 7, cc = r & 127;
    t.src = P.w_up + (size_t)(kt * 64) * NUP + n0; t.ldw = NUP; t.dst = WupT + (size_t)(pn * 256 + half * 128 + cc) * DM + kt * 64; t.ldd = DM; t.perm = 1; }
  else { const int w = v - 2560, kt = w >> 4, ntl = w & 15; t.src = P.w_down + (size_t)(kt * 64) * DM + ntl * 64; t.ldw = DM; t.dst = WdnT + (size_t)(ntl * 64) * DFF + kt * 64; t.ldd = DFF; t.perm = 0; }
}
__device__ void phase0a(const Params& P, float* sm) {
  const int tid = opaque_tid();
  float* mod = (float*)(P.ws + WS_MOD);
  for (int u = blockIdx.x; u < 24 * 8; u += gridDim.x) gemv5_unit<true>(P, u, 24, P.w_mod, NMOD, mod, NMOD, P.b_mod, nullptr, sm);
  constexpr int NTR = 896 + 256 + 1408 + 704;
  const int r = tid >> 4, c4 = (tid & 15) * 4, nn = tid >> 3, kk8 = (tid & 7) * 8;
  float* tile = sm;
  int v = gridDim.x - 1 - blockIdx.x;
  f32x4 p0 = (f32x4){0.f, 0.f, 0.f, 0.f}, p1 = p0; TrUnit cur;
  if (v < NTR) { tr_decode(P, v, cur); p0 = *(const f32x4*)(cur.src + (size_t)r * cur.ldw + c4); p1 = *(const f32x4*)(cur.src + (size_t)(r + 32) * cur.ldw + c4); }
  while (v < NTR) {
    { float* t = tile + r * 65 + c4; t[0] = p0[0]; t[1] = p0[1]; t[2] = p0[2]; t[3] = p0[3]; t += 32 * 65; t[0] = p1[0]; t[1] = p1[1]; t[2] = p1[2]; t[3] = p1[3]; }
    const int vn = v + gridDim.x; TrUnit nxt = cur;
    if (vn < NTR) tr_decode(P, vn, nxt);
    p0 = *(const f32x4*)(nxt.src + (size_t)r * nxt.ldw + c4); p1 = *(const f32x4*)(nxt.src + (size_t)(r + 32) * nxt.ldw + c4);
    __syncthreads();
    { float vv[8];
#pragma unroll
      for (int j = 0; j < 8; ++j) vv[j] = tile[(kk8 + j) * 65 + nn];
      u32x4 o; o.x = cvt_pk_bf16(vv[0], vv[1]); o.y = cvt_pk_bf16(vv[2], vv[3]); o.z = cvt_pk_bf16(vv[4], vv[5]); o.w = cvt_pk_bf16(vv[6], vv[7]);
      const int c5 = nn & 31, nnp = cur.perm ? ((nn & 32) + ((c5 >> 2) & 1) * 16 + (c5 >> 3) * 4 + (c5 & 3)) : nn;
      *(u32x4*)(cur.dst + (size_t)nnp * cur.ldd + kk8) = o; }
    __syncthreads();
    cur = nxt; v = vn;
  }
}

__device__ void phase0b(const Params& P, float* sm) {
  const int tid = opaque_tid(), wid = tid >> 6, lane = tid & 63;
  const float* mod = (const float*)(P.ws + WS_MOD);
  float* sbv = (float*)(P.ws + WS_SB);
  float* gates = (float*)(P.ws + WS_GATES);
  bf16_t* H = (bf16_t*)(P.ws + WS_H);
  for (int u = blockIdx.x; u < 22 * 8; u += gridDim.x) gemv5_unit<false>(P, u, 22, P.w_up, NUP, sbv, NUP, nullptr, mod, sm + 16384);
  for (int i0 = 0; i0 < 32; i0 += 8) {
    float wv[8];
#pragma unroll
    for (int i = 0; i < 8; ++i) { const int idx = tid + 512 * (i0 + i); wv[i] = P.w_in[(size_t)(idx >> 4) * DIN + NZ + (idx & 15)]; }
#pragma unroll
    for (int i = 0; i < 8; ++i) { const int idx = tid + 512 * (i0 + i); sm[(idx & 15) * 1024 + (idx >> 4)] = wv[i]; }
  }
  __syncthreads();
  f32x4 xnext[4];
  { const int Tn = blockIdx.x * 8 + wid; const float* xr = (Tn < NCTXT) ? P.x_prompt + (size_t)Tn * DM : P.x_sample + (size_t)(Tn - NCTXT) * DM;
#pragma unroll
    for (int i = 0; i < 4; ++i) xnext[i] = *(const f32x4*)(xr + i * 256 + lane * 4); }
  for (int T = blockIdx.x * 8 + wid; T < NTOK; T += gridDim.x * 8) {
    const int g = T < NCTXT ? 4 : ((T - NCTXT) >> 12);
    const float* modg = mod + g * NMOD;
    f32x4 xv[4]; float ss = 0.f;
#pragma unroll
    for (int i = 0; i < 4; ++i) xv[i] = xnext[i];
    { int Tn = T + gridDim.x * 8; Tn = Tn < NTOK ? Tn : T;
      const float* xr = (Tn < NCTXT) ? P.x_prompt + (size_t)Tn * DM : P.x_sample + (size_t)(Tn - NCTXT) * DM;
#pragma unroll
      for (int i = 0; i < 4; ++i) xnext[i] = *(const f32x4*)(xr + i * 256 + lane * 4); }
#pragma unroll
    for (int i = 0; i < 4; ++i) ss += xv[i][0] * xv[i][0] + xv[i][1] * xv[i][1] + xv[i][2] * xv[i][2] + xv[i][3] * xv[i][3];
#pragma unroll
    for (int o = 1; o < 64; o <<= 1) ss += __shfl_xor(ss, o);
    const float rstd = rsqrtf(ss * (1.0f / 1024.0f) + EPS);
    f32x4 hv[4];
#pragma unroll
    for (int i = 0; i < 4; ++i) {
      const int c = i * 256 + lane * 4;
      const f32x4 nv = *(const f32x4*)(P.norm1 + c), sc = *(const f32x4*)(modg + 1024 + c), sh = *(const f32x4*)(modg + c);
      hv[i] = xv[i] * rstd * nv * (sc + 1.0f) + sh;
      u32x2 o; o.x = cvt_pk_bf16(hv[i][0], hv[i][1]); o.y = cvt_pk_bf16(hv[i][2], hv[i][3]);
      *(u32x2*)(H + (size_t)T * DM + c) = o;
    }
    float v[16];
#pragma unroll
    for (int gi = 0; gi < 16; ++gi) {
      float a = 0.f;
#pragma unroll
      for (int i = 0; i < 4; ++i) { const f32x4 w = *(const f32x4*)(sm + gi * 1024 + i * 256 + lane * 4); a += hv[i][0] * w[0] + hv[i][1] * w[1] + hv[i][2] * w[2] + hv[i][3] * w[3]; }
      v[gi] = a;
    }
#pragma unroll
    for (int j = 0; j < 8; ++j) { const bool hi = lane & 32; const float keep = hi ? v[j + 8] : v[j], send = hi ? v[j] : v[j + 8]; v[j] = keep + __shfl_xor(send, 32); }
#pragma unroll
    for (int j = 0; j < 4; ++j) { const bool hi = lane & 16; const float keep = hi ? v[j + 4] : v[j], send = hi ? v[j] : v[j + 4]; v[j] = keep + __shfl_xor(send, 16); }
#pragma unroll
    for (int j = 0; j < 2; ++j) { const bool hi = lane & 8; const float keep = hi ? v[j + 2] : v[j], send = hi ? v[j] : v[j + 2]; v[j] = keep + __shfl_xor(send, 8); }
    { const bool hi = lane & 4; const float keep = hi ? v[1] : v[0], send = hi ? v[0] : v[1]; v[0] = keep + __shfl_xor(send, 4); }
    v[0] += __shfl_xor(v[0], 2); v[0] += __shfl_xor(v[0], 1);
    if ((lane & 3) == 0) {
      const int gi = ((lane >> 5) & 1) * 8 + ((lane >> 4) & 1) * 4 + ((lane >> 3) & 1) * 2 + ((lane >> 2) & 1);
      float val = v[0] + P.b_gate[gi];
      if ((gi >> 2) & 1) val = fminf(val, 0.f) - log1pf(__expf(-fabsf(val)));
      gates[(size_t)T * 16 + gi] = val;
    }
  }
  __syncthreads();
}

__device__ __forceinline__ void unit_info(int u, int& T0, int& nc, int& b, int& h, int& c) {
  if (u < 128) { nc = 2; b = u >> 3; h = (u >> 1) & 3; c = u & 1; T0 = b * 256 + c * 128; }
  else { const int v = u - 128; nc = 32; b = v >> 7; h = (v >> 5) & 3; c = v & 31; T0 = NCTXT + b * 4096 + c * 128; }
}
struct ScanOut { float beta0, beta1, cf0, cf1, pm0, pm1, bl, cmax; int t0, t1; };
__device__ __forceinline__ void chunk_scan(const float* gates, int T0, int h, int d, int lane, ScanOut& o) {
  const int t0 = d ? 127 - 2 * lane : 2 * lane, t1 = d ? t0 - 1 : t0 + 1;
  const float* g0 = gates + (size_t)(T0 + t0) * 16 + d * 8 + h; const float* g1 = gates + (size_t)(T0 + t1) * 16 + d * 8 + h;
  const float i0 = g0[0], f0 = g0[4], i1 = g1[0], f1 = g1[4];
  const float s = f0 + f1;
  float x = s;
#pragma unroll
  for (int off = 1; off < 64; off <<= 1) { const float y = __shfl_up(x, off); if (lane >= off) x += y; }
  const float excl = x - s;
  o.beta0 = excl + f0; o.beta1 = x;
  o.cf0 = i0 - o.beta0; o.cf1 = i1 - o.beta1;
  float mx = fmaxf(o.cf0, o.cf1);
#pragma unroll
  for (int off = 1; off < 64; off <<= 1) { const float y = __shfl_up(mx, off); if (lane >= off) mx = fmaxf(mx, y); }
  const float mex = __shfl_up(mx, 1);
  o.pm0 = lane ? fmaxf(mex, o.cf0) : o.cf0; o.pm1 = mx;
  o.bl = __shfl(x, 63); o.cmax = __shfl(mx, 63);
  o.t0 = t0; o.t1 = t1;
}

constexpr int LROW = 136;
constexpr int CST_ELEMS = 129 * 128;

__device__ void shortconv_items(const Params& P) {
  const bf16_t* Z = (const bf16_t*)(P.ws + WS_Z);
  bf16_t* ucat = (bf16_t*)(P.ws + WS_UCAT);
  const int tid = opaque_tid(), wid = tid >> 6, lane = tid & 63, cgp = lane * 8;
  float w0[8], w1[8], w2[8], bb[8];
#pragma unroll
  for (int q = 0; q < 2; ++q) {
    const f32x4 a = *(const f32x4*)(P.conv_sc_w + cgp + q * 4), b = *(const f32x4*)(P.conv_sc_w + 512 + cgp + q * 4), cc = *(const f32x4*)(P.conv_sc_w + 1024 + cgp + q * 4), d = *(const f32x4*)(P.conv_sc_b + cgp + q * 4);
#pragma unroll
    for (int e = 0; e < 4; ++e) { w0[q * 4 + e] = a[e]; w1[q * 4 + e] = b[e]; w2[q * 4 + e] = cc[e]; bb[q * 4 + e] = d[e]; }
  }
  const int nwaves = gridDim.x * 8, gw = blockIdx.x * 8 + wid;
  const int per = (NTOK + nwaves - 1) / nwaves;
  const int Tb = gw * per, Te = (Tb + per < NTOK) ? Tb + per : NTOK;
  if (Tb >= Te) return;
  auto loadu = [&](int T, float (&u)[8]) {
    const int Tc = T < 0 ? 0 : (T >= NTOK ? NTOK - 1 : T);
    const bf16_t* zr = Z + (size_t)Tc * NZ + cgp;
    const u32x4 c = *(const u32x4*)(zr + 512), x = *(const u32x4*)(zr + 1024);
#pragma unroll
    for (int q = 0; q < 4; ++q) { u[2 * q] = bflo(c[q]) * bflo(x[q]); u[2 * q + 1] = bfhi(c[q]) * bfhi(x[q]); }
  };
  float up[8], uc[8], un[8];
  loadu(Tb - 1, up); loadu(Tb, uc);
  for (int T = Tb; T < Te; ++T) {
    loadu(T + 1, un);
    const u32x4 sbq = *(const u32x4*)(Z + (size_t)T * NZ + cgp);
    const int pos = (T < NCTXT) ? (T & 255) : ((T - NCTXT) & 63), lastp = (T < NCTXT) ? 255 : 63;
    const float mp = pos != 0 ? 1.f : 0.f, mn = pos != lastp ? 1.f : 0.f;
    float o[8];
#pragma unroll
    for (int q = 0; q < 4; ++q) {
      o[2 * q] = bflo(sbq[q]) * (w0[2 * q] * (mp * up[2 * q]) + w1[2 * q] * uc[2 * q] + w2[2 * q] * (mn * un[2 * q]) + bb[2 * q]);
      o[2 * q + 1] = bfhi(sbq[q]) * (w0[2 * q + 1] * (mp * up[2 * q + 1]) + w1[2 * q + 1] * uc[2 * q + 1] + w2[2 * q + 1] * (mn * un[2 * q + 1]) + bb[2 * q + 1]);
    }
    u32x4 ov; ov.x = cvt_pk_bf16(o[0], o[1]); ov.y = cvt_pk_bf16(o[2], o[3]); ov.z = cvt_pk_bf16(o[4], o[5]); ov.w = cvt_pk_bf16(o[6], o[7]);
    *(u32x4*)(ucat + (size_t)T * DM + cgp) = ov;
#pragma unroll
    for (int e = 0; e < 8; ++e) { up[e] = uc[e]; uc[e] = un[e]; }
  }
}

__device__ void phaseM1(const Params& P, LAS unsigned char* lds) {
  const int tid = opaque_tid(), wid = tid >> 6, lane = tid & 63, fr = lane & 15, fq = lane >> 4;
  const bf16_t* Z = (const bf16_t*)(P.ws + WS_Z);
  const float* gates = (const float*)(P.ws + WS_GATES);
  float* stat = (float*)(P.ws + WS_STAT);
  bf16_t* dC = (bf16_t*)P.out;
  LAS bf16_t* KT = (LAS bf16_t*)lds;
  LAS bf16_t* VT0 = (LAS bf16_t*)(lds + 34816);
  LAS bf16_t* VT1 = (LAS bf16_t*)(lds + 34816 + 36992);
  LAS float* ecs = (LAS float*)(lds + 34816 + 2 * 36992 + 4096);
  for (int u = blockIdx.x; u < 640; u += gridDim.x) {
    int T0, nc, b, h, c; unit_info(u, T0, nc, b, h, c);
    if (wid < 2) {
      ScanOut so; chunk_scan(gates, T0, h, wid, lane, so);
      ecs[wid * 128 + so.t0] = __expf(so.cf0 - so.cmax); ecs[wid * 128 + so.t1] = __expf(so.cf1 - so.cmax);
      if (lane == 0) { stat[(u * 2 + wid) * 2] = so.bl; stat[(u * 2 + wid) * 2 + 1] = so.cmax; }
    }
    __syncthreads();
    {
      const int s = 2 * (tid & 63);
#pragma unroll
      for (int i = 0; i < 2; ++i) {
        const int kg = (tid >> 6) + 8 * i;
        const bf16_t* zr = Z + (size_t)(T0 + s) * NZ + h * 128 + kg * 8;
        const u32x4 ka = *(const u32x4*)(zr + 2048), va = *(const u32x4*)(zr + 2560);
        const u32x4 kb = *(const u32x4*)(zr + NZ + 2048), vb = *(const u32x4*)(zr + NZ + 2560);
        const float e0a = ecs[s], e0b = ecs[s + 1], e1a = ecs[128 + s], e1b = ecs[128 + s + 1];
#pragma unroll
        for (int q = 0; q < 4; ++q) {
          const int r0 = (kg * 8 + 2 * q) * LROW + s, r1 = r0 + LROW;
          *(LAS unsigned*)(KT + r0) = (ka[q] & 0xffffu) | (kb[q] << 16);
          *(LAS unsigned*)(KT + r1) = (ka[q] >> 16) | (kb[q] & 0xffff0000u);
          const float al = bflo(va[q]), ah = bfhi(va[q]), bl_ = bflo(vb[q]), bh = bfhi(vb[q]);
          *(LAS unsigned*)(VT0 + r0) = cvt_pk_bf16_c(al * e0a, bl_ * e0b);
          *(LAS unsigned*)(VT0 + r1) = cvt_pk_bf16_c(ah * e0a, bh * e0b);
          *(LAS unsigned*)(VT1 + r0) = cvt_pk_bf16_c(al * e1a, bl_ * e1b);
          *(LAS unsigned*)(VT1 + r1) = cvt_pk_bf16_c(ah * e1a, bh * e1b);
        }
      }
      if (tid < 64) { *(LAS unsigned*)(VT0 + 128 * LROW + 2 * tid) = cvt_pk_bf16_c(ecs[2 * tid], ecs[2 * tid + 1]); *(LAS unsigned*)(VT1 + 128 * LROW + 2 * tid) = cvt_pk_bf16_c(ecs[128 + 2 * tid], ecs[128 + 2 * tid + 1]); }
    }
    __syncthreads();
    {
      bf16x8 Kf[4];
#pragma unroll
      for (int ks = 0; ks < 4; ++ks) Kf[ks] = *(const LAS bf16x8*)(KT + (16 * wid + fr) * LROW + 32 * ks + 8 * fq);
#pragma unroll
      for (int d = 0; d < 2; ++d) {
        LAS bf16_t* VT = d ? VT1 : VT0;
        bf16_t* dst = dC + (size_t)(u * 2 + d) * CST_ELEMS;
#pragma unroll
        for (int mt = 0; mt < 9; ++mt) {
          f32x4 a = (f32x4){0.f, 0.f, 0.f, 0.f};
#pragma unroll
          for (int ks = 0; ks < 4; ++ks) { const bf16x8 Vf = *(const LAS bf16x8*)(VT + (16 * mt + fr) * LROW + 32 * ks + 8 * fq); a = __builtin_amdgcn_mfma_f32_16x16x32_bf16(Kf[ks], Vf, a, 0, 0, 0); }
          if (mt < 8 || fr == 0) { u32x2 o; o.x = cvt_pk_bf16_c(a[0], a[1]); o.y = cvt_pk_bf16_c(a[2], a[3]); *(u32x2*)(dst + (16 * mt + fr) * 128 + 16 * wid + 4 * fq) = o; }
        }
      }
    }
    __syncthreads();
  }
}

template <int NC, int BLK, bool HASN>
__device__ __forceinline__ void m2_loop(const bf16_t* dC, bf16_t* Cst, float* mst, const float* sm, int ubase, int d, int e, int kn, bool wm, f32x4& C4, f32x4& n4, float& m) {
#pragma unroll 1
  for (int jb = 0; jb < NC; jb += BLK) {
    u32x2 dv[BLK], nv[BLK];
#pragma unroll
    for (int jj = 0; jj < BLK; ++jj) {
      const int j = jb + jj, c = d ? NC - 1 - j : j;
      const bf16_t* dp = dC + (size_t)((ubase + c) * 2 + d) * CST_ELEMS;
      dv[jj] = *(const u32x2*)(dp + e);
      if (HASN) nv[jj] = *(const u32x2*)(dp + 16384 + kn);
    }
#pragma unroll
    for (int jj = 0; jj < BLK; ++jj) {
      const int j = jb + jj, c = d ? NC - 1 - j : j;
      const int idx = (ubase + c) * 2 + d;
      bf16_t* cs = Cst + (size_t)idx * CST_ELEMS;
      { u32x2 o; o.x = cvt_pk_bf16(C4[0], C4[1]); o.y = cvt_pk_bf16(C4[2], C4[3]); *(u32x2*)(cs + e) = o; }
      if (HASN) { u32x2 o; o.x = cvt_pk_bf16(n4[0], n4[1]); o.y = cvt_pk_bf16(n4[2], n4[3]); *(u32x2*)(cs + 16384 + kn) = o; if (wm) mst[idx] = m; }
      const float bl = sm[2 * j], cmax = sm[2 * j + 1];
      const float mn = bl + fmaxf(m, cmax);
      const float decay = __expf(bl + m - mn), scale = __expf(bl + cmax - mn);
      const u32x2 dvv = dv[jj];
      C4[0] = decay * C4[0] + scale * bflo(dvv.x); C4[1] = decay * C4[1] + scale * bfhi(dvv.x); C4[2] = decay * C4[2] + scale * bflo(dvv.y); C4[3] = decay * C4[3] + scale * bfhi(dvv.y);
      if (HASN) { const u32x2 nvv = nv[jj];
        n4[0] = decay * n4[0] + scale * bflo(nvv.x); n4[1] = decay * n4[1] + scale * bfhi(nvv.x); n4[2] = decay * n4[2] + scale * bflo(nvv.y); n4[3] = decay * n4[3] + scale * bfhi(nvv.y); }
      m = mn;
    }
  }
}
template <int NC, int BLK>
__device__ __forceinline__ void m2_unit(const Params& P, bool lat, int sq, int slice, float* sm) {
  const int tid = opaque_tid();
  const bf16_t* dC = (const bf16_t*)P.out;
  bf16_t* Cst = (bf16_t*)(P.ws + WS_H);
  const float* stat = (const float*)(P.ws + WS_STAT);
  float* mst = (float*)(P.ws + WS_MST);
  const int b = sq >> 3, h = (sq >> 1) & 3, d = sq & 1;
  const int ubase = lat ? 128 + (b * 4 + h) * 32 : (b * 4 + h) * 2;
  const int e = slice * 2048 + tid * 4;
  const bool hasn = (slice == 0) && (tid < 64);
  const int kn = (tid & 31) * 4;
  if (tid < NC) { const int c = d ? NC - 1 - tid : tid; const int idx = (ubase + c) * 2 + d; sm[2 * tid] = stat[idx * 2]; sm[2 * tid + 1] = stat[idx * 2 + 1]; }
  f32x4 C4 = (f32x4){0.f, 0.f, 0.f, 0.f}, n4 = C4; float m = 0.f;
  const int sidx = (b * 2 + d) * 4 + h;
  if (lat) {
    C4 = *(const f32x4*)(P.state_C + (size_t)sidx * 16384 + e);
    n4 = *(const f32x4*)(P.state_n + sidx * 128 + kn);
    m = P.state_m[sidx];
  }
  __syncthreads();
  if (hasn) m2_loop<NC, BLK, true>(dC, Cst, mst, sm, ubase, d, e, kn, tid == 0, C4, n4, m);
  else m2_loop<NC, BLK, false>(dC, Cst, mst, sm, ubase, d, e, kn, false, C4, n4, m);
  if (!lat) {
    *(f32x4*)(P.out + OUT_TAIL + (size_t)sidx * 16384 + e) = C4;
    if (hasn) { *(f32x4*)(P.out + OUT_TAIL + 2097152 + sidx * 128 + kn) = n4; if (tid == 0) P.out[OUT_TAIL + 2097152 + 16384 + sidx] = m; }
  }
  __syncthreads();
}
__device__ void phaseM2(const Params& P, float* sm) {
  for (int unit = blockIdx.x; unit < 1280; unit += gridDim.x) {
    if (unit < 256) m2_unit<32, 16>(P, true, unit >> 3, unit & 7, sm);
    else { const int v = unit - 256; m2_unit<2, 2>(P, false, v >> 3, v & 7, sm); }
  }
}

__device__ __forceinline__ bf16x8 scale_frag(bf16x8 q, float s) {
  const u32x4 a = __builtin_bit_cast(u32x4, q); u32x4 r;
  r.x = cvt_pk_bf16_c(bflo(a.x) * s, bfhi(a.x) * s); r.y = cvt_pk_bf16_c(bflo(a.y) * s, bfhi(a.y) * s);
  r.z = cvt_pk_bf16_c(bflo(a.z) * s, bfhi(a.z) * s); r.w = cvt_pk_bf16_c(bflo(a.w) * s, bfhi(a.w) * s);
  return __builtin_bit_cast(bf16x8, r);
}

__device__ void phaseM3(const Params& P, LAS unsigned char* lds) {
  const int tid = opaque_tid(), wid = tid >> 6, lane = tid & 63, fr = lane & 15, fq = lane >> 4;
  const bf16_t* Z = (const bf16_t*)(P.ws + WS_Z);
  const float* gates = (const float*)(P.ws + WS_GATES);
  const bf16_t* Cst = (const bf16_t*)(P.ws + WS_H);
  const float* mst = (const float*)(P.ws + WS_MST);
  bf16_t* ucat = (bf16_t*)(P.ws + WS_UCAT);
  LAS bf16_t* Ks = (LAS bf16_t*)lds;
  LAS bf16_t* VT = (LAS bf16_t*)(lds + 34816);
  LAS bf16_t* Sb = (LAS bf16_t*)(lds + 34816 + 36992);
  LAS float* arr = (LAS float*)(lds + 34816 + 36992 + 34816);
  LAS float* ecA = arr; LAS float* erA = arr + 256; LAS float* wiA = arr + 512; LAS float* flA = arr + 768;
  LAS bf16_t* Cb = (LAS bf16_t*)(lds + 34816 + 36992 + 34816 + 4096);
  const float qs = 0.08838834764831845f;
  for (int u = blockIdx.x; u < 640; u += gridDim.x) {
    int T0, nc, b, h, c; unit_info(u, T0, nc, b, h, c);
    if (wid < 2) {
      const int d = wid;
      ScanOut so; chunk_scan(gates, T0, h, d, lane, so);
      const float mc = mst[u * 2 + d];
      const float mx0 = fmaxf(mc, so.pm0), mx1 = fmaxf(mc, so.pm1);
      ecA[d * 128 + so.t0] = __expf(so.cf0 - so.cmax); ecA[d * 128 + so.t1] = __expf(so.cf1 - so.cmax);
      erA[d * 128 + so.t0] = __expf(so.cmax - mx0) * qs; erA[d * 128 + so.t1] = __expf(so.cmax - mx1) * qs;
      wiA[d * 128 + so.t0] = __expf(mc - mx0) * qs; wiA[d * 128 + so.t1] = __expf(mc - mx1) * qs;
      flA[d * 128 + so.t0] = __expf(-(so.beta0 + mx0)); flA[d * 128 + so.t1] = __expf(-(so.beta1 + mx1));
    }
    {
      const int s = 2 * (tid & 63);
#pragma unroll
      for (int i = 0; i < 2; ++i) {
        const int kg = (tid >> 6) + 8 * i;
        const bf16_t* zr = Z + (size_t)(T0 + s) * NZ + h * 128 + kg * 8;
        const u32x4 ka = *(const u32x4*)(zr + 2048), va = *(const u32x4*)(zr + 2560);
        const u32x4 kb = *(const u32x4*)(zr + NZ + 2048), vb = *(const u32x4*)(zr + NZ + 2560);
        *(LAS u32x4*)(Ks + s * LROW + kg * 8) = ka;
        *(LAS u32x4*)(Ks + (s + 1) * LROW + kg * 8) = kb;
#pragma unroll
        for (int q = 0; q < 4; ++q) {
          const int r0 = (kg * 8 + 2 * q) * LROW + s, r1 = r0 + LROW;
          *(LAS unsigned*)(VT + r0) = (va[q] & 0xffffu) | (vb[q] << 16);
          *(LAS unsigned*)(VT + r1) = (va[q] >> 16) | (vb[q] & 0xffff0000u);
        }
      }
      if (tid < 64) *(LAS unsigned*)(VT + 128 * LROW + 2 * tid) = 0x3F803F80u;
    }
    u32x4 creg[5];
    {
      const bf16_t* cs0 = Cst + (size_t)(u * 2) * CST_ELEMS;
#pragma unroll
      for (int i = 0; i < 4; ++i) creg[i] = *(const u32x4*)(cs0 + (tid + 512 * i) * 8);
      creg[4] = *(const u32x4*)(cs0 + 16384 + (tid & 15) * 8);
#pragma unroll
      for (int i = 0; i < 4; ++i) { const int ci = tid + 512 * i; *(LAS u32x4*)(Cb + (ci >> 4) * LROW + (ci & 15) * 8) = creg[i]; }
      if (tid < 16) *(LAS u32x4*)(Cb + 128 * LROW + tid * 8) = creg[4];
    }
    __syncthreads();
    {
      const bf16_t* cs1 = Cst + (size_t)(u * 2 + 1) * CST_ELEMS;
#pragma unroll
      for (int i = 0; i < 4; ++i) creg[i] = *(const u32x4*)(cs1 + (tid + 512 * i) * 8);
      creg[4] = *(const u32x4*)(cs1 + 16384 + (tid & 15) * 8);
    }
    {
      const int w = wid;
      bf16x8 Qf[4];
      { const bf16_t* qr = Z + (size_t)(T0 + 16 * w + fr) * NZ + 1536 + h * 128 + 8 * fq;
#pragma unroll
        for (int ks = 0; ks < 4; ++ks) Qf[ks] = *(const bf16x8*)(qr + 32 * ks); }
      f32x4 hsum[8];
#pragma unroll
      for (int vt = 0; vt < 8; ++vt) hsum[vt] = (f32x4){0.f, 0.f, 0.f, 0.f};
      LAS bf16_t* Sw = Sb + w * 16 * LROW;
#pragma unroll
      for (int d = 0; d < 2; ++d) {
        if (d == 1) {
          __syncthreads();
#pragma unroll
          for (int i = 0; i < 4; ++i) { const int ci = tid + 512 * i; *(LAS u32x4*)(Cb + (ci >> 4) * LROW + (ci & 15) * 8) = creg[i]; }
          if (tid < 16) *(LAS u32x4*)(Cb + 128 * LROW + tid * 8) = creg[4];
          __syncthreads();
        }
        const int lo = d ? w : 0, hi = d ? 7 : w;
        const int ks_lo = lo >> 1, ks_hi = hi >> 1;
        float er4[4];
#pragma unroll
        for (int j = 0; j < 4; ++j) er4[j] = erA[d * 128 + 16 * w + 4 * fq + j];
#pragma unroll
        for (int nt = 0; nt < 8; ++nt) {
          if (nt >= 2 * ks_lo && nt <= 2 * ks_hi + 1) {
            f32x4 a = (f32x4){0.f, 0.f, 0.f, 0.f};
            if (nt >= lo && nt <= hi) {
#pragma unroll
              for (int ks = 0; ks < 4; ++ks) { const bf16x8 Kf = *(const LAS bf16x8*)(Ks + (16 * nt + fr) * LROW + 32 * ks + 8 * fq); a = __builtin_amdgcn_mfma_f32_16x16x32_bf16(Qf[ks], Kf, a, 0, 0, 0); }
              const float ecv = ecA[d * 128 + 16 * nt + fr];
#pragma unroll
              for (int j = 0; j < 4; ++j) {
                float val = a[j] * er4[j] * ecv;
                if (nt == w) { const int tl = 4 * fq + j; const bool ok = d ? (fr >= tl) : (fr <= tl); val = ok ? val : 0.f; }
                a[j] = val;
              }
            }
#pragma unroll
            for (int j = 0; j < 4; ++j) { const float nb = dppf<0x12F>(a[j]); if ((fr & 1) == 0) *(LAS unsigned*)(Sw + (4 * fq + j) * LROW + 16 * nt + fr) = cvt_pk_bf16_c(a[j], nb); }
          }
        }
        asm volatile("s_waitcnt lgkmcnt(0)" ::: "memory");
        f32x4 ao[9];
#pragma unroll
        for (int vt = 0; vt < 9; ++vt) ao[vt] = (f32x4){0.f, 0.f, 0.f, 0.f};
        const bf16x8 zf = (bf16x8){0, 0, 0, 0, 0, 0, 0, 0};
#pragma unroll
        for (int ks = 0; ks < 4; ++ks) {
          if (ks >= ks_lo && ks <= ks_hi) {
            const bf16x8 Sf = *(const LAS bf16x8*)(Sw + fr * LROW + 32 * ks + 8 * fq);
#pragma unroll
            for (int vt = 0; vt < 9; ++vt) {
              bf16x8 Vf = *(const LAS bf16x8*)(VT + (vt < 8 ? 16 * vt + fr : 128) * LROW + 32 * ks + 8 * fq);
              if (vt == 8 && fr != 0) Vf = zf;
              ao[vt] = __builtin_amdgcn_mfma_f32_16x16x32_bf16(Sf, Vf, ao[vt], 0, 0, 0);
            }
          }
        }
        {
          const float wv = wiA[d * 128 + 16 * w + fr];
#pragma unroll
          for (int ks = 0; ks < 4; ++ks) {
            const bf16x8 Qs = scale_frag(Qf[ks], wv);
#pragma unroll
            for (int vt = 0; vt < 9; ++vt) {
              bf16x8 Cf = *(const LAS bf16x8*)(Cb + (vt < 8 ? 16 * vt + fr : 128) * LROW + 32 * ks + 8 * fq);
              if (vt == 8 && fr != 0) Cf = zf;
              ao[vt] = __builtin_amdgcn_mfma_f32_16x16x32_bf16(Qs, Cf, ao[vt], 0, 0, 0);
            }
          }
        }
#pragma unroll
        for (int j = 0; j < 4; ++j) {
          const float den = __shfl(ao[8][j], lane & 48);
          const float fl = flA[d * 128 + 16 * w + 4 * fq + j];
          const float inv = 1.0f / fmaxf(fabsf(den), fl);
#pragma unroll
          for (int vt = 0; vt < 8; ++vt) hsum[vt][j] += ao[vt][j] * inv;
        }
        asm volatile("" ::: "memory");
      }
#pragma unroll
      for (int j = 0; j < 4; ++j) {
        float ms = 0.f;
#pragma unroll
        for (int vt = 0; vt < 8; ++vt) ms += hsum[vt][j] * hsum[vt][j];
        ms += __shfl_xor(ms, 1); ms += __shfl_xor(ms, 2); ms += __shfl_xor(ms, 4); ms += __shfl_xor(ms, 8);
        const float r = rsqrtf(ms * (1.0f / 128.0f) + EPS);
        const int T = T0 + 16 * w + 4 * fq + j;
#pragma unroll
        for (int vt = 0; vt < 8; ++vt) {
          const int col = h * 128 + 16 * vt + fr;
          const float og = bf2f(Z[(size_t)T * NZ + 3072 + col]);
          const float val = hsum[vt][j] * r * P.mh_norm[col] * fast_sigmoid(og);
          ucat[(size_t)T * DM + 512 + col] = f2bf_c(val);
        }
      }
    }
    __syncthreads();
  }
}

__device__ void phase7(const Params& P) {
  const int tid7 = opaque_tid(); const int wid = tid7 >> 6, lane = tid7 & 63;
  const float* rss2 = (const float*)(P.ws + WS_RSS2);
  f32x4 fn[4];
#pragma unroll
  for (int i = 0; i < 4; ++i) fn[i] = *(const f32x4*)(P.final_norm + i * 256 + lane * 4);
  const int stride = gridDim.x * 8;
  for (int T0 = blockIdx.x * 8 + wid; T0 < NTOK; T0 += 5 * stride) {
    f32x4 v[5][4]; float r[5];
#pragma unroll
    for (int q = 0; q < 5; ++q) {
      int T = T0 + q * stride; T = T < NTOK ? T : NTOK - 1;
      r[q] = rss2[T];
#pragma unroll
      for (int i = 0; i < 4; ++i) v[q][i] = *(const f32x4*)(P.out + (size_t)T * DM + i * 256 + lane * 4);
    }
#pragma unroll
    for (int q = 0; q < 5; ++q) {
      const int T = T0 + q * stride;
      if (T < NTOK) {
        const float rr = rsqrtf(r[q] * (1.0f / 1024.0f) + EPS);
#pragma unroll
        for (int i = 0; i < 4; ++i) *(f32x4*)(P.out + (size_t)T * DM + i * 256 + lane * 4) = v[q][i] * rr * fn[i];
      }
    }
  }
}

#define GSYNC() do { asm volatile("s_waitcnt vmcnt(0) lgkmcnt(0)" ::: "memory"); grid.sync(); } while (0)
__global__ void __launch_bounds__(512, 2) fwd_megakernel(Params P) {
  extern __shared__ __attribute__((aligned(16))) unsigned char shm[];
  cg::grid_group grid = cg::this_grid();
  LAS unsigned char* lds = (LAS unsigned char*)shm;
  float* smf = (float*)shm;
#define RUN_P2() { EpiZ E; E.Z = (bf16_t*)(P.ws + WS_Z); \
    gemm_phase<EpiZ>(lds, (const bf16_t*)(P.ws + WS_H), (const bf16_t*)(P.ws + WS_WIN), NTOK, NZ, DM, E); } GSYNC();
#define RUN_M() phaseM1(P, lds); shortconv_items(P); GSYNC(); phaseM2(P, smf); GSYNC(); phaseM3(P, lds); GSYNC();
#define RUN_P5() { EpiUp E; E.rowss1 = (const float*)(P.ws + WS_RSS1); E.sb = (const float*)(P.ws + WS_SB); E.cw = P.conv_ffn_w; E.cb = P.conv_ffn_b; E.act = (bf16_t*)(P.ws + WS_Z); \
    gemm_phase<EpiUp>(lds, (const bf16_t*)(P.ws + WS_H), (const bf16_t*)(P.ws + WS_WUP), NTOK, NUP, DM, E); } GSYNC();
  phase0a(P, smf);
  GSYNC();
  phase0b(P, smf);
  GSYNC();
  RUN_P2()
#if DUP == 2
  RUN_P2()
#endif
#if DUP == 21
  { EpiNone E; E.Z = (bf16_t*)(P.ws + WS_UCAT);
    gemm_phase<EpiNone>(lds, (const bf16_t*)(P.ws + WS_H), (const bf16_t*)(P.ws + WS_WIN), NTOK, NZ, DM, E); } GSYNC();
#endif
  RUN_M()
#if DUP == 3
  RUN_M()
#endif
#if DUP == 31
  phaseM1(P, lds); GSYNC();
#endif
#if DUP == 32
  phaseM2(P, smf); GSYNC();
#endif
#if DUP == 33
  phaseM3(P, lds); GSYNC();
#endif
#if DUP == 34
  shortconv_items(P); GSYNC();
#endif
#if DUP == 6
  RUN_P5()
#endif
  { EpiX1 E; E.xp = P.x_prompt; E.xs = P.x_sample; E.mod = (const float*)(P.ws + WS_MOD); E.norm2 = P.norm2; E.x1out = P.out; E.x1g = (bf16_t*)(P.ws + WS_H); E.rowss = (float*)(P.ws + WS_RSS1);
    gemm_phase<EpiX1>(lds, (const bf16_t*)(P.ws + WS_UCAT), (const bf16_t*)(P.ws + WS_WOUT), NTOK, DM, DM, E); }
  GSYNC();
  RUN_P5()
#if DUP == 5
  RUN_P5()
#endif
  { EpiDown E; E.mod = (const float*)(P.ws + WS_MOD); E.out = P.out; E.rowss2 = (float*)(P.ws + WS_RSS2);
    gemm_phase<EpiDown>(lds, (const bf16_t*)(P.ws + WS_Z), (const bf16_t*)(P.ws + WS_WDN), NTOK, DM, DFF, E); }
  GSYNC();
  phase7(P);
}

extern "C" void kernel_launch(void* const* d_in, const int* in_sizes, int n_in, void* d_out, int out_size, void* d_ws, size_t ws_size, hipStream_t stream) {
  static int grid_blocks = 0;
  if (!grid_blocks) {
    int dev = 0, cus = 0, per_cu = 0;
    hipGetDevice(&dev);
    hipDeviceGetAttribute(&cus, hipDeviceAttributeMultiprocessorCount, dev);
    hipFuncSetAttribute((const void*)fwd_megakernel, hipFuncAttributeMaxDynamicSharedMemorySize, LDS_BYTES);
    hipOccupancyMaxActiveBlocksPerMultiprocessor(&per_cu, (const void*)fwd_megakernel, 512, LDS_BYTES);
    (void)hipGetLastError();
    if (per_cu < 1) per_cu = 1;
    if (per_cu > 1) per_cu = 1;
    grid_blocks = cus * per_cu;
  }
  hipMemsetAsync(d_ws, 0, WS_ZERO_BYTES, stream);
  Params p{};
  const float** pp = (const float**)&p;
  for (int i = 0; i < 22; ++i) pp[i] = (const float*)d_in[i];
  p.out = (float*)d_out; p.ws = (unsigned char*)d_ws;
  void* args[] = {&p};
  hipError_t e = hipLaunchCooperativeKernel((const void*)fwd_megakernel, dim3(grid_blocks), dim3(512), args, LDS_BYTES, stream);
  if (e != hipSuccess) fprintf(stderr, "cooperative launch failed: %s (grid %d)\n", hipGetErrorString(e), grid_blocks);
}
```

```cpp
#include <hip/hip_runtime.h>
#include <hip/hip_cooperative_groups.h>
#include <cstdio>
namespace cg = cooperative_groups;

#ifndef DUP
#define DUP 0
#endif
#define LAS __attribute__((address_space(3)))
typedef unsigned short bf16_t;
typedef short bf16x8 __attribute__((ext_vector_type(8)));
typedef float f32x4 __attribute__((ext_vector_type(4)));
typedef unsigned u32x2 __attribute__((ext_vector_type(2)));
typedef unsigned u32x4 __attribute__((ext_vector_type(4)));

constexpr int DM = 1024, NTOK = 20480, NCTXT = 4096, DIN = 3600, NZ = 3584, DFF = 2816, NUP = 5632, NMOD = 6144;
constexpr float EPS = 1e-6f;
constexpr size_t WS_MOD = 0, WS_SB = 122880, WS_RSS1 = 235520, WS_RSS2 = 317440, WS_BAR = 399360, WS_ZERO_BYTES = 415744;
constexpr size_t WS_GATES = 415744, WS_STAT = 1726464, WS_MST = 1736704;
constexpr size_t WS_WIN = 2097152, WS_WOUT = 9437184, WS_WUP = 11534336, WS_WDN = 23068672;
constexpr size_t WS_H = 28835840;
constexpr size_t WS_UCAT = 71106560;
constexpr size_t WS_Z = 113049600;
constexpr int OUT_TAIL = 20971520;
constexpr int LDS_BYTES = 146432;

struct Params {
  const float *x_prompt, *x_sample, *state_C, *state_n, *state_m, *c, *c_ctx, *w_mod, *b_mod, *norm1, *w_in, *b_gate,
      *conv_sc_w, *conv_sc_b, *mh_norm, *w_out, *norm2, *w_up, *conv_ffn_w, *conv_ffn_b, *w_down, *final_norm;
  float* out; unsigned char* ws;
};

typedef __bf16 bf16x2_n __attribute__((ext_vector_type(2)));
typedef float f32x2_n __attribute__((ext_vector_type(2)));
__device__ __forceinline__ unsigned cvt_pk_bf16_c(float lo, float hi) { const f32x2_n v = {lo, hi}; return __builtin_bit_cast(unsigned, __builtin_convertvector(v, bf16x2_n)); }
__device__ __forceinline__ unsigned cvt_pk_bf16(float lo, float hi) { unsigned r; asm("v_cvt_pk_bf16_f32 %0, %1, %2" : "=v"(r) : "v"(lo), "v"(hi)); return r; }
__device__ __forceinline__ bf16_t f2bf_c(float f) { return (bf16_t)(cvt_pk_bf16_c(f, 0.f) & 0xffffu); }
__device__ __forceinline__ bf16_t f2bf(float f) { return (bf16_t)(cvt_pk_bf16(f, 0.f) & 0xffffu); }
__device__ __forceinline__ float bf2f(bf16_t b) { return __uint_as_float(((unsigned)b) << 16); }
__device__ __forceinline__ float bflo(unsigned u) { return __uint_as_float(u << 16); }
__device__ __forceinline__ float bfhi(unsigned u) { return __uint_as_float(u & 0xffff0000u); }
__device__ __forceinline__ int permtok(int T) { if (T < NCTXT) return T; const int q = T - NCTXT; return NCTXT + (q & ~4095) + ((q & 63) << 6) + ((q >> 6) & 63); }
template <int CTRL> __device__ __forceinline__ float dppf(float x) { return __builtin_bit_cast(float, __builtin_amdgcn_mov_dpp(__builtin_bit_cast(int, x), CTRL, 0xf, 0xf, true)); }
__device__ __forceinline__ float fast_sigmoid(float x) { return __builtin_amdgcn_rcpf(1.0f + __expf(-x)); }

__device__ __forceinline__ int opaque_tid() { int t = threadIdx.x; asm volatile("" : "+v"(t)); return t; }

constexpr int BM = 256, BK = 64, HALF = 128, HTB = HALF * BK * 2, NXCD = 8, WGM = 8;
__device__ __forceinline__ int lds_byte(int r, int c) { const int st = (r >> 4) * 2 + (c >> 5), rr = r & 15, cc = c & 31, ob = rr * 64 + cc * 2; return st * 1024 + (ob ^ (((ob >> 9) & 1) << 5)); }
__device__ __forceinline__ void stage_rc(int b, int& R, int& C) { const int st = b / 1024, sb = b % 1024, swz = sb ^ (((sb >> 9) & 1) << 5); R = (st >> 1) * 16 + swz / 64; C = (st & 1) * 32 + (swz % 64) / 2; }

struct Order {
  int nM, nN, nwg, G, c;
  __device__ __forceinline__ void init(int M, int N) { nM = M / BM; nN = N / BM; nwg = nM * nN; G = gridDim.x; c = blockIdx.x; }
  __device__ __forceinline__ bool next(int i, int& pm, int& pn) const {
    const long L = (long)i * G + c; if (L >= nwg) return false;
    int wgid = (int)L; { const int q = nwg / NXCD, r = nwg % NXCD, xcd = wgid % NXCD, off = wgid / NXCD; wgid = (xcd < r ? xcd * (q + 1) : r * (q + 1) + (xcd - r) * q) + off; }
    const int nig = WGM * nN, gid = wgid / nig, fm = gid * WGM, gsz = (nM - fm) < WGM ? (nM - fm) : WGM;
    pm = fm + ((wgid % nig) % gsz); pn = (wgid % nig) / gsz; return true;
  }
};

template <class Epi>
__device__ __forceinline__ void gemm_phase(LAS unsigned char* lds, const bf16_t* gA, const bf16_t* gBt, int M, int N, int K, const Epi& E) {
  const int tid = opaque_tid(), wid = __builtin_amdgcn_readfirstlane(tid >> 6), lane = tid & 63, wr = wid >> 2, wc = wid & 3, fr = lane & 15, fq = lane >> 4;
  const int nt = K / BK;
  Order S; S.init(M, N);
  unsigned voffA[2];
#pragma unroll
  for (int i = 0; i < 2; ++i) { int R, C; stage_rc(tid * 16 + i * 8192, R, C); voffA[i] = (unsigned)(R * K + C) * 2u; }
  const size_t kstep = (size_t)(BK * 2);
  const size_t hstep = (size_t)HALF * K * 2;
  const size_t tstep = 2 * hstep;
  const unsigned ldsw = (unsigned)wid * 1024u;
  const int aoff = lds_byte(wr * 64 + fr, fq * 8), boff = lds_byte(wc * 32 + fr, fq * 8);
#define G_SA(b, h) (((b) * 2 + (h)) * HTB)
#define G_SB(b, h) ((4 + (b) * 2 + (h)) * HTB)
#define G_STAGE(bufoff, gbase) do { _Pragma("unroll") for (int _i = 0; _i < 2; ++_i) \
    __builtin_amdgcn_global_load_lds((const unsigned*)((const char*)(gbase) + voffA[_i]), (LAS unsigned*)(lds + (bufoff) + ldsw + _i * 8192), 16, 0, 0); } while (0)
#define G_LDA(dst, b, h) do { _Pragma("unroll") for (int m = 0; m < 4; ++m) _Pragma("unroll") for (int k = 0; k < 2; ++k) dst[m][k] = *(const LAS bf16x8*)(lds + G_SA(b, h) + aoff + m * 2048 + k * 1024); } while (0)
#define G_LDB(dst, b, h) do { _Pragma("unroll") for (int n = 0; n < 2; ++n) _Pragma("unroll") for (int k = 0; k < 2; ++k) dst[n][k] = *(const LAS bf16x8*)(lds + G_SB(b, h) + boff + n * 2048 + k * 1024); } while (0)
#define G_MMA(ai, bj, At, Bt) do { __builtin_amdgcn_s_setprio(1); _Pragma("unroll") for (int m = 0; m < 4; ++m) _Pragma("unroll") for (int n = 0; n < 2; ++n) _Pragma("unroll") for (int k = 0; k < 2; ++k) \
    acc[ai][bj][m][n] = __builtin_amdgcn_mfma_f32_16x16x32_bf16(Bt[n][k], At[m][k], acc[ai][bj][m][n], 0, 0, 0); __builtin_amdgcn_s_setprio(0); } while (0)
#define G_WAIT_V(n) asm volatile("s_waitcnt vmcnt(" #n ")" ::: "memory")
#define G_WAIT_L(n) asm volatile("s_waitcnt lgkmcnt(" #n ")" ::: "memory")
#define G_BAR __builtin_amdgcn_s_barrier()
#define G_SCHED __builtin_amdgcn_sched_barrier(0)
  int cpm, cpn, npm = 0, npn = 0, ui = 0;
  if (!S.next(0, cpm, cpn)) return;
  f32x4 acc[2][2][4][2];
#pragma unroll
  for (int a = 0; a < 2; ++a)
#pragma unroll
    for (int b = 0; b < 2; ++b)
#pragma unroll
      for (int m = 0; m < 4; ++m)
#pragma unroll
        for (int n = 0; n < 2; ++n) acc[a][b][m][n] = (f32x4){0.f, 0.f, 0.f, 0.f};
  bf16x8 At[4][2], B0[2][2], B1[2][2];
  const char* cA = (const char*)gA + (size_t)cpm * tstep; const char* cB = (const char*)gBt + (size_t)cpn * tstep;
  G_STAGE(G_SB(0, 0), cB); G_STAGE(G_SA(0, 0), cA); G_STAGE(G_SB(0, 1), cB + hstep); G_STAGE(G_SA(0, 1), cA + hstep);
  if (wr == 1) G_BAR;
  G_WAIT_V(4); G_BAR;
  G_STAGE(G_SB(1, 0), cB + kstep); G_STAGE(G_SA(1, 0), cA + kstep); G_STAGE(G_SB(1, 1), cB + hstep + kstep);
  G_WAIT_V(6); G_BAR;
  for (;;) {
    const bool has_next = S.next(ui + 1, npm, npn);
    const char* nA = has_next ? (const char*)gA + (size_t)npm * tstep : cA; const char* nB = has_next ? (const char*)gBt + (size_t)npn * tstep : cB;
    for (int t = 0; t < nt; t += 2) {
      const bool last = (t == nt - 2);
      const char* a1 = cA + (size_t)(t + 1) * kstep;
      const char* a2 = last ? nA : cA + (size_t)(t + 2) * kstep; const char* b2 = last ? nB : cB + (size_t)(t + 2) * kstep;
      const char* a3 = a2 + kstep; const char* b3 = b2 + kstep;
      G_LDB(B0, 0, 0); G_SCHED; G_LDA(At, 0, 0); G_STAGE(G_SA(1, 1), a1 + hstep);
      G_WAIT_L(8); G_BAR; G_WAIT_L(0); G_MMA(0, 0, At, B0); G_BAR; G_SCHED;
      G_LDB(B1, 0, 1); G_STAGE(G_SB(0, 0), b2);
      G_BAR; G_WAIT_L(0); G_MMA(0, 1, At, B1); G_BAR;
      G_LDA(At, 0, 1); G_STAGE(G_SA(0, 0), a2);
      G_BAR; G_WAIT_L(0); G_MMA(1, 0, At, B0); G_BAR; G_SCHED;
      G_STAGE(G_SB(0, 1), b2 + hstep);
      G_WAIT_V(6); G_BAR; G_MMA(1, 1, At, B1); G_BAR;
      G_LDB(B0, 1, 0); G_SCHED; G_LDA(At, 1, 0); G_STAGE(G_SA(0, 1), a2 + hstep);
      G_WAIT_L(8); G_BAR; G_WAIT_L(0); G_MMA(0, 0, At, B0); G_BAR; G_SCHED;
      G_LDB(B1, 1, 1); G_STAGE(G_SB(1, 0), b3);
      G_BAR; G_WAIT_L(0); G_MMA(0, 1, At, B1); G_BAR;
      G_LDA(At, 1, 1); G_STAGE(G_SA(1, 0), a3);
      G_BAR; G_WAIT_L(0); G_MMA(1, 0, At, B0); G_BAR; G_SCHED;
      G_STAGE(G_SB(1, 1), b3 + hstep);
      G_WAIT_V(6); G_BAR; G_MMA(1, 1, At, B1); G_BAR;
    }
    asm volatile("s_nop 15\n\ts_nop 15" ::: "memory");
    E(acc, cpm, cpn, wr, wc, fr, fq, lds);
    if (!has_next) break;
#pragma unroll
    for (int a = 0; a < 2; ++a)
#pragma unroll
      for (int b = 0; b < 2; ++b)
#pragma unroll
        for (int m = 0; m < 4; ++m)
#pragma unroll
          for (int n = 0; n < 2; ++n) acc[a][b][m][n] = (f32x4){0.f, 0.f, 0.f, 0.f};
    cpm = npm; cpn = npn; cA = nA; cB = nB; ++ui;
  }
  G_WAIT_V(0);
  if (wr == 0) G_BAR;
  G_BAR;
}

struct EpiZ {
  bf16_t* Z;
  __device__ __forceinline__ void operator()(f32x4 (&acc)[2][2][4][2], int pm, int pn, int wr, int wc, int fr, int fq, LAS unsigned char*) const {
    const int row0 = pm * BM + wr * 64 + fr, col0 = pn * BM + wc * 32 + 8 * fq;
#pragma unroll
    for (int ai = 0; ai < 2; ++ai)
#pragma unroll
      for (int m = 0; m < 4; ++m) {
        bf16_t* rowp = Z + (size_t)(row0 + ai * HALF + m * 16) * NZ + col0;
#pragma unroll
        for (int bj = 0; bj < 2; ++bj) { const f32x4 v0 = acc[ai][bj][m][0], v1 = acc[ai][bj][m][1];
          u32x4 o; o.x = cvt_pk_bf16(v0[0], v0[1]); o.y = cvt_pk_bf16(v0[2], v0[3]); o.z = cvt_pk_bf16(v1[0], v1[1]); o.w = cvt_pk_bf16(v1[2], v1[3]);
          *(u32x4*)(rowp + bj * HALF) = o; }
      }
  }
};

struct EpiNone {
  bf16_t* Z;
  __device__ __forceinline__ void operator()(f32x4 (&acc)[2][2][4][2], int pm, int pn, int wr, int wc, int fr, int fq, LAS unsigned char*) const {
    f32x4 s = (f32x4){0.f, 0.f, 0.f, 0.f};
#pragma unroll
    for (int ai = 0; ai < 2; ++ai)
#pragma unroll
      for (int bj = 0; bj < 2; ++bj)
#pragma unroll
        for (int m = 0; m < 4; ++m)
#pragma unroll
          for (int n = 0; n < 2; ++n) s += acc[ai][bj][m][n];
    if (s[0] + s[1] + s[2] + s[3] == 12345.678f) Z[pm + pn] = 1;
  }
};

struct EpiX1 {
  const float* xp; const float* xs; const float* mod; const float* norm2; float* x1out; bf16_t* x1g; float* rowss;
  __device__ __forceinline__ void operator()(f32x4 (&acc)[2][2][4][2], int pm, int pn, int wr, int wc, int fr, int fq, LAS unsigned char*) const {
    const int g = pm < 16 ? 4 : ((pm - 16) >> 4);
    const float* modg = mod + g * NMOD;
    const int col0 = pn * BM + wc * 32 + 4 * fq;
    f32x4 g1[2][2], g2[2][2];
#pragma unroll
    for (int bj = 0; bj < 2; ++bj)
#pragma unroll
      for (int n = 0; n < 2; ++n) { const int c = col0 + bj * HALF + n * 16; g1[bj][n] = *(const f32x4*)(modg + 2048 + c); const f32x4 s2 = *(const f32x4*)(modg + 4096 + c); const f32x4 nv = *(const f32x4*)(norm2 + c); g2[bj][n] = nv * (s2 + 1.0f); }
#pragma unroll
    for (int ai = 0; ai < 2; ++ai)
#pragma unroll
      for (int m = 0; m < 4; ++m) {
        const int T = pm * BM + ai * HALF + wr * 64 + m * 16 + fr;
        const float* xrow = (T < NCTXT) ? xp + (size_t)T * DM : xs + (size_t)(T - NCTXT) * DM;
        const int p = permtok(T);
        float ss = 0.f;
#pragma unroll
        for (int bj = 0; bj < 2; ++bj)
#pragma unroll
          for (int n = 0; n < 2; ++n) {
            const int c = col0 + bj * HALF + n * 16;
            const f32x4 xv = *(const f32x4*)(xrow + c);
            const f32x4 v = xv + g1[bj][n] * acc[ai][bj][m][n];
            *(f32x4*)(x1out + (size_t)T * DM + c) = v;
            ss += v[0] * v[0] + v[1] * v[1] + v[2] * v[2] + v[3] * v[3];
            const f32x4 w = v * g2[bj][n];
            u32x2 o; o.x = cvt_pk_bf16(w[0], w[1]); o.y = cvt_pk_bf16(w[2], w[3]);
            *(u32x2*)(x1g + (size_t)p * DM + c) = o;
          }
        ss += __shfl_xor(ss, 16); ss += __shfl_xor(ss, 32);
        if (fq == 0) __hip_atomic_fetch_add(rowss + p, ss, __ATOMIC_RELAXED, __HIP_MEMORY_SCOPE_AGENT);
      }
  }
};

struct EpiDown {
  const float* mod; float* out; float* rowss2;
  __device__ __forceinline__ void operator()(f32x4 (&acc)[2][2][4][2], int pm, int pn, int wr, int wc, int fr, int fq, LAS unsigned char*) const {
    const int g = pm < 16 ? 4 : ((pm - 16) >> 4);
    const float* modg = mod + g * NMOD;
    const int col0 = pn * BM + wc * 32 + 4 * fq;
    f32x4 g2[2][2];
#pragma unroll
    for (int bj = 0; bj < 2; ++bj)
#pragma unroll
      for (int n = 0; n < 2; ++n) g2[bj][n] = *(const f32x4*)(modg + 5120 + col0 + bj * HALF + n * 16);
#pragma unroll
    for (int ai = 0; ai < 2; ++ai)
#pragma unroll
      for (int m = 0; m < 4; ++m) {
        const int p = pm * BM + ai * HALF + wr * 64 + m * 16 + fr;
        const int T = permtok(p);
        float* orow = out + (size_t)T * DM;
        float ss = 0.f;
#pragma unroll
        for (int bj = 0; bj < 2; ++bj)
#pragma unroll
          for (int n = 0; n < 2; ++n) {
            const int c = col0 + bj * HALF + n * 16;
            const f32x4 xv = *(const f32x4*)(orow + c);
            const f32x4 v = xv + g2[bj][n] * acc[ai][bj][m][n];
            *(f32x4*)(orow + c) = v;
            ss += v[0] * v[0] + v[1] * v[1] + v[2] * v[2] + v[3] * v[3];
          }
        ss += __shfl_xor(ss, 16); ss += __shfl_xor(ss, 32);
        if (fq == 0) __hip_atomic_fetch_add(rowss2 + T, ss, __ATOMIC_RELAXED, __HIP_MEMORY_SCOPE_AGENT);
      }
  }
};

struct EpiUp {
  const float* rowss1; const float* sb; const float* cw; const float* cb; bf16_t* act;
  __device__ __forceinline__ void operator()(f32x4 (&acc)[2][2][4][2], int pm, int pn, int wr, int wc, int fr, int fq, LAS unsigned char* lds) const {
    asm volatile("" : "+v"(fr), "+v"(fq));
    const bool ctx = pm < 16;
    const int g = ctx ? 4 : ((pm - 16) >> 4);
    const float* sbg = sb + g * NUP;
    LAS float* halo = (LAS float*)(lds + 131072);
    const int prow0 = pm * BM + wr * 64 + fr;
    {
      float rs[2][4];
#pragma unroll
      for (int ai = 0; ai < 2; ++ai)
#pragma unroll
        for (int m = 0; m < 4; ++m) rs[ai][m] = __builtin_amdgcn_rsqf(rowss1[prow0 + ai * HALF + m * 16] * (1.0f / 1024.0f) + EPS);
#pragma unroll
      for (int bj = 0; bj < 2; ++bj)
#pragma unroll
        for (int n = 0; n < 2; ++n) {
          asm volatile("" ::: "memory"); __builtin_amdgcn_sched_barrier(0);
          const f32x4 sv = *(const f32x4*)(sbg + bj * DFF + pn * HALF + wc * 32 + 8 * fq + 4 * n);
#pragma unroll
          for (int ai = 0; ai < 2; ++ai)
#pragma unroll
            for (int m = 0; m < 4; ++m) { acc[ai][bj][m][n] = acc[ai][bj][m][n] * rs[ai][m] + sv; asm volatile("" : "+v"(acc[ai][bj][m][n])); }
        }
    }
    if (ctx) {
#pragma unroll
      for (int ai = 0; ai < 2; ++ai)
#pragma unroll
        for (int bj = 0; bj < 2; ++bj)
#pragma unroll
          for (int n = 0; n < 2; ++n) {
            const int rb = 2 * ai + wr, colt = bj * HALF + wc * 32 + 8 * fq + 4 * n;
            if (fr == 0) *(LAS f32x4*)(halo + (rb * 2 + 0) * 256 + colt) = acc[ai][bj][0][n];
            if (fr == 15) *(LAS f32x4*)(halo + (rb * 2 + 1) * 256 + colt) = acc[ai][bj][3][n];
          }
      asm volatile("s_waitcnt lgkmcnt(0)" ::: "memory");
      __builtin_amdgcn_s_barrier();
      __builtin_amdgcn_s_barrier();
      asm volatile("" ::: "memory");
    }
#pragma unroll
    for (int ai = 0; ai < 2; ++ai) {
      u32x2 st[4];
#pragma unroll
      for (int n = 0; n < 2; ++n) {
        f32x4 ya[4];
        const int rb = 2 * ai + wr;
#pragma unroll
        for (int bj = 0; bj < 2; ++bj) {
          const int cnat = bj * DFF + pn * HALF + wc * 32 + 8 * fq + 4 * n, colt = bj * HALF + wc * 32 + 8 * fq + 4 * n;
          const f32x4 w0 = *(const f32x4*)(cw + cnat), w1 = *(const f32x4*)(cw + NUP + cnat), w2 = *(const f32x4*)(cw + 2 * NUP + cnat), bb = *(const f32x4*)(cb + cnat);
          f32x4 hp = (f32x4){0.f, 0.f, 0.f, 0.f}, hn = hp;
          if (ctx) {
            if (rb > 0) hp = *(const LAS f32x4*)(halo + ((rb - 1) * 2 + 1) * 256 + colt);
            if (rb < 3) hn = *(const LAS f32x4*)(halo + ((rb + 1) * 2 + 0) * 256 + colt);
          }
#pragma unroll
          for (int m = 0; m < 4; ++m) {
            const f32x4 cur = acc[ai][bj][m][n];
            f32x4 prev, next;
#pragma unroll
            for (int e = 0; e < 4; ++e) {
              if (m > 0) { const float snd = (fr == 15) ? acc[ai][bj][m > 0 ? m - 1 : 0][n][e] : cur[e]; prev[e] = dppf<0x121>(snd); }
              else { const float rcv = dppf<0x121>(cur[e]); prev[e] = (fr == 0) ? hp[e] : rcv; }
              if (m < 3) { const float snd = (fr == 0) ? acc[ai][bj][m < 3 ? m + 1 : 3][n][e] : cur[e]; next[e] = dppf<0x12F>(snd); }
              else { const float rcv = dppf<0x12F>(cur[e]); next[e] = (fr == 15) ? hn[e] : rcv; }
            }
            const f32x4 y = w0 * prev + w1 * cur + w2 * next + bb;
            if (bj == 0) ya[m] = y;
            else {
              float o[4];
#pragma unroll
              for (int e = 0; e < 4; ++e) o[e] = y[e] * fast_sigmoid(y[e]) * ya[m][e];
              u32x2 ov; ov.x = cvt_pk_bf16(o[0], o[1]); ov.y = cvt_pk_bf16(o[2], o[3]);
              if (n == 0) st[m] = ov;
              else { u32x4 o4; o4.x = st[m].x; o4.y = st[m].y; o4.z = ov.x; o4.w = ov.y;
                *(u32x4*)(act + (size_t)(prow0 + ai * HALF + m * 16) * DFF + pn * HALF + wc * 32 + 8 * fq) = o4; }
            }
          }
        }
      }
    }
  }
};

template <bool SILU>
__device__ __forceinline__ void gemv5_unit(const Params& P, int unit, int ncb, const float* W, int ldw, float* outp, int ldo, const float* bias, const float* modv, float* sm) {
  const int tid = opaque_tid();
  const int cb = unit % ncb, ks = unit / ncb, n0 = cb * 256, k0 = ks * 128;
  float* sv = sm; float* red = sm + 640;
  for (int i = tid; i < 640; i += 512) {
    const int g = i >> 7, k = k0 + (i & 127);
    float v;
    if (SILU) { v = (g < 4) ? P.c[g * DM + k] : P.c_ctx[k]; v = v / (1.0f + __expf(-v)); }
    else v = modv[g * NMOD + 3072 + k];
    sv[i] = v;
  }
  __syncthreads();
  const int col = tid & 255, kh = tid >> 8;
  float a0 = 0.f, a1 = 0.f, a2 = 0.f, a3 = 0.f, a4 = 0.f;
  const float* wp = W + (size_t)(k0 + kh * 64) * ldw + n0 + col;
#pragma unroll 8
  for (int kk = 0; kk < 64; ++kk) {
    const float w = wp[(size_t)kk * ldw];
    const int ki = kh * 64 + kk;
    a0 += sv[ki] * w; a1 += sv[128 + ki] * w; a2 += sv[256 + ki] * w; a3 += sv[384 + ki] * w; a4 += sv[512 + ki] * w;
  }
  if (kh == 1) { red[col] = a0; red[256 + col] = a1; red[512 + col] = a2; red[768 + col] = a3; red[1024 + col] = a4; }
  __syncthreads();
  if (kh == 0) {
    const float bv = (bias != nullptr && ks == 0) ? bias[n0 + col] : 0.f;
    a0 += red[col] + bv; a1 += red[256 + col] + bv; a2 += red[512 + col] + bv; a3 += red[768 + col] + bv; a4 += red[1024 + col] + bv;
    float* o = outp + n0 + col;
    __hip_atomic_fetch_add(o, a0, __ATOMIC_RELAXED, __HIP_MEMORY_SCOPE_AGENT);
    __hip_atomic_fetch_add(o + ldo, a1, __ATOMIC_RELAXED, __HIP_MEMORY_SCOPE_AGENT);
    __hip_atomic_fetch_add(o + 2 * ldo, a2, __ATOMIC_RELAXED, __HIP_MEMORY_SCOPE_AGENT);
    __hip_atomic_fetch_add(o + 3 * ldo, a3, __ATOMIC_RELAXED, __HIP_MEMORY_SCOPE_AGENT);
    __hip_atomic_fetch_add(o + 4 * ldo, a4, __ATOMIC_RELAXED, __HIP_MEMORY_SCOPE_AGENT);
  }
  __syncthreads();
}

struct TrUnit { const float* src; bf16_t* dst; int ldw, ldd, perm; };
__device__ __forceinline__ void tr_decode(const Params& P, int v, TrUnit& t) {
  bf16_t* WinT = (bf16_t*)(P.ws + WS_WIN); bf16_t* WoutT = (bf16_t*)(P.ws + WS_WOUT); bf16_t* WupT = (bf16_t*)(P.ws + WS_WUP); bf16_t* WdnT = (bf16_t*)(P.ws + WS_WDN);
  if (v < 896) { const int kt = v / 56, ntl = v % 56; t.src = P.w_in + (size_t)(kt * 64) * DIN + ntl * 64; t.ldw = DIN; t.dst = WinT + (size_t)(ntl * 64) * DM + kt * 64; t.ldd = DM; t.perm = 1; }
  else if (v < 1152) { const int w = v - 896, kt = w >> 4, ntl = w & 15; t.src = P.w_out + (size_t)(kt * 64) * DM + ntl * 64; t.ldw = DM; t.dst = WoutT + (size_t)(ntl * 64) * DM + kt * 64; t.ldd = DM; t.perm = 0; }
  else if (v < 2560) { const int w = v - 1152, kt = w / 88, ntl = w % 88; const int n0 = ntl * 64, half = n0 / DFF, r = n0 % DFF, pn = r >> 7, cc = r & 127;
    t.src = P.w_up + (size_t)(kt * 64) * NUP + n0; t.ldw = NUP; t.dst = WupT + (size_t)(pn * 256 + half * 128 + cc) * DM + kt * 64; t.ldd = DM; t.perm = 1; }
  else { const int w = v - 2560, kt = w >> 4, ntl = w & 15; t.src = P.w_down + (size_t)(kt * 64) * DM + ntl * 64; t.ldw = DM; t.dst = WdnT + (size_t)(ntl * 64) * DFF + kt * 64; t.ldd = DFF; t.perm = 0; }
}
__device__ void phase0a(const Params& P, float* sm) {
  const int tid = opaque_tid();
  float* mod = (float*)(P.ws + WS_MOD);
  for (int u = blockIdx.x; u < 24 * 8; u += gridDim.x) gemv5_unit<true>(P, u, 24, P.w_mod, NMOD, mod, NMOD, P.b_mod, nullptr, sm);
  constexpr int NTR = 896 + 256 + 1408 + 704;
  const int r = tid >> 4, c4 = (tid & 15) * 4, nn = tid >> 3, kk8 = (tid & 7) * 8;
  float* tile = sm;
  int v = gridDim.x - 1 - blockIdx.x;
  f32x4 p0 = (f32x4){0.f, 0.f, 0.f, 0.f}, p1 = p0; TrUnit cur;
  if (v < NTR) { tr_decode(P, v, cur); p0 = *(const f32x4*)(cur.src + (size_t)r * cur.ldw + c4); p1 = *(const f32x4*)(cur.src + (size_t)(r + 32) * cur.ldw + c4); }
  while (v < NTR) {
    { float* t = tile + r * 65 + c4; t[0] = p0[0]; t[1] = p0[1]; t[2] = p0[2]; t[3] = p0[3]; t += 32 * 65; t[0] = p1[0]; t[1] = p1[1]; t[2] = p1[2]; t[3] = p1[3]; }
    const int vn = v + gridDim.x; TrUnit nxt = cur;
    if (vn < NTR) tr_decode(P, vn, nxt);
    p0 = *(const f32x4*)(nxt.src + (size_t)r * nxt.ldw + c4); p1 = *(const f32x4*)(nxt.src + (size_t)(r + 32) * nxt.ldw + c4);
    __syncthreads();
    { float vv[8];
#pragma unroll
      for (int j = 0; j < 8; ++j) vv[j] = tile[(kk8 + j) * 65 + nn];
      u32x4 o; o.x = cvt_pk_bf16(vv[0], vv[1]); o.y = cvt_pk_bf16(vv[2], vv[3]); o.z = cvt_pk_bf16(vv[4], vv[5]); o.w = cvt_pk_bf16(vv[6], vv[7]);
      const int c5 = nn & 31, nnp = cur.perm ? ((nn & 32) + ((c5 >> 2) & 1) * 16 + (c5 >> 3) * 4 + (c5 & 3)) : nn;
      *(u32x4*)(cur.dst + (size_t)nnp * cur.ldd + kk8) = o; }
    __syncthreads();
    cur = nxt; v = vn;
  }
}

__device__ void phase0b(const Params& P, float* sm) {
  const int tid = opaque_tid(), wid = tid >> 6, lane = tid & 63;
  const float* mod = (const float*)(P.ws + WS_MOD);
  float* sbv = (float*)(P.ws + WS_SB);
  float* gates = (float*)(P.ws + WS_GATES);
  bf16_t* H = (bf16_t*)(P.ws + WS_H);
  for (int u = blockIdx.x; u < 22 * 8; u += gridDim.x) gemv5_unit<false>(P, u, 22, P.w_up, NUP, sbv, NUP, nullptr, mod, sm + 16384);
  for (int i0 = 0; i0 < 32; i0 += 8) {
    float wv[8];
#pragma unroll
    for (int i = 0; i < 8; ++i) { const int idx = tid + 512 * (i0 + i); wv[i] = P.w_in[(size_t)(idx >> 4) * DIN + NZ + (idx & 15)]; }
#pragma unroll
    for (int i = 0; i < 8; ++i) { const int idx = tid + 512 * (i0 + i); sm[(idx & 15) * 1024 + (idx >> 4)] = wv[i]; }
  }
  __syncthreads();
  f32x4 xnext[4];
  { const int Tn = blockIdx.x * 8 + wid; const float* xr = (Tn < NCTXT) ? P.x_prompt + (size_t)Tn * DM : P.x_sample + (size_t)(Tn - NCTXT) * DM;
#pragma unroll
    for (int i = 0; i < 4; ++i) xnext[i] = *(const f32x4*)(xr + i * 256 + lane * 4); }
  for (int T = blockIdx.x * 8 + wid; T < NTOK; T += gridDim.x * 8) {
    const int g = T < NCTXT ? 4 : ((T - NCTXT) >> 12);
    const float* modg = mod + g * NMOD;
    f32x4 xv[4]; float ss = 0.f;
#pragma unroll
    for (int i = 0; i < 4; ++i) xv[i] = xnext[i];
    { int Tn = T + gridDim.x * 8; Tn = Tn < NTOK ? Tn : T;
      const float* xr = (Tn < NCTXT) ? P.x_prompt + (size_t)Tn * DM : P.x_sample + (size_t)(Tn - NCTXT) * DM;
#pragma unroll
      for (int i = 0; i < 4; ++i) xnext[i] = *(const f32x4*)(xr + i * 256 + lane * 4); }
#pragma unroll
    for (int i = 0; i < 4; ++i) ss += xv[i][0] * xv[i][0] + xv[i][1] * xv[i][1] + xv[i][2] * xv[i][2] + xv[i][3] * xv[i][3];
#pragma unroll
    for (int o = 1; o < 64; o <<= 1) ss += __shfl_xor(ss, o);
    const float rstd = rsqrtf(ss * (1.0f / 1024.0f) + EPS);
    f32x4 hv[4];
#pragma unroll
    for (int i = 0; i < 4; ++i) {
      const int c = i * 256 + lane * 4;
      const f32x4 nv = *(const f32x4*)(P.norm1 + c), sc = *(const f32x4*)(modg + 1024 + c), sh = *(const f32x4*)(modg + c);
      hv[i] = xv[i] * rstd * nv * (sc + 1.0f) + sh;
      u32x2 o; o.x = cvt_pk_bf16(hv[i][0], hv[i][1]); o.y = cvt_pk_bf16(hv[i][2], hv[i][3]);
      *(u32x2*)(H + (size_t)T * DM + c) = o;
    }
    float v[16];
#pragma unroll
    for (int gi = 0; gi < 16; ++gi) {
      float a = 0.f;
#pragma unroll
      for (int i = 0; i < 4; ++i) { const f32x4 w = *(const f32x4*)(sm + gi * 1024 + i * 256 + lane * 4); a += hv[i][0] * w[0] + hv[i][1] * w[1] + hv[i][2] * w[2] + hv[i][3] * w[3]; }
      v[gi] = a;
    }
#pragma unroll
    for (int j = 0; j < 8; ++j) { const bool hi = lane & 32; const float keep = hi ? v[j + 8] : v[j], send = hi ? v[j] : v[j + 8]; v[j] = keep + __shfl_xor(send, 32); }
#pragma unroll
    for (int j = 0; j < 4; ++j) { const bool hi = lane & 16; const float keep = hi ? v[j + 4] : v[j], send = hi ? v[j] : v[j + 4]; v[j] = keep + __shfl_xor(send, 16); }
#pragma unroll
    for (int j = 0; j < 2; ++j) { const bool hi = lane & 8; const float keep = hi ? v[j + 2] : v[j], send = hi ? v[j] : v[j + 2]; v[j] = keep + __shfl_xor(send, 8); }
    { const bool hi = lane & 4; const float keep = hi ? v[1] : v[0], send = hi ? v[0] : v[1]; v[0] = keep + __shfl_xor(send, 4); }
    v[0] += __shfl_xor(v[0], 2); v[0] += __shfl_xor(v[0], 1);
    if ((lane & 3) == 0) {
      const int gi = ((lane >> 5) & 1) * 8 + ((lane >> 4) & 1) * 4 + ((lane >> 3) & 1) * 2 + ((lane >> 2) & 1);
      float val = v[0] + P.b_gate[gi];
      if ((gi >> 2) & 1) val = fminf(val, 0.f) - log1pf(__expf(-fabsf(val)));
      gates[(size_t)T * 16 + gi] = val;
    }
  }
  __syncthreads();
}

__device__ __forceinline__ void unit_info(int u, int& T0, int& nc, int& b, int& h, int& c) {
  if (u < 128) { nc = 2; b = u >> 3; h = (u >> 1) & 3; c = u & 1; T0 = b * 256 + c * 128; }
  else { const int v = u - 128; nc = 32; b = v >> 7; h = (v >> 5) & 3; c = v & 31; T0 = NCTXT + b * 4096 + c * 128; }
}
struct ScanOut { float beta0, beta1, cf0, cf1, pm0, pm1, bl, cmax; int t0, t1; };
__device__ __forceinline__ void chunk_scan(const float* gates, int T0, int h, int d, int lane, ScanOut& o) {
  const int t0 = d ? 127 - 2 * lane : 2 * lane, t1 = d ? t0 - 1 : t0 + 1;
  const float* g0 = gates + (size_t)(T0 + t0) * 16 + d * 8 + h; const float* g1 = gates + (size_t)(T0 + t1) * 16 + d * 8 + h;
  const float i0 = g0[0], f0 = g0[4], i1 = g1[0], f1 = g1[4];
  const float s = f0 + f1;
  float x = s;
#pragma unroll
  for (int off = 1; off < 64; off <<= 1) { const float y = __shfl_up(x, off); if (lane >= off) x += y; }
  const float excl = x - s;
  o.beta0 = excl + f0; o.beta1 = x;
  o.cf0 = i0 - o.beta0; o.cf1 = i1 - o.beta1;
  float mx = fmaxf(o.cf0, o.cf1);
#pragma unroll
  for (int off = 1; off < 64; off <<= 1) { const float y = __shfl_up(mx, off); if (lane >= off) mx = fmaxf(mx, y); }
  const float mex = __shfl_up(mx, 1);
  o.pm0 = lane ? fmaxf(mex, o.cf0) : o.cf0; o.pm1 = mx;
  o.bl = __shfl(x, 63); o.cmax = __shfl(mx, 63);
  o.t0 = t0; o.t1 = t1;
}

constexpr int LROW = 136;
constexpr int CST_ELEMS = 129 * 128;

__device__ void shortconv_items(const Params& P) {
  const bf16_t* Z = (const bf16_t*)(P.ws + WS_Z);
  bf16_t* ucat = (bf16_t*)(P.ws + WS_UCAT);
  const int tid = opaque_tid(), wid = tid >> 6, lane = tid & 63, cgp = lane * 8;
  float w0[8], w1[8], w2[8], bb[8];
#pragma unroll
  for (int q = 0; q < 2; ++q) {
    const f32x4 a = *(const f32x4*)(P.conv_sc_w + cgp + q * 4), b = *(const f32x4*)(P.conv_sc_w + 512 + cgp + q * 4), cc = *(const f32x4*)(P.conv_sc_w + 1024 + cgp + q * 4), d = *(const f32x4*)(P.conv_sc_b + cgp + q * 4);
#pragma unroll
    for (int e = 0; e < 4; ++e) { w0[q * 4 + e] = a[e]; w1[q * 4 + e] = b[e]; w2[q * 4 + e] = cc[e]; bb[q * 4 + e] = d[e]; }
  }
  const int nwaves = gridDim.x * 8, gw = blockIdx.x * 8 + wid;
  const int per = (NTOK + nwaves - 1) / nwaves;
  const int Tb = gw * per, Te = (Tb + per < NTOK) ? Tb + per : NTOK;
  if (Tb >= Te) return;
  auto loadu = [&](int T, float (&u)[8]) {
    const int Tc = T < 0 ? 0 : (T >= NTOK ? NTOK - 1 : T);
    const bf16_t* zr = Z + (size_t)Tc * NZ + cgp;
    const u32x4 c = *(const u32x4*)(zr + 512), x = *(const u32x4*)(zr + 1024);
#pragma unroll
    for (int q = 0; q < 4; ++q) { u[2 * q] = bflo(c[q]) * bflo(x[q]); u[2 * q + 1] = bfhi(c[q]) * bfhi(x[q]); }
  };
  float up[8], uc[8], un[8];
  loadu(Tb - 1, up); loadu(Tb, uc);
  for (int T = Tb; T < Te; ++T) {
    loadu(T + 1, un);
    const u32x4 sbq = *(const u32x4*)(Z + (size_t)T * NZ + cgp);
    const int pos = (T < NCTXT) ? (T & 255) : ((T - NCTXT) & 63), lastp = (T < NCTXT) ? 255 : 63;
    const float mp = pos != 0 ? 1.f : 0.f, mn = pos != lastp ? 1.f : 0.f;
    float o[8];
#pragma unroll
    for (int q = 0; q < 4; ++q) {
      o[2 * q] = bflo(sbq[q]) * (w0[2 * q] * (mp * up[2 * q]) + w1[2 * q] * uc[2 * q] + w2[2 * q] * (mn * un[2 * q]) + bb[2 * q]);
      o[2 * q + 1] = bfhi(sbq[q]) * (w0[2 * q + 1] * (mp * up[2 * q + 1]) + w1[2 * q + 1] * uc[2 * q + 1] + w2[2 * q + 1] * (mn * un[2 * q + 1]) + bb[2 * q + 1]);
    }
    u32x4 ov; ov.x = cvt_pk_bf16(o[0], o[1]); ov.y = cvt_pk_bf16(o[2], o[3]); ov.z = cvt_pk_bf16(o[4], o[5]); ov.w = cvt_pk_bf16(o[6], o[7]);
    *(u32x4*)(ucat + (size_t)T * DM + cgp) = ov;
#pragma unroll
    for (int e = 0; e < 8; ++e) { up[e] = uc[e]; uc[e] = un[e]; }
  }
}

__device__ void phaseM1(const Params& P, LAS unsigned char* lds) {
  const int tid = opaque_tid(), wid = tid >> 6, lane = tid & 63, fr = lane & 15, fq = lane >> 4;
  const bf16_t* Z = (const bf16_t*)(P.ws + WS_Z);
  const float* gates = (const float*)(P.ws + WS_GATES);
  float* stat = (float*)(P.ws + WS_STAT);
  bf16_t* dC = (bf16_t*)P.out;
  LAS bf16_t* KT = (LAS bf16_t*)lds;
  LAS bf16_t* VT0 = (LAS bf16_t*)(lds + 34816);
  LAS bf16_t* VT1 = (LAS bf16_t*)(lds + 34816 + 36992);
  LAS float* ecs = (LAS float*)(lds + 34816 + 2 * 36992 + 4096);
  for (int u = blockIdx.x; u < 640; u += gridDim.x) {
    int T0, nc, b, h, c; unit_info(u, T0, nc, b, h, c);
    if (wid < 2) {
      ScanOut so; chunk_scan(gates, T0, h, wid, lane, so);
      ecs[wid * 128 + so.t0] = __expf(so.cf0 - so.cmax); ecs[wid * 128 + so.t1] = __expf(so.cf1 - so.cmax);
      if (lane == 0) { stat[(u * 2 + wid) * 2] = so.bl; stat[(u * 2 + wid) * 2 + 1] = so.cmax; }
    }
    __syncthreads();
    {
      const int s = 2 * (tid & 63);
#pragma unroll
      for (int i = 0; i < 2; ++i) {
        const int kg = (tid >> 6) + 8 * i;
        const bf16_t* zr = Z + (size_t)(T0 + s) * NZ + h * 128 + kg * 8;
        const u32x4 ka = *(const u32x4*)(zr + 2048), va = *(const u32x4*)(zr + 2560);
        const u32x4 kb = *(const u32x4*)(zr + NZ + 2048), vb = *(const u32x4*)(zr + NZ + 2560);
        const float e0a = ecs[s], e0b = ecs[s + 1], e1a = ecs[128 + s], e1b = ecs[128 + s + 1];
#pragma unroll
        for (int q = 0; q < 4; ++q) {
          const int r0 = (kg * 8 + 2 * q) * LROW + s, r1 = r0 + LROW;
          *(LAS unsigned*)(KT + r0) = (ka[q] & 0xffffu) | (kb[q] << 16);
          *(LAS unsigned*)(KT + r1) = (ka[q] >> 16) | (kb[q] & 0xffff0000u);
          const float al = bflo(va[q]), ah = bfhi(va[q]), bl_ = bflo(vb[q]), bh = bfhi(vb[q]);
          *(LAS unsigned*)(VT0 + r0) = cvt_pk_bf16_c(al * e0a, bl_ * e0b);
          *(LAS unsigned*)(VT0 + r1) = cvt_pk_bf16_c(ah * e0a, bh * e0b);
          *(LAS unsigned*)(VT1 + r0) = cvt_pk_bf16_c(al * e1a, bl_ * e1b);
          *(LAS unsigned*)(VT1 + r1) = cvt_pk_bf16_c(ah * e1a, bh * e1b);
        }
      }
      if (tid < 64) { *(LAS unsigned*)(VT0 + 128 * LROW + 2 * tid) = cvt_pk_bf16_c(ecs[2 * tid], ecs[2 * tid + 1]); *(LAS unsigned*)(VT1 + 128 * LROW + 2 * tid) = cvt_pk_bf16_c(ecs[128 + 2 * tid], ecs[128 + 2 * tid + 1]); }
    }
    __syncthreads();
    {
      bf16x8 Kf[4];
#pragma unroll
      for (int ks = 0; ks < 4; ++ks) Kf[ks] = *(const LAS bf16x8*)(KT + (16 * wid + fr) * LROW + 32 * ks + 8 * fq);
#pragma unroll
      for (int d = 0; d < 2; ++d) {
        LAS bf16_t* VT = d ? VT1 : VT0;
        bf16_t* dst = dC + (size_t)(u * 2 + d) * CST_ELEMS;
#pragma unroll
        for (int mt = 0; mt < 9; ++mt) {
          f32x4 a = (f32x4){0.f, 0.f, 0.f, 0.f};
#pragma unroll
          for (int ks = 0; ks < 4; ++ks) { const bf16x8 Vf = *(const LAS bf16x8*)(VT + (16 * mt + fr) * LROW + 32 * ks + 8 * fq); a = __builtin_amdgcn_mfma_f32_16x16x32_bf16(Kf[ks], Vf, a, 0, 0, 0); }
          if (mt < 8 || fr == 0) { u32x2 o; o.x = cvt_pk_bf16_c(a[0], a[1]); o.y = cvt_pk_bf16_c(a[2], a[3]); *(u32x2*)(dst + (16 * mt + fr) * 128 + 16 * wid + 4 * fq) = o; }
        }
      }
    }
    __syncthreads();
  }
}

template <int NC, int BLK, bool HASN>
__device__ __forceinline__ void m2_loop(const bf16_t* dC, bf16_t* Cst, float* mst, const float* sm, int ubase, int d, int e, int kn, bool wm, f32x4& C4, f32x4& n4, float& m) {
#pragma unroll 1
  for (int jb = 0; jb < NC; jb += BLK) {
    u32x2 dv[BLK], nv[BLK];
#pragma unroll
    for (int jj = 0; jj < BLK; ++jj) {
      const int j = jb + jj, c = d ? NC - 1 - j : j;
      const bf16_t* dp = dC + (size_t)((ubase + c) * 2 + d) * CST_ELEMS;
      dv[jj] = *(const u32x2*)(dp + e);
      if (HASN) nv[jj] = *(const u32x2*)(dp + 16384 + kn);
    }
#pragma unroll
    for (int jj = 0; jj < BLK; ++jj) {
      const int j = jb + jj, c = d ? NC - 1 - j : j;
      const int idx = (ubase + c) * 2 + d;
      bf16_t* cs = Cst + (size_t)idx * CST_ELEMS;
      { u32x2 o; o.x = cvt_pk_bf16(C4[0], C4[1]); o.y = cvt_pk_bf16(C4[2], C4[3]); *(u32x2*)(cs + e) = o; }
      if (HASN) { u32x2 o; o.x = cvt_pk_bf16(n4[0], n4[1]); o.y = cvt_pk_bf16(n4[2], n4[3]); *(u32x2*)(cs + 16384 + kn) = o; if (wm) mst[idx] = m; }
      const float bl = sm[2 * j], cmax = sm[2 * j + 1];
      const float mn = bl + fmaxf(m, cmax);
      const float decay = __expf(bl + m - mn), scale = __expf(bl + cmax - mn);
      const u32x2 dvv = dv[jj];
      C4[0] = decay * C4[0] + scale * bflo(dvv.x); C4[1] = decay * C4[1] + scale * bfhi(dvv.x); C4[2] = decay * C4[2] + scale * bflo(dvv.y); C4[3] = decay * C4[3] + scale * bfhi(dvv.y);
      if (HASN) { const u32x2 nvv = nv[jj];
        n4[0] = decay * n4[0] + scale * bflo(nvv.x); n4[1] = decay * n4[1] + scale * bfhi(nvv.x); n4[2] = decay * n4[2] + scale * bflo(nvv.y); n4[3] = decay * n4[3] + scale * bfhi(nvv.y); }
      m = mn;
    }
  }
}
template <int NC, int BLK>
__device__ __forceinline__ void m2_unit(const Params& P, bool lat, int sq, int slice, float* sm) {
  const int tid = opaque_tid();
  const bf16_t* dC = (const bf16_t*)P.out;
  bf16_t* Cst = (bf16_t*)(P.ws + WS_H);
  const float* stat = (const float*)(P.ws + WS_STAT);
  float* mst = (float*)(P.ws + WS_MST);
  const int b = sq >> 3, h = (sq >> 1) & 3, d = sq & 1;
  const int ubase = lat ? 128 + (b * 4 + h) * 32 : (b * 4 + h) * 2;
  const int e = slice * 2048 + tid * 4;
  const bool hasn = (slice == 0) && (tid < 64);
  const int kn = (tid & 31) * 4;
  if (tid < NC) { const int c = d ? NC - 1 - tid : tid; const int idx = (ubase + c) * 2 + d; sm[2 * tid] = stat[idx * 2]; sm[2 * tid + 1] = stat[idx * 2 + 1]; }
  f32x4 C4 = (f32x4){0.f, 0.f, 0.f, 0.f}, n4 = C4; float m = 0.f;
  const int sidx = (b * 2 + d) * 4 + h;
  if (lat) {
    C4 = *(const f32x4*)(P.state_C + (size_t)sidx * 16384 + e);
    n4 = *(const f32x4*)(P.state_n + sidx * 128 + kn);
    m = P.state_m[sidx];
  }
  __syncthreads();
  if (hasn) m2_loop<NC, BLK, true>(dC, Cst, mst, sm, ubase, d, e, kn, tid == 0, C4, n4, m);
  else m2_loop<NC, BLK, false>(dC, Cst, mst, sm, ubase, d, e, kn, false, C4, n4, m);
  if (!lat) {
    *(f32x4*)(P.out + OUT_TAIL + (size_t)sidx * 16384 + e) = C4;
    if (hasn) { *(f32x4*)(P.out + OUT_TAIL + 2097152 + sidx * 128 + kn) = n4; if (tid == 0) P.out[OUT_TAIL + 2097152 + 16384 + sidx] = m; }
  }
  __syncthreads();
}
__device__ void phaseM2(const Params& P, float* sm) {
  for (int unit = blockIdx.x; unit < 1280; unit += gridDim.x) {
    if (unit < 256) m2_unit<32, 16>(P, true, unit >> 3, unit & 7, sm);
    else { const int v = unit - 256; m2_unit<2, 2>(P, false, v >> 3, v & 7, sm); }
  }
}

__device__ __forceinline__ bf16x8 scale_frag(bf16x8 q, float s) {
  const u32x4 a = __builtin_bit_cast(u32x4, q); u32x4 r;
  r.x = cvt_pk_bf16_c(bflo(a.x) * s, bfhi(a.x) * s); r.y = cvt_pk_bf16_c(bflo(a.y) * s, bfhi(a.y) * s);
  r.z = cvt_pk_bf16_c(bflo(a.z) * s, bfhi(a.z) * s); r.w = cvt_pk_bf16_c(bflo(a.w) * s, bfhi(a.w) * s);
  return __builtin_bit_cast(bf16x8, r);
}

__device__ void phaseM3(const Params& P, LAS unsigned char* lds) {
  const int tid = opaque_tid(), wid = tid >> 6, lane = tid & 63, fr = lane & 15, fq = lane >> 4;
  const bf16_t* Z = (const bf16_t*)(P.ws + WS_Z);
  const float* gates = (const float*)(P.ws + WS_GATES);
  const bf16_t* Cst = (const bf16_t*)(P.ws + WS_H);
  const float* mst = (const float*)(P.ws + WS_MST);
  bf16_t* ucat = (bf16_t*)(P.ws + WS_UCAT);
  LAS bf16_t* Ks = (LAS bf16_t*)lds;
  LAS bf16_t* VT = (LAS bf16_t*)(lds + 34816);
  LAS bf16_t* Sb = (LAS bf16_t*)(lds + 34816 + 36992);
  LAS float* arr = (LAS float*)(lds + 34816 + 36992 + 34816);
  LAS float* ecA = arr; LAS float* erA = arr + 256; LAS float* wiA = arr + 512; LAS float* flA = arr + 768;
  LAS bf16_t* Cb = (LAS bf16_t*)(lds + 34816 + 36992 + 34816 + 4096);
  const float qs = 0.08838834764831845f;
  for (int u = blockIdx.x; u < 640; u += gridDim.x) {
    int T0, nc, b, h, c; unit_info(u, T0, nc, b, h, c);
    if (wid < 2) {
      const int d = wid;
      ScanOut so; chunk_scan(gates, T0, h, d, lane, so);
      const float mc = mst[u * 2 + d];
      const float mx0 = fmaxf(mc, so.pm0), mx1 = fmaxf(mc, so.pm1);
      ecA[d * 128 + so.t0] = __expf(so.cf0 - so.cmax); ecA[d * 128 + so.t1] = __expf(so.cf1 - so.cmax);
      erA[d * 128 + so.t0] = __expf(so.cmax - mx0) * qs; erA[d * 128 + so.t1] = __expf(so.cmax - mx1) * qs;
      wiA[d * 128 + so.t0] = __expf(mc - mx0) * qs; wiA[d * 128 + so.t1] = __expf(mc - mx1) * qs;
      flA[d * 128 + so.t0] = __expf(-(so.beta0 + mx0)); flA[d * 128 + so.t1] = __expf(-(so.beta1 + mx1));
    }
    {
      const int s = 2 * (tid & 63);
#pragma unroll
      for (int i = 0; i < 2; ++i) {
        const int kg = (tid >> 6) + 8 * i;
        const bf16_t* zr = Z + (size_t)(T0 + s) * NZ + h * 128 + kg * 8;
        const u32x4 ka = *(const u32x4*)(zr + 2048), va = *(const u32x4*)(zr + 2560);
        const u32x4 kb = *(const u32x4*)(zr + NZ + 2048), vb = *(const u32x4*)(zr + NZ + 2560);
        *(LAS u32x4*)(Ks + s * LROW + kg * 8) = ka;
        *(LAS u32x4*)(Ks + (s + 1) * LROW + kg * 8) = kb;
#pragma unroll
        for (int q = 0; q < 4; ++q) {
          const int r0 = (kg * 8 + 2 * q) * LROW + s, r1 = r0 + LROW;
          *(LAS unsigned*)(VT + r0) = (va[q] & 0xffffu) | (vb[q] << 16);
          *(LAS unsigned*)(VT + r1) = (va[q] >> 16) | (vb[q] & 0xffff0000u);
        }
      }
      if (tid < 64) *(LAS unsigned*)(VT + 128 * LROW + 2 * tid) = 0x3F803F80u;
    }
    u32x4 creg[5];
    {
      const bf16_t* cs0 = Cst + (size_t)(u * 2) * CST_ELEMS;
#pragma unroll
      for (int i = 0; i < 4; ++i) creg[i] = *(const u32x4*)(cs0 + (tid + 512 * i) * 8);
      creg[4] = *(const u32x4*)(cs0 + 16384 + (tid & 15) * 8);
#pragma unroll
      for (int i = 0; i < 4; ++i) { const int ci = tid + 512 * i; *(LAS u32x4*)(Cb + (ci >> 4) * LROW + (ci & 15) * 8) = creg[i]; }
      if (tid < 16) *(LAS u32x4*)(Cb + 128 * LROW + tid * 8) = creg[4];
    }
    __syncthreads();
    {
      const bf16_t* cs1 = Cst + (size_t)(u * 2 + 1) * CST_ELEMS;
#pragma unroll
      for (int i = 0; i < 4; ++i) creg[i] = *(const u32x4*)(cs1 + (tid + 512 * i) * 8);
      creg[4] = *(const u32x4*)(cs1 + 16384 + (tid & 15) * 8);
    }
    {
      const int w = wid;
      bf16x8 Qf[4];
      { const bf16_t* qr = Z + (size_t)(T0 + 16 * w + fr) * NZ + 1536 + h * 128 + 8 * fq;
#pragma unroll
        for (int ks = 0; ks < 4; ++ks) Qf[ks] = *(const bf16x8*)(qr + 32 * ks); }
      f32x4 hsum[8];
#pragma unroll
      for (int vt = 0; vt < 8; ++vt) hsum[vt] = (f32x4){0.f, 0.f, 0.f, 0.f};
      LAS bf16_t* Sw = Sb + w * 16 * LROW;
#pragma unroll
      for (int d = 0; d < 2; ++d) {
        if (d == 1) {
          __syncthreads();
#pragma unroll
          for (int i = 0; i < 4; ++i) { const int ci = tid + 512 * i; *(LAS u32x4*)(Cb + (ci >> 4) * LROW + (ci & 15) * 8) = creg[i]; }
          if (tid < 16) *(LAS u32x4*)(Cb + 128 * LROW + tid * 8) = creg[4];
          __syncthreads();
        }
        const int lo = d ? w : 0, hi = d ? 7 : w;
        const int ks_lo = lo >> 1, ks_hi = hi >> 1;
        float er4[4];
#pragma unroll
        for (int j = 0; j < 4; ++j) er4[j] = erA[d * 128 + 16 * w + 4 * fq + j];
#pragma unroll
        for (int nt = 0; nt < 8; ++nt) {
          if (nt >= 2 * ks_lo && nt <= 2 * ks_hi + 1) {
            f32x4 a = (f32x4){0.f, 0.f, 0.f, 0.f};
            if (nt >= lo && nt <= hi) {
#pragma unroll
              for (int ks = 0; ks < 4; ++ks) { const bf16x8 Kf = *(const LAS bf16x8*)(Ks + (16 * nt + fr) * LROW + 32 * ks + 8 * fq); a = __builtin_amdgcn_mfma_f32_16x16x32_bf16(Qf[ks], Kf, a, 0, 0, 0); }
              const float ecv = ecA[d * 128 + 16 * nt + fr];
#pragma unroll
              for (int j = 0; j < 4; ++j) {
                float val = a[j] * er4[j] * ecv;
                if (nt == w) { const int tl = 4 * fq + j; const bool ok = d ? (fr >= tl) : (fr <= tl); val = ok ? val : 0.f; }
                a[j] = val;
              }
            }
#pragma unroll
            for (int j = 0; j < 4; ++j) { const float nb = dppf<0x12F>(a[j]); if ((fr & 1) == 0) *(LAS unsigned*)(Sw + (4 * fq + j) * LROW + 16 * nt + fr) = cvt_pk_bf16_c(a[j], nb); }
          }
        }
        asm volatile("s_waitcnt lgkmcnt(0)" ::: "memory");
        f32x4 ao[9];
#pragma unroll
        for (int vt = 0; vt < 9; ++vt) ao[vt] = (f32x4){0.f, 0.f, 0.f, 0.f};
        const bf16x8 zf = (bf16x8){0, 0, 0, 0, 0, 0, 0, 0};
#pragma unroll
        for (int ks = 0; ks < 4; ++ks) {
          if (ks >= ks_lo && ks <= ks_hi) {
            const bf16x8 Sf = *(const LAS bf16x8*)(Sw + fr * LROW + 32 * ks + 8 * fq);
#pragma unroll
            for (int vt = 0; vt < 9; ++vt) {
              bf16x8 Vf = *(const LAS bf16x8*)(VT + (vt < 8 ? 16 * vt + fr : 128) * LROW + 32 * ks + 8 * fq);
              if (vt == 8 && fr != 0) Vf = zf;
              ao[vt] = __builtin_amdgcn_mfma_f32_16x16x32_bf16(Sf, Vf, ao[vt], 0, 0, 0);
            }
          }
        }
        {
          const float wv = wiA[d * 128 + 16 * w + fr];
#pragma unroll
          for (int ks = 0; ks < 4; ++ks) {
            const bf16x8 Qs = scale_frag(Qf[ks], wv);
#pragma unroll
            for (int vt = 0; vt < 9; ++vt) {
              bf16x8 Cf = *(const LAS bf16x8*)(Cb + (vt < 8 ? 16 * vt + fr : 128) * LROW + 32 * ks + 8 * fq);
              if (vt == 8 && fr != 0) Cf = zf;
              ao[vt] = __builtin_amdgcn_mfma_f32_16x16x32_bf16(Qs, Cf, ao[vt], 0, 0, 0);
            }
          }
        }
#pragma unroll
        for (int j = 0; j < 4; ++j) {
          const float den = __shfl(ao[8][j], lane & 48);
          const float fl = flA[d * 128 + 16 * w + 4 * fq + j];
          const float inv = 1.0f / fmaxf(fabsf(den), fl);
#pragma unroll
          for (int vt = 0; vt < 8; ++vt) hsum[vt][j] += ao[vt][j] * inv;
        }
        asm volatile("" ::: "memory");
      }
#pragma unroll
      for (int j = 0; j < 4; ++j) {
        float ms = 0.f;
#pragma unroll
        for (int vt = 0; vt < 8; ++vt) ms += hsum[vt][j] * hsum[vt][j];
        ms += __shfl_xor(ms, 1); ms += __shfl_xor(ms, 2); ms += __shfl_xor(ms, 4); ms += __shfl_xor(ms, 8);
        const float r = rsqrtf(ms * (1.0f / 128.0f) + EPS);
        const int T = T0 + 16 * w + 4 * fq + j;
#pragma unroll
        for (int vt = 0; vt < 8; ++vt) {
          const int col = h * 128 + 16 * vt + fr;
          const float og = bf2f(Z[(size_t)T * NZ + 3072 + col]);
          const float val = hsum[vt][j] * r * P.mh_norm[col] * fast_sigmoid(og);
          ucat[(size_t)T * DM + 512 + col] = f2bf_c(val);
        }
      }
    }
    __syncthreads();
  }
}

__device__ void phase7(const Params& P) {
  const int tid7 = opaque_tid(); const int wid = tid7 >> 6, lane = tid7 & 63;
  const float* rss2 = (const float*)(P.ws + WS_RSS2);
  f32x4 fn[4];
#pragma unroll
  for (int i = 0; i < 4; ++i) fn[i] = *(const f32x4*)(P.final_norm + i * 256 + lane * 4);
  const int stride = gridDim.x * 8;
  for (int T0 = blockIdx.x * 8 + wid; T0 < NTOK; T0 += 5 * stride) {
    f32x4 v[5][4]; float r[5];
#pragma unroll
    for (int q = 0; q < 5; ++q) {
      int T = T0 + q * stride; T = T < NTOK ? T : NTOK - 1;
      r[q] = rss2[T];
#pragma unroll
      for (int i = 0; i < 4; ++i) v[q][i] = *(const f32x4*)(P.out + (size_t)T * DM + i * 256 + lane * 4);
    }
#pragma unroll
    for (int q = 0; q < 5; ++q) {
      const int T = T0 + q * stride;
      if (T < NTOK) {
        const float rr = rsqrtf(r[q] * (1.0f / 1024.0f) + EPS);
#pragma unroll
        for (int i = 0; i < 4; ++i) *(f32x4*)(P.out + (size_t)T * DM + i * 256 + lane * 4) = v[q][i] * rr * fn[i];
      }
    }
  }
}


#define XB_TMO      128
#define XB_XCNT(j)  (256  + 64 * (j))
#define XB_XSUB(j)  (1280 + 64 * (j))
#define XB_XGEN(j)  (2304 + 64 * (j))
#define XB_TOP      3328
#define XB_TOPGEN   3392
#define XCD_BAR_WORDS 3456
#define XB_SPIN_CAP (1u << 18)
__device__ __forceinline__ unsigned xb_ld(unsigned* p)              { return __hip_atomic_load(p, __ATOMIC_RELAXED, __HIP_MEMORY_SCOPE_AGENT); }
__device__ __forceinline__ unsigned xb_add(unsigned* p, unsigned v) { return __hip_atomic_fetch_add(p, v, __ATOMIC_RELAXED, __HIP_MEMORY_SCOPE_AGENT); }
__device__ __forceinline__ unsigned xb_xcc_id() { return (unsigned)__builtin_amdgcn_s_getreg((3 << 11) | 20) & 0xFu; }
#define XB_SPIN(cond, bar) do { unsigned _sp = 0; while (cond) { __builtin_amdgcn_s_sleep(1); \
    if ((++_sp & 255u) == 0u) { if (xb_ld(&(bar)[XB_TMO])) break; if (_sp > XB_SPIN_CAP) { atomicAdd(&(bar)[XB_TMO], 1u); break; } } } } while (0)
struct XcdBarrier { unsigned* bar; unsigned x; volatile LAS unsigned* st; };
__device__ __forceinline__ XcdBarrier xcd_barrier_post(unsigned* bar, volatile LAS unsigned* st) {
  XcdBarrier b; b.bar = bar; b.x = xb_xcc_id(); b.st = st;
  if (threadIdx.x == 0) (void)xb_add(&bar[XB_XCNT(b.x)], 1u);
  return b;
}
__device__ __forceinline__ void xcd_barrier_complete(unsigned* bar, unsigned x, unsigned& nloc, unsigned& nx) {
  const unsigned G = gridDim.x * gridDim.y * gridDim.z;
  unsigned sum, cnt, mine, sp = 0u;
  for (;;) {
    sum = 0u; cnt = 0u; mine = 0u;
#pragma unroll
    for (unsigned j = 0; j < 16; ++j) { const unsigned c = xb_ld(&bar[XB_XCNT(j)]); sum += c; cnt += (c > 0u) ? 1u : 0u; mine = (j == x) ? c : mine; }
    if (sum == G) break;
    __builtin_amdgcn_s_sleep(1);
    if ((++sp & 255u) == 0u) { if (xb_ld(&bar[XB_TMO])) break; if (sp > XB_SPIN_CAP) { atomicAdd(&bar[XB_TMO], 1u); break; } }
  }
  nloc = mine > 0u ? mine : 1u; nx = cnt > 0u ? cnt : 1u;
}
__device__ __forceinline__ void xcd_barrier(const XcdBarrier& b) {
  asm volatile("s_waitcnt vmcnt(0) lgkmcnt(0)" ::: "memory");
  __syncthreads();
  if (threadIdx.x == 0) {
    unsigned* bar = b.bar;
    __builtin_amdgcn_s_waitcnt(0);
    unsigned nloc = b.st[0], nx = b.st[1];
    if (nloc == 0u) { xcd_barrier_complete(bar, b.x, nloc, nx); b.st[0] = nloc; b.st[1] = nx; }
    const unsigned old = xb_add(&bar[XB_XSUB(b.x)], 1u);
    const unsigned gen = old / nloc;
    if (old + 1u == (gen + 1u) * nloc) {
      __builtin_amdgcn_fence(__ATOMIC_RELEASE, "agent");
      asm volatile("s_waitcnt vmcnt(0)" ::: "memory");
      const unsigned og = xb_add(&bar[XB_TOP], 1u);
      const unsigned tg = og / nx;
      if (og + 1u == (tg + 1u) * nx) xb_add(&bar[XB_TOPGEN], 1u);
      else XB_SPIN(xb_ld(&bar[XB_TOPGEN]) == tg, bar);
      __builtin_amdgcn_fence(__ATOMIC_ACQUIRE, "agent");
      xb_add(&bar[XB_XGEN(b.x)], 1u);
      asm volatile("s_waitcnt vmcnt(0)" ::: "memory");
    } else {
      XB_SPIN(xb_ld(&bar[XB_XGEN(b.x)]) == gen, bar);
      __builtin_amdgcn_fence(__ATOMIC_ACQUIRE, "agent");
      asm volatile("s_waitcnt vmcnt(0)" ::: "memory");
    }
  }
  __syncthreads();
}

#define GSYNC() xcd_barrier(xb)
__global__ void __launch_bounds__(512, 2) fwd_megakernel(Params P) {
  extern __shared__ __attribute__((aligned(16))) unsigned char shm[];
  cg::grid_group grid = cg::this_grid();
  LAS unsigned char* lds = (LAS unsigned char*)shm;
  float* smf = (float*)shm;
  if (P.ws == nullptr) grid.sync();
  volatile LAS unsigned* xst = (volatile LAS unsigned*)(lds + (LDS_BYTES - 16));
  if (threadIdx.x == 0) { xst[0] = 0u; xst[1] = 0u; }
  __syncthreads();
  const XcdBarrier xb = xcd_barrier_post((unsigned*)(P.ws + WS_BAR), xst);
#define RUN_P2() { EpiZ E; E.Z = (bf16_t*)(P.ws + WS_Z); \
    gemm_phase<EpiZ>(lds, (const bf16_t*)(P.ws + WS_H), (const bf16_t*)(P.ws + WS_WIN), NTOK, NZ, DM, E); } GSYNC();
#define RUN_M() phaseM1(P, lds); shortconv_items(P); GSYNC(); phaseM2(P, smf); GSYNC(); phaseM3(P, lds); GSYNC();
#define RUN_P5() { EpiUp E; E.rowss1 = (const float*)(P.ws + WS_RSS1); E.sb = (const float*)(P.ws + WS_SB); E.cw = P.conv_ffn_w; E.cb = P.conv_ffn_b; E.act = (bf16_t*)(P.ws + WS_Z); \
    gemm_phase<EpiUp>(lds, (const bf16_t*)(P.ws + WS_H), (const bf16_t*)(P.ws + WS_WUP), NTOK, NUP, DM, E); } GSYNC();
  phase0a(P, smf);
  GSYNC();
  phase0b(P, smf);
  GSYNC();
  RUN_P2()
#if DUP == 2
  RUN_P2()
#endif
#if DUP == 21
  { EpiNone E; E.Z = (bf16_t*)(P.ws + WS_UCAT);
    gemm_phase<EpiNone>(lds, (const bf16_t*)(P.ws + WS_H), (const bf16_t*)(P.ws + WS_WIN), NTOK, NZ, DM, E); } GSYNC();
#endif
  RUN_M()
#if DUP == 3
  RUN_M()
#endif
#if DUP == 31
  phaseM1(P, lds); GSYNC();
#endif
#if DUP == 32
  phaseM2(P, smf); GSYNC();
#endif
#if DUP == 33
  phaseM3(P, lds); GSYNC();
#endif
#if DUP == 34
  shortconv_items(P); GSYNC();
#endif
#if DUP == 6
  RUN_P5()
#endif
  { EpiX1 E; E.xp = P.x_prompt; E.xs = P.x_sample; E.mod = (const float*)(P.ws + WS_MOD); E.norm2 = P.norm2; E.x1out = P.out; E.x1g = (bf16_t*)(P.ws + WS_H); E.rowss = (float*)(P.ws + WS_RSS1);
    gemm_phase<EpiX1>(lds, (const bf16_t*)(P.ws + WS_UCAT), (const bf16_t*)(P.ws + WS_WOUT), NTOK, DM, DM, E); }
  GSYNC();
  RUN_P5()
#if DUP == 5
  RUN_P5()
#endif
  { EpiDown E; E.mod = (const float*)(P.ws + WS_MOD); E.out = P.out; E.rowss2 = (float*)(P.ws + WS_RSS2);
    gemm_phase<EpiDown>(lds, (const bf16_t*)(P.ws + WS_Z), (const bf16_t*)(P.ws + WS_WDN), NTOK, DM, DFF, E); }
  GSYNC();
  phase7(P);
}

extern "C" void kernel_launch(void* const* d_in, const int* in_sizes, int n_in, void* d_out, int out_size, void* d_ws, size_t ws_size, hipStream_t stream) {
  static int grid_blocks = 0;
  if (!grid_blocks) {
    int dev = 0, cus = 0, per_cu = 0;
    hipGetDevice(&dev);
    hipDeviceGetAttribute(&cus, hipDeviceAttributeMultiprocessorCount, dev);
    hipFuncSetAttribute((const void*)fwd_megakernel, hipFuncAttributeMaxDynamicSharedMemorySize, LDS_BYTES);
    hipOccupancyMaxActiveBlocksPerMultiprocessor(&per_cu, (const void*)fwd_megakernel, 512, LDS_BYTES);
    (void)hipGetLastError();
    if (per_cu < 1) per_cu = 1;
    if (per_cu > 1) per_cu = 1;
    grid_blocks = cus * per_cu;
  }
  hipMemsetAsync(d_ws, 0, WS_ZERO_BYTES, stream);
  Params p{};
  const float** pp = (const float**)&p;
  for (int i = 0; i < 22; ++i) pp[i] = (const float*)d_in[i];
  p.out = (float*)d_out; p.ws = (unsigned char*)d_ws;
  void* args[] = {&p};
  hipError_t e = hipLaunchCooperativeKernel((const void*)fwd_megakernel, dim3(grid_blocks), dim3(512), args, LDS_BYTES, stream);
  if (e != hipSuccess) fprintf(stderr, "cooperative launch failed: %s (grid %d)\n", hipGetErrorString(e), grid_blocks);
}
```

```cpp
#include <hip/hip_runtime.h>
#include <hip/hip_cooperative_groups.h>
#include <cstdio>
namespace cg = cooperative_groups;

#ifndef DUP
#define DUP 0
#endif
#define LAS __attribute__((address_space(3)))
typedef unsigned short bf16_t;
typedef short bf16x8 __attribute__((ext_vector_type(8)));
typedef float f32x4 __attribute__((ext_vector_type(4)));
typedef unsigned u32x2 __attribute__((ext_vector_type(2)));
typedef unsigned u32x4 __attribute__((ext_vector_type(4)));

constexpr int DM = 1024, NTOK = 20480, NCTXT = 4096, DIN = 3600, NZ = 3584, DFF = 2816, NUP = 5632, NMOD = 6144;
constexpr float EPS = 1e-6f;
constexpr size_t WS_MOD = 0, WS_SB = 122880, WS_RSS1 = 235520, WS_RSS2 = 317440, WS_BAR = 399360, WS_ZERO_BYTES = 415744;
constexpr size_t WS_GATES = 415744, WS_STAT = 1726464, WS_MST = 1736704;
constexpr size_t WS_WIN = 2097152, WS_WOUT = 9437184, WS_WUP = 11534336, WS_WDN = 23068672;
constexpr size_t WS_H = 28835840;
constexpr size_t WS_UCAT = 71106560;
constexpr size_t WS_Z = 113049600;
constexpr int OUT_TAIL = 20971520;
constexpr int LDS_BYTES = 146432;

struct Params {
  const float *x_prompt, *x_sample, *state_C, *state_n, *state_m, *c, *c_ctx, *w_mod, *b_mod, *norm1, *w_in, *b_gate,
      *conv_sc_w, *conv_sc_b, *mh_norm, *w_out, *norm2, *w_up, *conv_ffn_w, *conv_ffn_b, *w_down, *final_norm;
  float* out; unsigned char* ws;
};

typedef __bf16 bf16x2_n __attribute__((ext_vector_type(2)));
typedef float f32x2_n __attribute__((ext_vector_type(2)));
__device__ __forceinline__ unsigned cvt_pk_bf16_c(float lo, float hi) { const f32x2_n v = {lo, hi}; return __builtin_bit_cast(unsigned, __builtin_convertvector(v, bf16x2_n)); }
__device__ __forceinline__ unsigned cvt_pk_bf16(float lo, float hi) { unsigned r; asm("v_cvt_pk_bf16_f32 %0, %1, %2" : "=v"(r) : "v"(lo), "v"(hi)); return r; }
__device__ __forceinline__ bf16_t f2bf_c(float f) { return (bf16_t)(cvt_pk_bf16_c(f, 0.f) & 0xffffu); }
__device__ __forceinline__ bf16_t f2bf(float f) { return (bf16_t)(cvt_pk_bf16(f, 0.f) & 0xffffu); }
__device__ __forceinline__ float bf2f(bf16_t b) { return __uint_as_float(((unsigned)b) << 16); }
__device__ __forceinline__ float bflo(unsigned u) { return __uint_as_float(u << 16); }
__device__ __forceinline__ float bfhi(unsigned u) { return __uint_as_float(u & 0xffff0000u); }
__device__ __forceinline__ int permtok(int T) { if (T < NCTXT) return T; const int q = T - NCTXT; return NCTXT + (q & ~4095) + ((q & 63) << 6) + ((q >> 6) & 63); }
template <int CTRL> __device__ __forceinline__ float dppf(float x) { return __builtin_bit_cast(float, __builtin_amdgcn_mov_dpp(__builtin_bit_cast(int, x), CTRL, 0xf, 0xf, true)); }
__device__ __forceinline__ float fast_sigmoid(float x) { return __builtin_amdgcn_rcpf(1.0f + __expf(-x)); }

__device__ __forceinline__ int opaque_tid() { int t = threadIdx.x; asm volatile("" : "+v"(t)); return t; }

constexpr int BM = 256, BK = 64, HALF = 128, HTB = HALF * BK * 2, NXCD = 8, WGM = 8;
__device__ __forceinline__ int lds_byte(int r, int c) { const int st = (r >> 4) * 2 + (c >> 5), rr = r & 15, cc = c & 31, ob = rr * 64 + cc * 2; return st * 1024 + (ob ^ (((ob >> 9) & 1) << 5)); }
__device__ __forceinline__ void stage_rc(int b, int& R, int& C) { const int st = b / 1024, sb = b % 1024, swz = sb ^ (((sb >> 9) & 1) << 5); R = (st >> 1) * 16 + swz / 64; C = (st & 1) * 32 + (swz % 64) / 2; }

struct Order {
  int nM, nN, nwg, G, c;
  __device__ __forceinline__ void init(int M, int N) { nM = M / BM; nN = N / BM; nwg = nM * nN; G = gridDim.x; c = blockIdx.x; }
  template <int MODE> __device__ __forceinline__ bool next_m(int i, int& pm, int& pn, int& kb, int& ntu, int nt_full) const {
    if (MODE == 0) { kb = 0; ntu = nt_full; return next(i, pm, pn); }
    const long L = (long)i * G + c; if (L >= 256) return false;
    const int x = (int)L & 7, j = (int)L >> 3, kq = j & 3;
    pm = 64 + 2 * x + (j >> 4); pn = ((j >> 2) & 3) | (kq << 8);
    kb = kq < 2 ? 12 * kq : 24 + 10 * (kq - 2); ntu = kq < 2 ? 12 : 10; return true;
  }
  __device__ __forceinline__ bool next(int i, int& pm, int& pn) const {
    const long L = (long)i * G + c; if (L >= nwg) return false;
    int wgid = (int)L; { const int q = nwg / NXCD, r = nwg % NXCD, xcd = wgid % NXCD, off = wgid / NXCD; wgid = (xcd < r ? xcd * (q + 1) : r * (q + 1) + (xcd - r) * q) + off; }
    const int nig = WGM * nN, gid = wgid / nig, fm = gid * WGM, gsz = (nM - fm) < WGM ? (nM - fm) : WGM;
    pm = fm + ((wgid % nig) % gsz); pn = (wgid % nig) / gsz; return true;
  }
};

template <class Epi, int MODE = 0>
__device__ __forceinline__ void gemm_phase(LAS unsigned char* lds, const bf16_t* gA, const bf16_t* gBt, int M, int N, int K, const Epi& E) {
  const int tid = opaque_tid(), wid = __builtin_amdgcn_readfirstlane(tid >> 6), lane = tid & 63, wr = wid >> 2, wc = wid & 3, fr = lane & 15, fq = lane >> 4;
  const int nt = K / BK;
  Order S; S.init(M, N);
  unsigned voffA[2];
#pragma unroll
  for (int i = 0; i < 2; ++i) { int R, C; stage_rc(tid * 16 + i * 8192, R, C); voffA[i] = (unsigned)(R * K + C) * 2u; }
  const size_t kstep = (size_t)(BK * 2);
  const size_t hstep = (size_t)HALF * K * 2;
  const size_t tstep = 2 * hstep;
  const unsigned ldsw = (unsigned)wid * 1024u;
  const int aoff = lds_byte(wr * 64 + fr, fq * 8), boff = lds_byte(wc * 32 + fr, fq * 8);
#define G_SA(b, h) (((b) * 2 + (h)) * HTB)
#define G_SB(b, h) ((4 + (b) * 2 + (h)) * HTB)
#define G_STAGE(bufoff, gbase) do { _Pragma("unroll") for (int _i = 0; _i < 2; ++_i) \
    __builtin_amdgcn_global_load_lds((const unsigned*)((const char*)(gbase) + voffA[_i]), (LAS unsigned*)(lds + (bufoff) + ldsw + _i * 8192), 16, 0, 0); } while (0)
#define G_LDA(dst, b, h) do { _Pragma("unroll") for (int m = 0; m < 4; ++m) _Pragma("unroll") for (int k = 0; k < 2; ++k) dst[m][k] = *(const LAS bf16x8*)(lds + G_SA(b, h) + aoff + m * 2048 + k * 1024); } while (0)
#define G_LDB(dst, b, h) do { _Pragma("unroll") for (int n = 0; n < 2; ++n) _Pragma("unroll") for (int k = 0; k < 2; ++k) dst[n][k] = *(const LAS bf16x8*)(lds + G_SB(b, h) + boff + n * 2048 + k * 1024); } while (0)
#define G_MMA(ai, bj, At, Bt) do { __builtin_amdgcn_s_setprio(1); _Pragma("unroll") for (int m = 0; m < 4; ++m) _Pragma("unroll") for (int n = 0; n < 2; ++n) _Pragma("unroll") for (int k = 0; k < 2; ++k) \
    acc[ai][bj][m][n] = __builtin_amdgcn_mfma_f32_16x16x32_bf16(Bt[n][k], At[m][k], acc[ai][bj][m][n], 0, 0, 0); __builtin_amdgcn_s_setprio(0); } while (0)
#define G_WAIT_V(n) asm volatile("s_waitcnt vmcnt(" #n ")" ::: "memory")
#define G_WAIT_L(n) asm volatile("s_waitcnt lgkmcnt(" #n ")" ::: "memory")
#define G_BAR __builtin_amdgcn_s_barrier()
#define G_SCHED __builtin_amdgcn_sched_barrier(0)
  int cpm, cpn, npm = 0, npn = 0, ui = 0, ckb = 0, cnt = nt, nkb = 0, nnt = nt;
  if (!S.template next_m<MODE>(0, cpm, cpn, ckb, cnt, nt)) return;
  f32x4 acc[2][2][4][2];
#pragma unroll
  for (int a = 0; a < 2; ++a)
#pragma unroll
    for (int b = 0; b < 2; ++b)
#pragma unroll
      for (int m = 0; m < 4; ++m)
#pragma unroll
        for (int n = 0; n < 2; ++n) acc[a][b][m][n] = (f32x4){0.f, 0.f, 0.f, 0.f};
  bf16x8 At[4][2], B0[2][2], B1[2][2];
  const char* cA = (const char*)gA + (size_t)cpm * tstep + (size_t)ckb * kstep; const char* cB = (const char*)gBt + (size_t)(cpn & 255) * tstep + (size_t)ckb * kstep;
  G_STAGE(G_SB(0, 0), cB); G_STAGE(G_SA(0, 0), cA); G_STAGE(G_SB(0, 1), cB + hstep); G_STAGE(G_SA(0, 1), cA + hstep);
  if (wr == 1) G_BAR;
  G_WAIT_V(4); G_BAR;
  G_STAGE(G_SB(1, 0), cB + kstep); G_STAGE(G_SA(1, 0), cA + kstep); G_STAGE(G_SB(1, 1), cB + hstep + kstep);
  G_WAIT_V(6); G_BAR;
  for (;;) {
    const bool has_next = S.template next_m<MODE>(ui + 1, npm, npn, nkb, nnt, nt);
    const char* nA = has_next ? (const char*)gA + (size_t)npm * tstep + (size_t)nkb * kstep : cA; const char* nB = has_next ? (const char*)gBt + (size_t)(npn & 255) * tstep + (size_t)nkb * kstep : cB;
    for (int t = 0; t < cnt; t += 2) {
      const bool last = (t == cnt - 2);
      const char* a1 = cA + (size_t)(t + 1) * kstep;
      const char* a2 = last ? nA : cA + (size_t)(t + 2) * kstep; const char* b2 = last ? nB : cB + (size_t)(t + 2) * kstep;
      const char* a3 = a2 + kstep; const char* b3 = b2 + kstep;
      G_LDB(B0, 0, 0); G_SCHED; G_LDA(At, 0, 0); G_STAGE(G_SA(1, 1), a1 + hstep);
      G_WAIT_L(8); G_BAR; G_WAIT_L(0); G_MMA(0, 0, At, B0); G_BAR; G_SCHED;
      G_LDB(B1, 0, 1); G_STAGE(G_SB(0, 0), b2);
      G_BAR; G_WAIT_L(0); G_MMA(0, 1, At, B1); G_BAR;
      G_LDA(At, 0, 1); G_STAGE(G_SA(0, 0), a2);
      G_BAR; G_WAIT_L(0); G_MMA(1, 0, At, B0); G_BAR; G_SCHED;
      G_STAGE(G_SB(0, 1), b2 + hstep);
      G_WAIT_V(6); G_BAR; G_MMA(1, 1, At, B1); G_BAR;
      G_LDB(B0, 1, 0); G_SCHED; G_LDA(At, 1, 0); G_STAGE(G_SA(0, 1), a2 + hstep);
      G_WAIT_L(8); G_BAR; G_WAIT_L(0); G_MMA(0, 0, At, B0); G_BAR; G_SCHED;
      G_LDB(B1, 1, 1); G_STAGE(G_SB(1, 0), b3);
      G_BAR; G_WAIT_L(0); G_MMA(0, 1, At, B1); G_BAR;
      G_LDA(At, 1, 1); G_STAGE(G_SA(1, 0), a3);
      G_BAR; G_WAIT_L(0); G_MMA(1, 0, At, B0); G_BAR; G_SCHED;
      G_STAGE(G_SB(1, 1), b3 + hstep);
      G_WAIT_V(6); G_BAR; G_MMA(1, 1, At, B1); G_BAR;
    }
    asm volatile("s_nop 15\n\ts_nop 15" ::: "memory");
    E(acc, cpm, cpn, wr, wc, fr, fq, lds);
    if (!has_next) break;
#pragma unroll
    for (int a = 0; a < 2; ++a)
#pragma unroll
      for (int b = 0; b < 2; ++b)
#pragma unroll
        for (int m = 0; m < 4; ++m)
#pragma unroll
          for (int n = 0; n < 2; ++n) acc[a][b][m][n] = (f32x4){0.f, 0.f, 0.f, 0.f};
    cpm = npm; cpn = npn; cA = nA; cB = nB; cnt = nnt; ++ui;
  }
  G_WAIT_V(0);
  if (wr == 0) G_BAR;
  G_BAR;
}

struct EpiZ {
  bf16_t* Z;
  __device__ __forceinline__ void operator()(f32x4 (&acc)[2][2][4][2], int pm, int pn, int wr, int wc, int fr, int fq, LAS unsigned char*) const {
    const int row0 = pm * BM + wr * 64 + fr, col0 = pn * BM + wc * 32 + 8 * fq;
#pragma unroll
    for (int ai = 0; ai < 2; ++ai)
#pragma unroll
      for (int m = 0; m < 4; ++m) {
        bf16_t* rowp = Z + (size_t)(row0 + ai * HALF + m * 16) * NZ + col0;
#pragma unroll
        for (int bj = 0; bj < 2; ++bj) { const f32x4 v0 = acc[ai][bj][m][0], v1 = acc[ai][bj][m][1];
          u32x4 o; o.x = cvt_pk_bf16(v0[0], v0[1]); o.y = cvt_pk_bf16(v0[2], v0[3]); o.z = cvt_pk_bf16(v1[0], v1[1]); o.w = cvt_pk_bf16(v1[2], v1[3]);
          *(u32x4*)(rowp + bj * HALF) = o; }
      }
  }
};

struct EpiNone {
  bf16_t* Z;
  __device__ __forceinline__ void operator()(f32x4 (&acc)[2][2][4][2], int pm, int pn, int wr, int wc, int fr, int fq, LAS unsigned char*) const {
    f32x4 s = (f32x4){0.f, 0.f, 0.f, 0.f};
#pragma unroll
    for (int ai = 0; ai < 2; ++ai)
#pragma unroll
      for (int bj = 0; bj < 2; ++bj)
#pragma unroll
        for (int m = 0; m < 4; ++m)
#pragma unroll
          for (int n = 0; n < 2; ++n) s += acc[ai][bj][m][n];
    if (s[0] + s[1] + s[2] + s[3] == 12345.678f) Z[pm + pn] = 1;
  }
};

struct EpiX1 {
  const float* xp; const float* xs; const float* mod; const float* norm2; float* x1out; bf16_t* x1g; float* rowss;
  __device__ __forceinline__ void operator()(f32x4 (&acc)[2][2][4][2], int pm, int pn, int wr, int wc, int fr, int fq, LAS unsigned char*) const {
    const int g = pm < 16 ? 4 : ((pm - 16) >> 4);
    const float* modg = mod + g * NMOD;
    const int col0 = pn * BM + wc * 32 + 4 * fq;
    f32x4 g1[2][2], g2[2][2];
#pragma unroll
    for (int bj = 0; bj < 2; ++bj)
#pragma unroll
      for (int n = 0; n < 2; ++n) { const int c = col0 + bj * HALF + n * 16; g1[bj][n] = *(const f32x4*)(modg + 2048 + c); const f32x4 s2 = *(const f32x4*)(modg + 4096 + c); const f32x4 nv = *(const f32x4*)(norm2 + c); g2[bj][n] = nv * (s2 + 1.0f); }
#pragma unroll
    for (int ai = 0; ai < 2; ++ai)
#pragma unroll
      for (int m = 0; m < 4; ++m) {
        const int T = pm * BM + ai * HALF + wr * 64 + m * 16 + fr;
        const float* xrow = (T < NCTXT) ? xp + (size_t)T * DM : xs + (size_t)(T - NCTXT) * DM;
        const int p = permtok(T);
        float ss = 0.f;
#pragma unroll
        for (int bj = 0; bj < 2; ++bj)
#pragma unroll
          for (int n = 0; n < 2; ++n) {
            const int c = col0 + bj * HALF + n * 16;
            const f32x4 xv = *(const f32x4*)(xrow + c);
            const f32x4 v = xv + g1[bj][n] * acc[ai][bj][m][n];
            *(f32x4*)(x1out + (size_t)T * DM + c) = v;
            ss += v[0] * v[0] + v[1] * v[1] + v[2] * v[2] + v[3] * v[3];
            const f32x4 w = v * g2[bj][n];
            u32x2 o; o.x = cvt_pk_bf16(w[0], w[1]); o.y = cvt_pk_bf16(w[2], w[3]);
            *(u32x2*)(x1g + (size_t)p * DM + c) = o;
          }
        ss += __shfl_xor(ss, 16); ss += __shfl_xor(ss, 32);
        if (fq == 0) __hip_atomic_fetch_add(rowss + p, ss, __ATOMIC_RELAXED, __HIP_MEMORY_SCOPE_AGENT);
      }
  }
};

struct EpiDown {
  const float* mod; float* out; float* rowss2;
  __device__ __forceinline__ void operator()(f32x4 (&acc)[2][2][4][2], int pm, int pn, int wr, int wc, int fr, int fq, LAS unsigned char*) const {
    const int g = pm < 16 ? 4 : ((pm - 16) >> 4);
    const float* modg = mod + g * NMOD;
    const int col0 = pn * BM + wc * 32 + 4 * fq;
    f32x4 g2[2][2];
#pragma unroll
    for (int bj = 0; bj < 2; ++bj)
#pragma unroll
      for (int n = 0; n < 2; ++n) g2[bj][n] = *(const f32x4*)(modg + 5120 + col0 + bj * HALF + n * 16);
#pragma unroll
    for (int ai = 0; ai < 2; ++ai)
#pragma unroll
      for (int m = 0; m < 4; ++m) {
        const int p = pm * BM + ai * HALF + wr * 64 + m * 16 + fr;
        const int T = permtok(p);
        float* orow = out + (size_t)T * DM;
        float ss = 0.f;
#pragma unroll
        for (int bj = 0; bj < 2; ++bj)
#pragma unroll
          for (int n = 0; n < 2; ++n) {
            const int c = col0 + bj * HALF + n * 16;
            const f32x4 xv = *(const f32x4*)(orow + c);
            const f32x4 v = xv + g2[bj][n] * acc[ai][bj][m][n];
            *(f32x4*)(orow + c) = v;
            ss += v[0] * v[0] + v[1] * v[1] + v[2] * v[2] + v[3] * v[3];
          }
        ss += __shfl_xor(ss, 16); ss += __shfl_xor(ss, 32);
        if (fq == 0) __hip_atomic_fetch_add(rowss2 + T, ss, __ATOMIC_RELAXED, __HIP_MEMORY_SCOPE_AGENT);
      }
  }
};

struct EpiDownPart {
  const float* mod; float* out; float* part;
  __device__ __forceinline__ void operator()(f32x4 (&acc)[2][2][4][2], int pm, int pnk, int wr, int wc, int fr, int fq, LAS unsigned char*) const {
    const int pn = pnk & 255, kq = pnk >> 8;
    const int g = pm < 16 ? 4 : ((pm - 16) >> 4);
    const float* modg = mod + g * NMOD;
    const int col0 = pn * BM + wc * 32 + 4 * fq;
    f32x4 g2[2][2];
#pragma unroll
    for (int bj = 0; bj < 2; ++bj)
#pragma unroll
      for (int n = 0; n < 2; ++n) g2[bj][n] = *(const f32x4*)(modg + 5120 + col0 + bj * HALF + n * 16);
#pragma unroll
    for (int ai = 0; ai < 2; ++ai)
#pragma unroll
      for (int m = 0; m < 4; ++m) {
        const int p = pm * BM + ai * HALF + wr * 64 + m * 16 + fr;
        const int T = permtok(p);
        if (kq == 0) {
          float* orow = out + (size_t)T * DM;
#pragma unroll
          for (int bj = 0; bj < 2; ++bj)
#pragma unroll
            for (int n = 0; n < 2; ++n) { const int c = col0 + bj * HALF + n * 16; const f32x4 xv = *(const f32x4*)(orow + c); *(f32x4*)(orow + c) = xv + g2[bj][n] * acc[ai][bj][m][n]; }
        } else {
          float* prow = part + ((size_t)(kq - 1) * 4096 + (T - 16384)) * DM;
#pragma unroll
          for (int bj = 0; bj < 2; ++bj)
#pragma unroll
            for (int n = 0; n < 2; ++n) { const int c = col0 + bj * HALF + n * 16; *(f32x4*)(prow + c) = g2[bj][n] * acc[ai][bj][m][n]; }
        }
      }
  }
};

struct EpiUp {
  const float* rowss1; const float* sb; const float* cw; const float* cb; bf16_t* act;
  __device__ __forceinline__ void operator()(f32x4 (&acc)[2][2][4][2], int pm, int pn, int wr, int wc, int fr, int fq, LAS unsigned char* lds) const {
    asm volatile("" : "+v"(fr), "+v"(fq));
    const bool ctx = pm < 16;
    const int g = ctx ? 4 : ((pm - 16) >> 4);
    const float* sbg = sb + g * NUP;
    LAS float* halo = (LAS float*)(lds + 131072);
    const int prow0 = pm * BM + wr * 64 + fr;
    {
      float rs[2][4];
#pragma unroll
      for (int ai = 0; ai < 2; ++ai)
#pragma unroll
        for (int m = 0; m < 4; ++m) rs[ai][m] = __builtin_amdgcn_rsqf(rowss1[prow0 + ai * HALF + m * 16] * (1.0f / 1024.0f) + EPS);
#pragma unroll
      for (int bj = 0; bj < 2; ++bj)
#pragma unroll
        for (int n = 0; n < 2; ++n) {
          asm volatile("" ::: "memory"); __builtin_amdgcn_sched_barrier(0);
          const f32x4 sv = *(const f32x4*)(sbg + bj * DFF + pn * HALF + wc * 32 + 8 * fq + 4 * n);
#pragma unroll
          for (int ai = 0; ai < 2; ++ai)
#pragma unroll
            for (int m = 0; m < 4; ++m) { acc[ai][bj][m][n] = acc[ai][bj][m][n] * rs[ai][m] + sv; asm volatile("" : "+v"(acc[ai][bj][m][n])); }
        }
    }
    if (ctx) {
#pragma unroll
      for (int ai = 0; ai < 2; ++ai)
#pragma unroll
        for (int bj = 0; bj < 2; ++bj)
#pragma unroll
          for (int n = 0; n < 2; ++n) {
            const int rb = 2 * ai + wr, colt = bj * HALF + wc * 32 + 8 * fq + 4 * n;
            if (fr == 0) *(LAS f32x4*)(halo + (rb * 2 + 0) * 256 + colt) = acc[ai][bj][0][n];
            if (fr == 15) *(LAS f32x4*)(halo + (rb * 2 + 1) * 256 + colt) = acc[ai][bj][3][n];
          }
      asm volatile("s_waitcnt lgkmcnt(0)" ::: "memory");
      __builtin_amdgcn_s_barrier();
      __builtin_amdgcn_s_barrier();
      asm volatile("" ::: "memory");
    }
#pragma unroll
    for (int ai = 0; ai < 2; ++ai) {
      u32x2 st[4];
#pragma unroll
      for (int n = 0; n < 2; ++n) {
        f32x4 ya[4];
        const int rb = 2 * ai + wr;
#pragma unroll
        for (int bj = 0; bj < 2; ++bj) {
          const int cnat = bj * DFF + pn * HALF + wc * 32 + 8 * fq + 4 * n, colt = bj * HALF + wc * 32 + 8 * fq + 4 * n;
          const f32x4 w0 = *(const f32x4*)(cw + cnat), w1 = *(const f32x4*)(cw + NUP + cnat), w2 = *(const f32x4*)(cw + 2 * NUP + cnat), bb = *(const f32x4*)(cb + cnat);
          f32x4 hp = (f32x4){0.f, 0.f, 0.f, 0.f}, hn = hp;
          if (ctx) {
            if (rb > 0) hp = *(const LAS f32x4*)(halo + ((rb - 1) * 2 + 1) * 256 + colt);
            if (rb < 3) hn = *(const LAS f32x4*)(halo + ((rb + 1) * 2 + 0) * 256 + colt);
          }
#pragma unroll
          for (int m = 0; m < 4; ++m) {
            const f32x4 cur = acc[ai][bj][m][n];
            f32x4 prev, next;
#pragma unroll
            for (int e = 0; e < 4; ++e) {
              if (m > 0) { const float snd = (fr == 15) ? acc[ai][bj][m > 0 ? m - 1 : 0][n][e] : cur[e]; prev[e] = dppf<0x121>(snd); }
              else { const float rcv = dppf<0x121>(cur[e]); prev[e] = (fr == 0) ? hp[e] : rcv; }
              if (m < 3) { const float snd = (fr == 0) ? acc[ai][bj][m < 3 ? m + 1 : 3][n][e] : cur[e]; next[e] = dppf<0x12F>(snd); }
              else { const float rcv = dppf<0x12F>(cur[e]); next[e] = (fr == 15) ? hn[e] : rcv; }
            }
            const f32x4 y = w0 * prev + w1 * cur + w2 * next + bb;
            if (bj == 0) ya[m] = y;
            else {
              float o[4];
#pragma unroll
              for (int e = 0; e < 4; ++e) o[e] = y[e] * fast_sigmoid(y[e]) * ya[m][e];
              u32x2 ov; ov.x = cvt_pk_bf16(o[0], o[1]); ov.y = cvt_pk_bf16(o[2], o[3]);
              if (n == 0) st[m] = ov;
              else { u32x4 o4; o4.x = st[m].x; o4.y = st[m].y; o4.z = ov.x; o4.w = ov.y;
                *(u32x4*)(act + (size_t)(prow0 + ai * HALF + m * 16) * DFF + pn * HALF + wc * 32 + 8 * fq) = o4; }
            }
          }
        }
      }
    }
  }
};

template <bool SILU>
__device__ __forceinline__ void gemv5_unit(const Params& P, int unit, int ncb, const float* W, int ldw, float* outp, int ldo, const float* bias, const float* modv, float* sm) {
  const int tid = opaque_tid();
  const int cb = unit % ncb, ks = unit / ncb, n0 = cb * 256, k0 = ks * 128;
  float* sv = sm; float* red = sm + 640;
  for (int i = tid; i < 640; i += 512) {
    const int g = i >> 7, k = k0 + (i & 127);
    float v;
    if (SILU) { v = (g < 4) ? P.c[g * DM + k] : P.c_ctx[k]; v = v / (1.0f + __expf(-v)); }
    else v = modv[g * NMOD + 3072 + k];
    sv[i] = v;
  }
  __syncthreads();
  const int col = tid & 255, kh = tid >> 8;
  float a0 = 0.f, a1 = 0.f, a2 = 0.f, a3 = 0.f, a4 = 0.f;
  const float* wp = W + (size_t)(k0 + kh * 64) * ldw + n0 + col;
#pragma unroll 8
  for (int kk = 0; kk < 64; ++kk) {
    const float w = wp[(size_t)kk * ldw];
    const int ki = kh * 64 + kk;
    a0 += sv[ki] * w; a1 += sv[128 + ki] * w; a2 += sv[256 + ki] * w; a3 += sv[384 + ki] * w; a4 += sv[512 + ki] * w;
  }
  if (kh == 1) { red[col] = a0; red[256 + col] = a1; red[512 + col] = a2; red[768 + col] = a3; red[1024 + col] = a4; }
  __syncthreads();
  if (kh == 0) {
    const float bv = (bias != nullptr && ks == 0) ? bias[n0 + col] : 0.f;
    a0 += red[col] + bv; a1 += red[256 + col] + bv; a2 += red[512 + col] + bv; a3 += red[768 + col] + bv; a4 += red[1024 + col] + bv;
    float* o = outp + n0 + col;
    __hip_atomic_fetch_add(o, a0, __ATOMIC_RELAXED, __HIP_MEMORY_SCOPE_AGENT);
    __hip_atomic_fetch_add(o + ldo, a1, __ATOMIC_RELAXED, __HIP_MEMORY_SCOPE_AGENT);
    __hip_atomic_fetch_add(o + 2 * ldo, a2, __ATOMIC_RELAXED, __HIP_MEMORY_SCOPE_AGENT);
    __hip_atomic_fetch_add(o + 3 * ldo, a3, __ATOMIC_RELAXED, __HIP_MEMORY_SCOPE_AGENT);
    __hip_atomic_fetch_add(o + 4 * ldo, a4, __ATOMIC_RELAXED, __HIP_MEMORY_SCOPE_AGENT);
  }
  __syncthreads();
}

struct TrUnit { const float* src; bf16_t* dst; int ldw, ldd, perm; };
__device__ __forceinline__ void tr_decode(const Params& P, int v, TrUnit& t) {
  bf16_t* WinT = (bf16_t*)(P.ws + WS_WIN); bf16_t* WoutT = (bf16_t*)(P.ws + WS_WOUT); bf16_t* WupT = (bf16_t*)(P.ws + WS_WUP); bf16_t* WdnT = (bf16_t*)(P.ws + WS_WDN);
  if (v < 896) { const int kt = v / 56, ntl = v % 56; t.src = P.w_in + (size_t)(kt * 64) * DIN + ntl * 64; t.ldw = DIN; t.dst = WinT + (size_t)(ntl * 64) * DM + kt * 64; t.ldd = DM; t.perm = 1; }
  else if (v < 1152) { const int w = v - 896, kt = w >> 4, ntl = w & 15; t.src = P.w_out + (size_t)(kt * 64) * DM + ntl * 64; t.ldw = DM; t.dst = WoutT + (size_t)(ntl * 64) * DM + kt * 64; t.ldd = DM; t.perm = 0; }
  else if (v < 2560) { const int w = v - 1152, kt = w / 88, ntl = w % 88; const int n0 = ntl * 64, half = n0 / DFF, r = n0 % DFF, pn = r >> 7, cc = r & 127;
    t.src = P.w_up + (size_t)(kt * 64) * NUP + n0; t.ldw = NUP; t.dst = WupT + (size_t)(pn * 256 + half * 128 + cc) * DM + kt * 64; t.ldd = DM; t.perm = 1; }
  else { const int w = v - 2560, kt = w >> 4, ntl = w & 15; t.src = P.w_down + (size_t)(kt * 64) * DM + ntl * 64; t.ldw = DM; t.dst = WdnT + (size_t)(ntl * 64) * DFF + kt * 64; t.ldd = DFF; t.perm = 0; }
}
__device__ void phase0a(const Params& P, float* sm) {
  const int tid = opaque_tid();
  float* mod = (float*)(P.ws + WS_MOD);
  for (int u = blockIdx.x; u < 24 * 8; u += gridDim.x) gemv5_unit<true>(P, u, 24, P.w_mod, NMOD, mod, NMOD, P.b_mod, nullptr, sm);
  constexpr int NTR = 896 + 256 + 1408 + 704;
  const int r = tid >> 4, c4 = (tid & 15) * 4, nn = tid >> 3, kk8 = (tid & 7) * 8;
  float* tile = sm;
  int v = gridDim.x - 1 - blockIdx.x;
  f32x4 p0 = (f32x4){0.f, 0.f, 0.f, 0.f}, p1 = p0; TrUnit cur;
  if (v < NTR) { tr_decode(P, v, cur); p0 = *(const f32x4*)(cur.src + (size_t)r * cur.ldw + c4); p1 = *(const f32x4*)(cur.src + (size_t)(r + 32) * cur.ldw + c4); }
  while (v < NTR) {
    { float* t = tile + r * 65 + c4; t[0] = p0[0]; t[1] = p0[1]; t[2] = p0[2]; t[3] = p0[3]; t += 32 * 65; t[0] = p1[0]; t[1] = p1[1]; t[2] = p1[2]; t[3] = p1[3]; }
    const int vn = v + gridDim.x; TrUnit nxt = cur;
    if (vn < NTR) tr_decode(P, vn, nxt);
    p0 = *(const f32x4*)(nxt.src + (size_t)r * nxt.ldw + c4); p1 = *(const f32x4*)(nxt.src + (size_t)(r + 32) * nxt.ldw + c4);
    __syncthreads();
    { float vv[8];
#pragma unroll
      for (int j = 0; j < 8; ++j) vv[j] = tile[(kk8 + j) * 65 + nn];
      u32x4 o; o.x = cvt_pk_bf16(vv[0], vv[1]); o.y = cvt_pk_bf16(vv[2], vv[3]); o.z = cvt_pk_bf16(vv[4], vv[5]); o.w = cvt_pk_bf16(vv[6], vv[7]);
      const int c5 = nn & 31, nnp = cur.perm ? ((nn & 32) + ((c5 >> 2) & 1) * 16 + (c5 >> 3) * 4 + (c5 & 3)) : nn;
      *(u32x4*)(cur.dst + (size_t)nnp * cur.ldd + kk8) = o; }
    __syncthreads();
    cur = nxt; v = vn;
  }
}

__device__ void phase0b(const Params& P, float* sm) {
  const int tid = opaque_tid(), wid = tid >> 6, lane = tid & 63;
  const float* mod = (const float*)(P.ws + WS_MOD);
  float* sbv = (float*)(P.ws + WS_SB);
  float* gates = (float*)(P.ws + WS_GATES);
  bf16_t* H = (bf16_t*)(P.ws + WS_H);
  for (int u = blockIdx.x; u < 22 * 8; u += gridDim.x) gemv5_unit<false>(P, u, 22, P.w_up, NUP, sbv, NUP, nullptr, mod, sm + 16384);
  for (int i0 = 0; i0 < 32; i0 += 8) {
    float wv[8];
#pragma unroll
    for (int i = 0; i < 8; ++i) { const int idx = tid + 512 * (i0 + i); wv[i] = P.w_in[(size_t)(idx >> 4) * DIN + NZ + (idx & 15)]; }
#pragma unroll
    for (int i = 0; i < 8; ++i) { const int idx = tid + 512 * (i0 + i); sm[(idx & 15) * 1024 + (idx >> 4)] = wv[i]; }
  }
  __syncthreads();
  f32x4 xnext[4];
  { const int Tn = blockIdx.x * 8 + wid; const float* xr = (Tn < NCTXT) ? P.x_prompt + (size_t)Tn * DM : P.x_sample + (size_t)(Tn - NCTXT) * DM;
#pragma unroll
    for (int i = 0; i < 4; ++i) xnext[i] = *(const f32x4*)(xr + i * 256 + lane * 4); }
  for (int T = blockIdx.x * 8 + wid; T < NTOK; T += gridDim.x * 8) {
    const int g = T < NCTXT ? 4 : ((T - NCTXT) >> 12);
    const float* modg = mod + g * NMOD;
    f32x4 xv[4]; float ss = 0.f;
#pragma unroll
    for (int i = 0; i < 4; ++i) xv[i] = xnext[i];
    { int Tn = T + gridDim.x * 8; Tn = Tn < NTOK ? Tn : T;
      const float* xr = (Tn < NCTXT) ? P.x_prompt + (size_t)Tn * DM : P.x_sample + (size_t)(Tn - NCTXT) * DM;
#pragma unroll
      for (int i = 0; i < 4; ++i) xnext[i] = *(const f32x4*)(xr + i * 256 + lane * 4); }
#pragma unroll
    for (int i = 0; i < 4; ++i) ss += xv[i][0] * xv[i][0] + xv[i][1] * xv[i][1] + xv[i][2] * xv[i][2] + xv[i][3] * xv[i][3];
#pragma unroll
    for (int o = 1; o < 64; o <<= 1) ss += __shfl_xor(ss, o);
    const float rstd = rsqrtf(ss * (1.0f / 1024.0f) + EPS);
    f32x4 hv[4];
#pragma unroll
    for (int i = 0; i < 4; ++i) {
      const int c = i * 256 + lane * 4;
      const f32x4 nv = *(const f32x4*)(P.norm1 + c), sc = *(const f32x4*)(modg + 1024 + c), sh = *(const f32x4*)(modg + c);
      hv[i] = xv[i] * rstd * nv * (sc + 1.0f) + sh;
      u32x2 o; o.x = cvt_pk_bf16(hv[i][0], hv[i][1]); o.y = cvt_pk_bf16(hv[i][2], hv[i][3]);
      *(u32x2*)(H + (size_t)T * DM + c) = o;
    }
    float v[16];
#pragma unroll
    for (int gi = 0; gi < 16; ++gi) {
      float a = 0.f;
#pragma unroll
      for (int i = 0; i < 4; ++i) { const f32x4 w = *(const f32x4*)(sm + gi * 1024 + i * 256 + lane * 4); a += hv[i][0] * w[0] + hv[i][1] * w[1] + hv[i][2] * w[2] + hv[i][3] * w[3]; }
      v[gi] = a;
    }
#pragma unroll
    for (int j = 0; j < 8; ++j) { const bool hi = lane & 32; const float keep = hi ? v[j + 8] : v[j], send = hi ? v[j] : v[j + 8]; v[j] = keep + __shfl_xor(send, 32); }
#pragma unroll
    for (int j = 0; j < 4; ++j) { const bool hi = lane & 16; const float keep = hi ? v[j + 4] : v[j], send = hi ? v[j] : v[j + 4]; v[j] = keep + __shfl_xor(send, 16); }
#pragma unroll
    for (int j = 0; j < 2; ++j) { const bool hi = lane & 8; const float keep = hi ? v[j + 2] : v[j], send = hi ? v[j] : v[j + 2]; v[j] = keep + __shfl_xor(send, 8); }
    { const bool hi = lane & 4; const float keep = hi ? v[1] : v[0], send = hi ? v[0] : v[1]; v[0] = keep + __shfl_xor(send, 4); }
    v[0] += __shfl_xor(v[0], 2); v[0] += __shfl_xor(v[0], 1);
    if ((lane & 3) == 0) {
      const int gi = ((lane >> 5) & 1) * 8 + ((lane >> 4) & 1) * 4 + ((lane >> 3) & 1) * 2 + ((lane >> 2) & 1);
      float val = v[0] + P.b_gate[gi];
      if ((gi >> 2) & 1) val = fminf(val, 0.f) - log1pf(__expf(-fabsf(val)));
      gates[(size_t)T * 16 + gi] = val;
    }
  }
  __syncthreads();
}

__device__ __forceinline__ void unit_info(int u, int& T0, int& nc, int& b, int& h, int& c) {
  if (u < 128) { nc = 2; b = u >> 3; h = (u >> 1) & 3; c = u & 1; T0 = b * 256 + c * 128; }
  else { const int v = u - 128; nc = 32; b = v >> 7; h = (v >> 5) & 3; c = v & 31; T0 = NCTXT + b * 4096 + c * 128; }
}
struct ScanOut { float beta0, beta1, cf0, cf1, pm0, pm1, bl, cmax; int t0, t1; };
__device__ __forceinline__ void chunk_scan(const float* gates, int T0, int h, int d, int lane, ScanOut& o) {
  const int t0 = d ? 127 - 2 * lane : 2 * lane, t1 = d ? t0 - 1 : t0 + 1;
  const float* g0 = gates + (size_t)(T0 + t0) * 16 + d * 8 + h; const float* g1 = gates + (size_t)(T0 + t1) * 16 + d * 8 + h;
  const float i0 = g0[0], f0 = g0[4], i1 = g1[0], f1 = g1[4];
  const float s = f0 + f1;
  float x = s;
#pragma unroll
  for (int off = 1; off < 64; off <<= 1) { const float y = __shfl_up(x, off); if (lane >= off) x += y; }
  const float excl = x - s;
  o.beta0 = excl + f0; o.beta1 = x;
  o.cf0 = i0 - o.beta0; o.cf1 = i1 - o.beta1;
  float mx = fmaxf(o.cf0, o.cf1);
#pragma unroll
  for (int off = 1; off < 64; off <<= 1) { const float y = __shfl_up(mx, off); if (lane >= off) mx = fmaxf(mx, y); }
  const float mex = __shfl_up(mx, 1);
  o.pm0 = lane ? fmaxf(mex, o.cf0) : o.cf0; o.pm1 = mx;
  o.bl = __shfl(x, 63); o.cmax = __shfl(mx, 63);
  o.t0 = t0; o.t1 = t1;
}

constexpr int LROW = 136;
constexpr int CST_ELEMS = 129 * 128;

__device__ void shortconv_items(const Params& P) {
  const bf16_t* Z = (const bf16_t*)(P.ws + WS_Z);
  bf16_t* ucat = (bf16_t*)(P.ws + WS_UCAT);
  const int tid = opaque_tid(), wid = tid >> 6, lane = tid & 63, cgp = lane * 8;
  float w0[8], w1[8], w2[8], bb[8];
#pragma unroll
  for (int q = 0; q < 2; ++q) {
    const f32x4 a = *(const f32x4*)(P.conv_sc_w + cgp + q * 4), b = *(const f32x4*)(P.conv_sc_w + 512 + cgp + q * 4), cc = *(const f32x4*)(P.conv_sc_w + 1024 + cgp + q * 4), d = *(const f32x4*)(P.conv_sc_b + cgp + q * 4);
#pragma unroll
    for (int e = 0; e < 4; ++e) { w0[q * 4 + e] = a[e]; w1[q * 4 + e] = b[e]; w2[q * 4 + e] = cc[e]; bb[q * 4 + e] = d[e]; }
  }
  const int nwaves = gridDim.x * 8, gw = blockIdx.x * 8 + wid;
  const int per = (NTOK + nwaves - 1) / nwaves;
  const int Tb = gw * per, Te = (Tb + per < NTOK) ? Tb + per : NTOK;
  if (Tb >= Te) return;
  auto loadu = [&](int T, float (&u)[8]) {
    const int Tc = T < 0 ? 0 : (T >= NTOK ? NTOK - 1 : T);
    const bf16_t* zr = Z + (size_t)Tc * NZ + cgp;
    const u32x4 c = *(const u32x4*)(zr + 512), x = *(const u32x4*)(zr + 1024);
#pragma unroll
    for (int q = 0; q < 4; ++q) { u[2 * q] = bflo(c[q]) * bflo(x[q]); u[2 * q + 1] = bfhi(c[q]) * bfhi(x[q]); }
  };
  float up[8], uc[8], un[8];
  loadu(Tb - 1, up); loadu(Tb, uc);
  for (int T = Tb; T < Te; ++T) {
    loadu(T + 1, un);
    const u32x4 sbq = *(const u32x4*)(Z + (size_t)T * NZ + cgp);
    const int pos = (T < NCTXT) ? (T & 255) : ((T - NCTXT) & 63), lastp = (T < NCTXT) ? 255 : 63;
    const float mp = pos != 0 ? 1.f : 0.f, mn = pos != lastp ? 1.f : 0.f;
    float o[8];
#pragma unroll
    for (int q = 0; q < 4; ++q) {
      o[2 * q] = bflo(sbq[q]) * (w0[2 * q] * (mp * up[2 * q]) + w1[2 * q] * uc[2 * q] + w2[2 * q] * (mn * un[2 * q]) + bb[2 * q]);
      o[2 * q + 1] = bfhi(sbq[q]) * (w0[2 * q + 1] * (mp * up[2 * q + 1]) + w1[2 * q + 1] * uc[2 * q + 1] + w2[2 * q + 1] * (mn * un[2 * q + 1]) + bb[2 * q + 1]);
    }
    u32x4 ov; ov.x = cvt_pk_bf16(o[0], o[1]); ov.y = cvt_pk_bf16(o[2], o[3]); ov.z = cvt_pk_bf16(o[4], o[5]); ov.w = cvt_pk_bf16(o[6], o[7]);
    *(u32x4*)(ucat + (size_t)T * DM + cgp) = ov;
#pragma unroll
    for (int e = 0; e < 8; ++e) { up[e] = uc[e]; uc[e] = un[e]; }
  }
}

__device__ void phaseM1(const Params& P, LAS unsigned char* lds) {
  const int tid = opaque_tid(), wid = tid >> 6, lane = tid & 63, fr = lane & 15, fq = lane >> 4;
  const bf16_t* Z = (const bf16_t*)(P.ws + WS_Z);
  const float* gates = (const float*)(P.ws + WS_GATES);
  float* stat = (float*)(P.ws + WS_STAT);
  bf16_t* dC = (bf16_t*)P.out;
  LAS bf16_t* KT = (LAS bf16_t*)lds;
  LAS bf16_t* VT0 = (LAS bf16_t*)(lds + 34816);
  LAS bf16_t* VT1 = (LAS bf16_t*)(lds + 34816 + 36992);
  LAS float* ecs = (LAS float*)(lds + 34816 + 2 * 36992 + 4096);
  for (int u = blockIdx.x; u < 640; u += gridDim.x) {
    int T0, nc, b, h, c; unit_info(u, T0, nc, b, h, c);
    if (wid < 2) {
      ScanOut so; chunk_scan(gates, T0, h, wid, lane, so);
      ecs[wid * 128 + so.t0] = __expf(so.cf0 - so.cmax); ecs[wid * 128 + so.t1] = __expf(so.cf1 - so.cmax);
      if (lane == 0) { stat[(u * 2 + wid) * 2] = so.bl; stat[(u * 2 + wid) * 2 + 1] = so.cmax; }
    }
    __syncthreads();
    {
      const int s = 2 * (tid & 63);
#pragma unroll
      for (int i = 0; i < 2; ++i) {
        const int kg = (tid >> 6) + 8 * i;
        const bf16_t* zr = Z + (size_t)(T0 + s) * NZ + h * 128 + kg * 8;
        const u32x4 ka = *(const u32x4*)(zr + 2048), va = *(const u32x4*)(zr + 2560);
        const u32x4 kb = *(const u32x4*)(zr + NZ + 2048), vb = *(const u32x4*)(zr + NZ + 2560);
        const float e0a = ecs[s], e0b = ecs[s + 1], e1a = ecs[128 + s], e1b = ecs[128 + s + 1];
#pragma unroll
        for (int q = 0; q < 4; ++q) {
          const int r0 = (kg * 8 + 2 * q) * LROW + s, r1 = r0 + LROW;
          *(LAS unsigned*)(KT + r0) = (ka[q] & 0xffffu) | (kb[q] << 16);
          *(LAS unsigned*)(KT + r1) = (ka[q] >> 16) | (kb[q] & 0xffff0000u);
          const float al = bflo(va[q]), ah = bfhi(va[q]), bl_ = bflo(vb[q]), bh = bfhi(vb[q]);
          *(LAS unsigned*)(VT0 + r0) = cvt_pk_bf16_c(al * e0a, bl_ * e0b);
          *(LAS unsigned*)(VT0 + r1) = cvt_pk_bf16_c(ah * e0a, bh * e0b);
          *(LAS unsigned*)(VT1 + r0) = cvt_pk_bf16_c(al * e1a, bl_ * e1b);
          *(LAS unsigned*)(VT1 + r1) = cvt_pk_bf16_c(ah * e1a, bh * e1b);
        }
      }
      if (tid < 64) { *(LAS unsigned*)(VT0 + 128 * LROW + 2 * tid) = cvt_pk_bf16_c(ecs[2 * tid], ecs[2 * tid + 1]); *(LAS unsigned*)(VT1 + 128 * LROW + 2 * tid) = cvt_pk_bf16_c(ecs[128 + 2 * tid], ecs[128 + 2 * tid + 1]); }
    }
    __syncthreads();
    {
      bf16x8 Kf[4];
#pragma unroll
      for (int ks = 0; ks < 4; ++ks) Kf[ks] = *(const LAS bf16x8*)(KT + (16 * wid + fr) * LROW + 32 * ks + 8 * fq);
#pragma unroll
      for (int d = 0; d < 2; ++d) {
        LAS bf16_t* VT = d ? VT1 : VT0;
        bf16_t* dst = dC + (size_t)(u * 2 + d) * CST_ELEMS;
#pragma unroll
        for (int mt = 0; mt < 9; ++mt) {
          f32x4 a = (f32x4){0.f, 0.f, 0.f, 0.f};
#pragma unroll
          for (int ks = 0; ks < 4; ++ks) { const bf16x8 Vf = *(const LAS bf16x8*)(VT + (16 * mt + fr) * LROW + 32 * ks + 8 * fq); a = __builtin_amdgcn_mfma_f32_16x16x32_bf16(Kf[ks], Vf, a, 0, 0, 0); }
          if (mt < 8 || fr == 0) { u32x2 o; o.x = cvt_pk_bf16_c(a[0], a[1]); o.y = cvt_pk_bf16_c(a[2], a[3]); *(u32x2*)(dst + (16 * mt + fr) * 128 + 16 * wid + 4 * fq) = o; }
        }
      }
    }
    __syncthreads();
  }
}

template <int NC, int BLK, bool HASN>
__device__ __forceinline__ void m2_loop(const bf16_t* dC, bf16_t* Cst, float* mst, const float* sm, int ubase, int d, int e, int kn, bool wm, f32x4& C4, f32x4& n4, float& m) {
#pragma unroll 1
  for (int jb = 0; jb < NC; jb += BLK) {
    u32x2 dv[BLK], nv[BLK];
#pragma unroll
    for (int jj = 0; jj < BLK; ++jj) {
      const int j = jb + jj, c = d ? NC - 1 - j : j;
      const bf16_t* dp = dC + (size_t)((ubase + c) * 2 + d) * CST_ELEMS;
      dv[jj] = *(const u32x2*)(dp + e);
      if (HASN) nv[jj] = *(const u32x2*)(dp + 16384 + kn);
    }
#pragma unroll
    for (int jj = 0; jj < BLK; ++jj) {
      const int j = jb + jj, c = d ? NC - 1 - j : j;
      const int idx = (ubase + c) * 2 + d;
      bf16_t* cs = Cst + (size_t)idx * CST_ELEMS;
      { u32x2 o; o.x = cvt_pk_bf16(C4[0], C4[1]); o.y = cvt_pk_bf16(C4[2], C4[3]); *(u32x2*)(cs + e) = o; }
      if (HASN) { u32x2 o; o.x = cvt_pk_bf16(n4[0], n4[1]); o.y = cvt_pk_bf16(n4[2], n4[3]); *(u32x2*)(cs + 16384 + kn) = o; if (wm) mst[idx] = m; }
      const float bl = sm[2 * j], cmax = sm[2 * j + 1];
      const float mn = bl + fmaxf(m, cmax);
      const float decay = __expf(bl + m - mn), scale = __expf(bl + cmax - mn);
      const u32x2 dvv = dv[jj];
      C4[0] = decay * C4[0] + scale * bflo(dvv.x); C4[1] = decay * C4[1] + scale * bfhi(dvv.x); C4[2] = decay * C4[2] + scale * bflo(dvv.y); C4[3] = decay * C4[3] + scale * bfhi(dvv.y);
      if (HASN) { const u32x2 nvv = nv[jj];
        n4[0] = decay * n4[0] + scale * bflo(nvv.x); n4[1] = decay * n4[1] + scale * bfhi(nvv.x); n4[2] = decay * n4[2] + scale * bflo(nvv.y); n4[3] = decay * n4[3] + scale * bfhi(nvv.y); }
      m = mn;
    }
  }
}
template <int NC, int BLK>
__device__ __forceinline__ void m2_unit(const Params& P, bool lat, int sq, int slice, float* sm) {
  const int tid = opaque_tid();
  const bf16_t* dC = (const bf16_t*)P.out;
  bf16_t* Cst = (bf16_t*)(P.ws + WS_H);
  const float* stat = (const float*)(P.ws + WS_STAT);
  float* mst = (float*)(P.ws + WS_MST);
  const int b = sq >> 3, h = (sq >> 1) & 3, d = sq & 1;
  const int ubase = lat ? 128 + (b * 4 + h) * 32 : (b * 4 + h) * 2;
  const int e = slice * 2048 + tid * 4;
  const bool hasn = (slice == 0) && (tid < 64);
  const int kn = (tid & 31) * 4;
  if (tid < NC) { const int c = d ? NC - 1 - tid : tid; const int idx = (ubase + c) * 2 + d; sm[2 * tid] = stat[idx * 2]; sm[2 * tid + 1] = stat[idx * 2 + 1]; }
  f32x4 C4 = (f32x4){0.f, 0.f, 0.f, 0.f}, n4 = C4; float m = 0.f;
  const int sidx = (b * 2 + d) * 4 + h;
  if (lat) {
    C4 = *(const f32x4*)(P.state_C + (size_t)sidx * 16384 + e);
    n4 = *(const f32x4*)(P.state_n + sidx * 128 + kn);
    m = P.state_m[sidx];
  }
  __syncthreads();
  if (hasn) m2_loop<NC, BLK, true>(dC, Cst, mst, sm, ubase, d, e, kn, tid == 0, C4, n4, m);
  else m2_loop<NC, BLK, false>(dC, Cst, mst, sm, ubase, d, e, kn, false, C4, n4, m);
  if (!lat) {
    *(f32x4*)(P.out + OUT_TAIL + (size_t)sidx * 16384 + e) = C4;
    if (hasn) { *(f32x4*)(P.out + OUT_TAIL + 2097152 + sidx * 128 + kn) = n4; if (tid == 0) P.out[OUT_TAIL + 2097152 + 16384 + sidx] = m; }
  }
  __syncthreads();
}
__device__ void phaseM2(const Params& P, float* sm) {
  for (int unit = blockIdx.x; unit < 1280; unit += gridDim.x) {
    if (unit < 256) m2_unit<32, 16>(P, true, unit >> 3, unit & 7, sm);
    else { const int v = unit - 256; m2_unit<2, 2>(P, false, v >> 3, v & 7, sm); }
  }
}

__device__ __forceinline__ bf16x8 scale_frag(bf16x8 q, float s) {
  const u32x4 a = __builtin_bit_cast(u32x4, q); u32x4 r;
  r.x = cvt_pk_bf16_c(bflo(a.x) * s, bfhi(a.x) * s); r.y = cvt_pk_bf16_c(bflo(a.y) * s, bfhi(a.y) * s);
  r.z = cvt_pk_bf16_c(bflo(a.z) * s, bfhi(a.z) * s); r.w = cvt_pk_bf16_c(bflo(a.w) * s, bfhi(a.w) * s);
  return __builtin_bit_cast(bf16x8, r);
}

__device__ void phaseM3(const Params& P, LAS unsigned char* lds) {
  const int tid = opaque_tid(), wid = tid >> 6, lane = tid & 63, fr = lane & 15, fq = lane >> 4;
  const bf16_t* Z = (const bf16_t*)(P.ws + WS_Z);
  const float* gates = (const float*)(P.ws + WS_GATES);
  const bf16_t* Cst = (const bf16_t*)(P.ws + WS_H);
  const float* mst = (const float*)(P.ws + WS_MST);
  bf16_t* ucat = (bf16_t*)(P.ws + WS_UCAT);
  LAS bf16_t* Ks = (LAS bf16_t*)lds;
  LAS bf16_t* VT = (LAS bf16_t*)(lds + 34816);
  LAS bf16_t* Sb = (LAS bf16_t*)(lds + 34816 + 36992);
  LAS float* arr = (LAS float*)(lds + 34816 + 36992 + 34816);
  LAS float* ecA = arr; LAS float* erA = arr + 256; LAS float* wiA = arr + 512; LAS float* flA = arr + 768;
  LAS bf16_t* Cb = (LAS bf16_t*)(lds + 34816 + 36992 + 34816 + 4096);
  const float qs = 0.08838834764831845f;
  for (int u = blockIdx.x; u < 640; u += gridDim.x) {
    int T0, nc, b, h, c; unit_info(u, T0, nc, b, h, c);
    if (wid < 2) {
      const int d = wid;
      ScanOut so; chunk_scan(gates, T0, h, d, lane, so);
      const float mc = mst[u * 2 + d];
      const float mx0 = fmaxf(mc, so.pm0), mx1 = fmaxf(mc, so.pm1);
      ecA[d * 128 + so.t0] = __expf(so.cf0 - so.cmax); ecA[d * 128 + so.t1] = __expf(so.cf1 - so.cmax);
      erA[d * 128 + so.t0] = __expf(so.cmax - mx0) * qs; erA[d * 128 + so.t1] = __expf(so.cmax - mx1) * qs;
      wiA[d * 128 + so.t0] = __expf(mc - mx0) * qs; wiA[d * 128 + so.t1] = __expf(mc - mx1) * qs;
      flA[d * 128 + so.t0] = __expf(-(so.beta0 + mx0)); flA[d * 128 + so.t1] = __expf(-(so.beta1 + mx1));
    }
    {
      const int s = 2 * (tid & 63);
#pragma unroll
      for (int i = 0; i < 2; ++i) {
        const int kg = (tid >> 6) + 8 * i;
        const bf16_t* zr = Z + (size_t)(T0 + s) * NZ + h * 128 + kg * 8;
        const u32x4 ka = *(const u32x4*)(zr + 2048), va = *(const u32x4*)(zr + 2560);
        const u32x4 kb = *(const u32x4*)(zr + NZ + 2048), vb = *(const u32x4*)(zr + NZ + 2560);
        *(LAS u32x4*)(Ks + s * LROW + kg * 8) = ka;
        *(LAS u32x4*)(Ks + (s + 1) * LROW + kg * 8) = kb;
#pragma unroll
        for (int q = 0; q < 4; ++q) {
          const int r0 = (kg * 8 + 2 * q) * LROW + s, r1 = r0 + LROW;
          *(LAS unsigned*)(VT + r0) = (va[q] & 0xffffu) | (vb[q] << 16);
          *(LAS unsigned*)(VT + r1) = (va[q] >> 16) | (vb[q] & 0xffff0000u);
        }
      }
      if (tid < 64) *(LAS unsigned*)(VT + 128 * LROW + 2 * tid) = 0x3F803F80u;
    }
    u32x4 creg[5];
    {
      const bf16_t* cs0 = Cst + (size_t)(u * 2) * CST_ELEMS;
#pragma unroll
      for (int i = 0; i < 4; ++i) creg[i] = *(const u32x4*)(cs0 + (tid + 512 * i) * 8);
      creg[4] = *(const u32x4*)(cs0 + 16384 + (tid & 15) * 8);
#pragma unroll
      for (int i = 0; i < 4; ++i) { const int ci = tid + 512 * i; *(LAS u32x4*)(Cb + (ci >> 4) * LROW + (ci & 15) * 8) = creg[i]; }
      if (tid < 16) *(LAS u32x4*)(Cb + 128 * LROW + tid * 8) = creg[4];
    }
    __syncthreads();
    {
      const bf16_t* cs1 = Cst + (size_t)(u * 2 + 1) * CST_ELEMS;
#pragma unroll
      for (int i = 0; i < 4; ++i) creg[i] = *(const u32x4*)(cs1 + (tid + 512 * i) * 8);
      creg[4] = *(const u32x4*)(cs1 + 16384 + (tid & 15) * 8);
    }
    {
      const int w = wid;
      bf16x8 Qf[4];
      { const bf16_t* qr = Z + (size_t)(T0 + 16 * w + fr) * NZ + 1536 + h * 128 + 8 * fq;
#pragma unroll
        for (int ks = 0; ks < 4; ++ks) Qf[ks] = *(const bf16x8*)(qr + 32 * ks); }
      f32x4 hsum[8];
#pragma unroll
      for (int vt = 0; vt < 8; ++vt) hsum[vt] = (f32x4){0.f, 0.f, 0.f, 0.f};
      LAS bf16_t* Sw = Sb + w * 16 * LROW;
#pragma unroll
      for (int d = 0; d < 2; ++d) {
        if (d == 1) {
          __syncthreads();
#pragma unroll
          for (int i = 0; i < 4; ++i) { const int ci = tid + 512 * i; *(LAS u32x4*)(Cb + (ci >> 4) * LROW + (ci & 15) * 8) = creg[i]; }
          if (tid < 16) *(LAS u32x4*)(Cb + 128 * LROW + tid * 8) = creg[4];
          __syncthreads();
        }
        const int lo = d ? w : 0, hi = d ? 7 : w;
        const int ks_lo = lo >> 1, ks_hi = hi >> 1;
        float er4[4];
#pragma unroll
        for (int j = 0; j < 4; ++j) er4[j] = erA[d * 128 + 16 * w + 4 * fq + j];
#pragma unroll
        for (int nt = 0; nt < 8; ++nt) {
          if (nt >= 2 * ks_lo && nt <= 2 * ks_hi + 1) {
            f32x4 a = (f32x4){0.f, 0.f, 0.f, 0.f};
            if (nt >= lo && nt <= hi) {
#pragma unroll
              for (int ks = 0; ks < 4; ++ks) { const bf16x8 Kf = *(const LAS bf16x8*)(Ks + (16 * nt + fr) * LROW + 32 * ks + 8 * fq); a = __builtin_amdgcn_mfma_f32_16x16x32_bf16(Qf[ks], Kf, a, 0, 0, 0); }
              const float ecv = ecA[d * 128 + 16 * nt + fr];
#pragma unroll
              for (int j = 0; j < 4; ++j) {
                float val = a[j] * er4[j] * ecv;
                if (nt == w) { const int tl = 4 * fq + j; const bool ok = d ? (fr >= tl) : (fr <= tl); val = ok ? val : 0.f; }
                a[j] = val;
              }
            }
#pragma unroll
            for (int j = 0; j < 4; ++j) { const float nb = dppf<0x12F>(a[j]); if ((fr & 1) == 0) *(LAS unsigned*)(Sw + (4 * fq + j) * LROW + 16 * nt + fr) = cvt_pk_bf16_c(a[j], nb); }
          }
        }
        asm volatile("s_waitcnt lgkmcnt(0)" ::: "memory");
        f32x4 ao[9];
#pragma unroll
        for (int vt = 0; vt < 9; ++vt) ao[vt] = (f32x4){0.f, 0.f, 0.f, 0.f};
        const bf16x8 zf = (bf16x8){0, 0, 0, 0, 0, 0, 0, 0};
#pragma unroll
        for (int ks = 0; ks < 4; ++ks) {
          if (ks >= ks_lo && ks <= ks_hi) {
            const bf16x8 Sf = *(const LAS bf16x8*)(Sw + fr * LROW + 32 * ks + 8 * fq);
#pragma unroll
            for (int vt = 0; vt < 9; ++vt) {
              bf16x8 Vf = *(const LAS bf16x8*)(VT + (vt < 8 ? 16 * vt + fr : 128) * LROW + 32 * ks + 8 * fq);
              if (vt == 8 && fr != 0) Vf = zf;
              ao[vt] = __builtin_amdgcn_mfma_f32_16x16x32_bf16(Sf, Vf, ao[vt], 0, 0, 0);
            }
          }
        }
        {
          const float wv = wiA[d * 128 + 16 * w + fr];
#pragma unroll
          for (int ks = 0; ks < 4; ++ks) {
            const bf16x8 Qs = scale_frag(Qf[ks], wv);
#pragma unroll
            for (int vt = 0; vt < 9; ++vt) {
              bf16x8 Cf = *(const LAS bf16x8*)(Cb + (vt < 8 ? 16 * vt + fr : 128) * LROW + 32 * ks + 8 * fq);
              if (vt == 8 && fr != 0) Cf = zf;
              ao[vt] = __builtin_amdgcn_mfma_f32_16x16x32_bf16(Qs, Cf, ao[vt], 0, 0, 0);
            }
          }
        }
#pragma unroll
        for (int j = 0; j < 4; ++j) {
          const float den = __shfl(ao[8][j], lane & 48);
          const float fl = flA[d * 128 + 16 * w + 4 * fq + j];
          const float inv = 1.0f / fmaxf(fabsf(den), fl);
#pragma unroll
          for (int vt = 0; vt < 8; ++vt) hsum[vt][j] += ao[vt][j] * inv;
        }
        asm volatile("" ::: "memory");
      }
#pragma unroll
      for (int j = 0; j < 4; ++j) {
        float ms = 0.f;
#pragma unroll
        for (int vt = 0; vt < 8; ++vt) ms += hsum[vt][j] * hsum[vt][j];
        ms += __shfl_xor(ms, 1); ms += __shfl_xor(ms, 2); ms += __shfl_xor(ms, 4); ms += __shfl_xor(ms, 8);
        const float r = rsqrtf(ms * (1.0f / 128.0f) + EPS);
        const int T = T0 + 16 * w + 4 * fq + j;
#pragma unroll
        for (int vt = 0; vt < 8; ++vt) {
          const int col = h * 128 + 16 * vt + fr;
          const float og = bf2f(Z[(size_t)T * NZ + 3072 + col]);
          const float val = hsum[vt][j] * r * P.mh_norm[col] * fast_sigmoid(og);
          ucat[(size_t)T * DM + 512 + col] = f2bf_c(val);
        }
      }
    }
    __syncthreads();
  }
}

__device__ void phase7(const Params& P) {
  const int tid7 = opaque_tid(); const int wid = tid7 >> 6, lane = tid7 & 63;
  const float* rss2 = (const float*)(P.ws + WS_RSS2);
  f32x4 fn[4];
#pragma unroll
  for (int i = 0; i < 4; ++i) fn[i] = *(const f32x4*)(P.final_norm + i * 256 + lane * 4);
  const int stride = gridDim.x * 8;
  for (int T0 = blockIdx.x * 8 + wid; T0 < 16384; T0 += 5 * stride) {
    f32x4 v[5][4]; float r[5];
#pragma unroll
    for (int q = 0; q < 5; ++q) {
      int T = T0 + q * stride; T = T < 16384 ? T : 16383;
      r[q] = rss2[T];
#pragma unroll
      for (int i = 0; i < 4; ++i) v[q][i] = *(const f32x4*)(P.out + (size_t)T * DM + i * 256 + lane * 4);
    }
#pragma unroll
    for (int q = 0; q < 5; ++q) {
      const int T = T0 + q * stride;
      if (T < 16384) {
        const float rr = rsqrtf(r[q] * (1.0f / 1024.0f) + EPS);
#pragma unroll
        for (int i = 0; i < 4; ++i) *(f32x4*)(P.out + (size_t)T * DM + i * 256 + lane * 4) = v[q][i] * rr * fn[i];
      }
    }
  }
  {
    const float* part = (const float*)(P.ws + WS_H);
    for (int T = 16384 + blockIdx.x * 8 + wid; T < NTOK; T += stride) {
      f32x4 v[4], a1[4], a2[4], a3[4];
      const size_t ro = (size_t)(T - 16384) * DM;
#pragma unroll
      for (int i = 0; i < 4; ++i) { const int c = i * 256 + lane * 4;
        v[i] = *(const f32x4*)(P.out + (size_t)T * DM + c); a1[i] = *(const f32x4*)(part + ro + c);
        a2[i] = *(const f32x4*)(part + (size_t)4096 * DM + ro + c); a3[i] = *(const f32x4*)(part + (size_t)8192 * DM + ro + c); }
      float ss = 0.f;
#pragma unroll
      for (int i = 0; i < 4; ++i) { v[i] = v[i] + a1[i] + a2[i] + a3[i]; ss += v[i][0] * v[i][0] + v[i][1] * v[i][1] + v[i][2] * v[i][2] + v[i][3] * v[i][3]; }
#pragma unroll
      for (int o = 1; o < 64; o <<= 1) ss += __shfl_xor(ss, o);
      const float rr = rsqrtf(ss * (1.0f / 1024.0f) + EPS);
#pragma unroll
      for (int i = 0; i < 4; ++i) *(f32x4*)(P.out + (size_t)T * DM + i * 256 + lane * 4) = v[i] * rr * fn[i];
    }
  }
}


#define XB_TMO      128
#define XB_XCNT(j)  (256  + 64 * (j))
#define XB_XSUB(j)  (1280 + 64 * (j))
#define XB_XGEN(j)  (2304 + 64 * (j))
#define XB_TOP      3328
#define XB_TOPGEN   3392
#define XCD_BAR_WORDS 3456
#define XB_SPIN_CAP (1u << 18)
__device__ __forceinline__ unsigned xb_ld(unsigned* p)              { return __hip_atomic_load(p, __ATOMIC_RELAXED, __HIP_MEMORY_SCOPE_AGENT); }
__device__ __forceinline__ unsigned xb_add(unsigned* p, unsigned v) { return __hip_atomic_fetch_add(p, v, __ATOMIC_RELAXED, __HIP_MEMORY_SCOPE_AGENT); }
__device__ __forceinline__ unsigned xb_xcc_id() { return (unsigned)__builtin_amdgcn_s_getreg((3 << 11) | 20) & 0xFu; }
#define XB_SPIN(cond, bar) do { unsigned _sp = 0; while (cond) { __builtin_amdgcn_s_sleep(1); \
    if ((++_sp & 255u) == 0u) { if (xb_ld(&(bar)[XB_TMO])) break; if (_sp > XB_SPIN_CAP) { atomicAdd(&(bar)[XB_TMO], 1u); break; } } } } while (0)
struct XcdBarrier { unsigned* bar; unsigned x; volatile LAS unsigned* st; };
__device__ __forceinline__ XcdBarrier xcd_barrier_post(unsigned* bar, volatile LAS unsigned* st) {
  XcdBarrier b; b.bar = bar; b.x = xb_xcc_id(); b.st = st;
  if (threadIdx.x == 0) (void)xb_add(&bar[XB_XCNT(b.x)], 1u);
  return b;
}
__device__ __forceinline__ void xcd_barrier_complete(unsigned* bar, unsigned x, unsigned& nloc, unsigned& nx) {
  const unsigned G = gridDim.x * gridDim.y * gridDim.z;
  unsigned sum, cnt, mine, sp = 0u;
  for (;;) {
    sum = 0u; cnt = 0u; mine = 0u;
#pragma unroll
    for (unsigned j = 0; j < 16; ++j) { const unsigned c = xb_ld(&bar[XB_XCNT(j)]); sum += c; cnt += (c > 0u) ? 1u : 0u; mine = (j == x) ? c : mine; }
    if (sum == G) break;
    __builtin_amdgcn_s_sleep(1);
    if ((++sp & 255u) == 0u) { if (xb_ld(&bar[XB_TMO])) break; if (sp > XB_SPIN_CAP) { atomicAdd(&bar[XB_TMO], 1u); break; } }
  }
  nloc = mine > 0u ? mine : 1u; nx = cnt > 0u ? cnt : 1u;
}
__device__ __forceinline__ void xcd_barrier(const XcdBarrier& b) {
  asm volatile("s_waitcnt vmcnt(0) lgkmcnt(0)" ::: "memory");
  __syncthreads();
  if (threadIdx.x == 0) {
    unsigned* bar = b.bar;
    __builtin_amdgcn_s_waitcnt(0);
    unsigned nloc = b.st[0], nx = b.st[1];
    if (nloc == 0u) { xcd_barrier_complete(bar, b.x, nloc, nx); b.st[0] = nloc; b.st[1] = nx; }
    const unsigned old = xb_add(&bar[XB_XSUB(b.x)], 1u);
    const unsigned gen = old / nloc;
    if (old + 1u == (gen + 1u) * nloc) {
      __builtin_amdgcn_fence(__ATOMIC_RELEASE, "agent");
      asm volatile("s_waitcnt vmcnt(0)" ::: "memory");
      const unsigned og = xb_add(&bar[XB_TOP], 1u);
      const unsigned tg = og / nx;
      if (og + 1u == (tg + 1u) * nx) xb_add(&bar[XB_TOPGEN], 1u);
      else XB_SPIN(xb_ld(&bar[XB_TOPGEN]) == tg, bar);
      __builtin_amdgcn_fence(__ATOMIC_ACQUIRE, "agent");
      xb_add(&bar[XB_XGEN(b.x)], 1u);
      asm volatile("s_waitcnt vmcnt(0)" ::: "memory");
    } else {
      XB_SPIN(xb_ld(&bar[XB_XGEN(b.x)]) == gen, bar);
      __builtin_amdgcn_fence(__ATOMIC_ACQUIRE, "agent");
      asm volatile("s_waitcnt vmcnt(0)" ::: "memory");
    }
  }
  __syncthreads();
}

#define GSYNC() xcd_barrier(xb)
__global__ void __launch_bounds__(512, 2) fwd_megakernel(Params P) {
  extern __shared__ __attribute__((aligned(16))) unsigned char shm[];
  cg::grid_group grid = cg::this_grid();
  LAS unsigned char* lds = (LAS unsigned char*)shm;
  float* smf = (float*)shm;
  if (P.ws == nullptr) grid.sync();
  volatile LAS unsigned* xst = (volatile LAS unsigned*)(lds + (LDS_BYTES - 16));
  if (threadIdx.x == 0) { xst[0] = 0u; xst[1] = 0u; }
  __syncthreads();
  const XcdBarrier xb = xcd_barrier_post((unsigned*)(P.ws + WS_BAR), xst);
#define RUN_P2() { EpiZ E; E.Z = (bf16_t*)(P.ws + WS_Z); \
    gemm_phase<EpiZ>(lds, (const bf16_t*)(P.ws + WS_H), (const bf16_t*)(P.ws + WS_WIN), NTOK, NZ, DM, E); } GSYNC();
#define RUN_M() phaseM1(P, lds); shortconv_items(P); GSYNC(); phaseM2(P, smf); GSYNC(); phaseM3(P, lds); GSYNC();
#define RUN_P5() { EpiUp E; E.rowss1 = (const float*)(P.ws + WS_RSS1); E.sb = (const float*)(P.ws + WS_SB); E.cw = P.conv_ffn_w; E.cb = P.conv_ffn_b; E.act = (bf16_t*)(P.ws + WS_Z); \
    gemm_phase<EpiUp>(lds, (const bf16_t*)(P.ws + WS_H), (const bf16_t*)(P.ws + WS_WUP), NTOK, NUP, DM, E); } GSYNC();
  phase0a(P, smf);
  GSYNC();
  phase0b(P, smf);
  GSYNC();
  RUN_P2()
#if DUP == 2
  RUN_P2()
#endif
#if DUP == 21
  { EpiNone E; E.Z = (bf16_t*)(P.ws + WS_UCAT);
    gemm_phase<EpiNone>(lds, (const bf16_t*)(P.ws + WS_H), (const bf16_t*)(P.ws + WS_WIN), NTOK, NZ, DM, E); } GSYNC();
#endif
  RUN_M()
#if DUP == 3
  RUN_M()
#endif
#if DUP == 31
  phaseM1(P, lds); GSYNC();
#endif
#if DUP == 32
  phaseM2(P, smf); GSYNC();
#endif
#if DUP == 33
  phaseM3(P, lds); GSYNC();
#endif
#if DUP == 34
  shortconv_items(P); GSYNC();
#endif
#if DUP == 6
  RUN_P5()
#endif
  { EpiX1 E; E.xp = P.x_prompt; E.xs = P.x_sample; E.mod = (const float*)(P.ws + WS_MOD); E.norm2 = P.norm2; E.x1out = P.out; E.x1g = (bf16_t*)(P.ws + WS_H); E.rowss = (float*)(P.ws + WS_RSS1);
    gemm_phase<EpiX1>(lds, (const bf16_t*)(P.ws + WS_UCAT), (const bf16_t*)(P.ws + WS_WOUT), NTOK, DM, DM, E); }
  GSYNC();
  RUN_P5()
#if DUP == 5
  RUN_P5()
#endif
  { EpiDown E; E.mod = (const float*)(P.ws + WS_MOD); E.out = P.out; E.rowss2 = (float*)(P.ws + WS_RSS2);
    gemm_phase<EpiDown>(lds, (const bf16_t*)(P.ws + WS_Z), (const bf16_t*)(P.ws + WS_WDN), 16384, DM, DFF, E); }
  { EpiDownPart E; E.mod = (const float*)(P.ws + WS_MOD); E.out = P.out; E.part = (float*)(P.ws + WS_H);
    gemm_phase<EpiDownPart, 4>(lds, (const bf16_t*)(P.ws + WS_Z), (const bf16_t*)(P.ws + WS_WDN), NTOK, DM, DFF, E); }
  GSYNC();
  phase7(P);
}

extern "C" void kernel_launch(void* const* d_in, const int* in_sizes, int n_in, void* d_out, int out_size, void* d_ws, size_t ws_size, hipStream_t stream) {
  static int grid_blocks = 0;
  if (!grid_blocks) {
    int dev = 0, cus = 0, per_cu = 0;
    hipGetDevice(&dev);
    hipDeviceGetAttribute(&cus, hipDeviceAttributeMultiprocessorCount, dev);
    hipFuncSetAttribute((const void*)fwd_megakernel, hipFuncAttributeMaxDynamicSharedMemorySize, LDS_BYTES);
    hipOccupancyMaxActiveBlocksPerMultiprocessor(&per_cu, (const void*)fwd_megakernel, 512, LDS_BYTES);
    (void)hipGetLastError();
    if (per_cu < 1) per_cu = 1;
    if (per_cu > 1) per_cu = 1;
    grid_blocks = cus * per_cu;
  }
  hipMemsetAsync(d_ws, 0, WS_ZERO_BYTES, stream);
  Params p{};
  const float** pp = (const float**)&p;
  for (int i = 0; i < 22; ++i) pp[i] = (const float*)d_in[i];
  p.out = (float*)d_out; p.ws = (unsigned char*)d_ws;
  void* args[] = {&p};
  hipError_t e = hipLaunchCooperativeKernel((const void*)fwd_megakernel, dim3(grid_blocks), dim3(512), args, LDS_BYTES, stream);
  if (e != hipSuccess) fprintf(stderr, "cooperative launch failed: %s (grid %d)\n", hipGetErrorString(e), grid_blocks);
}
```

```cpp
#include <hip/hip_runtime.h>
#include <hip/hip_cooperative_groups.h>
#include <cstdio>
namespace cg = cooperative_groups;

#ifndef DUP
#define DUP 0
#endif
#define LAS __attribute__((address_space(3)))
typedef unsigned short bf16_t;
typedef short bf16x8 __attribute__((ext_vector_type(8)));
typedef float f32x4 __attribute__((ext_vector_type(4)));
typedef unsigned u32x2 __attribute__((ext_vector_type(2)));
typedef unsigned u32x4 __attribute__((ext_vector_type(4)));

constexpr int DM = 1024, NTOK = 20480, NCTXT = 4096, DIN = 3600, NZ = 3584, DFF = 2816, NUP = 5632, NMOD = 6144;
constexpr float EPS = 1e-6f;
constexpr size_t WS_MOD = 0, WS_SB = 122880, WS_RSS1 = 235520, WS_RSS2 = 317440, WS_BAR = 399360, WS_ZERO_BYTES = 415744;
constexpr size_t WS_GATES = 415744, WS_STAT = 1726464, WS_MST = 1736704;
constexpr size_t WS_WIN = 2097152, WS_WOUT = 9437184, WS_WUP = 11534336, WS_WDN = 23068672;
constexpr size_t WS_H = 28835840;
constexpr size_t WS_UCAT = 71106560;
constexpr size_t WS_Z = 113049600;
constexpr int OUT_TAIL = 20971520;
constexpr int LDS_BYTES = 146432;

struct Params {
  const float *x_prompt, *x_sample, *state_C, *state_n, *state_m, *c, *c_ctx, *w_mod, *b_mod, *norm1, *w_in, *b_gate,
      *conv_sc_w, *conv_sc_b, *mh_norm, *w_out, *norm2, *w_up, *conv_ffn_w, *conv_ffn_b, *w_down, *final_norm;
  float* out; unsigned char* ws;
};

typedef __bf16 bf16x2_n __attribute__((ext_vector_type(2)));
typedef float f32x2_n __attribute__((ext_vector_type(2)));
__device__ __forceinline__ unsigned cvt_pk_bf16_c(float lo, float hi) { const f32x2_n v = {lo, hi}; return __builtin_bit_cast(unsigned, __builtin_convertvector(v, bf16x2_n)); }
__device__ __forceinline__ unsigned cvt_pk_bf16(float lo, float hi) { unsigned r; asm("v_cvt_pk_bf16_f32 %0, %1, %2" : "=v"(r) : "v"(lo), "v"(hi)); return r; }
__device__ __forceinline__ bf16_t f2bf_c(float f) { return (bf16_t)(cvt_pk_bf16_c(f, 0.f) & 0xffffu); }
__device__ __forceinline__ bf16_t f2bf(float f) { return (bf16_t)(cvt_pk_bf16(f, 0.f) & 0xffffu); }
__device__ __forceinline__ float bf2f(bf16_t b) { return __uint_as_float(((unsigned)b) << 16); }
__device__ __forceinline__ float bflo(unsigned u) { return __uint_as_float(u << 16); }
__device__ __forceinline__ float bfhi(unsigned u) { return __uint_as_float(u & 0xffff0000u); }
__device__ __forceinline__ int permtok(int T) { if (T < NCTXT) return T; const int q = T - NCTXT; return NCTXT + (q & ~4095) + ((q & 63) << 6) + ((q >> 6) & 63); }
template <int CTRL> __device__ __forceinline__ float dppf(float x) { return __builtin_bit_cast(float, __builtin_amdgcn_mov_dpp(__builtin_bit_cast(int, x), CTRL, 0xf, 0xf, true)); }
__device__ __forceinline__ float fast_sigmoid(float x) { return __builtin_amdgcn_rcpf(1.0f + __expf(-x)); }

__device__ __forceinline__ int opaque_tid() { int t = threadIdx.x; asm volatile("" : "+v"(t)); return t; }

constexpr int BM = 256, BK = 64, HALF = 128, HTB = HALF * BK * 2, NXCD = 8, WGM = 8;
__device__ __forceinline__ int lds_byte(int r, int c) { const int st = (r >> 4) * 2 + (c >> 5), rr = r & 15, cc = c & 31, ob = rr * 64 + cc * 2; return st * 1024 + (ob ^ (((ob >> 9) & 1) << 5)); }
__device__ __forceinline__ void stage_rc(int b, int& R, int& C) { const int st = b / 1024, sb = b % 1024, swz = sb ^ (((sb >> 9) & 1) << 5); R = (st >> 1) * 16 + swz / 64; C = (st & 1) * 32 + (swz % 64) / 2; }

struct Order {
  int nM, nN, nwg, G, c;
  __device__ __forceinline__ void init(int M, int N) { nM = M / BM; nN = N / BM; nwg = nM * nN; G = gridDim.x; c = blockIdx.x; }
  template <int MODE> __device__ __forceinline__ bool next_m(int i, int& pm, int& pn, int& kb, int& ntu, int nt_full) const {
    if (MODE == 0) { kb = 0; ntu = nt_full; return next(i, pm, pn); }
    const long L = (long)i * G + c; if (L >= 256) return false;
    const int x = (int)L & 7, j = (int)L >> 3, kq = j & 3;
    pm = 64 + 2 * x + (j >> 4); pn = ((j >> 2) & 3) | (kq << 8);
    kb = kq < 2 ? 12 * kq : 24 + 10 * (kq - 2); ntu = kq < 2 ? 12 : 10; return true;
  }
  __device__ __forceinline__ bool next(int i, int& pm, int& pn) const {
    const long L = (long)i * G + c; if (L >= nwg) return false;
    int wgid = (int)L; { const int q = nwg / NXCD, r = nwg % NXCD, xcd = wgid % NXCD, off = wgid / NXCD; wgid = (xcd < r ? xcd * (q + 1) : r * (q + 1) + (xcd - r) * q) + off; }
    const int nig = WGM * nN, gid = wgid / nig, fm = gid * WGM, gsz = (nM - fm) < WGM ? (nM - fm) : WGM;
    pm = fm + ((wgid % nig) % gsz); pn = (wgid % nig) / gsz; return true;
  }
};

template <class Epi, int MODE = 0>
__device__ __forceinline__ void gemm_phase(LAS unsigned char* lds, const bf16_t* gA, const bf16_t* gBt, int M, int N, int K, const Epi& E) {
  const int tid = opaque_tid(), wid = __builtin_amdgcn_readfirstlane(tid >> 6), lane = tid & 63, wr = wid >> 2, wc = wid & 3, fr = lane & 15, fq = lane >> 4;
  const int nt = K / BK;
  Order S; S.init(M, N);
  unsigned voffA[2];
#pragma unroll
  for (int i = 0; i < 2; ++i) { int R, C; stage_rc(tid * 16 + i * 8192, R, C); voffA[i] = (unsigned)(R * K + C) * 2u; }
  const size_t kstep = (size_t)(BK * 2);
  const size_t hstep = (size_t)HALF * K * 2;
  const size_t tstep = 2 * hstep;
  const unsigned ldsw = (unsigned)wid * 1024u;
  const int aoff = lds_byte(wr * 64 + fr, fq * 8), boff = lds_byte(wc * 32 + fr, fq * 8);
#define G_SA(b, h) (((b) * 2 + (h)) * HTB)
#define G_SB(b, h) ((4 + (b) * 2 + (h)) * HTB)
#define G_STAGE(bufoff, gbase) do { _Pragma("unroll") for (int _i = 0; _i < 2; ++_i) \
    __builtin_amdgcn_global_load_lds((const unsigned*)((const char*)(gbase) + voffA[_i]), (LAS unsigned*)(lds + (bufoff) + ldsw + _i * 8192), 16, 0, 0); } while (0)
#define G_LDA(dst, b, h) do { _Pragma("unroll") for (int m = 0; m < 4; ++m) _Pragma("unroll") for (int k = 0; k < 2; ++k) dst[m][k] = *(const LAS bf16x8*)(lds + G_SA(b, h) + aoff + m * 2048 + k * 1024); } while (0)
#define G_LDB(dst, b, h) do { _Pragma("unroll") for (int n = 0; n < 2; ++n) _Pragma("unroll") for (int k = 0; k < 2; ++k) dst[n][k] = *(const LAS bf16x8*)(lds + G_SB(b, h) + boff + n * 2048 + k * 1024); } while (0)
#define G_MMA(ai, bj, At, Bt) do { __builtin_amdgcn_s_setprio(1); _Pragma("unroll") for (int m = 0; m < 4; ++m) _Pragma("unroll") for (int n = 0; n < 2; ++n) _Pragma("unroll") for (int k = 0; k < 2; ++k) \
    acc[ai][bj][m][n] = __builtin_amdgcn_mfma_f32_16x16x32_bf16(Bt[n][k], At[m][k], acc[ai][bj][m][n], 0, 0, 0); __builtin_amdgcn_s_setprio(0); } while (0)
#define G_WAIT_V(n) asm volatile("s_waitcnt vmcnt(" #n ")" ::: "memory")
#define G_WAIT_L(n) asm volatile("s_waitcnt lgkmcnt(" #n ")" ::: "memory")
#define G_BAR __builtin_amdgcn_s_barrier()
#define G_SCHED __builtin_amdgcn_sched_barrier(0)
  int cpm, cpn, npm = 0, npn = 0, ui = 0, ckb = 0, cnt = nt, nkb = 0, nnt = nt;
  if (!S.template next_m<MODE>(0, cpm, cpn, ckb, cnt, nt)) return;
  f32x4 acc[2][2][4][2];
#pragma unroll
  for (int a = 0; a < 2; ++a)
#pragma unroll
    for (int b = 0; b < 2; ++b)
#pragma unroll
      for (int m = 0; m < 4; ++m)
#pragma unroll
        for (int n = 0; n < 2; ++n) acc[a][b][m][n] = (f32x4){0.f, 0.f, 0.f, 0.f};
  bf16x8 At[4][2], B0[2][2], B1[2][2];
  const char* cA = (const char*)gA + (size_t)cpm * tstep + (size_t)ckb * kstep; const char* cB = (const char*)gBt + (size_t)(cpn & 255) * tstep + (size_t)ckb * kstep;
  G_STAGE(G_SB(0, 0), cB); G_STAGE(G_SA(0, 0), cA); G_STAGE(G_SB(0, 1), cB + hstep); G_STAGE(G_SA(0, 1), cA + hstep);
  if (wr == 1) G_BAR;
  G_WAIT_V(4); G_BAR;
  G_STAGE(G_SB(1, 0), cB + kstep); G_STAGE(G_SA(1, 0), cA + kstep); G_STAGE(G_SB(1, 1), cB + hstep + kstep);
  G_WAIT_V(6); G_BAR;
  for (;;) {
    const bool has_next = S.template next_m<MODE>(ui + 1, npm, npn, nkb, nnt, nt);
    const char* nA = has_next ? (const char*)gA + (size_t)npm * tstep + (size_t)nkb * kstep : cA; const char* nB = has_next ? (const char*)gBt + (size_t)(npn & 255) * tstep + (size_t)nkb * kstep : cB;
    for (int t = 0; t < cnt; t += 2) {
      const bool last = (t == cnt - 2);
      const char* a1 = cA + (size_t)(t + 1) * kstep;
      const char* a2 = last ? nA : cA + (size_t)(t + 2) * kstep; const char* b2 = last ? nB : cB + (size_t)(t + 2) * kstep;
      const char* a3 = a2 + kstep; const char* b3 = b2 + kstep;
      G_LDB(B0, 0, 0); G_SCHED; G_LDA(At, 0, 0); G_STAGE(G_SA(1, 1), a1 + hstep);
      G_WAIT_L(8); G_BAR; G_WAIT_L(0); G_MMA(0, 0, At, B0); G_BAR; G_SCHED;
      G_LDB(B1, 0, 1); G_STAGE(G_SB(0, 0), b2);
      G_BAR; G_WAIT_L(0); G_MMA(0, 1, At, B1); G_BAR;
      G_LDA(At, 0, 1); G_STAGE(G_SA(0, 0), a2);
      G_BAR; G_WAIT_L(0); G_MMA(1, 0, At, B0); G_BAR; G_SCHED;
      G_STAGE(G_SB(0, 1), b2 + hstep);
      G_WAIT_V(6); G_BAR; G_MMA(1, 1, At, B1); G_BAR;
      G_LDB(B0, 1, 0); G_SCHED; G_LDA(At, 1, 0); G_STAGE(G_SA(0, 1), a2 + hstep);
      G_WAIT_L(8); G_BAR; G_WAIT_L(0); G_MMA(0, 0, At, B0); G_BAR; G_SCHED;
      G_LDB(B1, 1, 1); G_STAGE(G_SB(1, 0), b3);
      G_BAR; G_WAIT_L(0); G_MMA(0, 1, At, B1); G_BAR;
      G_LDA(At, 1, 1); G_STAGE(G_SA(1, 0), a3);
      G_BAR; G_WAIT_L(0); G_MMA(1, 0, At, B0); G_BAR; G_SCHED;
      G_STAGE(G_SB(1, 1), b3 + hstep);
      G_WAIT_V(6); G_BAR; G_MMA(1, 1, At, B1); G_BAR;
    }
    asm volatile("s_nop 15\n\ts_nop 15" ::: "memory");
    E(acc, cpm, cpn, wr, wc, fr, fq, lds);
    if (!has_next) break;
#pragma unroll
    for (int a = 0; a < 2; ++a)
#pragma unroll
      for (int b = 0; b < 2; ++b)
#pragma unroll
        for (int m = 0; m < 4; ++m)
#pragma unroll
          for (int n = 0; n < 2; ++n) acc[a][b][m][n] = (f32x4){0.f, 0.f, 0.f, 0.f};
    cpm = npm; cpn = npn; cA = nA; cB = nB; cnt = nnt; ++ui;
  }
  G_WAIT_V(0);
  if (wr == 0) G_BAR;
  G_BAR;
}

struct EpiZ {
  bf16_t* Z;
  __device__ __forceinline__ void operator()(f32x4 (&acc)[2][2][4][2], int pm, int pn, int wr, int wc, int fr, int fq, LAS unsigned char*) const {
    const int row0 = pm * BM + wr * 64 + fr, col0 = pn * BM + wc * 32 + 8 * fq;
#pragma unroll
    for (int ai = 0; ai < 2; ++ai)
#pragma unroll
      for (int m = 0; m < 4; ++m) {
        bf16_t* rowp = Z + (size_t)(row0 + ai * HALF + m * 16) * NZ + col0;
#pragma unroll
        for (int bj = 0; bj < 2; ++bj) { const f32x4 v0 = acc[ai][bj][m][0], v1 = acc[ai][bj][m][1];
          u32x4 o; o.x = cvt_pk_bf16(v0[0], v0[1]); o.y = cvt_pk_bf16(v0[2], v0[3]); o.z = cvt_pk_bf16(v1[0], v1[1]); o.w = cvt_pk_bf16(v1[2], v1[3]);
          *(u32x4*)(rowp + bj * HALF) = o; }
      }
  }
};

struct EpiNone {
  bf16_t* Z;
  __device__ __forceinline__ void operator()(f32x4 (&acc)[2][2][4][2], int pm, int pn, int wr, int wc, int fr, int fq, LAS unsigned char*) const {
    f32x4 s = (f32x4){0.f, 0.f, 0.f, 0.f};
#pragma unroll
    for (int ai = 0; ai < 2; ++ai)
#pragma unroll
      for (int bj = 0; bj < 2; ++bj)
#pragma unroll
        for (int m = 0; m < 4; ++m)
#pragma unroll
          for (int n = 0; n < 2; ++n) s += acc[ai][bj][m][n];
    if (s[0] + s[1] + s[2] + s[3] == 12345.678f) Z[pm + pn] = 1;
  }
};

struct EpiX1 {
  const float* xp; const float* xs; const float* mod; const float* norm2; float* x1out; bf16_t* x1g; float* rowss;
  __device__ __forceinline__ void operator()(f32x4 (&acc)[2][2][4][2], int pm, int pn, int wr, int wc, int fr, int fq, LAS unsigned char*) const {
    const int g = pm < 16 ? 4 : ((pm - 16) >> 4);
    const float* modg = mod + g * NMOD;
    const int col0 = pn * BM + wc * 32 + 4 * fq;
    f32x4 g1[2][2], g2[2][2];
#pragma unroll
    for (int bj = 0; bj < 2; ++bj)
#pragma unroll
      for (int n = 0; n < 2; ++n) { const int c = col0 + bj * HALF + n * 16; g1[bj][n] = *(const f32x4*)(modg + 2048 + c); const f32x4 s2 = *(const f32x4*)(modg + 4096 + c); const f32x4 nv = *(const f32x4*)(norm2 + c); g2[bj][n] = nv * (s2 + 1.0f); }
#pragma unroll
    for (int ai = 0; ai < 2; ++ai)
#pragma unroll
      for (int m = 0; m < 4; ++m) {
        const int T = pm * BM + ai * HALF + wr * 64 + m * 16 + fr;
        const float* xrow = (T < NCTXT) ? xp + (size_t)T * DM : xs + (size_t)(T - NCTXT) * DM;
        const int p = permtok(T);
        float ss = 0.f;
#pragma unroll
        for (int bj = 0; bj < 2; ++bj)
#pragma unroll
          for (int n = 0; n < 2; ++n) {
            const int c = col0 + bj * HALF + n * 16;
            const f32x4 xv = *(const f32x4*)(xrow + c);
            const f32x4 v = xv + g1[bj][n] * acc[ai][bj][m][n];
            *(f32x4*)(x1out + (size_t)T * DM + c) = v;
            ss += v[0] * v[0] + v[1] * v[1] + v[2] * v[2] + v[3] * v[3];
            const f32x4 w = v * g2[bj][n];
            u32x2 o; o.x = cvt_pk_bf16(w[0], w[1]); o.y = cvt_pk_bf16(w[2], w[3]);
            *(u32x2*)(x1g + (size_t)p * DM + c) = o;
          }
        ss += __shfl_xor(ss, 16); ss += __shfl_xor(ss, 32);
        if (fq == 0) __hip_atomic_fetch_add(rowss + p, ss, __ATOMIC_RELAXED, __HIP_MEMORY_SCOPE_AGENT);
      }
  }
};

struct EpiDown {
  const float* mod; float* out; float* rowss2;
  __device__ __forceinline__ void operator()(f32x4 (&acc)[2][2][4][2], int pm, int pn, int wr, int wc, int fr, int fq, LAS unsigned char*) const {
    const int g = pm < 16 ? 4 : ((pm - 16) >> 4);
    const float* modg = mod + g * NMOD;
    const int col0 = pn * BM + wc * 32 + 4 * fq;
    f32x4 g2[2][2];
#pragma unroll
    for (int bj = 0; bj < 2; ++bj)
#pragma unroll
      for (int n = 0; n < 2; ++n) g2[bj][n] = *(const f32x4*)(modg + 5120 + col0 + bj * HALF + n * 16);
#pragma unroll
    for (int ai = 0; ai < 2; ++ai)
#pragma unroll
      for (int m = 0; m < 4; ++m) {
        const int p = pm * BM + ai * HALF + wr * 64 + m * 16 + fr;
        const int T = permtok(p);
        float* orow = out + (size_t)T * DM;
        float ss = 0.f;
#pragma unroll
        for (int bj = 0; bj < 2; ++bj)
#pragma unroll
          for (int n = 0; n < 2; ++n) {
            const int c = col0 + bj * HALF + n * 16;
            const f32x4 xv = *(const f32x4*)(orow + c);
            const f32x4 v = xv + g2[bj][n] * acc[ai][bj][m][n];
            *(f32x4*)(orow + c) = v;
            ss += v[0] * v[0] + v[1] * v[1] + v[2] * v[2] + v[3] * v[3];
          }
        ss += __shfl_xor(ss, 16); ss += __shfl_xor(ss, 32);
        if (fq == 0) __hip_atomic_fetch_add(rowss2 + T, ss, __ATOMIC_RELAXED, __HIP_MEMORY_SCOPE_AGENT);
      }
  }
};

struct EpiDownPart {
  const float* mod; float* out; float* part;
  __device__ __forceinline__ void operator()(f32x4 (&acc)[2][2][4][2], int pm, int pnk, int wr, int wc, int fr, int fq, LAS unsigned char*) const {
    const int pn = pnk & 255, kq = pnk >> 8;
    const int g = pm < 16 ? 4 : ((pm - 16) >> 4);
    const float* modg = mod + g * NMOD;
    const int col0 = pn * BM + wc * 32 + 4 * fq;
    f32x4 g2[2][2];
#pragma unroll
    for (int bj = 0; bj < 2; ++bj)
#pragma unroll
      for (int n = 0; n < 2; ++n) g2[bj][n] = *(const f32x4*)(modg + 5120 + col0 + bj * HALF + n * 16);
#pragma unroll
    for (int ai = 0; ai < 2; ++ai)
#pragma unroll
      for (int m = 0; m < 4; ++m) {
        const int p = pm * BM + ai * HALF + wr * 64 + m * 16 + fr;
        const int T = permtok(p);
        if (kq == 0) {
          float* orow = out + (size_t)T * DM;
#pragma unroll
          for (int bj = 0; bj < 2; ++bj)
#pragma unroll
            for (int n = 0; n < 2; ++n) { const int c = col0 + bj * HALF + n * 16; const f32x4 xv = *(const f32x4*)(orow + c); *(f32x4*)(orow + c) = xv + g2[bj][n] * acc[ai][bj][m][n]; }
        } else {
          float* prow = part + ((size_t)(kq - 1) * 4096 + (T - 16384)) * DM;
#pragma unroll
          for (int bj = 0; bj < 2; ++bj)
#pragma unroll
            for (int n = 0; n < 2; ++n) { const int c = col0 + bj * HALF + n * 16; *(f32x4*)(prow + c) = g2[bj][n] * acc[ai][bj][m][n]; }
        }
      }
  }
};

struct EpiUp {
  const float* rowss1; const float* sb; const float* cw; const float* cb; bf16_t* act;
  __device__ __forceinline__ void operator()(f32x4 (&acc)[2][2][4][2], int pm, int pn, int wr, int wc, int fr, int fq, LAS unsigned char* lds) const {
    asm volatile("" : "+v"(fr), "+v"(fq));
    const bool ctx = pm < 16;
    const int g = ctx ? 4 : ((pm - 16) >> 4);
    const float* sbg = sb + g * NUP;
    LAS float* halo = (LAS float*)(lds + 131072);
    const int prow0 = pm * BM + wr * 64 + fr;
    {
      float rs[2][4];
#pragma unroll
      for (int ai = 0; ai < 2; ++ai)
#pragma unroll
        for (int m = 0; m < 4; ++m) rs[ai][m] = __builtin_amdgcn_rsqf(rowss1[prow0 + ai * HALF + m * 16] * (1.0f / 1024.0f) + EPS);
#pragma unroll
      for (int bj = 0; bj < 2; ++bj)
#pragma unroll
        for (int n = 0; n < 2; ++n) {
          asm volatile("" ::: "memory"); __builtin_amdgcn_sched_barrier(0);
          const f32x4 sv = *(const f32x4*)(sbg + bj * DFF + pn * HALF + wc * 32 + 8 * fq + 4 * n);
#pragma unroll
          for (int ai = 0; ai < 2; ++ai)
#pragma unroll
            for (int m = 0; m < 4; ++m) { acc[ai][bj][m][n] = acc[ai][bj][m][n] * rs[ai][m] + sv; asm volatile("" : "+v"(acc[ai][bj][m][n])); }
        }
    }
    if (ctx) {
#pragma unroll
      for (int ai = 0; ai < 2; ++ai)
#pragma unroll
        for (int bj = 0; bj < 2; ++bj)
#pragma unroll
          for (int n = 0; n < 2; ++n) {
            const int rb = 2 * ai + wr, colt = bj * HALF + wc * 32 + 8 * fq + 4 * n;
            if (fr == 0) *(LAS f32x4*)(halo + (rb * 2 + 0) * 256 + colt) = acc[ai][bj][0][n];
            if (fr == 15) *(LAS f32x4*)(halo + (rb * 2 + 1) * 256 + colt) = acc[ai][bj][3][n];
          }
      asm volatile("s_waitcnt lgkmcnt(0)" ::: "memory");
      __builtin_amdgcn_s_barrier();
      __builtin_amdgcn_s_barrier();
      asm volatile("" ::: "memory");
    }
#pragma unroll
    for (int ai = 0; ai < 2; ++ai) {
      u32x2 st[4];
#pragma unroll
      for (int n = 0; n < 2; ++n) {
        f32x4 ya[4];
        const int rb = 2 * ai + wr;
#pragma unroll
        for (int bj = 0; bj < 2; ++bj) {
          const int cnat = bj * DFF + pn * HALF + wc * 32 + 8 * fq + 4 * n, colt = bj * HALF + wc * 32 + 8 * fq + 4 * n;
          const f32x4 w0 = *(const f32x4*)(cw + cnat), w1 = *(const f32x4*)(cw + NUP + cnat), w2 = *(const f32x4*)(cw + 2 * NUP + cnat), bb = *(const f32x4*)(cb + cnat);
          f32x4 hp = (f32x4){0.f, 0.f, 0.f, 0.f}, hn = hp;
          if (ctx) {
            if (rb > 0) hp = *(const LAS f32x4*)(halo + ((rb - 1) * 2 + 1) * 256 + colt);
            if (rb < 3) hn = *(const LAS f32x4*)(halo + ((rb + 1) * 2 + 0) * 256 + colt);
          }
#pragma unroll
          for (int m = 0; m < 4; ++m) {
            const f32x4 cur = acc[ai][bj][m][n];
            f32x4 prev, next;
#pragma unroll
            for (int e = 0; e < 4; ++e) {
              if (m > 0) { const float snd = (fr == 15) ? acc[ai][bj][m > 0 ? m - 1 : 0][n][e] : cur[e]; prev[e] = dppf<0x121>(snd); }
              else { const float rcv = dppf<0x121>(cur[e]); prev[e] = (fr == 0) ? hp[e] : rcv; }
              if (m < 3) { const float snd = (fr == 0) ? acc[ai][bj][m < 3 ? m + 1 : 3][n][e] : cur[e]; next[e] = dppf<0x12F>(snd); }
              else { const float rcv = dppf<0x12F>(cur[e]); next[e] = (fr == 15) ? hn[e] : rcv; }
            }
            const f32x4 y = w0 * prev + w1 * cur + w2 * next + bb;
            if (bj == 0) ya[m] = y;
            else {
              float o[4];
#pragma unroll
              for (int e = 0; e < 4; ++e) o[e] = y[e] * fast_sigmoid(y[e]) * ya[m][e];
              u32x2 ov; ov.x = cvt_pk_bf16(o[0], o[1]); ov.y = cvt_pk_bf16(o[2], o[3]);
              if (n == 0) st[m] = ov;
              else { u32x4 o4; o4.x = st[m].x; o4.y = st[m].y; o4.z = ov.x; o4.w = ov.y;
                *(u32x4*)(act + (size_t)(prow0 + ai * HALF + m * 16) * DFF + pn * HALF + wc * 32 + 8 * fq) = o4; }
            }
          }
        }
      }
    }
  }
};

template <bool SILU>
__device__ __forceinline__ void gemv5_unit(const Params& P, int unit, int ncb, const float* W, int ldw, float* outp, int ldo, const float* bias, const float* modv, float* sm) {
  const int tid = opaque_tid();
  const int cb = unit % ncb, ks = unit / ncb, n0 = cb * 256, k0 = ks * 128;
  float* sv = sm; float* red = sm + 640;
  for (int i = tid; i < 640; i += 512) {
    const int g = i >> 7, k = k0 + (i & 127);
    float v;
    if (SILU) { v = (g < 4) ? P.c[g * DM + k] : P.c_ctx[k]; v = v / (1.0f + __expf(-v)); }
    else v = modv[g * NMOD + 3072 + k];
    sv[i] = v;
  }
  __syncthreads();
  const int col = tid & 255, kh = tid >> 8;
  float a0 = 0.f, a1 = 0.f, a2 = 0.f, a3 = 0.f, a4 = 0.f;
  const float* wp = W + (size_t)(k0 + kh * 64) * ldw + n0 + col;
#pragma unroll 8
  for (int kk = 0; kk < 64; ++kk) {
    const float w = wp[(size_t)kk * ldw];
    const int ki = kh * 64 + kk;
    a0 += sv[ki] * w; a1 += sv[128 + ki] * w; a2 += sv[256 + ki] * w; a3 += sv[384 + ki] * w; a4 += sv[512 + ki] * w;
  }
  if (kh == 1) { red[col] = a0; red[256 + col] = a1; red[512 + col] = a2; red[768 + col] = a3; red[1024 + col] = a4; }
  __syncthreads();
  if (kh == 0) {
    const float bv = (bias != nullptr && ks == 0) ? bias[n0 + col] : 0.f;
    a0 += red[col] + bv; a1 += red[256 + col] + bv; a2 += red[512 + col] + bv; a3 += red[768 + col] + bv; a4 += red[1024 + col] + bv;
    float* o = outp + n0 + col;
    __hip_atomic_fetch_add(o, a0, __ATOMIC_RELAXED, __HIP_MEMORY_SCOPE_AGENT);
    __hip_atomic_fetch_add(o + ldo, a1, __ATOMIC_RELAXED, __HIP_MEMORY_SCOPE_AGENT);
    __hip_atomic_fetch_add(o + 2 * ldo, a2, __ATOMIC_RELAXED, __HIP_MEMORY_SCOPE_AGENT);
    __hip_atomic_fetch_add(o + 3 * ldo, a3, __ATOMIC_RELAXED, __HIP_MEMORY_SCOPE_AGENT);
    __hip_atomic_fetch_add(o + 4 * ldo, a4, __ATOMIC_RELAXED, __HIP_MEMORY_SCOPE_AGENT);
  }
  __syncthreads();
}

struct TrUnit { const float* src; bf16_t* dst; int ldw, ldd, perm; };
__device__ __forceinline__ void tr_decode(const Params& P, int v, TrUnit& t) {
  bf16_t* WinT = (bf16_t*)(P.ws + WS_WIN); bf16_t* WoutT = (bf16_t*)(P.ws + WS_WOUT); bf16_t* WupT = (bf16_t*)(P.ws + WS_WUP); bf16_t* WdnT = (bf16_t*)(P.ws + WS_WDN);
  if (v < 896) { const int kt = v / 56, ntl = v % 56; t.src = P.w_in + (size_t)(kt * 64) * DIN + ntl * 64; t.ldw = DIN; t.dst = WinT + (size_t)(ntl * 64) * DM + kt * 64; t.ldd = DM; t.perm = 1; }
  else if (v < 1152) { const int w = v - 896, kt = w >> 4, ntl = w & 15; t.src = P.w_out + (size_t)(kt * 64) * DM + ntl * 64; t.ldw = DM; t.dst = WoutT + (size_t)(ntl * 64) * DM + kt * 64; t.ldd = DM; t.perm = 0; }
  else if (v < 2560) { const int w = v - 1152, kt = w / 88, ntl = w % 88; const int n0 = ntl * 64, half = n0 / DFF, r = n0 % DFF, pn = r >> 7, cc = r & 127;
    t.src = P.w_up + (size_t)(kt * 64) * NUP + n0; t.ldw = NUP; t.dst = WupT + (size_t)(pn * 256 + half * 128 + cc) * DM + kt * 64; t.ldd = DM; t.perm = 1; }
  else { const int w = v - 2560, kt = w >> 4, ntl = w & 15; t.src = P.w_down + (size_t)(kt * 64) * DM + ntl * 64; t.ldw = DM; t.dst = WdnT + (size_t)(ntl * 64) * DFF + kt * 64; t.ldd = DFF; t.perm = 0; }
}
__device__ void phase0a(const Params& P, float* sm) {
  const int tid = opaque_tid();
  float* mod = (float*)(P.ws + WS_MOD);
  for (int u = blockIdx.x; u < 24 * 8; u += gridDim.x) gemv5_unit<true>(P, u, 24, P.w_mod, NMOD, mod, NMOD, P.b_mod, nullptr, sm);
  constexpr int NTR = 896 + 256 + 1408 + 704;
  const int r = tid >> 4, c4 = (tid & 15) * 4, nn = tid >> 3, kk8 = (tid & 7) * 8;
  float* tile = sm;
  int v = gridDim.x - 1 - blockIdx.x;
  f32x4 p0 = (f32x4){0.f, 0.f, 0.f, 0.f}, p1 = p0; TrUnit cur;
  if (v < NTR) { tr_decode(P, v, cur); p0 = *(const f32x4*)(cur.src + (size_t)r * cur.ldw + c4); p1 = *(const f32x4*)(cur.src + (size_t)(r + 32) * cur.ldw + c4); }
  while (v < NTR) {
    { float* t = tile + r * 65 + c4; t[0] = p0[0]; t[1] = p0[1]; t[2] = p0[2]; t[3] = p0[3]; t += 32 * 65; t[0] = p1[0]; t[1] = p1[1]; t[2] = p1[2]; t[3] = p1[3]; }
    const int vn = v + gridDim.x; TrUnit nxt = cur;
    if (vn < NTR) tr_decode(P, vn, nxt);
    p0 = *(const f32x4*)(nxt.src + (size_t)r * nxt.ldw + c4); p1 = *(const f32x4*)(nxt.src + (size_t)(r + 32) * nxt.ldw + c4);
    __syncthreads();
    { float vv[8];
#pragma unroll
      for (int j = 0; j < 8; ++j) vv[j] = tile[(kk8 + j) * 65 + nn];
      u32x4 o; o.x = cvt_pk_bf16(vv[0], vv[1]); o.y = cvt_pk_bf16(vv[2], vv[3]); o.z = cvt_pk_bf16(vv[4], vv[5]); o.w = cvt_pk_bf16(vv[6], vv[7]);
      const int c5 = nn & 31, nnp = cur.perm ? ((nn & 32) + ((c5 >> 2) & 1) * 16 + (c5 >> 3) * 4 + (c5 & 3)) : nn;
      *(u32x4*)(cur.dst + (size_t)nnp * cur.ldd + kk8) = o; }
    __syncthreads();
    cur = nxt; v = vn;
  }
}

__device__ void phase0b(const Params& P, float* sm) {
  const int tid = opaque_tid(), wid = tid >> 6, lane = tid & 63;
  const float* mod = (const float*)(P.ws + WS_MOD);
  float* sbv = (float*)(P.ws + WS_SB);
  float* gates = (float*)(P.ws + WS_GATES);
  bf16_t* H = (bf16_t*)(P.ws + WS_H);
  for (int u = blockIdx.x; u < 22 * 8; u += gridDim.x) gemv5_unit<false>(P, u, 22, P.w_up, NUP, sbv, NUP, nullptr, mod, sm + 16384);
  for (int i0 = 0; i0 < 32; i0 += 8) {
    float wv[8];
#pragma unroll
    for (int i = 0; i < 8; ++i) { const int idx = tid + 512 * (i0 + i); wv[i] = P.w_in[(size_t)(idx >> 4) * DIN + NZ + (idx & 15)]; }
#pragma unroll
    for (int i = 0; i < 8; ++i) { const int idx = tid + 512 * (i0 + i); sm[(idx & 15) * 1024 + (idx >> 4)] = wv[i]; }
  }
  __syncthreads();
  f32x4 xnext[4];
  { const int Tn = blockIdx.x * 8 + wid; const float* xr = (Tn < NCTXT) ? P.x_prompt + (size_t)Tn * DM : P.x_sample + (size_t)(Tn - NCTXT) * DM;
#pragma unroll
    for (int i = 0; i < 4; ++i) xnext[i] = *(const f32x4*)(xr + i * 256 + lane * 4); }
  for (int T = blockIdx.x * 8 + wid; T < NTOK; T += gridDim.x * 8) {
    const int g = T < NCTXT ? 4 : ((T - NCTXT) >> 12);
    const float* modg = mod + g * NMOD;
    f32x4 xv[4]; float ss = 0.f;
#pragma unroll
    for (int i = 0; i < 4; ++i) xv[i] = xnext[i];
    { int Tn = T + gridDim.x * 8; Tn = Tn < NTOK ? Tn : T;
      const float* xr = (Tn < NCTXT) ? P.x_prompt + (size_t)Tn * DM : P.x_sample + (size_t)(Tn - NCTXT) * DM;
#pragma unroll
      for (int i = 0; i < 4; ++i) xnext[i] = *(const f32x4*)(xr + i * 256 + lane * 4); }
#pragma unroll
    for (int i = 0; i < 4; ++i) ss += xv[i][0] * xv[i][0] + xv[i][1] * xv[i][1] + xv[i][2] * xv[i][2] + xv[i][3] * xv[i][3];
#pragma unroll
    for (int o = 1; o < 64; o <<= 1) ss += __shfl_xor(ss, o);
    const float rstd = rsqrtf(ss * (1.0f / 1024.0f) + EPS);
    f32x4 hv[4];
#pragma unroll
    for (int i = 0; i < 4; ++i) {
      const int c = i * 256 + lane * 4;
      const f32x4 nv = *(const f32x4*)(P.norm1 + c), sc = *(const f32x4*)(modg + 1024 + c), sh = *(const f32x4*)(modg + c);
      hv[i] = xv[i] * rstd * nv * (sc + 1.0f) + sh;
      u32x2 o; o.x = cvt_pk_bf16(hv[i][0], hv[i][1]); o.y = cvt_pk_bf16(hv[i][2], hv[i][3]);
      *(u32x2*)(H + (size_t)T * DM + c) = o;
    }
    float v[16];
#pragma unroll
    for (int gi = 0; gi < 16; ++gi) {
      float a = 0.f;
#pragma unroll
      for (int i = 0; i < 4; ++i) { const f32x4 w = *(const f32x4*)(sm + gi * 1024 + i * 256 + lane * 4); a += hv[i][0] * w[0] + hv[i][1] * w[1] + hv[i][2] * w[2] + hv[i][3] * w[3]; }
      v[gi] = a;
    }
#pragma unroll
    for (int j = 0; j < 8; ++j) { const bool hi = lane & 32; const float keep = hi ? v[j + 8] : v[j], send = hi ? v[j] : v[j + 8]; v[j] = keep + __shfl_xor(send, 32); }
#pragma unroll
    for (int j = 0; j < 4; ++j) { const bool hi = lane & 16; const float keep = hi ? v[j + 4] : v[j], send = hi ? v[j] : v[j + 4]; v[j] = keep + __shfl_xor(send, 16); }
#pragma unroll
    for (int j = 0; j < 2; ++j) { const bool hi = lane & 8; const float keep = hi ? v[j + 2] : v[j], send = hi ? v[j] : v[j + 2]; v[j] = keep + __shfl_xor(send, 8); }
    { const bool hi = lane & 4; const float keep = hi ? v[1] : v[0], send = hi ? v[0] : v[1]; v[0] = keep + __shfl_xor(send, 4); }
    v[0] += __shfl_xor(v[0], 2); v[0] += __shfl_xor(v[0], 1);
    if ((lane & 3) == 0) {
      const int gi = ((lane >> 5) & 1) * 8 + ((lane >> 4) & 1) * 4 + ((lane >> 3) & 1) * 2 + ((lane >> 2) & 1);
      float val = v[0] + P.b_gate[gi];
      if ((gi >> 2) & 1) val = fminf(val, 0.f) - log1pf(__expf(-fabsf(val)));
      gates[(size_t)T * 16 + gi] = val;
    }
  }
  __syncthreads();
}

__device__ __forceinline__ void unit_info(int u, int& T0, int& nc, int& b, int& h, int& c) {
  if (u < 128) { nc = 2; b = u >> 3; h = (u >> 1) & 3; c = u & 1; T0 = b * 256 + c * 128; }
  else { const int v = u - 128; nc = 32; b = v >> 7; h = (v >> 5) & 3; c = v & 31; T0 = NCTXT + b * 4096 + c * 128; }
}
struct ScanOut { float beta0, beta1, cf0, cf1, pm0, pm1, bl, cmax; int t0, t1; };
__device__ __forceinline__ void chunk_scan(const float* gates, int T0, int h, int d, int lane, ScanOut& o) {
  const int t0 = d ? 127 - 2 * lane : 2 * lane, t1 = d ? t0 - 1 : t0 + 1;
  const float* g0 = gates + (size_t)(T0 + t0) * 16 + d * 8 + h; const float* g1 = gates + (size_t)(T0 + t1) * 16 + d * 8 + h;
  const float i0 = g0[0], f0 = g0[4], i1 = g1[0], f1 = g1[4];
  const float s = f0 + f1;
  float x = s;
#pragma unroll
  for (int off = 1; off < 64; off <<= 1) { const float y = __shfl_up(x, off); if (lane >= off) x += y; }
  const float excl = x - s;
  o.beta0 = excl + f0; o.beta1 = x;
  o.cf0 = i0 - o.beta0; o.cf1 = i1 - o.beta1;
  float mx = fmaxf(o.cf0, o.cf1);
#pragma unroll
  for (int off = 1; off < 64; off <<= 1) { const float y = __shfl_up(mx, off); if (lane >= off) mx = fmaxf(mx, y); }
  const float mex = __shfl_up(mx, 1);
  o.pm0 = lane ? fmaxf(mex, o.cf0) : o.cf0; o.pm1 = mx;
  o.bl = __shfl(x, 63); o.cmax = __shfl(mx, 63);
  o.t0 = t0; o.t1 = t1;
}

constexpr int LROW = 136;
constexpr int CST_ELEMS = 129 * 128;

__device__ void shortconv_items(const Params& P) {
  const bf16_t* Z = (const bf16_t*)(P.ws + WS_Z);
  bf16_t* ucat = (bf16_t*)(P.ws + WS_UCAT);
  const int tid = opaque_tid(), wid = tid >> 6, lane = tid & 63, cgp = lane * 8;
  float w0[8], w1[8], w2[8], bb[8];
#pragma unroll
  for (int q = 0; q < 2; ++q) {
    const f32x4 a = *(const f32x4*)(P.conv_sc_w + cgp + q * 4), b = *(const f32x4*)(P.conv_sc_w + 512 + cgp + q * 4), cc = *(const f32x4*)(P.conv_sc_w + 1024 + cgp + q * 4), d = *(const f32x4*)(P.conv_sc_b + cgp + q * 4);
#pragma unroll
    for (int e = 0; e < 4; ++e) { w0[q * 4 + e] = a[e]; w1[q * 4 + e] = b[e]; w2[q * 4 + e] = cc[e]; bb[q * 4 + e] = d[e]; }
  }
  int Tb, Te;
  { const int G = gridDim.x, nhi = 640 % G == 0 ? G : 640 % G;
    const int wlo = 1, whi = (nhi < G) ? 5 : 1;
    const long tot = (long)nhi * wlo + (long)(G - nhi) * whi;
    const int b = blockIdx.x;
    const long s0 = b < nhi ? (long)b * wlo : (long)nhi * wlo + (long)(b - nhi) * whi, s1 = s0 + (b < nhi ? wlo : whi);
    const int r0 = (int)((long)NTOK * s0 / tot), r1 = (int)((long)NTOK * s1 / tot);
    const int n = r1 - r0, per = (n + 7) >> 3;
    Tb = r0 + wid * per; Te = Tb + per < r1 ? Tb + per : r1; }
  if (Tb >= Te) return;
  auto loadu = [&](int T, float (&u)[8]) {
    const int Tc = T < 0 ? 0 : (T >= NTOK ? NTOK - 1 : T);
    const bf16_t* zr = Z + (size_t)Tc * NZ + cgp;
    const u32x4 c = *(const u32x4*)(zr + 512), x = *(const u32x4*)(zr + 1024);
#pragma unroll
    for (int q = 0; q < 4; ++q) { u[2 * q] = bflo(c[q]) * bflo(x[q]); u[2 * q + 1] = bfhi(c[q]) * bfhi(x[q]); }
  };
  float up[8], uc[8], un[8];
  loadu(Tb - 1, up); loadu(Tb, uc);
  for (int T = Tb; T < Te; ++T) {
    loadu(T + 1, un);
    const u32x4 sbq = *(const u32x4*)(Z + (size_t)T * NZ + cgp);
    const int pos = (T < NCTXT) ? (T & 255) : ((T - NCTXT) & 63), lastp = (T < NCTXT) ? 255 : 63;
    const float mp = pos != 0 ? 1.f : 0.f, mn = pos != lastp ? 1.f : 0.f;
    float o[8];
#pragma unroll
    for (int q = 0; q < 4; ++q) {
      o[2 * q] = bflo(sbq[q]) * (w0[2 * q] * (mp * up[2 * q]) + w1[2 * q] * uc[2 * q] + w2[2 * q] * (mn * un[2 * q]) + bb[2 * q]);
      o[2 * q + 1] = bfhi(sbq[q]) * (w0[2 * q + 1] * (mp * up[2 * q + 1]) + w1[2 * q + 1] * uc[2 * q + 1] + w2[2 * q + 1] * (mn * un[2 * q + 1]) + bb[2 * q + 1]);
    }
    u32x4 ov; ov.x = cvt_pk_bf16(o[0], o[1]); ov.y = cvt_pk_bf16(o[2], o[3]); ov.z = cvt_pk_bf16(o[4], o[5]); ov.w = cvt_pk_bf16(o[6], o[7]);
    *(u32x4*)(ucat + (size_t)T * DM + cgp) = ov;
#pragma unroll
    for (int e = 0; e < 8; ++e) { up[e] = uc[e]; uc[e] = un[e]; }
  }
}

__device__ void phaseM1(const Params& P, LAS unsigned char* lds) {
  const int tid = opaque_tid(), wid = tid >> 6, lane = tid & 63, fr = lane & 15, fq = lane >> 4;
  const bf16_t* Z = (const bf16_t*)(P.ws + WS_Z);
  const float* gates = (const float*)(P.ws + WS_GATES);
  float* stat = (float*)(P.ws + WS_STAT);
  bf16_t* dC = (bf16_t*)P.out;
  LAS bf16_t* KT = (LAS bf16_t*)lds;
  LAS bf16_t* VT0 = (LAS bf16_t*)(lds + 34816);
  LAS bf16_t* VT1 = (LAS bf16_t*)(lds + 34816 + 36992);
  LAS float* ecs = (LAS float*)(lds + 34816 + 2 * 36992 + 4096);
  for (int u = blockIdx.x; u < 640; u += gridDim.x) {
    int T0, nc, b, h, c; unit_info(u, T0, nc, b, h, c);
    if (wid < 2) {
      ScanOut so; chunk_scan(gates, T0, h, wid, lane, so);
      ecs[wid * 128 + so.t0] = __expf(so.cf0 - so.cmax); ecs[wid * 128 + so.t1] = __expf(so.cf1 - so.cmax);
      if (lane == 0) { stat[(u * 2 + wid) * 2] = so.bl; stat[(u * 2 + wid) * 2 + 1] = so.cmax; }
    }
    __syncthreads();
    {
      const int s = 2 * (tid & 63);
#pragma unroll
      for (int i = 0; i < 2; ++i) {
        const int kg = (tid >> 6) + 8 * i;
        const bf16_t* zr = Z + (size_t)(T0 + s) * NZ + h * 128 + kg * 8;
        const u32x4 ka = *(const u32x4*)(zr + 2048), va = *(const u32x4*)(zr + 2560);
        const u32x4 kb = *(const u32x4*)(zr + NZ + 2048), vb = *(const u32x4*)(zr + NZ + 2560);
        const float e0a = ecs[s], e0b = ecs[s + 1], e1a = ecs[128 + s], e1b = ecs[128 + s + 1];
#pragma unroll
        for (int q = 0; q < 4; ++q) {
          const int r0 = (kg * 8 + 2 * q) * LROW + s, r1 = r0 + LROW;
          *(LAS unsigned*)(KT + r0) = (ka[q] & 0xffffu) | (kb[q] << 16);
          *(LAS unsigned*)(KT + r1) = (ka[q] >> 16) | (kb[q] & 0xffff0000u);
          const float al = bflo(va[q]), ah = bfhi(va[q]), bl_ = bflo(vb[q]), bh = bfhi(vb[q]);
          *(LAS unsigned*)(VT0 + r0) = cvt_pk_bf16_c(al * e0a, bl_ * e0b);
          *(LAS unsigned*)(VT0 + r1) = cvt_pk_bf16_c(ah * e0a, bh * e0b);
          *(LAS unsigned*)(VT1 + r0) = cvt_pk_bf16_c(al * e1a, bl_ * e1b);
          *(LAS unsigned*)(VT1 + r1) = cvt_pk_bf16_c(ah * e1a, bh * e1b);
        }
      }
      if (tid < 64) { *(LAS unsigned*)(VT0 + 128 * LROW + 2 * tid) = cvt_pk_bf16_c(ecs[2 * tid], ecs[2 * tid + 1]); *(LAS unsigned*)(VT1 + 128 * LROW + 2 * tid) = cvt_pk_bf16_c(ecs[128 + 2 * tid], ecs[128 + 2 * tid + 1]); }
    }
    __syncthreads();
    {
      bf16x8 Kf[4];
#pragma unroll
      for (int ks = 0; ks < 4; ++ks) Kf[ks] = *(const LAS bf16x8*)(KT + (16 * wid + fr) * LROW + 32 * ks + 8 * fq);
#pragma unroll
      for (int d = 0; d < 2; ++d) {
        LAS bf16_t* VT = d ? VT1 : VT0;
        bf16_t* dst = dC + (size_t)(u * 2 + d) * CST_ELEMS;
#pragma unroll
        for (int mt = 0; mt < 9; ++mt) {
          f32x4 a = (f32x4){0.f, 0.f, 0.f, 0.f};
#pragma unroll
          for (int ks = 0; ks < 4; ++ks) { const bf16x8 Vf = *(const LAS bf16x8*)(VT + (16 * mt + fr) * LROW + 32 * ks + 8 * fq); a = __builtin_amdgcn_mfma_f32_16x16x32_bf16(Kf[ks], Vf, a, 0, 0, 0); }
          if (mt < 8 || fr == 0) { u32x2 o; o.x = cvt_pk_bf16_c(a[0], a[1]); o.y = cvt_pk_bf16_c(a[2], a[3]); *(u32x2*)(dst + (16 * mt + fr) * 128 + 16 * wid + 4 * fq) = o; }
        }
      }
    }
    __syncthreads();
  }
}

template <int NC, int BLK, bool HASN>
__device__ __forceinline__ void m2_loop(const bf16_t* dC, bf16_t* Cst, float* mst, const float* sm, int ubase, int d, int e, int kn, bool wm, f32x4& C4, f32x4& n4, float& m) {
#pragma unroll 1
  for (int jb = 0; jb < NC; jb += BLK) {
    u32x2 dv[BLK], nv[BLK];
#pragma unroll
    for (int jj = 0; jj < BLK; ++jj) {
      const int j = jb + jj, c = d ? NC - 1 - j : j;
      const bf16_t* dp = dC + (size_t)((ubase + c) * 2 + d) * CST_ELEMS;
      dv[jj] = *(const u32x2*)(dp + e);
      if (HASN) nv[jj] = *(const u32x2*)(dp + 16384 + kn);
    }
#pragma unroll
    for (int jj = 0; jj < BLK; ++jj) {
      const int j = jb + jj, c = d ? NC - 1 - j : j;
      const int idx = (ubase + c) * 2 + d;
      bf16_t* cs = Cst + (size_t)idx * CST_ELEMS;
      { u32x2 o; o.x = cvt_pk_bf16(C4[0], C4[1]); o.y = cvt_pk_bf16(C4[2], C4[3]); *(u32x2*)(cs + e) = o; }
      if (HASN) { u32x2 o; o.x = cvt_pk_bf16(n4[0], n4[1]); o.y = cvt_pk_bf16(n4[2], n4[3]); *(u32x2*)(cs + 16384 + kn) = o; if (wm) mst[idx] = m; }
      const float bl = sm[2 * j], cmax = sm[2 * j + 1];
      const float mn = bl + fmaxf(m, cmax);
      const float decay = __expf(bl + m - mn), scale = __expf(bl + cmax - mn);
      const u32x2 dvv = dv[jj];
      C4[0] = decay * C4[0] + scale * bflo(dvv.x); C4[1] = decay * C4[1] + scale * bfhi(dvv.x); C4[2] = decay * C4[2] + scale * bflo(dvv.y); C4[3] = decay * C4[3] + scale * bfhi(dvv.y);
      if (HASN) { const u32x2 nvv = nv[jj];
        n4[0] = decay * n4[0] + scale * bflo(nvv.x); n4[1] = decay * n4[1] + scale * bfhi(nvv.x); n4[2] = decay * n4[2] + scale * bflo(nvv.y); n4[3] = decay * n4[3] + scale * bfhi(nvv.y); }
      m = mn;
    }
  }
}
template <int NC, int BLK>
__device__ __forceinline__ void m2_unit(const Params& P, bool lat, int sq, int slice, float* sm) {
  const int tid = opaque_tid();
  const bf16_t* dC = (const bf16_t*)P.out;
  bf16_t* Cst = (bf16_t*)(P.ws + WS_H);
  const float* stat = (const float*)(P.ws + WS_STAT);
  float* mst = (float*)(P.ws + WS_MST);
  const int b = sq >> 3, h = (sq >> 1) & 3, d = sq & 1;
  const int ubase = lat ? 128 + (b * 4 + h) * 32 : (b * 4 + h) * 2;
  const int e = slice * 2048 + tid * 4;
  const bool hasn = (slice == 0) && (tid < 64);
  const int kn = (tid & 31) * 4;
  if (tid < NC) { const int c = d ? NC - 1 - tid : tid; const int idx = (ubase + c) * 2 + d; sm[2 * tid] = stat[idx * 2]; sm[2 * tid + 1] = stat[idx * 2 + 1]; }
  f32x4 C4 = (f32x4){0.f, 0.f, 0.f, 0.f}, n4 = C4; float m = 0.f;
  const int sidx = (b * 2 + d) * 4 + h;
  if (lat) {
    C4 = *(const f32x4*)(P.state_C + (size_t)sidx * 16384 + e);
    n4 = *(const f32x4*)(P.state_n + sidx * 128 + kn);
    m = P.state_m[sidx];
  }
  __syncthreads();
  if (hasn) m2_loop<NC, BLK, true>(dC, Cst, mst, sm, ubase, d, e, kn, tid == 0, C4, n4, m);
  else m2_loop<NC, BLK, false>(dC, Cst, mst, sm, ubase, d, e, kn, false, C4, n4, m);
  if (!lat) {
    *(f32x4*)(P.out + OUT_TAIL + (size_t)sidx * 16384 + e) = C4;
    if (hasn) { *(f32x4*)(P.out + OUT_TAIL + 2097152 + sidx * 128 + kn) = n4; if (tid == 0) P.out[OUT_TAIL + 2097152 + 16384 + sidx] = m; }
  }
  __syncthreads();
}
__device__ void phaseM2(const Params& P, float* sm) {
  for (int unit = blockIdx.x; unit < 1280; unit += gridDim.x) {
    if (unit < 256) m2_unit<32, 16>(P, true, unit >> 3, unit & 7, sm);
    else { const int v = unit - 256; m2_unit<2, 2>(P, false, v >> 3, v & 7, sm); }
  }
}

__device__ __forceinline__ bf16x8 scale_frag(bf16x8 q, float s) {
  const u32x4 a = __builtin_bit_cast(u32x4, q); u32x4 r;
  r.x = cvt_pk_bf16_c(bflo(a.x) * s, bfhi(a.x) * s); r.y = cvt_pk_bf16_c(bflo(a.y) * s, bfhi(a.y) * s);
  r.z = cvt_pk_bf16_c(bflo(a.z) * s, bfhi(a.z) * s); r.w = cvt_pk_bf16_c(bflo(a.w) * s, bfhi(a.w) * s);
  return __builtin_bit_cast(bf16x8, r);
}

__device__ void phaseM3(const Params& P, LAS unsigned char* lds) {
  const int tid = opaque_tid(), wid = tid >> 6, lane = tid & 63, fr = lane & 15, fq = lane >> 4;
  const bf16_t* Z = (const bf16_t*)(P.ws + WS_Z);
  const float* gates = (const float*)(P.ws + WS_GATES);
  const bf16_t* Cst = (const bf16_t*)(P.ws + WS_H);
  const float* mst = (const float*)(P.ws + WS_MST);
  bf16_t* ucat = (bf16_t*)(P.ws + WS_UCAT);
  LAS bf16_t* Ks = (LAS bf16_t*)lds;
  LAS bf16_t* VT = (LAS bf16_t*)(lds + 34816);
  LAS bf16_t* Sb = (LAS bf16_t*)(lds + 34816 + 36992);
  LAS float* arr = (LAS float*)(lds + 34816 + 36992 + 34816);
  LAS float* ecA = arr; LAS float* erA = arr + 256; LAS float* wiA = arr + 512; LAS float* flA = arr + 768;
  LAS bf16_t* Cb = (LAS bf16_t*)(lds + 34816 + 36992 + 34816 + 4096);
  const float qs = 0.08838834764831845f;
  for (int u = blockIdx.x; u < 640; u += gridDim.x) {
    int T0, nc, b, h, c; unit_info(u, T0, nc, b, h, c);
    if (wid < 2) {
      const int d = wid;
      ScanOut so; chunk_scan(gates, T0, h, d, lane, so);
      const float mc = mst[u * 2 + d];
      const float mx0 = fmaxf(mc, so.pm0), mx1 = fmaxf(mc, so.pm1);
      ecA[d * 128 + so.t0] = __expf(so.cf0 - so.cmax); ecA[d * 128 + so.t1] = __expf(so.cf1 - so.cmax);
      erA[d * 128 + so.t0] = __expf(so.cmax - mx0) * qs; erA[d * 128 + so.t1] = __expf(so.cmax - mx1) * qs;
      wiA[d * 128 + so.t0] = __expf(mc - mx0) * qs; wiA[d * 128 + so.t1] = __expf(mc - mx1) * qs;
      flA[d * 128 + so.t0] = __expf(-(so.beta0 + mx0)); flA[d * 128 + so.t1] = __expf(-(so.beta1 + mx1));
    }
    {
      const int s = 2 * (tid & 63);
#pragma unroll
      for (int i = 0; i < 2; ++i) {
        const int kg = (tid >> 6) + 8 * i;
        const bf16_t* zr = Z + (size_t)(T0 + s) * NZ + h * 128 + kg * 8;
        const u32x4 ka = *(const u32x4*)(zr + 2048), va = *(const u32x4*)(zr + 2560);
        const u32x4 kb = *(const u32x4*)(zr + NZ + 2048), vb = *(const u32x4*)(zr + NZ + 2560);
        *(LAS u32x4*)(Ks + s * LROW + kg * 8) = ka;
        *(LAS u32x4*)(Ks + (s + 1) * LROW + kg * 8) = kb;
#pragma unroll
        for (int q = 0; q < 4; ++q) {
          const int r0 = (kg * 8 + 2 * q) * LROW + s, r1 = r0 + LROW;
          *(LAS unsigned*)(VT + r0) = (va[q] & 0xffffu) | (vb[q] << 16);
          *(LAS unsigned*)(VT + r1) = (va[q] >> 16) | (vb[q] & 0xffff0000u);
        }
      }
      if (tid < 64) *(LAS unsigned*)(VT + 128 * LROW + 2 * tid) = 0x3F803F80u;
    }
    u32x4 creg[5];
    {
      const bf16_t* cs0 = Cst + (size_t)(u * 2) * CST_ELEMS;
#pragma unroll
      for (int i = 0; i < 4; ++i) creg[i] = *(const u32x4*)(cs0 + (tid + 512 * i) * 8);
      creg[4] = *(const u32x4*)(cs0 + 16384 + (tid & 15) * 8);
#pragma unroll
      for (int i = 0; i < 4; ++i) { const int ci = tid + 512 * i; *(LAS u32x4*)(Cb + (ci >> 4) * LROW + (ci & 15) * 8) = creg[i]; }
      if (tid < 16) *(LAS u32x4*)(Cb + 128 * LROW + tid * 8) = creg[4];
    }
    __syncthreads();
    {
      const bf16_t* cs1 = Cst + (size_t)(u * 2 + 1) * CST_ELEMS;
#pragma unroll
      for (int i = 0; i < 4; ++i) creg[i] = *(const u32x4*)(cs1 + (tid + 512 * i) * 8);
      creg[4] = *(const u32x4*)(cs1 + 16384 + (tid & 15) * 8);
    }
    {
      const int w = wid;
      bf16x8 Qf[4];
      { const bf16_t* qr = Z + (size_t)(T0 + 16 * w + fr) * NZ + 1536 + h * 128 + 8 * fq;
#pragma unroll
        for (int ks = 0; ks < 4; ++ks) Qf[ks] = *(const bf16x8*)(qr + 32 * ks); }
      f32x4 hsum[8];
#pragma unroll
      for (int vt = 0; vt < 8; ++vt) hsum[vt] = (f32x4){0.f, 0.f, 0.f, 0.f};
      LAS bf16_t* Sw = Sb + w * 16 * LROW;
#pragma unroll
      for (int d = 0; d < 2; ++d) {
        if (d == 1) {
          __syncthreads();
#pragma unroll
          for (int i = 0; i < 4; ++i) { const int ci = tid + 512 * i; *(LAS u32x4*)(Cb + (ci >> 4) * LROW + (ci & 15) * 8) = creg[i]; }
          if (tid < 16) *(LAS u32x4*)(Cb + 128 * LROW + tid * 8) = creg[4];
          __syncthreads();
        }
        const int lo = d ? w : 0, hi = d ? 7 : w;
        const int ks_lo = lo >> 1, ks_hi = hi >> 1;
        float er4[4];
#pragma unroll
        for (int j = 0; j < 4; ++j) er4[j] = erA[d * 128 + 16 * w + 4 * fq + j];
#pragma unroll
        for (int nt = 0; nt < 8; ++nt) {
          if (nt >= 2 * ks_lo && nt <= 2 * ks_hi + 1) {
            f32x4 a = (f32x4){0.f, 0.f, 0.f, 0.f};
            if (nt >= lo && nt <= hi) {
#pragma unroll
              for (int ks = 0; ks < 4; ++ks) { const bf16x8 Kf = *(const LAS bf16x8*)(Ks + (16 * nt + fr) * LROW + 32 * ks + 8 * fq); a = __builtin_amdgcn_mfma_f32_16x16x32_bf16(Qf[ks], Kf, a, 0, 0, 0); }
              const float ecv = ecA[d * 128 + 16 * nt + fr];
#pragma unroll
              for (int j = 0; j < 4; ++j) {
                float val = a[j] * er4[j] * ecv;
                if (nt == w) { const int tl = 4 * fq + j; const bool ok = d ? (fr >= tl) : (fr <= tl); val = ok ? val : 0.f; }
                a[j] = val;
              }
            }
#pragma unroll
            for (int j = 0; j < 4; ++j) { const float nb = dppf<0x12F>(a[j]); if ((fr & 1) == 0) *(LAS unsigned*)(Sw + (4 * fq + j) * LROW + 16 * nt + fr) = cvt_pk_bf16_c(a[j], nb); }
          }
        }
        asm volatile("s_waitcnt lgkmcnt(0)" ::: "memory");
        f32x4 ao[9];
#pragma unroll
        for (int vt = 0; vt < 9; ++vt) ao[vt] = (f32x4){0.f, 0.f, 0.f, 0.f};
        const bf16x8 zf = (bf16x8){0, 0, 0, 0, 0, 0, 0, 0};
#pragma unroll
        for (int ks = 0; ks < 4; ++ks) {
          if (ks >= ks_lo && ks <= ks_hi) {
            const bf16x8 Sf = *(const LAS bf16x8*)(Sw + fr * LROW + 32 * ks + 8 * fq);
#pragma unroll
            for (int vt = 0; vt < 9; ++vt) {
              bf16x8 Vf = *(const LAS bf16x8*)(VT + (vt < 8 ? 16 * vt + fr : 128) * LROW + 32 * ks + 8 * fq);
              if (vt == 8 && fr != 0) Vf = zf;
              ao[vt] = __builtin_amdgcn_mfma_f32_16x16x32_bf16(Sf, Vf, ao[vt], 0, 0, 0);
            }
          }
        }
        {
          const float wv = wiA[d * 128 + 16 * w + fr];
#pragma unroll
          for (int ks = 0; ks < 4; ++ks) {
            const bf16x8 Qs = scale_frag(Qf[ks], wv);
#pragma unroll
            for (int vt = 0; vt < 9; ++vt) {
              bf16x8 Cf = *(const LAS bf16x8*)(Cb + (vt < 8 ? 16 * vt + fr : 128) * LROW + 32 * ks + 8 * fq);
              if (vt == 8 && fr != 0) Cf = zf;
              ao[vt] = __builtin_amdgcn_mfma_f32_16x16x32_bf16(Qs, Cf, ao[vt], 0, 0, 0);
            }
          }
        }
#pragma unroll
        for (int j = 0; j < 4; ++j) {
          const float den = __shfl(ao[8][j], lane & 48);
          const float fl = flA[d * 128 + 16 * w + 4 * fq + j];
          const float inv = 1.0f / fmaxf(fabsf(den), fl);
#pragma unroll
          for (int vt = 0; vt < 8; ++vt) hsum[vt][j] += ao[vt][j] * inv;
        }
        asm volatile("" ::: "memory");
      }
#pragma unroll
      for (int j = 0; j < 4; ++j) {
        float ms = 0.f;
#pragma unroll
        for (int vt = 0; vt < 8; ++vt) ms += hsum[vt][j] * hsum[vt][j];
        ms += __shfl_xor(ms, 1); ms += __shfl_xor(ms, 2); ms += __shfl_xor(ms, 4); ms += __shfl_xor(ms, 8);
        const float r = rsqrtf(ms * (1.0f / 128.0f) + EPS);
        const int T = T0 + 16 * w + 4 * fq + j;
#pragma unroll
        for (int vt = 0; vt < 8; ++vt) {
          const int col = h * 128 + 16 * vt + fr;
          const float og = bf2f(Z[(size_t)T * NZ + 3072 + col]);
          const float val = hsum[vt][j] * r * P.mh_norm[col] * fast_sigmoid(og);
          ucat[(size_t)T * DM + 512 + col] = f2bf_c(val);
        }
      }
    }
    __syncthreads();
  }
}

__device__ void phase7(const Params& P) {
  const int tid7 = opaque_tid(); const int wid = tid7 >> 6, lane = tid7 & 63;
  const float* rss2 = (const float*)(P.ws + WS_RSS2);
  f32x4 fn[4];
#pragma unroll
  for (int i = 0; i < 4; ++i) fn[i] = *(const f32x4*)(P.final_norm + i * 256 + lane * 4);
  const int stride = gridDim.x * 8;
  for (int T0 = blockIdx.x * 8 + wid; T0 < 16384; T0 += 5 * stride) {
    f32x4 v[5][4]; float r[5];
#pragma unroll
    for (int q = 0; q < 5; ++q) {
      int T = T0 + q * stride; T = T < 16384 ? T : 16383;
      r[q] = rss2[T];
#pragma unroll
      for (int i = 0; i < 4; ++i) v[q][i] = *(const f32x4*)(P.out + (size_t)T * DM + i * 256 + lane * 4);
    }
#pragma unroll
    for (int q = 0; q < 5; ++q) {
      const int T = T0 + q * stride;
      if (T < 16384) {
        const float rr = rsqrtf(r[q] * (1.0f / 1024.0f) + EPS);
#pragma unroll
        for (int i = 0; i < 4; ++i) *(f32x4*)(P.out + (size_t)T * DM + i * 256 + lane * 4) = v[q][i] * rr * fn[i];
      }
    }
  }
  {
    const float* part = (const float*)(P.ws + WS_H);
    for (int T = 16384 + blockIdx.x * 8 + wid; T < NTOK; T += stride) {
      f32x4 v[4], a1[4], a2[4], a3[4];
      const size_t ro = (size_t)(T - 16384) * DM;
#pragma unroll
      for (int i = 0; i < 4; ++i) { const int c = i * 256 + lane * 4;
        v[i] = *(const f32x4*)(P.out + (size_t)T * DM + c); a1[i] = *(const f32x4*)(part + ro + c);
        a2[i] = *(const f32x4*)(part + (size_t)4096 * DM + ro + c); a3[i] = *(const f32x4*)(part + (size_t)8192 * DM + ro + c); }
      float ss = 0.f;
#pragma unroll
      for (int i = 0; i < 4; ++i) { v[i] = v[i] + a1[i] + a2[i] + a3[i]; ss += v[i][0] * v[i][0] + v[i][1] * v[i][1] + v[i][2] * v[i][2] + v[i][3] * v[i][3]; }
#pragma unroll
      for (int o = 1; o < 64; o <<= 1) ss += __shfl_xor(ss, o);
      const float rr = rsqrtf(ss * (1.0f / 1024.0f) + EPS);
#pragma unroll
      for (int i = 0; i < 4; ++i) *(f32x4*)(P.out + (size_t)T * DM + i * 256 + lane * 4) = v[i] * rr * fn[i];
    }
  }
}


#define XB_TMO      128
#define XB_XCNT(j)  (256  + 64 * (j))
#define XB_XSUB(j)  (1280 + 64 * (j))
#define XB_XGEN(j)  (2304 + 64 * (j))
#define XB_TOP      3328
#define XB_TOPGEN   3392
#define XCD_BAR_WORDS 3456
#define XB_SPIN_CAP (1u << 18)
__device__ __forceinline__ unsigned xb_ld(unsigned* p)              { return __hip_atomic_load(p, __ATOMIC_RELAXED, __HIP_MEMORY_SCOPE_AGENT); }
__device__ __forceinline__ unsigned xb_add(unsigned* p, unsigned v) { return __hip_atomic_fetch_add(p, v, __ATOMIC_RELAXED, __HIP_MEMORY_SCOPE_AGENT); }
__device__ __forceinline__ unsigned xb_xcc_id() { return (unsigned)__builtin_amdgcn_s_getreg((3 << 11) | 20) & 0xFu; }
#define XB_SPIN(cond, bar) do { unsigned _sp = 0; while (cond) { __builtin_amdgcn_s_sleep(1); \
    if ((++_sp & 255u) == 0u) { if (xb_ld(&(bar)[XB_TMO])) break; if (_sp > XB_SPIN_CAP) { atomicAdd(&(bar)[XB_TMO], 1u); break; } } } } while (0)
struct XcdBarrier { unsigned* bar; unsigned x; volatile LAS unsigned* st; };
__device__ __forceinline__ XcdBarrier xcd_barrier_post(unsigned* bar, volatile LAS unsigned* st) {
  XcdBarrier b; b.bar = bar; b.x = xb_xcc_id(); b.st = st;
  if (threadIdx.x == 0) (void)xb_add(&bar[XB_XCNT(b.x)], 1u);
  return b;
}
__device__ __forceinline__ void xcd_barrier_complete(unsigned* bar, unsigned x, unsigned& nloc, unsigned& nx) {
  const unsigned G = gridDim.x * gridDim.y * gridDim.z;
  unsigned sum, cnt, mine, sp = 0u;
  for (;;) {
    sum = 0u; cnt = 0u; mine = 0u;
#pragma unroll
    for (unsigned j = 0; j < 16; ++j) { const unsigned c = xb_ld(&bar[XB_XCNT(j)]); sum += c; cnt += (c > 0u) ? 1u : 0u; mine = (j == x) ? c : mine; }
    if (sum == G) break;
    __builtin_amdgcn_s_sleep(1);
    if ((++sp & 255u) == 0u) { if (xb_ld(&bar[XB_TMO])) break; if (sp > XB_SPIN_CAP) { atomicAdd(&bar[XB_TMO], 1u); break; } }
  }
  nloc = mine > 0u ? mine : 1u; nx = cnt > 0u ? cnt : 1u;
}
__device__ __forceinline__ void xcd_barrier(const XcdBarrier& b) {
  asm volatile("s_waitcnt vmcnt(0) lgkmcnt(0)" ::: "memory");
  __syncthreads();
  if (threadIdx.x == 0) {
    unsigned* bar = b.bar;
    __builtin_amdgcn_s_waitcnt(0);
    unsigned nloc = b.st[0], nx = b.st[1];
    if (nloc == 0u) { xcd_barrier_complete(bar, b.x, nloc, nx); b.st[0] = nloc; b.st[1] = nx; }
    const unsigned old = xb_add(&bar[XB_XSUB(b.x)], 1u);
    const unsigned gen = old / nloc;
    if (old + 1u == (gen + 1u) * nloc) {
      __builtin_amdgcn_fence(__ATOMIC_RELEASE, "agent");
      asm volatile("s_waitcnt vmcnt(0)" ::: "memory");
      const unsigned og = xb_add(&bar[XB_TOP], 1u);
      const unsigned tg = og / nx;
      if (og + 1u == (tg + 1u) * nx) xb_add(&bar[XB_TOPGEN], 1u);
      else XB_SPIN(xb_ld(&bar[XB_TOPGEN]) == tg, bar);
      __builtin_amdgcn_fence(__ATOMIC_ACQUIRE, "agent");
      xb_add(&bar[XB_XGEN(b.x)], 1u);
      asm volatile("s_waitcnt vmcnt(0)" ::: "memory");
    } else {
      XB_SPIN(xb_ld(&bar[XB_XGEN(b.x)]) == gen, bar);
      __builtin_amdgcn_fence(__ATOMIC_ACQUIRE, "agent");
      asm volatile("s_waitcnt vmcnt(0)" ::: "memory");
    }
  }
  __syncthreads();
}

#define GSYNC() xcd_barrier(xb)
__global__ void __launch_bounds__(512, 2) fwd_megakernel(Params P) {
  extern __shared__ __attribute__((aligned(16))) unsigned char shm[];
  cg::grid_group grid = cg::this_grid();
  LAS unsigned char* lds = (LAS unsigned char*)shm;
  float* smf = (float*)shm;
  if (P.ws == nullptr) grid.sync();
  volatile LAS unsigned* xst = (volatile LAS unsigned*)(lds + (LDS_BYTES - 16));
  if (threadIdx.x == 0) { xst[0] = 0u; xst[1] = 0u; }
  __syncthreads();
  const XcdBarrier xb = xcd_barrier_post((unsigned*)(P.ws + WS_BAR), xst);
#define RUN_P2() { EpiZ E; E.Z = (bf16_t*)(P.ws + WS_Z); \
    gemm_phase<EpiZ>(lds, (const bf16_t*)(P.ws + WS_H), (const bf16_t*)(P.ws + WS_WIN), NTOK, NZ, DM, E); } GSYNC();
#define RUN_M() phaseM1(P, lds); GSYNC(); phaseM2(P, smf); GSYNC(); phaseM3(P, lds); shortconv_items(P); GSYNC();
#define RUN_P5() { EpiUp E; E.rowss1 = (const float*)(P.ws + WS_RSS1); E.sb = (const float*)(P.ws + WS_SB); E.cw = P.conv_ffn_w; E.cb = P.conv_ffn_b; E.act = (bf16_t*)(P.ws + WS_Z); \
    gemm_phase<EpiUp>(lds, (const bf16_t*)(P.ws + WS_H), (const bf16_t*)(P.ws + WS_WUP), NTOK, NUP, DM, E); } GSYNC();
  phase0a(P, smf);
  GSYNC();
  phase0b(P, smf);
  GSYNC();
  RUN_P2()
#if DUP == 2
  RUN_P2()
#endif
#if DUP == 21
  { EpiNone E; E.Z = (bf16_t*)(P.ws + WS_UCAT);
    gemm_phase<EpiNone>(lds, (const bf16_t*)(P.ws + WS_H), (const bf16_t*)(P.ws + WS_WIN), NTOK, NZ, DM, E); } GSYNC();
#endif
  RUN_M()
#if DUP == 3
  RUN_M()
#endif
#if DUP == 31
  phaseM1(P, lds); GSYNC();
#endif
#if DUP == 32
  phaseM2(P, smf); GSYNC();
#endif
#if DUP == 33
  phaseM3(P, lds); GSYNC();
#endif
#if DUP == 34
  shortconv_items(P); GSYNC();
#endif
#if DUP == 6
  RUN_P5()
#endif
  { EpiX1 E; E.xp = P.x_prompt; E.xs = P.x_sample; E.mod = (const float*)(P.ws + WS_MOD); E.norm2 = P.norm2; E.x1out = P.out; E.x1g = (bf16_t*)(P.ws + WS_H); E.rowss = (float*)(P.ws + WS_RSS1);
    gemm_phase<EpiX1>(lds, (const bf16_t*)(P.ws + WS_UCAT), (const bf16_t*)(P.ws + WS_WOUT), NTOK, DM, DM, E); }
  GSYNC();
  RUN_P5()
#if DUP == 5
  RUN_P5()
#endif
  { EpiDown E; E.mod = (const float*)(P.ws + WS_MOD); E.out = P.out; E.rowss2 = (float*)(P.ws + WS_RSS2);
    gemm_phase<EpiDown>(lds, (const bf16_t*)(P.ws + WS_Z), (const bf16_t*)(P.ws + WS_WDN), 16384, DM, DFF, E); }
  { EpiDownPart E; E.mod = (const float*)(P.ws + WS_MOD); E.out = P.out; E.part = (float*)(P.ws + WS_H);
    gemm_phase<EpiDownPart, 4>(lds, (const bf16_t*)(P.ws + WS_Z), (const bf16_t*)(P.ws + WS_WDN), NTOK, DM, DFF, E); }
  GSYNC();
  phase7(P);
}

extern "C" void kernel_launch(void* const* d_in, const int* in_sizes, int n_in, void* d_out, int out_size, void* d_ws, size_t ws_size, hipStream_t stream) {
  static int grid_blocks = 0;
  if (!grid_blocks) {
    int dev = 0, cus = 0, per_cu = 0;
    hipGetDevice(&dev);
    hipDeviceGetAttribute(&cus, hipDeviceAttributeMultiprocessorCount, dev);
    hipFuncSetAttribute((const void*)fwd_megakernel, hipFuncAttributeMaxDynamicSharedMemorySize, LDS_BYTES);
    hipOccupancyMaxActiveBlocksPerMultiprocessor(&per_cu, (const void*)fwd_megakernel, 512, LDS_BYTES);
    (void)hipGetLastError();
    if (per_cu < 1) per_cu = 1;
    if (per_cu > 1) per_cu = 1;
    grid_blocks = cus * per_cu;
  }
  hipMemsetAsync(d_ws, 0, WS_ZERO_BYTES, stream);
  Params p{};
  const float** pp = (const float**)&p;
  for (int i = 0; i < 22; ++i) pp[i] = (const float*)d_in[i];
  p.out = (float*)d_out; p.ws = (unsigned char*)d_ws;
  void* args[] = {&p};
  hipError_t e = hipLaunchCooperativeKernel((const void*)fwd_megakernel, dim3(grid_blocks), dim3(512), args, LDS_BYTES, stream);
  if (e != hipSuccess) fprintf(stderr, "cooperative launch failed: %s (grid %d)\n", hipGetErrorString(e), grid_blocks);
}
```

```cpp
#include <hip/hip_runtime.h>
#include <hip/hip_cooperative_groups.h>
#include <cstdio>
namespace cg = cooperative_groups;

#ifndef DUP
#define DUP 0
#endif
#define LAS __attribute__((address_space(3)))
typedef unsigned short bf16_t;
typedef short bf16x8 __attribute__((ext_vector_type(8)));
typedef float f32x4 __attribute__((ext_vector_type(4)));
typedef unsigned u32x2 __attribute__((ext_vector_type(2)));
typedef unsigned u32x4 __attribute__((ext_vector_type(4)));

constexpr int DM = 1024, NTOK = 20480, NCTXT = 4096, DIN = 3600, NZ = 3584, DFF = 2816, NUP = 5632, NMOD = 6144;
constexpr float EPS = 1e-6f;
constexpr size_t WS_MOD = 0, WS_SB = 122880, WS_RSS1 = 235520, WS_RSS2 = 317440, WS_BAR = 399360, WS_ZERO_BYTES = 415744;
constexpr size_t WS_GATES = 415744, WS_STAT = 1726464, WS_MST = 1736704;
constexpr size_t WS_WIN = 2097152, WS_WOUT = 9437184, WS_WUP = 11534336, WS_WDN = 23068672;
constexpr size_t WS_H = 28835840;
constexpr size_t WS_UCAT = 71106560;
constexpr size_t WS_Z = 113049600;
constexpr int OUT_TAIL = 20971520;
constexpr int LDS_BYTES = 146432;

struct Params {
  const float *x_prompt, *x_sample, *state_C, *state_n, *state_m, *c, *c_ctx, *w_mod, *b_mod, *norm1, *w_in, *b_gate,
      *conv_sc_w, *conv_sc_b, *mh_norm, *w_out, *norm2, *w_up, *conv_ffn_w, *conv_ffn_b, *w_down, *final_norm;
  float* out; unsigned char* ws;
};

typedef __bf16 bf16x2_n __attribute__((ext_vector_type(2)));
typedef float f32x2_n __attribute__((ext_vector_type(2)));
__device__ __forceinline__ unsigned cvt_pk_bf16_c(float lo, float hi) { const f32x2_n v = {lo, hi}; return __builtin_bit_cast(unsigned, __builtin_convertvector(v, bf16x2_n)); }
__device__ __forceinline__ unsigned cvt_pk_bf16(float lo, float hi) { unsigned r; asm("v_cvt_pk_bf16_f32 %0, %1, %2" : "=v"(r) : "v"(lo), "v"(hi)); return r; }
__device__ __forceinline__ bf16_t f2bf_c(float f) { return (bf16_t)(cvt_pk_bf16_c(f, 0.f) & 0xffffu); }
__device__ __forceinline__ bf16_t f2bf(float f) { return (bf16_t)(cvt_pk_bf16(f, 0.f) & 0xffffu); }
__device__ __forceinline__ float bf2f(bf16_t b) { return __uint_as_float(((unsigned)b) << 16); }
__device__ __forceinline__ float bflo(unsigned u) { return __uint_as_float(u << 16); }
__device__ __forceinline__ float bfhi(unsigned u) { return __uint_as_float(u & 0xffff0000u); }
__device__ __forceinline__ int permtok(int T) { if (T < NCTXT) return T; const int q = T - NCTXT; return NCTXT + (q & ~4095) + ((q & 63) << 6) + ((q >> 6) & 63); }
template <int CTRL> __device__ __forceinline__ float dppf(float x) { return __builtin_bit_cast(float, __builtin_amdgcn_mov_dpp(__builtin_bit_cast(int, x), CTRL, 0xf, 0xf, true)); }
__device__ __forceinline__ float fast_sigmoid(float x) { return __builtin_amdgcn_rcpf(1.0f + __expf(-x)); }

__device__ __forceinline__ int opaque_tid() { int t = threadIdx.x; asm volatile("" : "+v"(t)); return t; }

constexpr int BM = 256, BK = 64, HALF = 128, HTB = HALF * BK * 2, NXCD = 8, WGM = 8;
__device__ __forceinline__ int lds_byte(int r, int c) { const int st = (r >> 4) * 2 + (c >> 5), rr = r & 15, cc = c & 31, ob = rr * 64 + cc * 2; return st * 1024 + (ob ^ (((ob >> 9) & 1) << 5)); }
__device__ __forceinline__ void stage_rc(int b, int& R, int& C) { const int st = b / 1024, sb = b % 1024, swz = sb ^ (((sb >> 9) & 1) << 5); R = (st >> 1) * 16 + swz / 64; C = (st & 1) * 32 + (swz % 64) / 2; }

struct Order {
  int nM, nN, nwg, G, c;
  __device__ __forceinline__ void init(int M, int N) { nM = M / BM; nN = N / BM; nwg = nM * nN; G = gridDim.x; c = blockIdx.x; }
  template <int MODE> __device__ __forceinline__ bool next_m(int i, int& pm, int& pn, int& kb, int& ntu, int nt_full) const {
    if (MODE == 0) { kb = 0; ntu = nt_full; return next(i, pm, pn); }
    const long L = (long)i * G + c; if (L >= 256) return false;
    const int x = (int)L & 7, j = (int)L >> 3, kq = j & 3;
    pm = 64 + 2 * x + (j >> 4); pn = ((j >> 2) & 3) | (kq << 8);
    kb = kq < 2 ? 12 * kq : 24 + 10 * (kq - 2); ntu = kq < 2 ? 12 : 10; return true;
  }
  __device__ __forceinline__ bool next(int i, int& pm, int& pn) const {
    const long L = (long)i * G + c; if (L >= nwg) return false;
    int wgid = (int)L; { const int q = nwg / NXCD, r = nwg % NXCD, xcd = wgid % NXCD, off = wgid / NXCD; wgid = (xcd < r ? xcd * (q + 1) : r * (q + 1) + (xcd - r) * q) + off; }
    const int nig = WGM * nN, gid = wgid / nig, fm = gid * WGM, gsz = (nM - fm) < WGM ? (nM - fm) : WGM;
    pm = fm + ((wgid % nig) % gsz); pn = (wgid % nig) / gsz; return true;
  }
};

template <class Epi, int MODE = 0>
__device__ __forceinline__ void gemm_phase(LAS unsigned char* lds, const bf16_t* gA, const bf16_t* gBt, int M, int N, int K, const Epi& E) {
  const int tid = opaque_tid(), wid = __builtin_amdgcn_readfirstlane(tid >> 6), lane = tid & 63, wr = wid >> 2, wc = wid & 3, fr = lane & 15, fq = lane >> 4;
  const int nt = K / BK;
  Order S; S.init(M, N);
  unsigned voffA[2];
#pragma unroll
  for (int i = 0; i < 2; ++i) { int R, C; stage_rc(tid * 16 + i * 8192, R, C); voffA[i] = (unsigned)(R * K + C) * 2u; }
  const size_t kstep = (size_t)(BK * 2);
  const size_t hstep = (size_t)HALF * K * 2;
  const size_t tstep = 2 * hstep;
  const unsigned ldsw = (unsigned)wid * 1024u;
  const int aoff = lds_byte(wr * 64 + fr, fq * 8), boff = lds_byte(wc * 32 + fr, fq * 8);
#define G_SA(b, h) (((b) * 2 + (h)) * HTB)
#define G_SB(b, h) ((4 + (b) * 2 + (h)) * HTB)
#define G_STAGE(bufoff, gbase) do { _Pragma("unroll") for (int _i = 0; _i < 2; ++_i) \
    __builtin_amdgcn_global_load_lds((const unsigned*)((const char*)(gbase) + voffA[_i]), (LAS unsigned*)(lds + (bufoff) + ldsw + _i * 8192), 16, 0, 0); } while (0)
#define G_LDA(dst, b, h) do { _Pragma("unroll") for (int m = 0; m < 4; ++m) _Pragma("unroll") for (int k = 0; k < 2; ++k) dst[m][k] = *(const LAS bf16x8*)(lds + G_SA(b, h) + aoff + m * 2048 + k * 1024); } while (0)
#define G_LDB(dst, b, h) do { _Pragma("unroll") for (int n = 0; n < 2; ++n) _Pragma("unroll") for (int k = 0; k < 2; ++k) dst[n][k] = *(const LAS bf16x8*)(lds + G_SB(b, h) + boff + n * 2048 + k * 1024); } while (0)
#define G_MMA(ai, bj, At, Bt) do { __builtin_amdgcn_s_setprio(1); _Pragma("unroll") for (int m = 0; m < 4; ++m) _Pragma("unroll") for (int n = 0; n < 2; ++n) _Pragma("unroll") for (int k = 0; k < 2; ++k) \
    acc[ai][bj][m][n] = __builtin_amdgcn_mfma_f32_16x16x32_bf16(Bt[n][k], At[m][k], acc[ai][bj][m][n], 0, 0, 0); __builtin_amdgcn_s_setprio(0); } while (0)
#define G_WAIT_V(n) asm volatile("s_waitcnt vmcnt(" #n ")" ::: "memory")
#define G_WAIT_L(n) asm volatile("s_waitcnt lgkmcnt(" #n ")" ::: "memory")
#define G_BAR __builtin_amdgcn_s_barrier()
#define G_SCHED __builtin_amdgcn_sched_barrier(0)
  int cpm, cpn, npm = 0, npn = 0, ui = 0, ckb = 0, cnt = nt, nkb = 0, nnt = nt;
  if (!S.template next_m<MODE>(0, cpm, cpn, ckb, cnt, nt)) return;
  f32x4 acc[2][2][4][2];
#pragma unroll
  for (int a = 0; a < 2; ++a)
#pragma unroll
    for (int b = 0; b < 2; ++b)
#pragma unroll
      for (int m = 0; m < 4; ++m)
#pragma unroll
        for (int n = 0; n < 2; ++n) acc[a][b][m][n] = (f32x4){0.f, 0.f, 0.f, 0.f};
  bf16x8 At[4][2], B0[2][2], B1[2][2];
  const char* cA = (const char*)gA + (size_t)cpm * tstep + (size_t)ckb * kstep; const char* cB = (const char*)gBt + (size_t)(cpn & 255) * tstep + (size_t)ckb * kstep;
  G_STAGE(G_SB(0, 0), cB); G_STAGE(G_SA(0, 0), cA); G_STAGE(G_SB(0, 1), cB + hstep); G_STAGE(G_SA(0, 1), cA + hstep);
  if (wr == 1) G_BAR;
  G_WAIT_V(4); G_BAR;
  G_STAGE(G_SB(1, 0), cB + kstep); G_STAGE(G_SA(1, 0), cA + kstep); G_STAGE(G_SB(1, 1), cB + hstep + kstep);
  G_WAIT_V(6); G_BAR;
  for (;;) {
    const bool has_next = S.template next_m<MODE>(ui + 1, npm, npn, nkb, nnt, nt);
    const char* nA = has_next ? (const char*)gA + (size_t)npm * tstep + (size_t)nkb * kstep : cA; const char* nB = has_next ? (const char*)gBt + (size_t)(npn & 255) * tstep + (size_t)nkb * kstep : cB;
    for (int t = 0; t < cnt; t += 2) {
      const bool last = (t == cnt - 2);
      const char* a1 = cA + (size_t)(t + 1) * kstep;
      const char* a2 = last ? nA : cA + (size_t)(t + 2) * kstep; const char* b2 = last ? nB : cB + (size_t)(t + 2) * kstep;
      const char* a3 = a2 + kstep; const char* b3 = b2 + kstep;
      G_LDB(B0, 0, 0); G_SCHED; G_LDA(At, 0, 0); G_STAGE(G_SA(1, 1), a1 + hstep);
      G_WAIT_L(8); G_BAR; G_WAIT_L(0); G_MMA(0, 0, At, B0); G_BAR; G_SCHED;
      G_LDB(B1, 0, 1); G_STAGE(G_SB(0, 0), b2);
      G_BAR; G_WAIT_L(0); G_MMA(0, 1, At, B1); G_BAR;
      G_LDA(At, 0, 1); G_STAGE(G_SA(0, 0), a2);
      G_BAR; G_WAIT_L(0); G_MMA(1, 0, At, B0); G_BAR; G_SCHED;
      G_STAGE(G_SB(0, 1), b2 + hstep);
      G_WAIT_V(6); G_BAR; G_MMA(1, 1, At, B1); G_BAR;
      G_LDB(B0, 1, 0); G_SCHED; G_LDA(At, 1, 0); G_STAGE(G_SA(0, 1), a2 + hstep);
      G_WAIT_L(8); G_BAR; G_WAIT_L(0); G_MMA(0, 0, At, B0); G_BAR; G_SCHED;
      G_LDB(B1, 1, 1); G_STAGE(G_SB(1, 0), b3);
      G_BAR; G_WAIT_L(0); G_MMA(0, 1, At, B1); G_BAR;
      G_LDA(At, 1, 1); G_STAGE(G_SA(1, 0), a3);
      G_BAR; G_WAIT_L(0); G_MMA(1, 0, At, B0); G_BAR; G_SCHED;
      G_STAGE(G_SB(1, 1), b3 + hstep);
      G_WAIT_V(6); G_BAR; G_MMA(1, 1, At, B1); G_BAR;
    }
    asm volatile("s_nop 15\n\ts_nop 15" ::: "memory");
    E(acc, cpm, cpn, wr, wc, fr, fq, lds);
    if (!has_next) break;
#pragma unroll
    for (int a = 0; a < 2; ++a)
#pragma unroll
      for (int b = 0; b < 2; ++b)
#pragma unroll
        for (int m = 0; m < 4; ++m)
#pragma unroll
          for (int n = 0; n < 2; ++n) acc[a][b][m][n] = (f32x4){0.f, 0.f, 0.f, 0.f};
    cpm = npm; cpn = npn; cA = nA; cB = nB; cnt = nnt; ++ui;
  }
  G_WAIT_V(0);
  if (wr == 0) G_BAR;
  G_BAR;
}

struct EpiZ {
  bf16_t* Z;
  __device__ __forceinline__ void operator()(f32x4 (&acc)[2][2][4][2], int pm, int pn, int wr, int wc, int fr, int fq, LAS unsigned char*) const {
    const int row0 = pm * BM + wr * 64 + fr, col0 = pn * BM + wc * 32 + 8 * fq;
#pragma unroll
    for (int ai = 0; ai < 2; ++ai)
#pragma unroll
      for (int m = 0; m < 4; ++m) {
        bf16_t* rowp = Z + (size_t)(row0 + ai * HALF + m * 16) * NZ + col0;
#pragma unroll
        for (int bj = 0; bj < 2; ++bj) { const f32x4 v0 = acc[ai][bj][m][0], v1 = acc[ai][bj][m][1];
          u32x4 o; o.x = cvt_pk_bf16(v0[0], v0[1]); o.y = cvt_pk_bf16(v0[2], v0[3]); o.z = cvt_pk_bf16(v1[0], v1[1]); o.w = cvt_pk_bf16(v1[2], v1[3]);
          *(u32x4*)(rowp + bj * HALF) = o; }
      }
  }
};

struct EpiNone {
  bf16_t* Z;
  __device__ __forceinline__ void operator()(f32x4 (&acc)[2][2][4][2], int pm, int pn, int wr, int wc, int fr, int fq, LAS unsigned char*) const {
    f32x4 s = (f32x4){0.f, 0.f, 0.f, 0.f};
#pragma unroll
    for (int ai = 0; ai < 2; ++ai)
#pragma unroll
      for (int bj = 0; bj < 2; ++bj)
#pragma unroll
        for (int m = 0; m < 4; ++m)
#pragma unroll
          for (int n = 0; n < 2; ++n) s += acc[ai][bj][m][n];
    if (s[0] + s[1] + s[2] + s[3] == 12345.678f) Z[pm + pn] = 1;
  }
};

struct EpiX1 {
  const float* xp; const float* xs; const float* mod; const float* norm2; float* x1out; bf16_t* x1g; float* rowss;
  __device__ __forceinline__ void operator()(f32x4 (&acc)[2][2][4][2], int pm, int pn, int wr, int wc, int fr, int fq, LAS unsigned char*) const {
    const int g = pm < 16 ? 4 : ((pm - 16) >> 4);
    const float* modg = mod + g * NMOD;
    const int col0 = pn * BM + wc * 32 + 4 * fq;
    f32x4 g1[2][2], g2[2][2];
#pragma unroll
    for (int bj = 0; bj < 2; ++bj)
#pragma unroll
      for (int n = 0; n < 2; ++n) { const int c = col0 + bj * HALF + n * 16; g1[bj][n] = *(const f32x4*)(modg + 2048 + c); const f32x4 s2 = *(const f32x4*)(modg + 4096 + c); const f32x4 nv = *(const f32x4*)(norm2 + c); g2[bj][n] = nv * (s2 + 1.0f); }
#pragma unroll
    for (int ai = 0; ai < 2; ++ai)
#pragma unroll
      for (int m = 0; m < 4; ++m) {
        const int T = pm * BM + ai * HALF + wr * 64 + m * 16 + fr;
        const float* xrow = (T < NCTXT) ? xp + (size_t)T * DM : xs + (size_t)(T - NCTXT) * DM;
        const int p = permtok(T);
        float ss = 0.f;
#pragma unroll
        for (int bj = 0; bj < 2; ++bj)
#pragma unroll
          for (int n = 0; n < 2; ++n) {
            const int c = col0 + bj * HALF + n * 16;
            const f32x4 xv = *(const f32x4*)(xrow + c);
            const f32x4 v = xv + g1[bj][n] * acc[ai][bj][m][n];
            *(f32x4*)(x1out + (size_t)T * DM + c) = v;
            ss += v[0] * v[0] + v[1] * v[1] + v[2] * v[2] + v[3] * v[3];
            const f32x4 w = v * g2[bj][n];
            u32x2 o; o.x = cvt_pk_bf16(w[0], w[1]); o.y = cvt_pk_bf16(w[2], w[3]);
            *(u32x2*)(x1g + (size_t)p * DM + c) = o;
          }
        ss += __shfl_xor(ss, 16); ss += __shfl_xor(ss, 32);
        if (fq == 0) __hip_atomic_fetch_add(rowss + p, ss, __ATOMIC_RELAXED, __HIP_MEMORY_SCOPE_AGENT);
      }
  }
};

struct EpiDown {
  const float* mod; float* out; float* rowss2;
  __device__ __forceinline__ void operator()(f32x4 (&acc)[2][2][4][2], int pm, int pn, int wr, int wc, int fr, int fq, LAS unsigned char*) const {
    const int g = pm < 16 ? 4 : ((pm - 16) >> 4);
    const float* modg = mod + g * NMOD;
    const int col0 = pn * BM + wc * 32 + 4 * fq;
    f32x4 g2[2][2];
#pragma unroll
    for (int bj = 0; bj < 2; ++bj)
#pragma unroll
      for (int n = 0; n < 2; ++n) g2[bj][n] = *(const f32x4*)(modg + 5120 + col0 + bj * HALF + n * 16);
#pragma unroll
    for (int ai = 0; ai < 2; ++ai)
#pragma unroll
      for (int m = 0; m < 4; ++m) {
        const int p = pm * BM + ai * HALF + wr * 64 + m * 16 + fr;
        const int T = permtok(p);
        float* orow = out + (size_t)T * DM;
        float ss = 0.f;
#pragma unroll
        for (int bj = 0; bj < 2; ++bj)
#pragma unroll
          for (int n = 0; n < 2; ++n) {
            const int c = col0 + bj * HALF + n * 16;
            const f32x4 xv = *(const f32x4*)(orow + c);
            const f32x4 v = xv + g2[bj][n] * acc[ai][bj][m][n];
            *(f32x4*)(orow + c) = v;
            ss += v[0] * v[0] + v[1] * v[1] + v[2] * v[2] + v[3] * v[3];
          }
        ss += __shfl_xor(ss, 16); ss += __shfl_xor(ss, 32);
        if (fq == 0) __hip_atomic_fetch_add(rowss2 + T, ss, __ATOMIC_RELAXED, __HIP_MEMORY_SCOPE_AGENT);
      }
  }
};

struct EpiDownPart {
  const float* mod; float* out; float* part;
  __device__ __forceinline__ void operator()(f32x4 (&acc)[2][2][4][2], int pm, int pnk, int wr, int wc, int fr, int fq, LAS unsigned char*) const {
    const int pn = pnk & 255, kq = pnk >> 8;
    const int g = pm < 16 ? 4 : ((pm - 16) >> 4);
    const float* modg = mod + g * NMOD;
    const int col0 = pn * BM + wc * 32 + 4 * fq;
    f32x4 g2[2][2];
#pragma unroll
    for (int bj = 0; bj < 2; ++bj)
#pragma unroll
      for (int n = 0; n < 2; ++n) g2[bj][n] = *(const f32x4*)(modg + 5120 + col0 + bj * HALF + n * 16);
#pragma unroll
    for (int ai = 0; ai < 2; ++ai)
#pragma unroll
      for (int m = 0; m < 4; ++m) {
        const int p = pm * BM + ai * HALF + wr * 64 + m * 16 + fr;
        const int T = permtok(p);
        if (kq == 0) {
          float* orow = out + (size_t)T * DM;
#pragma unroll
          for (int bj = 0; bj < 2; ++bj)
#pragma unroll
            for (int n = 0; n < 2; ++n) { const int c = col0 + bj * HALF + n * 16; const f32x4 xv = *(const f32x4*)(orow + c); *(f32x4*)(orow + c) = xv + g2[bj][n] * acc[ai][bj][m][n]; }
        } else {
          float* prow = part + ((size_t)(kq - 1) * 4096 + (T - 16384)) * DM;
#pragma unroll
          for (int bj = 0; bj < 2; ++bj)
#pragma unroll
            for (int n = 0; n < 2; ++n) { const int c = col0 + bj * HALF + n * 16; *(f32x4*)(prow + c) = g2[bj][n] * acc[ai][bj][m][n]; }
        }
      }
  }
};

struct EpiUp {
  const float* rowss1; const float* sb; const float* cw; const float* cb; bf16_t* act;
  __device__ __forceinline__ void operator()(f32x4 (&acc)[2][2][4][2], int pm, int pn, int wr, int wc, int fr, int fq, LAS unsigned char* lds) const {
    asm volatile("" : "+v"(fr), "+v"(fq));
    const bool ctx = pm < 16;
    const int g = ctx ? 4 : ((pm - 16) >> 4);
    const float* sbg = sb + g * NUP;
    LAS float* halo = (LAS float*)(lds + 131072);
    const int prow0 = pm * BM + wr * 64 + fr;
    {
      float rs[2][4];
#pragma unroll
      for (int ai = 0; ai < 2; ++ai)
#pragma unroll
        for (int m = 0; m < 4; ++m) rs[ai][m] = __builtin_amdgcn_rsqf(rowss1[prow0 + ai * HALF + m * 16] * (1.0f / 1024.0f) + EPS);
#pragma unroll
      for (int bj = 0; bj < 2; ++bj)
#pragma unroll
        for (int n = 0; n < 2; ++n) {
          asm volatile("" ::: "memory"); __builtin_amdgcn_sched_barrier(0);
          const f32x4 sv = *(const f32x4*)(sbg + bj * DFF + pn * HALF + wc * 32 + 8 * fq + 4 * n);
#pragma unroll
          for (int ai = 0; ai < 2; ++ai)
#pragma unroll
            for (int m = 0; m < 4; ++m) { acc[ai][bj][m][n] = acc[ai][bj][m][n] * rs[ai][m] + sv; asm volatile("" : "+v"(acc[ai][bj][m][n])); }
        }
    }
    if (ctx) {
#pragma unroll
      for (int ai = 0; ai < 2; ++ai)
#pragma unroll
        for (int bj = 0; bj < 2; ++bj)
#pragma unroll
          for (int n = 0; n < 2; ++n) {
            const int rb = 2 * ai + wr, colt = bj * HALF + wc * 32 + 8 * fq + 4 * n;
            if (fr == 0) *(LAS f32x4*)(halo + (rb * 2 + 0) * 256 + colt) = acc[ai][bj][0][n];
            if (fr == 15) *(LAS f32x4*)(halo + (rb * 2 + 1) * 256 + colt) = acc[ai][bj][3][n];
          }
      asm volatile("s_waitcnt lgkmcnt(0)" ::: "memory");
      __builtin_amdgcn_s_barrier();
      __builtin_amdgcn_s_barrier();
      asm volatile("" ::: "memory");
    }
#pragma unroll
    for (int ai = 0; ai < 2; ++ai) {
      u32x2 st[4];
#pragma unroll
      for (int n = 0; n < 2; ++n) {
        f32x4 ya[4];
        const int rb = 2 * ai + wr;
#pragma unroll
        for (int bj = 0; bj < 2; ++bj) {
          const int cnat = bj * DFF + pn * HALF + wc * 32 + 8 * fq + 4 * n, colt = bj * HALF + wc * 32 + 8 * fq + 4 * n;
          const f32x4 w0 = *(const f32x4*)(cw + cnat), w1 = *(const f32x4*)(cw + NUP + cnat), w2 = *(const f32x4*)(cw + 2 * NUP + cnat), bb = *(const f32x4*)(cb + cnat);
          f32x4 hp = (f32x4){0.f, 0.f, 0.f, 0.f}, hn = hp;
          if (ctx) {
            if (rb > 0) hp = *(const LAS f32x4*)(halo + ((rb - 1) * 2 + 1) * 256 + colt);
            if (rb < 3) hn = *(const LAS f32x4*)(halo + ((rb + 1) * 2 + 0) * 256 + colt);
          }
#pragma unroll
          for (int m = 0; m < 4; ++m) {
            const f32x4 cur = acc[ai][bj][m][n];
            f32x4 prev, next;
#pragma unroll
            for (int e = 0; e < 4; ++e) {
              if (m > 0) { const float snd = (fr == 15) ? acc[ai][bj][m > 0 ? m - 1 : 0][n][e] : cur[e]; prev[e] = dppf<0x121>(snd); }
              else { const float rcv = dppf<0x121>(cur[e]); prev[e] = (fr == 0) ? hp[e] : rcv; }
              if (m < 3) { const float snd = (fr == 0) ? acc[ai][bj][m < 3 ? m + 1 : 3][n][e] : cur[e]; next[e] = dppf<0x12F>(snd); }
              else { const float rcv = dppf<0x12F>(cur[e]); next[e] = (fr == 15) ? hn[e] : rcv; }
            }
            const f32x4 y = w0 * prev + w1 * cur + w2 * next + bb;
            if (bj == 0) ya[m] = y;
            else {
              float o[4];
#pragma unroll
              for (int e = 0; e < 4; ++e) o[e] = y[e] * fast_sigmoid(y[e]) * ya[m][e];
              u32x2 ov; ov.x = cvt_pk_bf16(o[0], o[1]); ov.y = cvt_pk_bf16(o[2], o[3]);
              if (n == 0) st[m] = ov;
              else { u32x4 o4; o4.x = st[m].x; o4.y = st[m].y; o4.z = ov.x; o4.w = ov.y;
                *(u32x4*)(act + (size_t)(prow0 + ai * HALF + m * 16) * DFF + pn * HALF + wc * 32 + 8 * fq) = o4; }
            }
          }
        }
      }
    }
  }
};

template <bool SILU>
__device__ __forceinline__ void gemv5_unit(const Params& P, int unit, int ncb, const float* W, int ldw, float* outp, int ldo, const float* bias, const float* modv, float* sm) {
  const int tid = opaque_tid();
  const int cb = unit % ncb, ks = unit / ncb, n0 = cb * 256, k0 = ks * 128;
  float* sv = sm; float* red = sm + 640;
  for (int i = tid; i < 640; i += 512) {
    const int g = i >> 7, k = k0 + (i & 127);
    float v;
    if (SILU) { v = (g < 4) ? P.c[g * DM + k] : P.c_ctx[k]; v = v / (1.0f + __expf(-v)); }
    else v = modv[g * NMOD + 3072 + k];
    sv[i] = v;
  }
  __syncthreads();
  const int col = tid & 255, kh = tid >> 8;
  float a0 = 0.f, a1 = 0.f, a2 = 0.f, a3 = 0.f, a4 = 0.f;
  const float* wp = W + (size_t)(k0 + kh * 64) * ldw + n0 + col;
#pragma unroll 8
  for (int kk = 0; kk < 64; ++kk) {
    const float w = wp[(size_t)kk * ldw];
    const int ki = kh * 64 + kk;
    a0 += sv[ki] * w; a1 += sv[128 + ki] * w; a2 += sv[256 + ki] * w; a3 += sv[384 + ki] * w; a4 += sv[512 + ki] * w;
  }
  if (kh == 1) { red[col] = a0; red[256 + col] = a1; red[512 + col] = a2; red[768 + col] = a3; red[1024 + col] = a4; }
  __syncthreads();
  if (kh == 0) {
    const float bv = (bias != nullptr && ks == 0) ? bias[n0 + col] : 0.f;
    a0 += red[col] + bv; a1 += red[256 + col] + bv; a2 += red[512 + col] + bv; a3 += red[768 + col] + bv; a4 += red[1024 + col] + bv;
    float* o = outp + n0 + col;
    __hip_atomic_fetch_add(o, a0, __ATOMIC_RELAXED, __HIP_MEMORY_SCOPE_AGENT);
    __hip_atomic_fetch_add(o + ldo, a1, __ATOMIC_RELAXED, __HIP_MEMORY_SCOPE_AGENT);
    __hip_atomic_fetch_add(o + 2 * ldo, a2, __ATOMIC_RELAXED, __HIP_MEMORY_SCOPE_AGENT);
    __hip_atomic_fetch_add(o + 3 * ldo, a3, __ATOMIC_RELAXED, __HIP_MEMORY_SCOPE_AGENT);
    __hip_atomic_fetch_add(o + 4 * ldo, a4, __ATOMIC_RELAXED, __HIP_MEMORY_SCOPE_AGENT);
  }
  __syncthreads();
}

struct TrUnit { const float* src; bf16_t* dst; int ldw, ldd, perm; };
__device__ __forceinline__ void tr_decode(const Params& P, int v, TrUnit& t) {
  bf16_t* WinT = (bf16_t*)(P.ws + WS_WIN); bf16_t* WoutT = (bf16_t*)(P.ws + WS_WOUT); bf16_t* WupT = (bf16_t*)(P.ws + WS_WUP); bf16_t* WdnT = (bf16_t*)(P.ws + WS_WDN);
  if (v < 896) { const int kt = v / 56, ntl = v % 56; t.src = P.w_in + (size_t)(kt * 64) * DIN + ntl * 64; t.ldw = DIN; t.dst = WinT + (size_t)(ntl * 64) * DM + kt * 64; t.ldd = DM; t.perm = 1; }
  else if (v < 1152) { const int w = v - 896, kt = w >> 4, ntl = w & 15; t.src = P.w_out + (size_t)(kt * 64) * DM + ntl * 64; t.ldw = DM; t.dst = WoutT + (size_t)(ntl * 64) * DM + kt * 64; t.ldd = DM; t.perm = 0; }
  else if (v < 2560) { const int w = v - 1152, kt = w / 88, ntl = w % 88; const int n0 = ntl * 64, half = n0 / DFF, r = n0 % DFF, pn = r >> 7, cc = r & 127;
    t.src = P.w_up + (size_t)(kt * 64) * NUP + n0; t.ldw = NUP; t.dst = WupT + (size_t)(pn * 256 + half * 128 + cc) * DM + kt * 64; t.ldd = DM; t.perm = 1; }
  else { const int w = v - 2560, kt = w >> 4, ntl = w & 15; t.src = P.w_down + (size_t)(kt * 64) * DM + ntl * 64; t.ldw = DM; t.dst = WdnT + (size_t)(ntl * 64) * DFF + kt * 64; t.ldd = DFF; t.perm = 0; }
}
__device__ __forceinline__ void transpose_range(const Params& P, float* tile, int rank, int nrank, int vfirst, int vend) {
  const int tid = opaque_tid();
  const int r = tid >> 4, c4 = (tid & 15) * 4, nn = tid >> 3, kk8 = (tid & 7) * 8;
  int v = vfirst + rank;
  f32x4 p0 = (f32x4){0.f, 0.f, 0.f, 0.f}, p1 = p0; TrUnit cur;
  if (v < vend) { tr_decode(P, v, cur); p0 = *(const f32x4*)(cur.src + (size_t)r * cur.ldw + c4); p1 = *(const f32x4*)(cur.src + (size_t)(r + 32) * cur.ldw + c4); }
  while (v < vend) {
    { float* t = tile + r * 65 + c4; t[0] = p0[0]; t[1] = p0[1]; t[2] = p0[2]; t[3] = p0[3]; t += 32 * 65; t[0] = p1[0]; t[1] = p1[1]; t[2] = p1[2]; t[3] = p1[3]; }
    const int vn = v + nrank; TrUnit nxt = cur;
    if (vn < vend) tr_decode(P, vn, nxt);
    p0 = *(const f32x4*)(nxt.src + (size_t)r * nxt.ldw + c4); p1 = *(const f32x4*)(nxt.src + (size_t)(r + 32) * nxt.ldw + c4);
    __syncthreads();
    { float vv[8];
#pragma unroll
      for (int j = 0; j < 8; ++j) vv[j] = tile[(kk8 + j) * 65 + nn];
      u32x4 o; o.x = cvt_pk_bf16(vv[0], vv[1]); o.y = cvt_pk_bf16(vv[2], vv[3]); o.z = cvt_pk_bf16(vv[4], vv[5]); o.w = cvt_pk_bf16(vv[6], vv[7]);
      const int c5 = nn & 31, nnp = cur.perm ? ((nn & 32) + ((c5 >> 2) & 1) * 16 + (c5 >> 3) * 4 + (c5 & 3)) : nn;
      *(u32x4*)(cur.dst + (size_t)nnp * cur.ldd + kk8) = o; }
    __syncthreads();
    cur = nxt; v = vn;
  }
}
constexpr int NTR_WIN = 896, NTR_ALL = 896 + 256 + 1408 + 704;
__device__ void phase0a(const Params& P, float* sm) {
  float* mod = (float*)(P.ws + WS_MOD);
  for (int u = blockIdx.x; u < 24 * 8; u += gridDim.x) gemv5_unit<true>(P, u, 24, P.w_mod, NMOD, mod, NMOD, P.b_mod, nullptr, sm);
  transpose_range(P, sm, gridDim.x - 1 - blockIdx.x, gridDim.x, 0, NTR_WIN);
}

__device__ void phase0b(const Params& P, float* sm) {
  const int tid = opaque_tid(), wid = tid >> 6, lane = tid & 63;
  const float* mod = (const float*)(P.ws + WS_MOD);
  float* sbv = (float*)(P.ws + WS_SB);
  float* gates = (float*)(P.ws + WS_GATES);
  bf16_t* H = (bf16_t*)(P.ws + WS_H);
  for (int u = blockIdx.x; u < 22 * 8; u += gridDim.x) gemv5_unit<false>(P, u, 22, P.w_up, NUP, sbv, NUP, nullptr, mod, sm + 16384);
  for (int i0 = 0; i0 < 32; i0 += 8) {
    float wv[8];
#pragma unroll
    for (int i = 0; i < 8; ++i) { const int idx = tid + 512 * (i0 + i); wv[i] = P.w_in[(size_t)(idx >> 4) * DIN + NZ + (idx & 15)]; }
#pragma unroll
    for (int i = 0; i < 8; ++i) { const int idx = tid + 512 * (i0 + i); sm[(idx & 15) * 1024 + (idx >> 4)] = wv[i]; }
  }
  __syncthreads();
  f32x4 xnext[4];
  { const int Tn = blockIdx.x * 8 + wid; const float* xr = (Tn < NCTXT) ? P.x_prompt + (size_t)Tn * DM : P.x_sample + (size_t)(Tn - NCTXT) * DM;
#pragma unroll
    for (int i = 0; i < 4; ++i) xnext[i] = *(const f32x4*)(xr + i * 256 + lane * 4); }
  for (int T = blockIdx.x * 8 + wid; T < NTOK; T += gridDim.x * 8) {
    const int g = T < NCTXT ? 4 : ((T - NCTXT) >> 12);
    const float* modg = mod + g * NMOD;
    f32x4 xv[4]; float ss = 0.f;
#pragma unroll
    for (int i = 0; i < 4; ++i) xv[i] = xnext[i];
    { int Tn = T + gridDim.x * 8; Tn = Tn < NTOK ? Tn : T;
      const float* xr = (Tn < NCTXT) ? P.x_prompt + (size_t)Tn * DM : P.x_sample + (size_t)(Tn - NCTXT) * DM;
#pragma unroll
      for (int i = 0; i < 4; ++i) xnext[i] = *(const f32x4*)(xr + i * 256 + lane * 4); }
#pragma unroll
    for (int i = 0; i < 4; ++i) ss += xv[i][0] * xv[i][0] + xv[i][1] * xv[i][1] + xv[i][2] * xv[i][2] + xv[i][3] * xv[i][3];
#pragma unroll
    for (int o = 1; o < 64; o <<= 1) ss += __shfl_xor(ss, o);
    const float rstd = rsqrtf(ss * (1.0f / 1024.0f) + EPS);
    f32x4 hv[4];
#pragma unroll
    for (int i = 0; i < 4; ++i) {
      const int c = i * 256 + lane * 4;
      const f32x4 nv = *(const f32x4*)(P.norm1 + c), sc = *(const f32x4*)(modg + 1024 + c), sh = *(const f32x4*)(modg + c);
      hv[i] = xv[i] * rstd * nv * (sc + 1.0f) + sh;
      u32x2 o; o.x = cvt_pk_bf16(hv[i][0], hv[i][1]); o.y = cvt_pk_bf16(hv[i][2], hv[i][3]);
      *(u32x2*)(H + (size_t)T * DM + c) = o;
    }
    float v[16];
#pragma unroll
    for (int gi = 0; gi < 16; ++gi) {
      float a = 0.f;
#pragma unroll
      for (int i = 0; i < 4; ++i) { const f32x4 w = *(const f32x4*)(sm + gi * 1024 + i * 256 + lane * 4); a += hv[i][0] * w[0] + hv[i][1] * w[1] + hv[i][2] * w[2] + hv[i][3] * w[3]; }
      v[gi] = a;
    }
#pragma unroll
    for (int j = 0; j < 8; ++j) { const bool hi = lane & 32; const float keep = hi ? v[j + 8] : v[j], send = hi ? v[j] : v[j + 8]; v[j] = keep + __shfl_xor(send, 32); }
#pragma unroll
    for (int j = 0; j < 4; ++j) { const bool hi = lane & 16; const float keep = hi ? v[j + 4] : v[j], send = hi ? v[j] : v[j + 4]; v[j] = keep + __shfl_xor(send, 16); }
#pragma unroll
    for (int j = 0; j < 2; ++j) { const bool hi = lane & 8; const float keep = hi ? v[j + 2] : v[j], send = hi ? v[j] : v[j + 2]; v[j] = keep + __shfl_xor(send, 8); }
    { const bool hi = lane & 4; const float keep = hi ? v[1] : v[0], send = hi ? v[0] : v[1]; v[0] = keep + __shfl_xor(send, 4); }
    v[0] += __shfl_xor(v[0], 2); v[0] += __shfl_xor(v[0], 1);
    if ((lane & 3) == 0) {
      const int gi = ((lane >> 5) & 1) * 8 + ((lane >> 4) & 1) * 4 + ((lane >> 3) & 1) * 2 + ((lane >> 2) & 1);
      float val = v[0] + P.b_gate[gi];
      if ((gi >> 2) & 1) val = fminf(val, 0.f) - log1pf(__expf(-fabsf(val)));
      gates[(size_t)T * 16 + gi] = val;
    }
  }
  __syncthreads();
}

__device__ __forceinline__ void unit_info(int u, int& T0, int& nc, int& b, int& h, int& c) {
  if (u < 128) { nc = 2; b = u >> 3; h = (u >> 1) & 3; c = u & 1; T0 = b * 256 + c * 128; }
  else { const int v = u - 128; nc = 32; b = v >> 7; h = (v >> 5) & 3; c = v & 31; T0 = NCTXT + b * 4096 + c * 128; }
}
struct ScanOut { float beta0, beta1, cf0, cf1, pm0, pm1, bl, cmax; int t0, t1; };
__device__ __forceinline__ void chunk_scan(const float* gates, int T0, int h, int d, int lane, ScanOut& o) {
  const int t0 = d ? 127 - 2 * lane : 2 * lane, t1 = d ? t0 - 1 : t0 + 1;
  const float* g0 = gates + (size_t)(T0 + t0) * 16 + d * 8 + h; const float* g1 = gates + (size_t)(T0 + t1) * 16 + d * 8 + h;
  const float i0 = g0[0], f0 = g0[4], i1 = g1[0], f1 = g1[4];
  const float s = f0 + f1;
  float x = s;
#pragma unroll
  for (int off = 1; off < 64; off <<= 1) { const float y = __shfl_up(x, off); if (lane >= off) x += y; }
  const float excl = x - s;
  o.beta0 = excl + f0; o.beta1 = x;
  o.cf0 = i0 - o.beta0; o.cf1 = i1 - o.beta1;
  float mx = fmaxf(o.cf0, o.cf1);
#pragma unroll
  for (int off = 1; off < 64; off <<= 1) { const float y = __shfl_up(mx, off); if (lane >= off) mx = fmaxf(mx, y); }
  const float mex = __shfl_up(mx, 1);
  o.pm0 = lane ? fmaxf(mex, o.cf0) : o.cf0; o.pm1 = mx;
  o.bl = __shfl(x, 63); o.cmax = __shfl(mx, 63);
  o.t0 = t0; o.t1 = t1;
}

constexpr int LROW = 136;
constexpr int CST_ELEMS = 129 * 128;

__device__ void shortconv_items(const Params& P) {
  const bf16_t* Z = (const bf16_t*)(P.ws + WS_Z);
  bf16_t* ucat = (bf16_t*)(P.ws + WS_UCAT);
  const int tid = opaque_tid(), wid = tid >> 6, lane = tid & 63, cgp = lane * 8;
  float w0[8], w1[8], w2[8], bb[8];
#pragma unroll
  for (int q = 0; q < 2; ++q) {
    const f32x4 a = *(const f32x4*)(P.conv_sc_w + cgp + q * 4), b = *(const f32x4*)(P.conv_sc_w + 512 + cgp + q * 4), cc = *(const f32x4*)(P.conv_sc_w + 1024 + cgp + q * 4), d = *(const f32x4*)(P.conv_sc_b + cgp + q * 4);
#pragma unroll
    for (int e = 0; e < 4; ++e) { w0[q * 4 + e] = a[e]; w1[q * 4 + e] = b[e]; w2[q * 4 + e] = cc[e]; bb[q * 4 + e] = d[e]; }
  }
  int Tb, Te;
  { const int G = gridDim.x, nhi = 640 % G == 0 ? G : 640 % G;
    const int wlo = 1, whi = (nhi < G) ? 5 : 1;
    const long tot = (long)nhi * wlo + (long)(G - nhi) * whi;
    const int b = blockIdx.x;
    const long s0 = b < nhi ? (long)b * wlo : (long)nhi * wlo + (long)(b - nhi) * whi, s1 = s0 + (b < nhi ? wlo : whi);
    const int r0 = (int)((long)NTOK * s0 / tot), r1 = (int)((long)NTOK * s1 / tot);
    const int n = r1 - r0, per = (n + 7) >> 3;
    Tb = r0 + wid * per; Te = Tb + per < r1 ? Tb + per : r1; }
  if (Tb >= Te) return;
  auto loadu = [&](int T, float (&u)[8]) {
    const int Tc = T < 0 ? 0 : (T >= NTOK ? NTOK - 1 : T);
    const bf16_t* zr = Z + (size_t)Tc * NZ + cgp;
    const u32x4 c = *(const u32x4*)(zr + 512), x = *(const u32x4*)(zr + 1024);
#pragma unroll
    for (int q = 0; q < 4; ++q) { u[2 * q] = bflo(c[q]) * bflo(x[q]); u[2 * q + 1] = bfhi(c[q]) * bfhi(x[q]); }
  };
  float up[8], uc[8], un[8];
  loadu(Tb - 1, up); loadu(Tb, uc);
  for (int T = Tb; T < Te; ++T) {
    loadu(T + 1, un);
    const u32x4 sbq = *(const u32x4*)(Z + (size_t)T * NZ + cgp);
    const int pos = (T < NCTXT) ? (T & 255) : ((T - NCTXT) & 63), lastp = (T < NCTXT) ? 255 : 63;
    const float mp = pos != 0 ? 1.f : 0.f, mn = pos != lastp ? 1.f : 0.f;
    float o[8];
#pragma unroll
    for (int q = 0; q < 4; ++q) {
      o[2 * q] = bflo(sbq[q]) * (w0[2 * q] * (mp * up[2 * q]) + w1[2 * q] * uc[2 * q] + w2[2 * q] * (mn * un[2 * q]) + bb[2 * q]);
      o[2 * q + 1] = bfhi(sbq[q]) * (w0[2 * q + 1] * (mp * up[2 * q + 1]) + w1[2 * q + 1] * uc[2 * q + 1] + w2[2 * q + 1] * (mn * un[2 * q + 1]) + bb[2 * q + 1]);
    }
    u32x4 ov; ov.x = cvt_pk_bf16(o[0], o[1]); ov.y = cvt_pk_bf16(o[2], o[3]); ov.z = cvt_pk_bf16(o[4], o[5]); ov.w = cvt_pk_bf16(o[6], o[7]);
    *(u32x4*)(ucat + (size_t)T * DM + cgp) = ov;
#pragma unroll
    for (int e = 0; e < 8; ++e) { up[e] = uc[e]; uc[e] = un[e]; }
  }
}

__device__ void phaseM1(const Params& P, LAS unsigned char* lds) {
  const int tid = opaque_tid(), wid = tid >> 6, lane = tid & 63, fr = lane & 15, fq = lane >> 4;
  const bf16_t* Z = (const bf16_t*)(P.ws + WS_Z);
  const float* gates = (const float*)(P.ws + WS_GATES);
  float* stat = (float*)(P.ws + WS_STAT);
  bf16_t* dC = (bf16_t*)P.out;
  LAS bf16_t* KT = (LAS bf16_t*)lds;
  LAS bf16_t* VT0 = (LAS bf16_t*)(lds + 34816);
  LAS bf16_t* VT1 = (LAS bf16_t*)(lds + 34816 + 36992);
  LAS float* ecs = (LAS float*)(lds + 34816 + 2 * 36992 + 4096);
  for (int u = blockIdx.x; u < 640; u += gridDim.x) {
    int T0, nc, b, h, c; unit_info(u, T0, nc, b, h, c);
    if (wid < 2) {
      ScanOut so; chunk_scan(gates, T0, h, wid, lane, so);
      ecs[wid * 128 + so.t0] = __expf(so.cf0 - so.cmax); ecs[wid * 128 + so.t1] = __expf(so.cf1 - so.cmax);
      if (lane == 0) { stat[(u * 2 + wid) * 2] = so.bl; stat[(u * 2 + wid) * 2 + 1] = so.cmax; }
    }
    __syncthreads();
    {
      const int s = 2 * (tid & 63);
#pragma unroll
      for (int i = 0; i < 2; ++i) {
        const int kg = (tid >> 6) + 8 * i;
        const bf16_t* zr = Z + (size_t)(T0 + s) * NZ + h * 128 + kg * 8;
        const u32x4 ka = *(const u32x4*)(zr + 2048), va = *(const u32x4*)(zr + 2560);
        const u32x4 kb = *(const u32x4*)(zr + NZ + 2048), vb = *(const u32x4*)(zr + NZ + 2560);
        const float e0a = ecs[s], e0b = ecs[s + 1], e1a = ecs[128 + s], e1b = ecs[128 + s + 1];
#pragma unroll
        for (int q = 0; q < 4; ++q) {
          const int r0 = (kg * 8 + 2 * q) * LROW + s, r1 = r0 + LROW;
          *(LAS unsigned*)(KT + r0) = (ka[q] & 0xffffu) | (kb[q] << 16);
          *(LAS unsigned*)(KT + r1) = (ka[q] >> 16) | (kb[q] & 0xffff0000u);
          const float al = bflo(va[q]), ah = bfhi(va[q]), bl_ = bflo(vb[q]), bh = bfhi(vb[q]);
          *(LAS unsigned*)(VT0 + r0) = cvt_pk_bf16_c(al * e0a, bl_ * e0b);
          *(LAS unsigned*)(VT0 + r1) = cvt_pk_bf16_c(ah * e0a, bh * e0b);
          *(LAS unsigned*)(VT1 + r0) = cvt_pk_bf16_c(al * e1a, bl_ * e1b);
          *(LAS unsigned*)(VT1 + r1) = cvt_pk_bf16_c(ah * e1a, bh * e1b);
        }
      }
      if (tid < 64) { *(LAS unsigned*)(VT0 + 128 * LROW + 2 * tid) = cvt_pk_bf16_c(ecs[2 * tid], ecs[2 * tid + 1]); *(LAS unsigned*)(VT1 + 128 * LROW + 2 * tid) = cvt_pk_bf16_c(ecs[128 + 2 * tid], ecs[128 + 2 * tid + 1]); }
    }
    __syncthreads();
    {
      bf16x8 Kf[4];
#pragma unroll
      for (int ks = 0; ks < 4; ++ks) Kf[ks] = *(const LAS bf16x8*)(KT + (16 * wid + fr) * LROW + 32 * ks + 8 * fq);
#pragma unroll
      for (int d = 0; d < 2; ++d) {
        LAS bf16_t* VT = d ? VT1 : VT0;
        bf16_t* dst = dC + (size_t)(u * 2 + d) * CST_ELEMS;
#pragma unroll
        for (int mt = 0; mt < 9; ++mt) {
          f32x4 a = (f32x4){0.f, 0.f, 0.f, 0.f};
#pragma unroll
          for (int ks = 0; ks < 4; ++ks) { const bf16x8 Vf = *(const LAS bf16x8*)(VT + (16 * mt + fr) * LROW + 32 * ks + 8 * fq); a = __builtin_amdgcn_mfma_f32_16x16x32_bf16(Kf[ks], Vf, a, 0, 0, 0); }
          if (mt < 8 || fr == 0) { u32x2 o; o.x = cvt_pk_bf16_c(a[0], a[1]); o.y = cvt_pk_bf16_c(a[2], a[3]); *(u32x2*)(dst + (16 * mt + fr) * 128 + 16 * wid + 4 * fq) = o; }
        }
      }
    }
    __syncthreads();
  }
}

template <int NC, int BLK, bool HASN>
__device__ __forceinline__ void m2_loop(const bf16_t* dC, bf16_t* Cst, float* mst, const float* sm, int ubase, int d, int e, int kn, bool wm, f32x4& C4, f32x4& n4, float& m) {
#pragma unroll 1
  for (int jb = 0; jb < NC; jb += BLK) {
    u32x2 dv[BLK], nv[BLK];
#pragma unroll
    for (int jj = 0; jj < BLK; ++jj) {
      const int j = jb + jj, c = d ? NC - 1 - j : j;
      const bf16_t* dp = dC + (size_t)((ubase + c) * 2 + d) * CST_ELEMS;
      dv[jj] = *(const u32x2*)(dp + e);
      if (HASN) nv[jj] = *(const u32x2*)(dp + 16384 + kn);
    }
#pragma unroll
    for (int jj = 0; jj < BLK; ++jj) {
      const int j = jb + jj, c = d ? NC - 1 - j : j;
      const int idx = (ubase + c) * 2 + d;
      bf16_t* cs = Cst + (size_t)idx * CST_ELEMS;
      { u32x2 o; o.x = cvt_pk_bf16(C4[0], C4[1]); o.y = cvt_pk_bf16(C4[2], C4[3]); *(u32x2*)(cs + e) = o; }
      if (HASN) { u32x2 o; o.x = cvt_pk_bf16(n4[0], n4[1]); o.y = cvt_pk_bf16(n4[2], n4[3]); *(u32x2*)(cs + 16384 + kn) = o; if (wm) mst[idx] = m; }
      const float bl = sm[2 * j], cmax = sm[2 * j + 1];
      const float mn = bl + fmaxf(m, cmax);
      const float decay = __expf(bl + m - mn), scale = __expf(bl + cmax - mn);
      const u32x2 dvv = dv[jj];
      C4[0] = decay * C4[0] + scale * bflo(dvv.x); C4[1] = decay * C4[1] + scale * bfhi(dvv.x); C4[2] = decay * C4[2] + scale * bflo(dvv.y); C4[3] = decay * C4[3] + scale * bfhi(dvv.y);
      if (HASN) { const u32x2 nvv = nv[jj];
        n4[0] = decay * n4[0] + scale * bflo(nvv.x); n4[1] = decay * n4[1] + scale * bfhi(nvv.x); n4[2] = decay * n4[2] + scale * bflo(nvv.y); n4[3] = decay * n4[3] + scale * bfhi(nvv.y); }
      m = mn;
    }
  }
}
template <int NC, int BLK>
__device__ __forceinline__ void m2_unit(const Params& P, bool lat, int sq, int slice, float* sm) {
  const int tid = opaque_tid();
  const bf16_t* dC = (const bf16_t*)P.out;
  bf16_t* Cst = (bf16_t*)(P.ws + WS_H);
  const float* stat = (const float*)(P.ws + WS_STAT);
  float* mst = (float*)(P.ws + WS_MST);
  const int b = sq >> 3, h = (sq >> 1) & 3, d = sq & 1;
  const int ubase = lat ? 128 + (b * 4 + h) * 32 : (b * 4 + h) * 2;
  const int e = slice * 2048 + tid * 4;
  const bool hasn = (slice == 0) && (tid < 64);
  const int kn = (tid & 31) * 4;
  if (tid < NC) { const int c = d ? NC - 1 - tid : tid; const int idx = (ubase + c) * 2 + d; sm[2 * tid] = stat[idx * 2]; sm[2 * tid + 1] = stat[idx * 2 + 1]; }
  f32x4 C4 = (f32x4){0.f, 0.f, 0.f, 0.f}, n4 = C4; float m = 0.f;
  const int sidx = (b * 2 + d) * 4 + h;
  if (lat) {
    C4 = *(const f32x4*)(P.state_C + (size_t)sidx * 16384 + e);
    n4 = *(const f32x4*)(P.state_n + sidx * 128 + kn);
    m = P.state_m[sidx];
  }
  __syncthreads();
  if (hasn) m2_loop<NC, BLK, true>(dC, Cst, mst, sm, ubase, d, e, kn, tid == 0, C4, n4, m);
  else m2_loop<NC, BLK, false>(dC, Cst, mst, sm, ubase, d, e, kn, false, C4, n4, m);
  if (!lat) {
    *(f32x4*)(P.out + OUT_TAIL + (size_t)sidx * 16384 + e) = C4;
    if (hasn) { *(f32x4*)(P.out + OUT_TAIL + 2097152 + sidx * 128 + kn) = n4; if (tid == 0) P.out[OUT_TAIL + 2097152 + 16384 + sidx] = m; }
  }
  __syncthreads();
}
__device__ void phaseM2(const Params& P, float* sm) {
  for (int unit = blockIdx.x; unit < 1280; unit += gridDim.x) {
    if (unit < 256) m2_unit<32, 16>(P, true, unit >> 3, unit & 7, sm);
    else { const int v = unit - 256; m2_unit<2, 2>(P, false, v >> 3, v & 7, sm); }
  }
}

__device__ __forceinline__ bf16x8 scale_frag(bf16x8 q, float s) {
  const u32x4 a = __builtin_bit_cast(u32x4, q); u32x4 r;
  r.x = cvt_pk_bf16_c(bflo(a.x) * s, bfhi(a.x) * s); r.y = cvt_pk_bf16_c(bflo(a.y) * s, bfhi(a.y) * s);
  r.z = cvt_pk_bf16_c(bflo(a.z) * s, bfhi(a.z) * s); r.w = cvt_pk_bf16_c(bflo(a.w) * s, bfhi(a.w) * s);
  return __builtin_bit_cast(bf16x8, r);
}

__device__ void phaseM3(const Params& P, LAS unsigned char* lds) {
  const int tid = opaque_tid(), wid = tid >> 6, lane = tid & 63, fr = lane & 15, fq = lane >> 4;
  const bf16_t* Z = (const bf16_t*)(P.ws + WS_Z);
  const float* gates = (const float*)(P.ws + WS_GATES);
  const bf16_t* Cst = (const bf16_t*)(P.ws + WS_H);
  const float* mst = (const float*)(P.ws + WS_MST);
  bf16_t* ucat = (bf16_t*)(P.ws + WS_UCAT);
  LAS bf16_t* Ks = (LAS bf16_t*)lds;
  LAS bf16_t* VT = (LAS bf16_t*)(lds + 34816);
  LAS bf16_t* Sb = (LAS bf16_t*)(lds + 34816 + 36992);
  LAS float* arr = (LAS float*)(lds + 34816 + 36992 + 34816);
  LAS float* ecA = arr; LAS float* erA = arr + 256; LAS float* wiA = arr + 512; LAS float* flA = arr + 768;
  LAS bf16_t* Cb = (LAS bf16_t*)(lds + 34816 + 36992 + 34816 + 4096);
  const float qs = 0.08838834764831845f;
  for (int u = blockIdx.x; u < 640; u += gridDim.x) {
    int T0, nc, b, h, c; unit_info(u, T0, nc, b, h, c);
    if (wid < 2) {
      const int d = wid;
      ScanOut so; chunk_scan(gates, T0, h, d, lane, so);
      const float mc = mst[u * 2 + d];
      const float mx0 = fmaxf(mc, so.pm0), mx1 = fmaxf(mc, so.pm1);
      ecA[d * 128 + so.t0] = __expf(so.cf0 - so.cmax); ecA[d * 128 + so.t1] = __expf(so.cf1 - so.cmax);
      erA[d * 128 + so.t0] = __expf(so.cmax - mx0) * qs; erA[d * 128 + so.t1] = __expf(so.cmax - mx1) * qs;
      wiA[d * 128 + so.t0] = __expf(mc - mx0) * qs; wiA[d * 128 + so.t1] = __expf(mc - mx1) * qs;
      flA[d * 128 + so.t0] = __expf(-(so.beta0 + mx0)); flA[d * 128 + so.t1] = __expf(-(so.beta1 + mx1));
    }
    {
      const int s = 2 * (tid & 63);
#pragma unroll
      for (int i = 0; i < 2; ++i) {
        const int kg = (tid >> 6) + 8 * i;
        const bf16_t* zr = Z + (size_t)(T0 + s) * NZ + h * 128 + kg * 8;
        const u32x4 ka = *(const u32x4*)(zr + 2048), va = *(const u32x4*)(zr + 2560);
        const u32x4 kb = *(const u32x4*)(zr + NZ + 2048), vb = *(const u32x4*)(zr + NZ + 2560);
        *(LAS u32x4*)(Ks + s * LROW + kg * 8) = ka;
        *(LAS u32x4*)(Ks + (s + 1) * LROW + kg * 8) = kb;
#pragma unroll
        for (int q = 0; q < 4; ++q) {
          const int r0 = (kg * 8 + 2 * q) * LROW + s, r1 = r0 + LROW;
          *(LAS unsigned*)(VT + r0) = (va[q] & 0xffffu) | (vb[q] << 16);
          *(LAS unsigned*)(VT + r1) = (va[q] >> 16) | (vb[q] & 0xffff0000u);
        }
      }
      if (tid < 64) *(LAS unsigned*)(VT + 128 * LROW + 2 * tid) = 0x3F803F80u;
    }
    u32x4 creg[5];
    {
      const bf16_t* cs0 = Cst + (size_t)(u * 2) * CST_ELEMS;
#pragma unroll
      for (int i = 0; i < 4; ++i) creg[i] = *(const u32x4*)(cs0 + (tid + 512 * i) * 8);
      creg[4] = *(const u32x4*)(cs0 + 16384 + (tid & 15) * 8);
#pragma unroll
      for (int i = 0; i < 4; ++i) { const int ci = tid + 512 * i; *(LAS u32x4*)(Cb + (ci >> 4) * LROW + (ci & 15) * 8) = creg[i]; }
      if (tid < 16) *(LAS u32x4*)(Cb + 128 * LROW + tid * 8) = creg[4];
    }
    __syncthreads();
    {
      const bf16_t* cs1 = Cst + (size_t)(u * 2 + 1) * CST_ELEMS;
#pragma unroll
      for (int i = 0; i < 4; ++i) creg[i] = *(const u32x4*)(cs1 + (tid + 512 * i) * 8);
      creg[4] = *(const u32x4*)(cs1 + 16384 + (tid & 15) * 8);
    }
    {
      const int w = wid;
      bf16x8 Qf[4];
      { const bf16_t* qr = Z + (size_t)(T0 + 16 * w + fr) * NZ + 1536 + h * 128 + 8 * fq;
#pragma unroll
        for (int ks = 0; ks < 4; ++ks) Qf[ks] = *(const bf16x8*)(qr + 32 * ks); }
      f32x4 hsum[8];
#pragma unroll
      for (int vt = 0; vt < 8; ++vt) hsum[vt] = (f32x4){0.f, 0.f, 0.f, 0.f};
      LAS bf16_t* Sw = Sb + w * 16 * LROW;
#pragma unroll
      for (int d = 0; d < 2; ++d) {
        if (d == 1) {
          __syncthreads();
#pragma unroll
          for (int i = 0; i < 4; ++i) { const int ci = tid + 512 * i; *(LAS u32x4*)(Cb + (ci >> 4) * LROW + (ci & 15) * 8) = creg[i]; }
          if (tid < 16) *(LAS u32x4*)(Cb + 128 * LROW + tid * 8) = creg[4];
          __syncthreads();
        }
        const int lo = d ? w : 0, hi = d ? 7 : w;
        const int ks_lo = lo >> 1, ks_hi = hi >> 1;
        float er4[4];
#pragma unroll
        for (int j = 0; j < 4; ++j) er4[j] = erA[d * 128 + 16 * w + 4 * fq + j];
#pragma unroll
        for (int nt = 0; nt < 8; ++nt) {
          if (nt >= 2 * ks_lo && nt <= 2 * ks_hi + 1) {
            f32x4 a = (f32x4){0.f, 0.f, 0.f, 0.f};
            if (nt >= lo && nt <= hi) {
#pragma unroll
              for (int ks = 0; ks < 4; ++ks) { const bf16x8 Kf = *(const LAS bf16x8*)(Ks + (16 * nt + fr) * LROW + 32 * ks + 8 * fq); a = __builtin_amdgcn_mfma_f32_16x16x32_bf16(Qf[ks], Kf, a, 0, 0, 0); }
              const float ecv = ecA[d * 128 + 16 * nt + fr];
#pragma unroll
              for (int j = 0; j < 4; ++j) {
                float val = a[j] * er4[j] * ecv;
                if (nt == w) { const int tl = 4 * fq + j; const bool ok = d ? (fr >= tl) : (fr <= tl); val = ok ? val : 0.f; }
                a[j] = val;
              }
            }
#pragma unroll
            for (int j = 0; j < 4; ++j) { const float nb = dppf<0x12F>(a[j]); if ((fr & 1) == 0) *(LAS unsigned*)(Sw + (4 * fq + j) * LROW + 16 * nt + fr) = cvt_pk_bf16_c(a[j], nb); }
          }
        }
        asm volatile("s_waitcnt lgkmcnt(0)" ::: "memory");
        f32x4 ao[9];
#pragma unroll
        for (int vt = 0; vt < 9; ++vt) ao[vt] = (f32x4){0.f, 0.f, 0.f, 0.f};
        const bf16x8 zf = (bf16x8){0, 0, 0, 0, 0, 0, 0, 0};
#pragma unroll
        for (int ks = 0; ks < 4; ++ks) {
          if (ks >= ks_lo && ks <= ks_hi) {
            const bf16x8 Sf = *(const LAS bf16x8*)(Sw + fr * LROW + 32 * ks + 8 * fq);
#pragma unroll
            for (int vt = 0; vt < 9; ++vt) {
              bf16x8 Vf = *(const LAS bf16x8*)(VT + (vt < 8 ? 16 * vt + fr : 128) * LROW + 32 * ks + 8 * fq);
              if (vt == 8 && fr != 0) Vf = zf;
              ao[vt] = __builtin_amdgcn_mfma_f32_16x16x32_bf16(Sf, Vf, ao[vt], 0, 0, 0);
            }
          }
        }
        {
          const float wv = wiA[d * 128 + 16 * w + fr];
#pragma unroll
          for (int ks = 0; ks < 4; ++ks) {
            const bf16x8 Qs = scale_frag(Qf[ks], wv);
#pragma unroll
            for (int vt = 0; vt < 9; ++vt) {
              bf16x8 Cf = *(const LAS bf16x8*)(Cb + (vt < 8 ? 16 * vt + fr : 128) * LROW + 32 * ks + 8 * fq);
              if (vt == 8 && fr != 0) Cf = zf;
              ao[vt] = __builtin_amdgcn_mfma_f32_16x16x32_bf16(Qs, Cf, ao[vt], 0, 0, 0);
            }
          }
        }
#pragma unroll
        for (int j = 0; j < 4; ++j) {
          const float den = __shfl(ao[8][j], lane & 48);
          const float fl = flA[d * 128 + 16 * w + 4 * fq + j];
          const float inv = 1.0f / fmaxf(fabsf(den), fl);
#pragma unroll
          for (int vt = 0; vt < 8; ++vt) hsum[vt][j] += ao[vt][j] * inv;
        }
        asm volatile("" ::: "memory");
      }
#pragma unroll
      for (int j = 0; j < 4; ++j) {
        float ms = 0.f;
#pragma unroll
        for (int vt = 0; vt < 8; ++vt) ms += hsum[vt][j] * hsum[vt][j];
        ms += __shfl_xor(ms, 1); ms += __shfl_xor(ms, 2); ms += __shfl_xor(ms, 4); ms += __shfl_xor(ms, 8);
        const float r = rsqrtf(ms * (1.0f / 128.0f) + EPS);
        const int T = T0 + 16 * w + 4 * fq + j;
#pragma unroll
        for (int vt = 0; vt < 8; ++vt) {
          const int col = h * 128 + 16 * vt + fr;
          const float og = bf2f(Z[(size_t)T * NZ + 3072 + col]);
          const float val = hsum[vt][j] * r * P.mh_norm[col] * fast_sigmoid(og);
          ucat[(size_t)T * DM + 512 + col] = f2bf_c(val);
        }
      }
    }
    __syncthreads();
  }
}

__device__ void phase7(const Params& P) {
  const int tid7 = opaque_tid(); const int wid = tid7 >> 6, lane = tid7 & 63;
  const float* rss2 = (const float*)(P.ws + WS_RSS2);
  f32x4 fn[4];
#pragma unroll
  for (int i = 0; i < 4; ++i) fn[i] = *(const f32x4*)(P.final_norm + i * 256 + lane * 4);
  const int stride = gridDim.x * 8;
  for (int T0 = blockIdx.x * 8 + wid; T0 < 16384; T0 += 5 * stride) {
    f32x4 v[5][4]; float r[5];
#pragma unroll
    for (int q = 0; q < 5; ++q) {
      int T = T0 + q * stride; T = T < 16384 ? T : 16383;
      r[q] = rss2[T];
#pragma unroll
      for (int i = 0; i < 4; ++i) v[q][i] = *(const f32x4*)(P.out + (size_t)T * DM + i * 256 + lane * 4);
    }
#pragma unroll
    for (int q = 0; q < 5; ++q) {
      const int T = T0 + q * stride;
      if (T < 16384) {
        const float rr = rsqrtf(r[q] * (1.0f / 1024.0f) + EPS);
#pragma unroll
        for (int i = 0; i < 4; ++i) *(f32x4*)(P.out + (size_t)T * DM + i * 256 + lane * 4) = v[q][i] * rr * fn[i];
      }
    }
  }
  {
    const float* part = (const float*)(P.ws + WS_H);
    for (int T = 16384 + blockIdx.x * 8 + wid; T < NTOK; T += stride) {
      f32x4 v[4], a1[4], a2[4], a3[4];
      const size_t ro = (size_t)(T - 16384) * DM;
#pragma unroll
      for (int i = 0; i < 4; ++i) { const int c = i * 256 + lane * 4;
        v[i] = *(const f32x4*)(P.out + (size_t)T * DM + c); a1[i] = *(const f32x4*)(part + ro + c);
        a2[i] = *(const f32x4*)(part + (size_t)4096 * DM + ro + c); a3[i] = *(const f32x4*)(part + (size_t)8192 * DM + ro + c); }
      float ss = 0.f;
#pragma unroll
      for (int i = 0; i < 4; ++i) { v[i] = v[i] + a1[i] + a2[i] + a3[i]; ss += v[i][0] * v[i][0] + v[i][1] * v[i][1] + v[i][2] * v[i][2] + v[i][3] * v[i][3]; }
#pragma unroll
      for (int o = 1; o < 64; o <<= 1) ss += __shfl_xor(ss, o);
      const float rr = rsqrtf(ss * (1.0f / 1024.0f) + EPS);
#pragma unroll
      for (int i = 0; i < 4; ++i) *(f32x4*)(P.out + (size_t)T * DM + i * 256 + lane * 4) = v[i] * rr * fn[i];
    }
  }
}


#define XB_TMO      128
#define XB_XCNT(j)  (256  + 64 * (j))
#define XB_XSUB(j)  (1280 + 64 * (j))
#define XB_XGEN(j)  (2304 + 64 * (j))
#define XB_TOP      3328
#define XB_TOPGEN   3392
#define XCD_BAR_WORDS 3456
#define XB_SPIN_CAP (1u << 18)
__device__ __forceinline__ unsigned xb_ld(unsigned* p)              { return __hip_atomic_load(p, __ATOMIC_RELAXED, __HIP_MEMORY_SCOPE_AGENT); }
__device__ __forceinline__ unsigned xb_add(unsigned* p, unsigned v) { return __hip_atomic_fetch_add(p, v, __ATOMIC_RELAXED, __HIP_MEMORY_SCOPE_AGENT); }
__device__ __forceinline__ unsigned xb_xcc_id() { return (unsigned)__builtin_amdgcn_s_getreg((3 << 11) | 20) & 0xFu; }
#define XB_SPIN(cond, bar) do { unsigned _sp = 0; while (cond) { __builtin_amdgcn_s_sleep(1); \
    if ((++_sp & 255u) == 0u) { if (xb_ld(&(bar)[XB_TMO])) break; if (_sp > XB_SPIN_CAP) { atomicAdd(&(bar)[XB_TMO], 1u); break; } } } } while (0)
struct XcdBarrier { unsigned* bar; unsigned x; volatile LAS unsigned* st; };
__device__ __forceinline__ XcdBarrier xcd_barrier_post(unsigned* bar, volatile LAS unsigned* st) {
  XcdBarrier b; b.bar = bar; b.x = xb_xcc_id(); b.st = st;
  if (threadIdx.x == 0) (void)xb_add(&bar[XB_XCNT(b.x)], 1u);
  return b;
}
__device__ __forceinline__ void xcd_barrier_complete(unsigned* bar, unsigned x, unsigned& nloc, unsigned& nx) {
  const unsigned G = gridDim.x * gridDim.y * gridDim.z;
  unsigned sum, cnt, mine, sp = 0u;
  for (;;) {
    sum = 0u; cnt = 0u; mine = 0u;
#pragma unroll
    for (unsigned j = 0; j < 16; ++j) { const unsigned c = xb_ld(&bar[XB_XCNT(j)]); sum += c; cnt += (c > 0u) ? 1u : 0u; mine = (j == x) ? c : mine; }
    if (sum == G) break;
    __builtin_amdgcn_s_sleep(1);
    if ((++sp & 255u) == 0u) { if (xb_ld(&bar[XB_TMO])) break; if (sp > XB_SPIN_CAP) { atomicAdd(&bar[XB_TMO], 1u); break; } }
  }
  nloc = mine > 0u ? mine : 1u; nx = cnt > 0u ? cnt : 1u;
}
__device__ __forceinline__ void xcd_barrier(const XcdBarrier& b) {
  asm volatile("s_waitcnt vmcnt(0) lgkmcnt(0)" ::: "memory");
  __syncthreads();
  if (threadIdx.x == 0) {
    unsigned* bar = b.bar;
    __builtin_amdgcn_s_waitcnt(0);
    unsigned nloc = b.st[0], nx = b.st[1];
    if (nloc == 0u) { xcd_barrier_complete(bar, b.x, nloc, nx); b.st[0] = nloc; b.st[1] = nx; }
    const unsigned old = xb_add(&bar[XB_XSUB(b.x)], 1u);
    const unsigned gen = old / nloc;
    if (old + 1u == (gen + 1u) * nloc) {
      __builtin_amdgcn_fence(__ATOMIC_RELEASE, "agent");
      asm volatile("s_waitcnt vmcnt(0)" ::: "memory");
      const unsigned og = xb_add(&bar[XB_TOP], 1u);
      const unsigned tg = og / nx;
      if (og + 1u == (tg + 1u) * nx) xb_add(&bar[XB_TOPGEN], 1u);
      else XB_SPIN(xb_ld(&bar[XB_TOPGEN]) == tg, bar);
      __builtin_amdgcn_fence(__ATOMIC_ACQUIRE, "agent");
      xb_add(&bar[XB_XGEN(b.x)], 1u);
      asm volatile("s_waitcnt vmcnt(0)" ::: "memory");
    } else {
      XB_SPIN(xb_ld(&bar[XB_XGEN(b.x)]) == gen, bar);
      __builtin_amdgcn_fence(__ATOMIC_ACQUIRE, "agent");
      asm volatile("s_waitcnt vmcnt(0)" ::: "memory");
    }
  }
  __syncthreads();
}

#define GSYNC() xcd_barrier(xb)
__global__ void __launch_bounds__(512, 2) fwd_megakernel(Params P) {
  extern __shared__ __attribute__((aligned(16))) unsigned char shm[];
  cg::grid_group grid = cg::this_grid();
  LAS unsigned char* lds = (LAS unsigned char*)shm;
  float* smf = (float*)shm;
  if (P.ws == nullptr) grid.sync();
  volatile LAS unsigned* xst = (volatile LAS unsigned*)(lds + (LDS_BYTES - 16));
  if (threadIdx.x == 0) { xst[0] = 0u; xst[1] = 0u; }
  __syncthreads();
  const XcdBarrier xb = xcd_barrier_post((unsigned*)(P.ws + WS_BAR), xst);
#define RUN_P2() { EpiZ E; E.Z = (bf16_t*)(P.ws + WS_Z); \
    gemm_phase<EpiZ>(lds, (const bf16_t*)(P.ws + WS_H), (const bf16_t*)(P.ws + WS_WIN), NTOK, NZ, DM, E); } \
    { const int nfull = (80 * 14) % (int)gridDim.x;     \
      if ((int)blockIdx.x >= nfull) transpose_range(P, smf, blockIdx.x - nfull, gridDim.x - nfull, NTR_WIN, NTR_ALL); } GSYNC();
#define RUN_M() phaseM1(P, lds); GSYNC(); phaseM2(P, smf); GSYNC(); phaseM3(P, lds); shortconv_items(P); GSYNC();
#define RUN_P5() { EpiUp E; E.rowss1 = (const float*)(P.ws + WS_RSS1); E.sb = (const float*)(P.ws + WS_SB); E.cw = P.conv_ffn_w; E.cb = P.conv_ffn_b; E.act = (bf16_t*)(P.ws + WS_Z); \
    gemm_phase<EpiUp>(lds, (const bf16_t*)(P.ws + WS_H), (const bf16_t*)(P.ws + WS_WUP), NTOK, NUP, DM, E); } GSYNC();
  phase0a(P, smf);
  GSYNC();
  phase0b(P, smf);
  GSYNC();
  RUN_P2()
#if DUP == 2
  RUN_P2()
#endif
#if DUP == 21
  { EpiNone E; E.Z = (bf16_t*)(P.ws + WS_UCAT);
    gemm_phase<EpiNone>(lds, (const bf16_t*)(P.ws + WS_H), (const bf16_t*)(P.ws + WS_WIN), NTOK, NZ, DM, E); } GSYNC();
#endif
  RUN_M()
#if DUP == 3
  RUN_M()
#endif
#if DUP == 31
  phaseM1(P, lds); GSYNC();
#endif
#if DUP == 32
  phaseM2(P, smf); GSYNC();
#endif
#if DUP == 33
  phaseM3(P, lds); GSYNC();
#endif
#if DUP == 34
  shortconv_items(P); GSYNC();
#endif
#if DUP == 6
  RUN_P5()
#endif
  { EpiX1 E; E.xp = P.x_prompt; E.xs = P.x_sample; E.mod = (const float*)(P.ws + WS_MOD); E.norm2 = P.norm2; E.x1out = P.out; E.x1g = (bf16_t*)(P.ws + WS_H); E.rowss = (float*)(P.ws + WS_RSS1);
    gemm_phase<EpiX1>(lds, (const bf16_t*)(P.ws + WS_UCAT), (const bf16_t*)(P.ws + WS_WOUT), NTOK, DM, DM, E); }
  GSYNC();
  RUN_P5()
#if DUP == 5
  RUN_P5()
#endif
  { EpiDown E; E.mod = (const float*)(P.ws + WS_MOD); E.out = P.out; E.rowss2 = (float*)(P.ws + WS_RSS2);
    gemm_phase<EpiDown>(lds, (const bf16_t*)(P.ws + WS_Z), (const bf16_t*)(P.ws + WS_WDN), 16384, DM, DFF, E); }
  { EpiDownPart E; E.mod = (const float*)(P.ws + WS_MOD); E.out = P.out; E.part = (float*)(P.ws + WS_H);
    gemm_phase<EpiDownPart, 4>(lds, (const bf16_t*)(P.ws + WS_Z), (const bf16_t*)(P.ws + WS_WDN), NTOK, DM, DFF, E); }
  GSYNC();
  phase7(P);
}

extern "C" void kernel_launch(void* const* d_in, const int* in_sizes, int n_in, void* d_out, int out_size, void* d_ws, size_t ws_size, hipStream_t stream) {
  static int grid_blocks = 0;
  if (!grid_blocks) {
    int dev = 0, cus = 0, per_cu = 0;
    hipGetDevice(&dev);
    hipDeviceGetAttribute(&cus, hipDeviceAttributeMultiprocessorCount, dev);
    hipFuncSetAttribute((const void*)fwd_megakernel, hipFuncAttributeMaxDynamicSharedMemorySize, LDS_BYTES);
    hipOccupancyMaxActiveBlocksPerMultiprocessor(&per_cu, (const void*)fwd_megakernel, 512, LDS_BYTES);
    (void)hipGetLastError();
    if (per_cu < 1) per_cu = 1;
    if (per_cu > 1) per_cu = 1;
    grid_blocks = cus * per_cu;
  }
  hipMemsetAsync(d_ws, 0, WS_ZERO_BYTES, stream);
  Params p{};
  const float** pp = (const float**)&p;
  for (int i = 0; i < 22; ++i) pp[i] = (const float*)d_in[i];
  p.out = (float*)d_out; p.ws = (unsigned char*)d_ws;
  void* args[] = {&p};
  hipError_t e = hipLaunchCooperativeKernel((const void*)fwd_megakernel, dim3(grid_blocks), dim3(512), args, LDS_BYTES, stream);
  if (e != hipSuccess) fprintf(stderr, "cooperative launch failed: %s (grid %d)\n", hipGetErrorString(e), grid_blocks);
}
```

```cpp
#include <hip/hip_runtime.h>
#include <hip/hip_cooperative_groups.h>
#include <cstdio>
namespace cg = cooperative_groups;

#ifndef DUP
#define DUP 0
#endif
#define LAS __attribute__((address_space(3)))
typedef unsigned short bf16_t;
typedef short bf16x8 __attribute__((ext_vector_type(8)));
typedef float f32x4 __attribute__((ext_vector_type(4)));
typedef unsigned u32x2 __attribute__((ext_vector_type(2)));
typedef unsigned u32x4 __attribute__((ext_vector_type(4)));

constexpr int DM = 1024, NTOK = 20480, NCTXT = 4096, DIN = 3600, NZ = 3584, DFF = 2816, NUP = 5632, NMOD = 6144;
constexpr float EPS = 1e-6f;
constexpr size_t WS_MOD = 0, WS_SB = 122880, WS_RSS1 = 235520, WS_RSS2 = 317440, WS_BAR = 399360, WS_ZERO_BYTES = 415744;
constexpr size_t WS_GATES = 415744, WS_STAT = 1726464, WS_MST = 1736704;
constexpr size_t WS_WIN = 259850240, WS_WOUT = 9437184, WS_WUP = 11534336, WS_WDN = 23068672;
constexpr int NZG = 3840;
constexpr size_t WS_H = 28835840;
constexpr size_t WS_UCAT = 71106560;
constexpr size_t WS_Z = 113049600;
constexpr int OUT_TAIL = 20971520;
constexpr int LDS_BYTES = 146432;

struct Params {
  const float *x_prompt, *x_sample, *state_C, *state_n, *state_m, *c, *c_ctx, *w_mod, *b_mod, *norm1, *w_in, *b_gate,
      *conv_sc_w, *conv_sc_b, *mh_norm, *w_out, *norm2, *w_up, *conv_ffn_w, *conv_ffn_b, *w_down, *final_norm;
  float* out; unsigned char* ws;
};

typedef __bf16 bf16x2_n __attribute__((ext_vector_type(2)));
typedef float f32x2_n __attribute__((ext_vector_type(2)));
__device__ __forceinline__ unsigned cvt_pk_bf16_c(float lo, float hi) { const f32x2_n v = {lo, hi}; return __builtin_bit_cast(unsigned, __builtin_convertvector(v, bf16x2_n)); }
__device__ __forceinline__ unsigned cvt_pk_bf16(float lo, float hi) { unsigned r; asm("v_cvt_pk_bf16_f32 %0, %1, %2" : "=v"(r) : "v"(lo), "v"(hi)); return r; }
__device__ __forceinline__ bf16_t f2bf_c(float f) { return (bf16_t)(cvt_pk_bf16_c(f, 0.f) & 0xffffu); }
__device__ __forceinline__ bf16_t f2bf(float f) { return (bf16_t)(cvt_pk_bf16(f, 0.f) & 0xffffu); }
__device__ __forceinline__ float bf2f(bf16_t b) { return __uint_as_float(((unsigned)b) << 16); }
__device__ __forceinline__ float bflo(unsigned u) { return __uint_as_float(u << 16); }
__device__ __forceinline__ float bfhi(unsigned u) { return __uint_as_float(u & 0xffff0000u); }
__device__ __forceinline__ int permtok(int T) { if (T < NCTXT) return T; const int q = T - NCTXT; return NCTXT + (q & ~4095) + ((q & 63) << 6) + ((q >> 6) & 63); }
template <int CTRL> __device__ __forceinline__ float dppf(float x) { return __builtin_bit_cast(float, __builtin_amdgcn_mov_dpp(__builtin_bit_cast(int, x), CTRL, 0xf, 0xf, true)); }
__device__ __forceinline__ float fast_sigmoid(float x) { return __builtin_amdgcn_rcpf(1.0f + __expf(-x)); }

__device__ __forceinline__ int opaque_tid() { int t = threadIdx.x; asm volatile("" : "+v"(t)); return t; }

constexpr int BM = 256, BK = 64, HALF = 128, HTB = HALF * BK * 2, NXCD = 8, WGM = 8;
__device__ __forceinline__ int lds_byte(int r, int c) { const int st = (r >> 4) * 2 + (c >> 5), rr = r & 15, cc = c & 31, ob = rr * 64 + cc * 2; return st * 1024 + (ob ^ (((ob >> 9) & 1) << 5)); }
__device__ __forceinline__ void stage_rc(int b, int& R, int& C) { const int st = b / 1024, sb = b % 1024, swz = sb ^ (((sb >> 9) & 1) << 5); R = (st >> 1) * 16 + swz / 64; C = (st & 1) * 32 + (swz % 64) / 2; }

struct Order {
  int nM, nN, nwg, G, c;
  __device__ __forceinline__ void init(int M, int N) { nM = M / BM; nN = N / BM; nwg = nM * nN; G = gridDim.x; c = blockIdx.x; }
  template <int MODE> __device__ __forceinline__ bool next_m(int i, int& pm, int& pn, int& kb, int& ntu, int nt_full) const {
    if (MODE == 0) { kb = 0; ntu = nt_full; return next(i, pm, pn); }
    const long L = (long)i * G + c; if (L >= 256) return false;
    const int x = (int)L & 7, j = (int)L >> 3, kq = j & 3;
    pm = 64 + 2 * x + (j >> 4); pn = ((j >> 2) & 3) | (kq << 8);
    kb = kq < 2 ? 12 * kq : 24 + 10 * (kq - 2); ntu = kq < 2 ? 12 : 10; return true;
  }
  __device__ __forceinline__ bool next(int i, int& pm, int& pn) const {
    const long L = (long)i * G + c; if (L >= nwg) return false;
    int wgid = (int)L; { const int q = nwg / NXCD, r = nwg % NXCD, xcd = wgid % NXCD, off = wgid / NXCD; wgid = (xcd < r ? xcd * (q + 1) : r * (q + 1) + (xcd - r) * q) + off; }
    const int nig = WGM * nN, gid = wgid / nig, fm = gid * WGM, gsz = (nM - fm) < WGM ? (nM - fm) : WGM;
    pm = fm + ((wgid % nig) % gsz); pn = (wgid % nig) / gsz; return true;
  }
};

template <class Epi, int MODE = 0>
__device__ __forceinline__ void gemm_phase(LAS unsigned char* lds, const bf16_t* gA, const bf16_t* gBt, int M, int N, int K, const Epi& E) {
  const int tid = opaque_tid(), wid = __builtin_amdgcn_readfirstlane(tid >> 6), lane = tid & 63, wr = wid >> 2, wc = wid & 3, fr = lane & 15, fq = lane >> 4;
  const int nt = K / BK;
  Order S; S.init(M, N);
  unsigned voffA[2];
#pragma unroll
  for (int i = 0; i < 2; ++i) { int R, C; stage_rc(tid * 16 + i * 8192, R, C); voffA[i] = (unsigned)(R * K + C) * 2u; }
  const size_t kstep = (size_t)(BK * 2);
  const size_t hstep = (size_t)HALF * K * 2;
  const size_t tstep = 2 * hstep;
  const unsigned ldsw = (unsigned)wid * 1024u;
  const int aoff = lds_byte(wr * 64 + fr, fq * 8), boff = lds_byte(wc * 32 + fr, fq * 8);
#define G_SA(b, h) (((b) * 2 + (h)) * HTB)
#define G_SB(b, h) ((4 + (b) * 2 + (h)) * HTB)
#define G_STAGE(bufoff, gbase) do { _Pragma("unroll") for (int _i = 0; _i < 2; ++_i) \
    __builtin_amdgcn_global_load_lds((const unsigned*)((const char*)(gbase) + voffA[_i]), (LAS unsigned*)(lds + (bufoff) + ldsw + _i * 8192), 16, 0, 0); } while (0)
#define G_LDA(dst, b, h) do { _Pragma("unroll") for (int m = 0; m < 4; ++m) _Pragma("unroll") for (int k = 0; k < 2; ++k) dst[m][k] = *(const LAS bf16x8*)(lds + G_SA(b, h) + aoff + m * 2048 + k * 1024); } while (0)
#define G_LDB(dst, b, h) do { _Pragma("unroll") for (int n = 0; n < 2; ++n) _Pragma("unroll") for (int k = 0; k < 2; ++k) dst[n][k] = *(const LAS bf16x8*)(lds + G_SB(b, h) + boff + n * 2048 + k * 1024); } while (0)
#define G_MMA(ai, bj, At, Bt) do { __builtin_amdgcn_s_setprio(1); _Pragma("unroll") for (int m = 0; m < 4; ++m) _Pragma("unroll") for (int n = 0; n < 2; ++n) _Pragma("unroll") for (int k = 0; k < 2; ++k) \
    acc[ai][bj][m][n] = __builtin_amdgcn_mfma_f32_16x16x32_bf16(Bt[n][k], At[m][k], acc[ai][bj][m][n], 0, 0, 0); __builtin_amdgcn_s_setprio(0); } while (0)
#define G_WAIT_V(n) asm volatile("s_waitcnt vmcnt(" #n ")" ::: "memory")
#define G_WAIT_L(n) asm volatile("s_waitcnt lgkmcnt(" #n ")" ::: "memory")
#define G_BAR __builtin_amdgcn_s_barrier()
#define G_SCHED __builtin_amdgcn_sched_barrier(0)
  int cpm, cpn, npm = 0, npn = 0, ui = 0, ckb = 0, cnt = nt, nkb = 0, nnt = nt;
  if (!S.template next_m<MODE>(0, cpm, cpn, ckb, cnt, nt)) return;
  f32x4 acc[2][2][4][2];
#pragma unroll
  for (int a = 0; a < 2; ++a)
#pragma unroll
    for (int b = 0; b < 2; ++b)
#pragma unroll
      for (int m = 0; m < 4; ++m)
#pragma unroll
        for (int n = 0; n < 2; ++n) acc[a][b][m][n] = (f32x4){0.f, 0.f, 0.f, 0.f};
  bf16x8 At[4][2], B0[2][2], B1[2][2];
  const char* cA = (const char*)gA + (size_t)cpm * tstep + (size_t)ckb * kstep; const char* cB = (const char*)gBt + (size_t)(cpn & 255) * tstep + (size_t)ckb * kstep;
  G_STAGE(G_SB(0, 0), cB); G_STAGE(G_SA(0, 0), cA); G_STAGE(G_SB(0, 1), cB + hstep); G_STAGE(G_SA(0, 1), cA + hstep);
  if (wr == 1) G_BAR;
  G_WAIT_V(4); G_BAR;
  G_STAGE(G_SB(1, 0), cB + kstep); G_STAGE(G_SA(1, 0), cA + kstep); G_STAGE(G_SB(1, 1), cB + hstep + kstep);
  G_WAIT_V(6); G_BAR;
  for (;;) {
    const bool has_next = S.template next_m<MODE>(ui + 1, npm, npn, nkb, nnt, nt);
    const char* nA = has_next ? (const char*)gA + (size_t)npm * tstep + (size_t)nkb * kstep : cA; const char* nB = has_next ? (const char*)gBt + (size_t)(npn & 255) * tstep + (size_t)nkb * kstep : cB;
    for (int t = 0; t < cnt; t += 2) {
      const bool last = (t == cnt - 2);
      const char* a1 = cA + (size_t)(t + 1) * kstep;
      const char* a2 = last ? nA : cA + (size_t)(t + 2) * kstep; const char* b2 = last ? nB : cB + (size_t)(t + 2) * kstep;
      const char* a3 = a2 + kstep; const char* b3 = b2 + kstep;
      G_LDB(B0, 0, 0); G_SCHED; G_LDA(At, 0, 0); G_STAGE(G_SA(1, 1), a1 + hstep);
      G_WAIT_L(8); G_BAR; G_WAIT_L(0); G_MMA(0, 0, At, B0); G_BAR; G_SCHED;
      G_LDB(B1, 0, 1); G_STAGE(G_SB(0, 0), b2);
      G_BAR; G_WAIT_L(0); G_MMA(0, 1, At, B1); G_BAR;
      G_LDA(At, 0, 1); G_STAGE(G_SA(0, 0), a2);
      G_BAR; G_WAIT_L(0); G_MMA(1, 0, At, B0); G_BAR; G_SCHED;
      G_STAGE(G_SB(0, 1), b2 + hstep);
      G_WAIT_V(6); G_BAR; G_MMA(1, 1, At, B1); G_BAR;
      G_LDB(B0, 1, 0); G_SCHED; G_LDA(At, 1, 0); G_STAGE(G_SA(0, 1), a2 + hstep);
      G_WAIT_L(8); G_BAR; G_WAIT_L(0); G_MMA(0, 0, At, B0); G_BAR; G_SCHED;
      G_LDB(B1, 1, 1); G_STAGE(G_SB(1, 0), b3);
      G_BAR; G_WAIT_L(0); G_MMA(0, 1, At, B1); G_BAR;
      G_LDA(At, 1, 1); G_STAGE(G_SA(1, 0), a3);
      G_BAR; G_WAIT_L(0); G_MMA(1, 0, At, B0); G_BAR; G_SCHED;
      G_STAGE(G_SB(1, 1), b3 + hstep);
      G_WAIT_V(6); G_BAR; G_MMA(1, 1, At, B1); G_BAR;
    }
    asm volatile("s_nop 15\n\ts_nop 15" ::: "memory");
    E(acc, cpm, cpn, wr, wc, fr, fq, lds);
    if (!has_next) break;
#pragma unroll
    for (int a = 0; a < 2; ++a)
#pragma unroll
      for (int b = 0; b < 2; ++b)
#pragma unroll
        for (int m = 0; m < 4; ++m)
#pragma unroll
          for (int n = 0; n < 2; ++n) acc[a][b][m][n] = (f32x4){0.f, 0.f, 0.f, 0.f};
    cpm = npm; cpn = npn; cA = nA; cB = nB; cnt = nnt; ++ui;
  }
  G_WAIT_V(0);
  if (wr == 0) G_BAR;
  G_BAR;
}

struct EpiZ {
  bf16_t* Z; float* gates; const float* bgate;
  __device__ __forceinline__ void operator()(f32x4 (&acc)[2][2][4][2], int pm, int pn, int wr, int wc, int fr, int fq, LAS unsigned char*) const {
    const int row0 = pm * BM + wr * 64 + fr, col0 = pn * BM + wc * 32 + 8 * fq;
    if (pn == 14) {
      if (wc == 0 && fq < 2) {
        f32x4 bg[2]; bg[0] = *(const f32x4*)(bgate + 8 * fq); bg[1] = *(const f32x4*)(bgate + 8 * fq + 4);
#pragma unroll
        for (int ai = 0; ai < 2; ++ai)
#pragma unroll
          for (int m = 0; m < 4; ++m) {
            float* gp = gates + (size_t)(row0 + ai * HALF + m * 16) * 16 + 8 * fq;
#pragma unroll
            for (int n = 0; n < 2; ++n) {
              f32x4 v = acc[ai][0][m][n] + bg[n];
              if (n == 1) {
#pragma unroll
                for (int e = 0; e < 4; ++e) v[e] = fminf(v[e], 0.f) - log1pf(__expf(-fabsf(v[e])));
              }
              *(f32x4*)(gp + 4 * n) = v;
            }
          }
      }
      return;
    }
#pragma unroll
    for (int ai = 0; ai < 2; ++ai)
#pragma unroll
      for (int m = 0; m < 4; ++m) {
        bf16_t* rowp = Z + (size_t)(row0 + ai * HALF + m * 16) * NZ + col0;
#pragma unroll
        for (int bj = 0; bj < 2; ++bj) { const f32x4 v0 = acc[ai][bj][m][0], v1 = acc[ai][bj][m][1];
          u32x4 o; o.x = cvt_pk_bf16(v0[0], v0[1]); o.y = cvt_pk_bf16(v0[2], v0[3]); o.z = cvt_pk_bf16(v1[0], v1[1]); o.w = cvt_pk_bf16(v1[2], v1[3]);
          *(u32x4*)(rowp + bj * HALF) = o; }
      }
  }
};

struct EpiNone {
  bf16_t* Z;
  __device__ __forceinline__ void operator()(f32x4 (&acc)[2][2][4][2], int pm, int pn, int wr, int wc, int fr, int fq, LAS unsigned char*) const {
    f32x4 s = (f32x4){0.f, 0.f, 0.f, 0.f};
#pragma unroll
    for (int ai = 0; ai < 2; ++ai)
#pragma unroll
      for (int bj = 0; bj < 2; ++bj)
#pragma unroll
        for (int m = 0; m < 4; ++m)
#pragma unroll
          for (int n = 0; n < 2; ++n) s += acc[ai][bj][m][n];
    if (s[0] + s[1] + s[2] + s[3] == 12345.678f) Z[pm + pn] = 1;
  }
};

struct EpiX1 {
  const float* xp; const float* xs; const float* mod; const float* norm2; float* x1out; bf16_t* x1g; float* rowss;
  __device__ __forceinline__ void operator()(f32x4 (&acc)[2][2][4][2], int pm, int pn, int wr, int wc, int fr, int fq, LAS unsigned char*) const {
    const int g = pm < 16 ? 4 : ((pm - 16) >> 4);
    const float* modg = mod + g * NMOD;
    const int col0 = pn * BM + wc * 32 + 4 * fq;
    f32x4 g1[2][2], g2[2][2];
#pragma unroll
    for (int bj = 0; bj < 2; ++bj)
#pragma unroll
      for (int n = 0; n < 2; ++n) { const int c = col0 + bj * HALF + n * 16; g1[bj][n] = *(const f32x4*)(modg + 2048 + c); const f32x4 s2 = *(const f32x4*)(modg + 4096 + c); const f32x4 nv = *(const f32x4*)(norm2 + c); g2[bj][n] = nv * (s2 + 1.0f); }
#pragma unroll
    for (int ai = 0; ai < 2; ++ai)
#pragma unroll
      for (int m = 0; m < 4; ++m) {
        const int T = pm * BM + ai * HALF + wr * 64 + m * 16 + fr;
        const float* xrow = (T < NCTXT) ? xp + (size_t)T * DM : xs + (size_t)(T - NCTXT) * DM;
        const int p = permtok(T);
        float ss = 0.f;
#pragma unroll
        for (int bj = 0; bj < 2; ++bj)
#pragma unroll
          for (int n = 0; n < 2; ++n) {
            const int c = col0 + bj * HALF + n * 16;
            const f32x4 xv = *(const f32x4*)(xrow + c);
            const f32x4 v = xv + g1[bj][n] * acc[ai][bj][m][n];
            *(f32x4*)(x1out + (size_t)T * DM + c) = v;
            ss += v[0] * v[0] + v[1] * v[1] + v[2] * v[2] + v[3] * v[3];
            const f32x4 w = v * g2[bj][n];
            u32x2 o; o.x = cvt_pk_bf16(w[0], w[1]); o.y = cvt_pk_bf16(w[2], w[3]);
            *(u32x2*)(x1g + (size_t)p * DM + c) = o;
          }
        ss += __shfl_xor(ss, 16); ss += __shfl_xor(ss, 32);
        if (fq == 0) __hip_atomic_fetch_add(rowss + p, ss, __ATOMIC_RELAXED, __HIP_MEMORY_SCOPE_AGENT);
      }
  }
};

struct EpiDown {
  const float* mod; float* out; float* rowss2;
  __device__ __forceinline__ void operator()(f32x4 (&acc)[2][2][4][2], int pm, int pn, int wr, int wc, int fr, int fq, LAS unsigned char*) const {
    const int g = pm < 16 ? 4 : ((pm - 16) >> 4);
    const float* modg = mod + g * NMOD;
    const int col0 = pn * BM + wc * 32 + 4 * fq;
    f32x4 g2[2][2];
#pragma unroll
    for (int bj = 0; bj < 2; ++bj)
#pragma unroll
      for (int n = 0; n < 2; ++n) g2[bj][n] = *(const f32x4*)(modg + 5120 + col0 + bj * HALF + n * 16);
#pragma unroll
    for (int ai = 0; ai < 2; ++ai)
#pragma unroll
      for (int m = 0; m < 4; ++m) {
        const int p = pm * BM + ai * HALF + wr * 64 + m * 16 + fr;
        const int T = permtok(p);
        float* orow = out + (size_t)T * DM;
        float ss = 0.f;
#pragma unroll
        for (int bj = 0; bj < 2; ++bj)
#pragma unroll
          for (int n = 0; n < 2; ++n) {
            const int c = col0 + bj * HALF + n * 16;
            const f32x4 xv = *(const f32x4*)(orow + c);
            const f32x4 v = xv + g2[bj][n] * acc[ai][bj][m][n];
            *(f32x4*)(orow + c) = v;
            ss += v[0] * v[0] + v[1] * v[1] + v[2] * v[2] + v[3] * v[3];
          }
        ss += __shfl_xor(ss, 16); ss += __shfl_xor(ss, 32);
        if (fq == 0) __hip_atomic_fetch_add(rowss2 + T, ss, __ATOMIC_RELAXED, __HIP_MEMORY_SCOPE_AGENT);
      }
  }
};

struct EpiDownPart {
  const float* mod; float* out; float* part;
  __device__ __forceinline__ void operator()(f32x4 (&acc)[2][2][4][2], int pm, int pnk, int wr, int wc, int fr, int fq, LAS unsigned char*) const {
    const int pn = pnk & 255, kq = pnk >> 8;
    const int g = pm < 16 ? 4 : ((pm - 16) >> 4);
    const float* modg = mod + g * NMOD;
    const int col0 = pn * BM + wc * 32 + 4 * fq;
    f32x4 g2[2][2];
#pragma unroll
    for (int bj = 0; bj < 2; ++bj)
#pragma unroll
      for (int n = 0; n < 2; ++n) g2[bj][n] = *(const f32x4*)(modg + 5120 + col0 + bj * HALF + n * 16);
#pragma unroll
    for (int ai = 0; ai < 2; ++ai)
#pragma unroll
      for (int m = 0; m < 4; ++m) {
        const int p = pm * BM + ai * HALF + wr * 64 + m * 16 + fr;
        const int T = permtok(p);
        if (kq == 0) {
          float* orow = out + (size_t)T * DM;
#pragma unroll
          for (int bj = 0; bj < 2; ++bj)
#pragma unroll
            for (int n = 0; n < 2; ++n) { const int c = col0 + bj * HALF + n * 16; const f32x4 xv = *(const f32x4*)(orow + c); *(f32x4*)(orow + c) = xv + g2[bj][n] * acc[ai][bj][m][n]; }
        } else {
          float* prow = part + ((size_t)(kq - 1) * 4096 + (T - 16384)) * DM;
#pragma unroll
          for (int bj = 0; bj < 2; ++bj)
#pragma unroll
            for (int n = 0; n < 2; ++n) { const int c = col0 + bj * HALF + n * 16; *(f32x4*)(prow + c) = g2[bj][n] * acc[ai][bj][m][n]; }
        }
      }
  }
};

struct EpiUp {
  const float* rowss1; const float* sb; const float* cw; const float* cb; bf16_t* act;
  __device__ __forceinline__ void operator()(f32x4 (&acc)[2][2][4][2], int pm, int pn, int wr, int wc, int fr, int fq, LAS unsigned char* lds) const {
    asm volatile("" : "+v"(fr), "+v"(fq));
    const bool ctx = pm < 16;
    const int g = ctx ? 4 : ((pm - 16) >> 4);
    const float* sbg = sb + g * NUP;
    LAS float* halo = (LAS float*)(lds + 131072);
    const int prow0 = pm * BM + wr * 64 + fr;
    {
      float rs[2][4];
#pragma unroll
      for (int ai = 0; ai < 2; ++ai)
#pragma unroll
        for (int m = 0; m < 4; ++m) rs[ai][m] = __builtin_amdgcn_rsqf(rowss1[prow0 + ai * HALF + m * 16] * (1.0f / 1024.0f) + EPS);
#pragma unroll
      for (int bj = 0; bj < 2; ++bj)
#pragma unroll
        for (int n = 0; n < 2; ++n) {
          asm volatile("" ::: "memory"); __builtin_amdgcn_sched_barrier(0);
          const f32x4 sv = *(const f32x4*)(sbg + bj * DFF + pn * HALF + wc * 32 + 8 * fq + 4 * n);
#pragma unroll
          for (int ai = 0; ai < 2; ++ai)
#pragma unroll
            for (int m = 0; m < 4; ++m) { acc[ai][bj][m][n] = acc[ai][bj][m][n] * rs[ai][m] + sv; asm volatile("" : "+v"(acc[ai][bj][m][n])); }
        }
    }
    if (ctx) {
#pragma unroll
      for (int ai = 0; ai < 2; ++ai)
#pragma unroll
        for (int bj = 0; bj < 2; ++bj)
#pragma unroll
          for (int n = 0; n < 2; ++n) {
            const int rb = 2 * ai + wr, colt = bj * HALF + wc * 32 + 8 * fq + 4 * n;
            if (fr == 0) *(LAS f32x4*)(halo + (rb * 2 + 0) * 256 + colt) = acc[ai][bj][0][n];
            if (fr == 15) *(LAS f32x4*)(halo + (rb * 2 + 1) * 256 + colt) = acc[ai][bj][3][n];
          }
      asm volatile("s_waitcnt lgkmcnt(0)" ::: "memory");
      __builtin_amdgcn_s_barrier();
      __builtin_amdgcn_s_barrier();
      asm volatile("" ::: "memory");
    }
#pragma unroll
    for (int ai = 0; ai < 2; ++ai) {
      u32x2 st[4];
#pragma unroll
      for (int n = 0; n < 2; ++n) {
        f32x4 ya[4];
        const int rb = 2 * ai + wr;
#pragma unroll
        for (int bj = 0; bj < 2; ++bj) {
          const int cnat = bj * DFF + pn * HALF + wc * 32 + 8 * fq + 4 * n, colt = bj * HALF + wc * 32 + 8 * fq + 4 * n;
          const f32x4 w0 = *(const f32x4*)(cw + cnat), w1 = *(const f32x4*)(cw + NUP + cnat), w2 = *(const f32x4*)(cw + 2 * NUP + cnat), bb = *(const f32x4*)(cb + cnat);
          f32x4 hp = (f32x4){0.f, 0.f, 0.f, 0.f}, hn = hp;
          if (ctx) {
            if (rb > 0) hp = *(const LAS f32x4*)(halo + ((rb - 1) * 2 + 1) * 256 + colt);
            if (rb < 3) hn = *(const LAS f32x4*)(halo + ((rb + 1) * 2 + 0) * 256 + colt);
          }
#pragma unroll
          for (int m = 0; m < 4; ++m) {
            const f32x4 cur = acc[ai][bj][m][n];
            f32x4 prev, next;
#pragma unroll
            for (int e = 0; e < 4; ++e) {
              if (m > 0) { const float snd = (fr == 15) ? acc[ai][bj][m > 0 ? m - 1 : 0][n][e] : cur[e]; prev[e] = dppf<0x121>(snd); }
              else { const float rcv = dppf<0x121>(cur[e]); prev[e] = (fr == 0) ? hp[e] : rcv; }
              if (m < 3) { const float snd = (fr == 0) ? acc[ai][bj][m < 3 ? m + 1 : 3][n][e] : cur[e]; next[e] = dppf<0x12F>(snd); }
              else { const float rcv = dppf<0x12F>(cur[e]); next[e] = (fr == 15) ? hn[e] : rcv; }
            }
            const f32x4 y = w0 * prev + w1 * cur + w2 * next + bb;
            if (bj == 0) ya[m] = y;
            else {
              float o[4];
#pragma unroll
              for (int e = 0; e < 4; ++e) o[e] = y[e] * fast_sigmoid(y[e]) * ya[m][e];
              u32x2 ov; ov.x = cvt_pk_bf16(o[0], o[1]); ov.y = cvt_pk_bf16(o[2], o[3]);
              if (n == 0) st[m] = ov;
              else { u32x4 o4; o4.x = st[m].x; o4.y = st[m].y; o4.z = ov.x; o4.w = ov.y;
                *(u32x4*)(act + (size_t)(prow0 + ai * HALF + m * 16) * DFF + pn * HALF + wc * 32 + 8 * fq) = o4; }
            }
          }
        }
      }
    }
  }
};

template <bool SILU>
__device__ __forceinline__ void gemv5_unit(const Params& P, int unit, int ncb, const float* W, int ldw, float* outp, int ldo, const float* bias, const float* modv, float* sm) {
  const int tid = opaque_tid();
  const int cb = unit % ncb, ks = unit / ncb, n0 = cb * 256, k0 = ks * 128;
  float* sv = sm; float* red = sm + 640;
  for (int i = tid; i < 640; i += 512) {
    const int g = i >> 7, k = k0 + (i & 127);
    float v;
    if (SILU) { v = (g < 4) ? P.c[g * DM + k] : P.c_ctx[k]; v = v / (1.0f + __expf(-v)); }
    else v = modv[g * NMOD + 3072 + k];
    sv[i] = v;
  }
  __syncthreads();
  const int col = tid & 255, kh = tid >> 8;
  float a0 = 0.f, a1 = 0.f, a2 = 0.f, a3 = 0.f, a4 = 0.f;
  const float* wp = W + (size_t)(k0 + kh * 64) * ldw + n0 + col;
#pragma unroll 8
  for (int kk = 0; kk < 64; ++kk) {
    const float w = wp[(size_t)kk * ldw];
    const int ki = kh * 64 + kk;
    a0 += sv[ki] * w; a1 += sv[128 + ki] * w; a2 += sv[256 + ki] * w; a3 += sv[384 + ki] * w; a4 += sv[512 + ki] * w;
  }
  if (kh == 1) { red[col] = a0; red[256 + col] = a1; red[512 + col] = a2; red[768 + col] = a3; red[1024 + col] = a4; }
  __syncthreads();
  if (kh == 0) {
    const float bv = (bias != nullptr && ks == 0) ? bias[n0 + col] : 0.f;
    a0 += red[col] + bv; a1 += red[256 + col] + bv; a2 += red[512 + col] + bv; a3 += red[768 + col] + bv; a4 += red[1024 + col] + bv;
    float* o = outp + n0 + col;
    __hip_atomic_fetch_add(o, a0, __ATOMIC_RELAXED, __HIP_MEMORY_SCOPE_AGENT);
    __hip_atomic_fetch_add(o + ldo, a1, __ATOMIC_RELAXED, __HIP_MEMORY_SCOPE_AGENT);
    __hip_atomic_fetch_add(o + 2 * ldo, a2, __ATOMIC_RELAXED, __HIP_MEMORY_SCOPE_AGENT);
    __hip_atomic_fetch_add(o + 3 * ldo, a3, __ATOMIC_RELAXED, __HIP_MEMORY_SCOPE_AGENT);
    __hip_atomic_fetch_add(o + 4 * ldo, a4, __ATOMIC_RELAXED, __HIP_MEMORY_SCOPE_AGENT);
  }
  __syncthreads();
}

struct TrUnit { const float* src; bf16_t* dst; int ldw, ldd, perm; };
__device__ __forceinline__ void tr_decode(const Params& P, int v, TrUnit& t) {
  bf16_t* WinT = (bf16_t*)(P.ws + WS_WIN); bf16_t* WoutT = (bf16_t*)(P.ws + WS_WOUT); bf16_t* WupT = (bf16_t*)(P.ws + WS_WUP); bf16_t* WdnT = (bf16_t*)(P.ws + WS_WDN);
  if (v < 896) { const int kt = v / 56, ntl = v % 56; t.src = P.w_in + (size_t)(kt * 64) * DIN + ntl * 64; t.ldw = DIN; t.dst = WinT + (size_t)(ntl * 64) * DM + kt * 64; t.ldd = DM; t.perm = 1; }
  else if (v < 1152) { const int w = v - 896, kt = w >> 4, ntl = w & 15; t.src = P.w_out + (size_t)(kt * 64) * DM + ntl * 64; t.ldw = DM; t.dst = WoutT + (size_t)(ntl * 64) * DM + kt * 64; t.ldd = DM; t.perm = 0; }
  else if (v < 2560) { const int w = v - 1152, kt = w / 88, ntl = w % 88; const int n0 = ntl * 64, half = n0 / DFF, r = n0 % DFF, pn = r >> 7, cc = r & 127;
    t.src = P.w_up + (size_t)(kt * 64) * NUP + n0; t.ldw = NUP; t.dst = WupT + (size_t)(pn * 256 + half * 128 + cc) * DM + kt * 64; t.ldd = DM; t.perm = 1; }
  else { const int w = v - 2560, kt = w >> 4, ntl = w & 15; t.src = P.w_down + (size_t)(kt * 64) * DM + ntl * 64; t.ldw = DM; t.dst = WdnT + (size_t)(ntl * 64) * DFF + kt * 64; t.ldd = DFF; t.perm = 0; }
}
__device__ __forceinline__ void transpose_range(const Params& P, float* tile, int rank, int nrank, int vfirst, int vend) {
  const int tid = opaque_tid();
  const int r = tid >> 4, c4 = (tid & 15) * 4, nn = tid >> 3, kk8 = (tid & 7) * 8;
  int v = vfirst + rank;
  f32x4 p0 = (f32x4){0.f, 0.f, 0.f, 0.f}, p1 = p0; TrUnit cur;
  if (v < vend) { tr_decode(P, v, cur); p0 = *(const f32x4*)(cur.src + (size_t)r * cur.ldw + c4); p1 = *(const f32x4*)(cur.src + (size_t)(r + 32) * cur.ldw + c4); }
  while (v < vend) {
    { float* t = tile + r * 65 + c4; t[0] = p0[0]; t[1] = p0[1]; t[2] = p0[2]; t[3] = p0[3]; t += 32 * 65; t[0] = p1[0]; t[1] = p1[1]; t[2] = p1[2]; t[3] = p1[3]; }
    const int vn = v + nrank; TrUnit nxt = cur;
    if (vn < vend) tr_decode(P, vn, nxt);
    p0 = *(const f32x4*)(nxt.src + (size_t)r * nxt.ldw + c4); p1 = *(const f32x4*)(nxt.src + (size_t)(r + 32) * nxt.ldw + c4);
    __syncthreads();
    { float vv[8];
#pragma unroll
      for (int j = 0; j < 8; ++j) vv[j] = tile[(kk8 + j) * 65 + nn];
      u32x4 o; o.x = cvt_pk_bf16(vv[0], vv[1]); o.y = cvt_pk_bf16(vv[2], vv[3]); o.z = cvt_pk_bf16(vv[4], vv[5]); o.w = cvt_pk_bf16(vv[6], vv[7]);
      const int c5 = nn & 31, nnp = cur.perm ? ((nn & 32) + ((c5 >> 2) & 1) * 16 + (c5 >> 3) * 4 + (c5 & 3)) : nn;
      *(u32x4*)(cur.dst + (size_t)nnp * cur.ldd + kk8) = o; }
    __syncthreads();
    cur = nxt; v = vn;
  }
}
constexpr int NTR_WIN = 896, NTR_ALL = 896 + 256 + 1408 + 704;
__device__ void phase0a(const Params& P, float* sm) {
  float* mod = (float*)(P.ws + WS_MOD);
  for (int u = blockIdx.x; u < 24 * 8; u += gridDim.x) gemv5_unit<true>(P, u, 24, P.w_mod, NMOD, mod, NMOD, P.b_mod, nullptr, sm);
  transpose_range(P, sm, gridDim.x - 1 - blockIdx.x, gridDim.x, 0, NTR_WIN);
  if (blockIdx.x == gridDim.x - 1) {
    const int tid = opaque_tid();
    bf16_t* WinT = (bf16_t*)(P.ws + WS_WIN);
    for (int i0 = 0; i0 < 32; i0 += 8) {
      float wv[8];
#pragma unroll
      for (int i = 0; i < 8; ++i) { const int idx = tid + 512 * (i0 + i); wv[i] = P.w_in[(size_t)(idx >> 4) * DIN + NZ + (idx & 15)]; }
#pragma unroll
      for (int i = 0; i < 8; ++i) { const int idx = tid + 512 * (i0 + i); const int g = idx & 15, k = idx >> 4; const int slot = ((g >> 2) & 1) * 16 + (g >> 3) * 4 + (g & 3);
        WinT[(size_t)(NZ + slot) * DM + k] = f2bf(wv[i]); }
    }
  }
}

__device__ void phase0b(const Params& P, float* sm) {
  const int tid = opaque_tid(), wid = tid >> 6, lane = tid & 63;
  const float* mod = (const float*)(P.ws + WS_MOD);
  float* sbv = (float*)(P.ws + WS_SB);
  bf16_t* H = (bf16_t*)(P.ws + WS_H);
  for (int u = blockIdx.x; u < 22 * 8; u += gridDim.x) gemv5_unit<false>(P, u, 22, P.w_up, NUP, sbv, NUP, nullptr, mod, sm + 16384);
  f32x4 xnext[4];
  { const int Tn = blockIdx.x * 8 + wid; const float* xr = (Tn < NCTXT) ? P.x_prompt + (size_t)Tn * DM : P.x_sample + (size_t)(Tn - NCTXT) * DM;
#pragma unroll
    for (int i = 0; i < 4; ++i) xnext[i] = *(const f32x4*)(xr + i * 256 + lane * 4); }
  for (int T = blockIdx.x * 8 + wid; T < NTOK; T += gridDim.x * 8) {
    const int g = T < NCTXT ? 4 : ((T - NCTXT) >> 12);
    const float* modg = mod + g * NMOD;
    f32x4 xv[4]; float ss = 0.f;
#pragma unroll
    for (int i = 0; i < 4; ++i) xv[i] = xnext[i];
    { int Tn = T + gridDim.x * 8; Tn = Tn < NTOK ? Tn : T;
      const float* xr = (Tn < NCTXT) ? P.x_prompt + (size_t)Tn * DM : P.x_sample + (size_t)(Tn - NCTXT) * DM;
#pragma unroll
      for (int i = 0; i < 4; ++i) xnext[i] = *(const f32x4*)(xr + i * 256 + lane * 4); }
#pragma unroll
    for (int i = 0; i < 4; ++i) ss += xv[i][0] * xv[i][0] + xv[i][1] * xv[i][1] + xv[i][2] * xv[i][2] + xv[i][3] * xv[i][3];
#pragma unroll
    for (int o = 1; o < 64; o <<= 1) ss += __shfl_xor(ss, o);
    const float rstd = rsqrtf(ss * (1.0f / 1024.0f) + EPS);
    f32x4 hv[4];
#pragma unroll
    for (int i = 0; i < 4; ++i) {
      const int c = i * 256 + lane * 4;
      const f32x4 nv = *(const f32x4*)(P.norm1 + c), sc = *(const f32x4*)(modg + 1024 + c), sh = *(const f32x4*)(modg + c);
      hv[i] = xv[i] * rstd * nv * (sc + 1.0f) + sh;
      u32x2 o; o.x = cvt_pk_bf16(hv[i][0], hv[i][1]); o.y = cvt_pk_bf16(hv[i][2], hv[i][3]);
      *(u32x2*)(H + (size_t)T * DM + c) = o;
    }
  }
  __syncthreads();
}

__device__ __forceinline__ void unit_info(int u, int& T0, int& nc, int& b, int& h, int& c) {
  if (u < 128) { nc = 2; b = u >> 3; h = (u >> 1) & 3; c = u & 1; T0 = b * 256 + c * 128; }
  else { const int v = u - 128; nc = 32; b = v >> 7; h = (v >> 5) & 3; c = v & 31; T0 = NCTXT + b * 4096 + c * 128; }
}
struct ScanOut { float beta0, beta1, cf0, cf1, pm0, pm1, bl, cmax; int t0, t1; };
__device__ __forceinline__ void chunk_scan(const float* gates, int T0, int h, int d, int lane, ScanOut& o) {
  const int t0 = d ? 127 - 2 * lane : 2 * lane, t1 = d ? t0 - 1 : t0 + 1;
  const float* g0 = gates + (size_t)(T0 + t0) * 16 + d * 8 + h; const float* g1 = gates + (size_t)(T0 + t1) * 16 + d * 8 + h;
  const float i0 = g0[0], f0 = g0[4], i1 = g1[0], f1 = g1[4];
  const float s = f0 + f1;
  float x = s;
#pragma unroll
  for (int off = 1; off < 64; off <<= 1) { const float y = __shfl_up(x, off); if (lane >= off) x += y; }
  const float excl = x - s;
  o.beta0 = excl + f0; o.beta1 = x;
  o.cf0 = i0 - o.beta0; o.cf1 = i1 - o.beta1;
  float mx = fmaxf(o.cf0, o.cf1);
#pragma unroll
  for (int off = 1; off < 64; off <<= 1) { const float y = __shfl_up(mx, off); if (lane >= off) mx = fmaxf(mx, y); }
  const float mex = __shfl_up(mx, 1);
  o.pm0 = lane ? fmaxf(mex, o.cf0) : o.cf0; o.pm1 = mx;
  o.bl = __shfl(x, 63); o.cmax = __shfl(mx, 63);
  o.t0 = t0; o.t1 = t1;
}

constexpr int LROW = 136;
constexpr int CST_ELEMS = 129 * 128;

__device__ void shortconv_items(const Params& P) {
  const bf16_t* Z = (const bf16_t*)(P.ws + WS_Z);
  bf16_t* ucat = (bf16_t*)(P.ws + WS_UCAT);
  const int tid = opaque_tid(), wid = tid >> 6, lane = tid & 63, cgp = lane * 8;
  float w0[8], w1[8], w2[8], bb[8];
#pragma unroll
  for (int q = 0; q < 2; ++q) {
    const f32x4 a = *(const f32x4*)(P.conv_sc_w + cgp + q * 4), b = *(const f32x4*)(P.conv_sc_w + 512 + cgp + q * 4), cc = *(const f32x4*)(P.conv_sc_w + 1024 + cgp + q * 4), d = *(const f32x4*)(P.conv_sc_b + cgp + q * 4);
#pragma unroll
    for (int e = 0; e < 4; ++e) { w0[q * 4 + e] = a[e]; w1[q * 4 + e] = b[e]; w2[q * 4 + e] = cc[e]; bb[q * 4 + e] = d[e]; }
  }
  int Tb, Te;
  { const int G = gridDim.x, nhi = 640 % G == 0 ? G : 640 % G;
    const int wlo = 1, whi = (nhi < G) ? 5 : 1;
    const long tot = (long)nhi * wlo + (long)(G - nhi) * whi;
    const int b = blockIdx.x;
    const long s0 = b < nhi ? (long)b * wlo : (long)nhi * wlo + (long)(b - nhi) * whi, s1 = s0 + (b < nhi ? wlo : whi);
    const int r0 = (int)((long)NTOK * s0 / tot), r1 = (int)((long)NTOK * s1 / tot);
    const int n = r1 - r0, per = (n + 7) >> 3;
    Tb = r0 + wid * per; Te = Tb + per < r1 ? Tb + per : r1; }
  if (Tb >= Te) return;
  auto loadu = [&](int T, float (&u)[8]) {
    const int Tc = T < 0 ? 0 : (T >= NTOK ? NTOK - 1 : T);
    const bf16_t* zr = Z + (size_t)Tc * NZ + cgp;
    const u32x4 c = *(const u32x4*)(zr + 512), x = *(const u32x4*)(zr + 1024);
#pragma unroll
    for (int q = 0; q < 4; ++q) { u[2 * q] = bflo(c[q]) * bflo(x[q]); u[2 * q + 1] = bfhi(c[q]) * bfhi(x[q]); }
  };
  float up[8], uc[8], un[8];
  loadu(Tb - 1, up); loadu(Tb, uc);
  for (int T = Tb; T < Te; ++T) {
    loadu(T + 1, un);
    const u32x4 sbq = *(const u32x4*)(Z + (size_t)T * NZ + cgp);
    const int pos = (T < NCTXT) ? (T & 255) : ((T - NCTXT) & 63), lastp = (T < NCTXT) ? 255 : 63;
    const float mp = pos != 0 ? 1.f : 0.f, mn = pos != lastp ? 1.f : 0.f;
    float o[8];
#pragma unroll
    for (int q = 0; q < 4; ++q) {
      o[2 * q] = bflo(sbq[q]) * (w0[2 * q] * (mp * up[2 * q]) + w1[2 * q] * uc[2 * q] + w2[2 * q] * (mn * un[2 * q]) + bb[2 * q]);
      o[2 * q + 1] = bfhi(sbq[q]) * (w0[2 * q + 1] * (mp * up[2 * q + 1]) + w1[2 * q + 1] * uc[2 * q + 1] + w2[2 * q + 1] * (mn * un[2 * q + 1]) + bb[2 * q + 1]);
    }
    u32x4 ov; ov.x = cvt_pk_bf16(o[0], o[1]); ov.y = cvt_pk_bf16(o[2], o[3]); ov.z = cvt_pk_bf16(o[4], o[5]); ov.w = cvt_pk_bf16(o[6], o[7]);
    *(u32x4*)(ucat + (size_t)T * DM + cgp) = ov;
#pragma unroll
    for (int e = 0; e < 8; ++e) { up[e] = uc[e]; uc[e] = un[e]; }
  }
}

__device__ void phaseM1(const Params& P, LAS unsigned char* lds) {
  const int tid = opaque_tid(), wid = tid >> 6, lane = tid & 63, fr = lane & 15, fq = lane >> 4;
  const bf16_t* Z = (const bf16_t*)(P.ws + WS_Z);
  const float* gates = (const float*)(P.ws + WS_GATES);
  float* stat = (float*)(P.ws + WS_STAT);
  bf16_t* dC = (bf16_t*)P.out;
  LAS bf16_t* KT = (LAS bf16_t*)lds;
  LAS bf16_t* VT0 = (LAS bf16_t*)(lds + 34816);
  LAS bf16_t* VT1 = (LAS bf16_t*)(lds + 34816 + 36992);
  LAS float* ecs = (LAS float*)(lds + 34816 + 2 * 36992 + 4096);
  for (int u = blockIdx.x; u < 640; u += gridDim.x) {
    int T0, nc, b, h, c; unit_info(u, T0, nc, b, h, c);
    if (wid < 2) {
      ScanOut so; chunk_scan(gates, T0, h, wid, lane, so);
      ecs[wid * 128 + so.t0] = __expf(so.cf0 - so.cmax); ecs[wid * 128 + so.t1] = __expf(so.cf1 - so.cmax);
      if (lane == 0) { stat[(u * 2 + wid) * 2] = so.bl; stat[(u * 2 + wid) * 2 + 1] = so.cmax; }
    }
    __syncthreads();
    {
      const int s = 2 * (tid & 63);
#pragma unroll
      for (int i = 0; i < 2; ++i) {
        const int kg = (tid >> 6) + 8 * i;
        const bf16_t* zr = Z + (size_t)(T0 + s) * NZ + h * 128 + kg * 8;
        const u32x4 ka = *(const u32x4*)(zr + 2048), va = *(const u32x4*)(zr + 2560);
        const u32x4 kb = *(const u32x4*)(zr + NZ + 2048), vb = *(const u32x4*)(zr + NZ + 2560);
        const float e0a = ecs[s], e0b = ecs[s + 1], e1a = ecs[128 + s], e1b = ecs[128 + s + 1];
#pragma unroll
        for (int q = 0; q < 4; ++q) {
          const int r0 = (kg * 8 + 2 * q) * LROW + s, r1 = r0 + LROW;
          *(LAS unsigned*)(KT + r0) = (ka[q] & 0xffffu) | (kb[q] << 16);
          *(LAS unsigned*)(KT + r1) = (ka[q] >> 16) | (kb[q] & 0xffff0000u);
          const float al = bflo(va[q]), ah = bfhi(va[q]), bl_ = bflo(vb[q]), bh = bfhi(vb[q]);
          *(LAS unsigned*)(VT0 + r0) = cvt_pk_bf16_c(al * e0a, bl_ * e0b);
          *(LAS unsigned*)(VT0 + r1) = cvt_pk_bf16_c(ah * e0a, bh * e0b);
          *(LAS unsigned*)(VT1 + r0) = cvt_pk_bf16_c(al * e1a, bl_ * e1b);
          *(LAS unsigned*)(VT1 + r1) = cvt_pk_bf16_c(ah * e1a, bh * e1b);
        }
      }
      if (tid < 64) { *(LAS unsigned*)(VT0 + 128 * LROW + 2 * tid) = cvt_pk_bf16_c(ecs[2 * tid], ecs[2 * tid + 1]); *(LAS unsigned*)(VT1 + 128 * LROW + 2 * tid) = cvt_pk_bf16_c(ecs[128 + 2 * tid], ecs[128 + 2 * tid + 1]); }
    }
    __syncthreads();
    {
      bf16x8 Kf[4];
#pragma unroll
      for (int ks = 0; ks < 4; ++ks) Kf[ks] = *(const LAS bf16x8*)(KT + (16 * wid + fr) * LROW + 32 * ks + 8 * fq);
#pragma unroll
      for (int d = 0; d < 2; ++d) {
        LAS bf16_t* VT = d ? VT1 : VT0;
        bf16_t* dst = dC + (size_t)(u * 2 + d) * CST_ELEMS;
#pragma unroll
        for (int mt = 0; mt < 9; ++mt) {
          f32x4 a = (f32x4){0.f, 0.f, 0.f, 0.f};
#pragma unroll
          for (int ks = 0; ks < 4; ++ks) { const bf16x8 Vf = *(const LAS bf16x8*)(VT + (16 * mt + fr) * LROW + 32 * ks + 8 * fq); a = __builtin_amdgcn_mfma_f32_16x16x32_bf16(Kf[ks], Vf, a, 0, 0, 0); }
          if (mt < 8 || fr == 0) { u32x2 o; o.x = cvt_pk_bf16_c(a[0], a[1]); o.y = cvt_pk_bf16_c(a[2], a[3]); *(u32x2*)(dst + (16 * mt + fr) * 128 + 16 * wid + 4 * fq) = o; }
        }
      }
    }
    __syncthreads();
  }
}

template <int NC, int BLK, bool HASN>
__device__ __forceinline__ void m2_loop(const bf16_t* dC, bf16_t* Cst, float* mst, const float* sm, int ubase, int d, int e, int kn, bool wm, f32x4& C4, f32x4& n4, float& m) {
#pragma unroll 1
  for (int jb = 0; jb < NC; jb += BLK) {
    u32x2 dv[BLK], nv[BLK];
#pragma unroll
    for (int jj = 0; jj < BLK; ++jj) {
      const int j = jb + jj, c = d ? NC - 1 - j : j;
      const bf16_t* dp = dC + (size_t)((ubase + c) * 2 + d) * CST_ELEMS;
      dv[jj] = *(const u32x2*)(dp + e);
      if (HASN) nv[jj] = *(const u32x2*)(dp + 16384 + kn);
    }
#pragma unroll
    for (int jj = 0; jj < BLK; ++jj) {
      const int j = jb + jj, c = d ? NC - 1 - j : j;
      const int idx = (ubase + c) * 2 + d;
      bf16_t* cs = Cst + (size_t)idx * CST_ELEMS;
      { u32x2 o; o.x = cvt_pk_bf16(C4[0], C4[1]); o.y = cvt_pk_bf16(C4[2], C4[3]); *(u32x2*)(cs + e) = o; }
      if (HASN) { u32x2 o; o.x = cvt_pk_bf16(n4[0], n4[1]); o.y = cvt_pk_bf16(n4[2], n4[3]); *(u32x2*)(cs + 16384 + kn) = o; if (wm) mst[idx] = m; }
      const float bl = sm[2 * j], cmax = sm[2 * j + 1];
      const float mn = bl + fmaxf(m, cmax);
      const float decay = __expf(bl + m - mn), scale = __expf(bl + cmax - mn);
      const u32x2 dvv = dv[jj];
      C4[0] = decay * C4[0] + scale * bflo(dvv.x); C4[1] = decay * C4[1] + scale * bfhi(dvv.x); C4[2] = decay * C4[2] + scale * bflo(dvv.y); C4[3] = decay * C4[3] + scale * bfhi(dvv.y);
      if (HASN) { const u32x2 nvv = nv[jj];
        n4[0] = decay * n4[0] + scale * bflo(nvv.x); n4[1] = decay * n4[1] + scale * bfhi(nvv.x); n4[2] = decay * n4[2] + scale * bflo(nvv.y); n4[3] = decay * n4[3] + scale * bfhi(nvv.y); }
      m = mn;
    }
  }
}
template <int NC, int BLK>
__device__ __forceinline__ void m2_unit(const Params& P, bool lat, int sq, int slice, float* sm) {
  const int tid = opaque_tid();
  const bf16_t* dC = (const bf16_t*)P.out;
  bf16_t* Cst = (bf16_t*)(P.ws + WS_H);
  const float* stat = (const float*)(P.ws + WS_STAT);
  float* mst = (float*)(P.ws + WS_MST);
  const int b = sq >> 3, h = (sq >> 1) & 3, d = sq & 1;
  const int ubase = lat ? 128 + (b * 4 + h) * 32 : (b * 4 + h) * 2;
  const int e = slice * 2048 + tid * 4;
  const bool hasn = (slice == 0) && (tid < 64);
  const int kn = (tid & 31) * 4;
  if (tid < NC) { const int c = d ? NC - 1 - tid : tid; const int idx = (ubase + c) * 2 + d; sm[2 * tid] = stat[idx * 2]; sm[2 * tid + 1] = stat[idx * 2 + 1]; }
  f32x4 C4 = (f32x4){0.f, 0.f, 0.f, 0.f}, n4 = C4; float m = 0.f;
  const int sidx = (b * 2 + d) * 4 + h;
  if (lat) {
    C4 = *(const f32x4*)(P.state_C + (size_t)sidx * 16384 + e);
    n4 = *(const f32x4*)(P.state_n + sidx * 128 + kn);
    m = P.state_m[sidx];
  }
  __syncthreads();
  if (hasn) m2_loop<NC, BLK, true>(dC, Cst, mst, sm, ubase, d, e, kn, tid == 0, C4, n4, m);
  else m2_loop<NC, BLK, false>(dC, Cst, mst, sm, ubase, d, e, kn, false, C4, n4, m);
  if (!lat) {
    *(f32x4*)(P.out + OUT_TAIL + (size_t)sidx * 16384 + e) = C4;
    if (hasn) { *(f32x4*)(P.out + OUT_TAIL + 2097152 + sidx * 128 + kn) = n4; if (tid == 0) P.out[OUT_TAIL + 2097152 + 16384 + sidx] = m; }
  }
  __syncthreads();
}
__device__ void phaseM2(const Params& P, float* sm) {
  for (int unit = blockIdx.x; unit < 1280; unit += gridDim.x) {
    if (unit < 256) m2_unit<32, 16>(P, true, unit >> 3, unit & 7, sm);
    else { const int v = unit - 256; m2_unit<2, 2>(P, false, v >> 3, v & 7, sm); }
  }
}

__device__ __forceinline__ bf16x8 scale_frag(bf16x8 q, float s) {
  const u32x4 a = __builtin_bit_cast(u32x4, q); u32x4 r;
  r.x = cvt_pk_bf16_c(bflo(a.x) * s, bfhi(a.x) * s); r.y = cvt_pk_bf16_c(bflo(a.y) * s, bfhi(a.y) * s);
  r.z = cvt_pk_bf16_c(bflo(a.z) * s, bfhi(a.z) * s); r.w = cvt_pk_bf16_c(bflo(a.w) * s, bfhi(a.w) * s);
  return __builtin_bit_cast(bf16x8, r);
}

__device__ void phaseM3(const Params& P, LAS unsigned char* lds) {
  const int tid = opaque_tid(), wid = tid >> 6, lane = tid & 63, fr = lane & 15, fq = lane >> 4;
  const bf16_t* Z = (const bf16_t*)(P.ws + WS_Z);
  const float* gates = (const float*)(P.ws + WS_GATES);
  const bf16_t* Cst = (const bf16_t*)(P.ws + WS_H);
  const float* mst = (const float*)(P.ws + WS_MST);
  bf16_t* ucat = (bf16_t*)(P.ws + WS_UCAT);
  LAS bf16_t* Ks = (LAS bf16_t*)lds;
  LAS bf16_t* VT = (LAS bf16_t*)(lds + 34816);
  LAS bf16_t* Sb = (LAS bf16_t*)(lds + 34816 + 36992);
  LAS float* arr = (LAS float*)(lds + 34816 + 36992 + 34816);
  LAS float* ecA = arr; LAS float* erA = arr + 256; LAS float* wiA = arr + 512; LAS float* flA = arr + 768;
  LAS bf16_t* Cb = (LAS bf16_t*)(lds + 34816 + 36992 + 34816 + 4096);
  const float qs = 0.08838834764831845f;
  for (int u = blockIdx.x; u < 640; u += gridDim.x) {
    int T0, nc, b, h, c; unit_info(u, T0, nc, b, h, c);
    if (wid < 2) {
      const int d = wid;
      ScanOut so; chunk_scan(gates, T0, h, d, lane, so);
      const float mc = mst[u * 2 + d];
      const float mx0 = fmaxf(mc, so.pm0), mx1 = fmaxf(mc, so.pm1);
      ecA[d * 128 + so.t0] = __expf(so.cf0 - so.cmax); ecA[d * 128 + so.t1] = __expf(so.cf1 - so.cmax);
      erA[d * 128 + so.t0] = __expf(so.cmax - mx0) * qs; erA[d * 128 + so.t1] = __expf(so.cmax - mx1) * qs;
      wiA[d * 128 + so.t0] = __expf(mc - mx0) * qs; wiA[d * 128 + so.t1] = __expf(mc - mx1) * qs;
      flA[d * 128 + so.t0] = __expf(-(so.beta0 + mx0)); flA[d * 128 + so.t1] = __expf(-(so.beta1 + mx1));
    }
    {
      const int s = 2 * (tid & 63);
#pragma unroll
      for (int i = 0; i < 2; ++i) {
        const int kg = (tid >> 6) + 8 * i;
        const bf16_t* zr = Z + (size_t)(T0 + s) * NZ + h * 128 + kg * 8;
        const u32x4 ka = *(const u32x4*)(zr + 2048), va = *(const u32x4*)(zr + 2560);
        const u32x4 kb = *(const u32x4*)(zr + NZ + 2048), vb = *(const u32x4*)(zr + NZ + 2560);
        *(LAS u32x4*)(Ks + s * LROW + kg * 8) = ka;
        *(LAS u32x4*)(Ks + (s + 1) * LROW + kg * 8) = kb;
#pragma unroll
        for (int q = 0; q < 4; ++q) {
          const int r0 = (kg * 8 + 2 * q) * LROW + s, r1 = r0 + LROW;
          *(LAS unsigned*)(VT + r0) = (va[q] & 0xffffu) | (vb[q] << 16);
          *(LAS unsigned*)(VT + r1) = (va[q] >> 16) | (vb[q] & 0xffff0000u);
        }
      }
      if (tid < 64) *(LAS unsigned*)(VT + 128 * LROW + 2 * tid) = 0x3F803F80u;
    }
    u32x4 creg[5];
    {
      const bf16_t* cs0 = Cst + (size_t)(u * 2) * CST_ELEMS;
#pragma unroll
      for (int i = 0; i < 4; ++i) creg[i] = *(const u32x4*)(cs0 + (tid + 512 * i) * 8);
      creg[4] = *(const u32x4*)(cs0 + 16384 + (tid & 15) * 8);
#pragma unroll
      for (int i = 0; i < 4; ++i) { const int ci = tid + 512 * i; *(LAS u32x4*)(Cb + (ci >> 4) * LROW + (ci & 15) * 8) = creg[i]; }
      if (tid < 16) *(LAS u32x4*)(Cb + 128 * LROW + tid * 8) = creg[4];
    }
    __syncthreads();
    {
      const bf16_t* cs1 = Cst + (size_t)(u * 2 + 1) * CST_ELEMS;
#pragma unroll
      for (int i = 0; i < 4; ++i) creg[i] = *(const u32x4*)(cs1 + (tid + 512 * i) * 8);
      creg[4] = *(const u32x4*)(cs1 + 16384 + (tid & 15) * 8);
    }
    {
      const int w = wid;
      bf16x8 Qf[4];
      { const bf16_t* qr = Z + (size_t)(T0 + 16 * w + fr) * NZ + 1536 + h * 128 + 8 * fq;
#pragma unroll
        for (int ks = 0; ks < 4; ++ks) Qf[ks] = *(const bf16x8*)(qr + 32 * ks); }
      f32x4 hsum[8];
#pragma unroll
      for (int vt = 0; vt < 8; ++vt) hsum[vt] = (f32x4){0.f, 0.f, 0.f, 0.f};
      LAS bf16_t* Sw = Sb + w * 16 * LROW;
#pragma unroll
      for (int d = 0; d < 2; ++d) {
        if (d == 1) {
          __syncthreads();
#pragma unroll
          for (int i = 0; i < 4; ++i) { const int ci = tid + 512 * i; *(LAS u32x4*)(Cb + (ci >> 4) * LROW + (ci & 15) * 8) = creg[i]; }
          if (tid < 16) *(LAS u32x4*)(Cb + 128 * LROW + tid * 8) = creg[4];
          __syncthreads();
        }
        const int lo = d ? w : 0, hi = d ? 7 : w;
        const int ks_lo = lo >> 1, ks_hi = hi >> 1;
        float er4[4];
#pragma unroll
        for (int j = 0; j < 4; ++j) er4[j] = erA[d * 128 + 16 * w + 4 * fq + j];
#pragma unroll
        for (int nt = 0; nt < 8; ++nt) {
          if (nt >= 2 * ks_lo && nt <= 2 * ks_hi + 1) {
            f32x4 a = (f32x4){0.f, 0.f, 0.f, 0.f};
            if (nt >= lo && nt <= hi) {
#pragma unroll
              for (int ks = 0; ks < 4; ++ks) { const bf16x8 Kf = *(const LAS bf16x8*)(Ks + (16 * nt + fr) * LROW + 32 * ks + 8 * fq); a = __builtin_amdgcn_mfma_f32_16x16x32_bf16(Qf[ks], Kf, a, 0, 0, 0); }
              const float ecv = ecA[d * 128 + 16 * nt + fr];
#pragma unroll
              for (int j = 0; j < 4; ++j) {
                float val = a[j] * er4[j] * ecv;
                if (nt == w) { const int tl = 4 * fq + j; const bool ok = d ? (fr >= tl) : (fr <= tl); val = ok ? val : 0.f; }
                a[j] = val;
              }
            }
#pragma unroll
            for (int j = 0; j < 4; ++j) { const float nb = dppf<0x12F>(a[j]); if ((fr & 1) == 0) *(LAS unsigned*)(Sw + (4 * fq + j) * LROW + 16 * nt + fr) = cvt_pk_bf16_c(a[j], nb); }
          }
        }
        asm volatile("s_waitcnt lgkmcnt(0)" ::: "memory");
        f32x4 ao[9];
#pragma unroll
        for (int vt = 0; vt < 9; ++vt) ao[vt] = (f32x4){0.f, 0.f, 0.f, 0.f};
        const bf16x8 zf = (bf16x8){0, 0, 0, 0, 0, 0, 0, 0};
#pragma unroll
        for (int ks = 0; ks < 4; ++ks) {
          if (ks >= ks_lo && ks <= ks_hi) {
            const bf16x8 Sf = *(const LAS bf16x8*)(Sw + fr * LROW + 32 * ks + 8 * fq);
#pragma unroll
            for (int vt = 0; vt < 9; ++vt) {
              bf16x8 Vf = *(const LAS bf16x8*)(VT + (vt < 8 ? 16 * vt + fr : 128) * LROW + 32 * ks + 8 * fq);
              if (vt == 8 && fr != 0) Vf = zf;
              ao[vt] = __builtin_amdgcn_mfma_f32_16x16x32_bf16(Sf, Vf, ao[vt], 0, 0, 0);
            }
          }
        }
        {
          const float wv = wiA[d * 128 + 16 * w + fr];
#pragma unroll
          for (int ks = 0; ks < 4; ++ks) {
            const bf16x8 Qs = scale_frag(Qf[ks], wv);
#pragma unroll
            for (int vt = 0; vt < 9; ++vt) {
              bf16x8 Cf = *(const LAS bf16x8*)(Cb + (vt < 8 ? 16 * vt + fr : 128) * LROW + 32 * ks + 8 * fq);
              if (vt == 8 && fr != 0) Cf = zf;
              ao[vt] = __builtin_amdgcn_mfma_f32_16x16x32_bf16(Qs, Cf, ao[vt], 0, 0, 0);
            }
          }
        }
#pragma unroll
        for (int j = 0; j < 4; ++j) {
          const float den = __shfl(ao[8][j], lane & 48);
          const float fl = flA[d * 128 + 16 * w + 4 * fq + j];
          const float inv = 1.0f / fmaxf(fabsf(den), fl);
#pragma unroll
          for (int vt = 0; vt < 8; ++vt) hsum[vt][j] += ao[vt][j] * inv;
        }
        asm volatile("" ::: "memory");
      }
#pragma unroll
      for (int j = 0; j < 4; ++j) {
        float ms = 0.f;
#pragma unroll
        for (int vt = 0; vt < 8; ++vt) ms += hsum[vt][j] * hsum[vt][j];
        ms += __shfl_xor(ms, 1); ms += __shfl_xor(ms, 2); ms += __shfl_xor(ms, 4); ms += __shfl_xor(ms, 8);
        const float r = rsqrtf(ms * (1.0f / 128.0f) + EPS);
        const int T = T0 + 16 * w + 4 * fq + j;
#pragma unroll
        for (int vt = 0; vt < 8; ++vt) {
          const int col = h * 128 + 16 * vt + fr;
          const float og = bf2f(Z[(size_t)T * NZ + 3072 + col]);
          const float val = hsum[vt][j] * r * P.mh_norm[col] * fast_sigmoid(og);
          ucat[(size_t)T * DM + 512 + col] = f2bf_c(val);
        }
      }
    }
    __syncthreads();
  }
}

__device__ void phase7(const Params& P) {
  const int tid7 = opaque_tid(); const int wid = tid7 >> 6, lane = tid7 & 63;
  const float* rss2 = (const float*)(P.ws + WS_RSS2);
  f32x4 fn[4];
#pragma unroll
  for (int i = 0; i < 4; ++i) fn[i] = *(const f32x4*)(P.final_norm + i * 256 + lane * 4);
  const int stride = gridDim.x * 8;
  for (int T0 = blockIdx.x * 8 + wid; T0 < 16384; T0 += 5 * stride) {
    f32x4 v[5][4]; float r[5];
#pragma unroll
    for (int q = 0; q < 5; ++q) {
      int T = T0 + q * stride; T = T < 16384 ? T : 16383;
      r[q] = rss2[T];
#pragma unroll
      for (int i = 0; i < 4; ++i) v[q][i] = *(const f32x4*)(P.out + (size_t)T * DM + i * 256 + lane * 4);
    }
#pragma unroll
    for (int q = 0; q < 5; ++q) {
      const int T = T0 + q * stride;
      if (T < 16384) {
        const float rr = rsqrtf(r[q] * (1.0f / 1024.0f) + EPS);
#pragma unroll
        for (int i = 0; i < 4; ++i) *(f32x4*)(P.out + (size_t)T * DM + i * 256 + lane * 4) = v[q][i] * rr * fn[i];
      }
    }
  }
  {
    const float* part = (const float*)(P.ws + WS_H);
    for (int T = 16384 + blockIdx.x * 8 + wid; T < NTOK; T += stride) {
      f32x4 v[4], a1[4], a2[4], a3[4];
      const size_t ro = (size_t)(T - 16384) * DM;
#pragma unroll
      for (int i = 0; i < 4; ++i) { const int c = i * 256 + lane * 4;
        v[i] = *(const f32x4*)(P.out + (size_t)T * DM + c); a1[i] = *(const f32x4*)(part + ro + c);
        a2[i] = *(const f32x4*)(part + (size_t)4096 * DM + ro + c); a3[i] = *(const f32x4*)(part + (size_t)8192 * DM + ro + c); }
      float ss = 0.f;
#pragma unroll
      for (int i = 0; i < 4; ++i) { v[i] = v[i] + a1[i] + a2[i] + a3[i]; ss += v[i][0] * v[i][0] + v[i][1] * v[i][1] + v[i][2] * v[i][2] + v[i][3] * v[i][3]; }
#pragma unroll
      for (int o = 1; o < 64; o <<= 1) ss += __shfl_xor(ss, o);
      const float rr = rsqrtf(ss * (1.0f / 1024.0f) + EPS);
#pragma unroll
      for (int i = 0; i < 4; ++i) *(f32x4*)(P.out + (size_t)T * DM + i * 256 + lane * 4) = v[i] * rr * fn[i];
    }
  }
}


#define XB_TMO      128
#define XB_XCNT(j)  (256  + 64 * (j))
#define XB_XSUB(j)  (1280 + 64 * (j))
#define XB_XGEN(j)  (2304 + 64 * (j))
#define XB_TOP      3328
#define XB_TOPGEN   3392
#define XCD_BAR_WORDS 3456
#define XB_SPIN_CAP (1u << 18)
__device__ __forceinline__ unsigned xb_ld(unsigned* p)              { return __hip_atomic_load(p, __ATOMIC_RELAXED, __HIP_MEMORY_SCOPE_AGENT); }
__device__ __forceinline__ unsigned xb_add(unsigned* p, unsigned v) { return __hip_atomic_fetch_add(p, v, __ATOMIC_RELAXED, __HIP_MEMORY_SCOPE_AGENT); }
__device__ __forceinline__ unsigned xb_xcc_id() { return (unsigned)__builtin_amdgcn_s_getreg((3 << 11) | 20) & 0xFu; }
#define XB_SPIN(cond, bar) do { unsigned _sp = 0; while (cond) { __builtin_amdgcn_s_sleep(1); \
    if ((++_sp & 255u) == 0u) { if (xb_ld(&(bar)[XB_TMO])) break; if (_sp > XB_SPIN_CAP) { atomicAdd(&(bar)[XB_TMO], 1u); break; } } } } while (0)
struct XcdBarrier { unsigned* bar; unsigned x; volatile LAS unsigned* st; };
__device__ __forceinline__ XcdBarrier xcd_barrier_post(unsigned* bar, volatile LAS unsigned* st) {
  XcdBarrier b; b.bar = bar; b.x = xb_xcc_id(); b.st = st;
  if (threadIdx.x == 0) (void)xb_add(&bar[XB_XCNT(b.x)], 1u);
  return b;
}
__device__ __forceinline__ void xcd_barrier_complete(unsigned* bar, unsigned x, unsigned& nloc, unsigned& nx) {
  const unsigned G = gridDim.x * gridDim.y * gridDim.z;
  unsigned sum, cnt, mine, sp = 0u;
  for (;;) {
    sum = 0u; cnt = 0u; mine = 0u;
#pragma unroll
    for (unsigned j = 0; j < 16; ++j) { const unsigned c = xb_ld(&bar[XB_XCNT(j)]); sum += c; cnt += (c > 0u) ? 1u : 0u; mine = (j == x) ? c : mine; }
    if (sum == G) break;
    __builtin_amdgcn_s_sleep(1);
    if ((++sp & 255u) == 0u) { if (xb_ld(&bar[XB_TMO])) break; if (sp > XB_SPIN_CAP) { atomicAdd(&bar[XB_TMO], 1u); break; } }
  }
  nloc = mine > 0u ? mine : 1u; nx = cnt > 0u ? cnt : 1u;
}
__device__ __forceinline__ void xcd_barrier(const XcdBarrier& b) {
  asm volatile("s_waitcnt vmcnt(0) lgkmcnt(0)" ::: "memory");
  __syncthreads();
  if (threadIdx.x == 0) {
    unsigned* bar = b.bar;
    __builtin_amdgcn_s_waitcnt(0);
    unsigned nloc = b.st[0], nx = b.st[1];
    if (nloc == 0u) { xcd_barrier_complete(bar, b.x, nloc, nx); b.st[0] = nloc; b.st[1] = nx; }
    const unsigned old = xb_add(&bar[XB_XSUB(b.x)], 1u);
    const unsigned gen = old / nloc;
    if (old + 1u == (gen + 1u) * nloc) {
      __builtin_amdgcn_fence(__ATOMIC_RELEASE, "agent");
      asm volatile("s_waitcnt vmcnt(0)" ::: "memory");
      const unsigned og = xb_add(&bar[XB_TOP], 1u);
      const unsigned tg = og / nx;
      if (og + 1u == (tg + 1u) * nx) xb_add(&bar[XB_TOPGEN], 1u);
      else XB_SPIN(xb_ld(&bar[XB_TOPGEN]) == tg, bar);
      __builtin_amdgcn_fence(__ATOMIC_ACQUIRE, "agent");
      xb_add(&bar[XB_XGEN(b.x)], 1u);
      asm volatile("s_waitcnt vmcnt(0)" ::: "memory");
    } else {
      XB_SPIN(xb_ld(&bar[XB_XGEN(b.x)]) == gen, bar);
      __builtin_amdgcn_fence(__ATOMIC_ACQUIRE, "agent");
      asm volatile("s_waitcnt vmcnt(0)" ::: "memory");
    }
  }
  __syncthreads();
}

#define GSYNC() xcd_barrier(xb)
__global__ void __launch_bounds__(512, 2) fwd_megakernel(Params P) {
  extern __shared__ __attribute__((aligned(16))) unsigned char shm[];
  cg::grid_group grid = cg::this_grid();
  LAS unsigned char* lds = (LAS unsigned char*)shm;
  float* smf = (float*)shm;
  if (P.ws == nullptr) grid.sync();
  volatile LAS unsigned* xst = (volatile LAS unsigned*)(lds + (LDS_BYTES - 16));
  if (threadIdx.x == 0) { xst[0] = 0u; xst[1] = 0u; }
  __syncthreads();
  const XcdBarrier xb = xcd_barrier_post((unsigned*)(P.ws + WS_BAR), xst);
#define RUN_P2() { EpiZ E; E.Z = (bf16_t*)(P.ws + WS_Z); E.gates = (float*)(P.ws + WS_GATES); E.bgate = P.b_gate; \
    gemm_phase<EpiZ>(lds, (const bf16_t*)(P.ws + WS_H), (const bf16_t*)(P.ws + WS_WIN), NTOK, NZG, DM, E); } \
    { const int nfull = (80 * 15) % (int)gridDim.x;     \
      if ((int)blockIdx.x >= nfull) transpose_range(P, smf, blockIdx.x - nfull, gridDim.x - nfull, NTR_WIN, NTR_WIN + 256); } GSYNC();
#define RUN_M() phaseM1(P, lds); GSYNC(); phaseM2(P, smf); GSYNC(); phaseM3(P, lds); shortconv_items(P); GSYNC();
#define RUN_P5() { EpiUp E; E.rowss1 = (const float*)(P.ws + WS_RSS1); E.sb = (const float*)(P.ws + WS_SB); E.cw = P.conv_ffn_w; E.cb = P.conv_ffn_b; E.act = (bf16_t*)(P.ws + WS_Z); \
    gemm_phase<EpiUp>(lds, (const bf16_t*)(P.ws + WS_H), (const bf16_t*)(P.ws + WS_WUP), NTOK, NUP, DM, E); } GSYNC();
  phase0a(P, smf);
  GSYNC();
  phase0b(P, smf);
  GSYNC();
  RUN_P2()
#if DUP == 2
  RUN_P2()
#endif
#if DUP == 21
  { EpiNone E; E.Z = (bf16_t*)(P.ws + WS_UCAT);
    gemm_phase<EpiNone>(lds, (const bf16_t*)(P.ws + WS_H), (const bf16_t*)(P.ws + WS_WIN), NTOK, NZ, DM, E); } GSYNC();
#endif
  RUN_M()
#if DUP == 3
  RUN_M()
#endif
#if DUP == 31
  phaseM1(P, lds); GSYNC();
#endif
#if DUP == 32
  phaseM2(P, smf); GSYNC();
#endif
#if DUP == 33
  phaseM3(P, lds); GSYNC();
#endif
#if DUP == 34
  shortconv_items(P); GSYNC();
#endif
#if DUP == 6
  RUN_P5()
#endif
  { EpiX1 E; E.xp = P.x_prompt; E.xs = P.x_sample; E.mod = (const float*)(P.ws + WS_MOD); E.norm2 = P.norm2; E.x1out = P.out; E.x1g = (bf16_t*)(P.ws + WS_H); E.rowss = (float*)(P.ws + WS_RSS1);
    gemm_phase<EpiX1>(lds, (const bf16_t*)(P.ws + WS_UCAT), (const bf16_t*)(P.ws + WS_WOUT), NTOK, DM, DM, E); }
  if (blockIdx.x >= 64) transpose_range(P, smf, blockIdx.x - 64, gridDim.x - 64, NTR_WIN + 256, NTR_ALL);
  GSYNC();
  RUN_P5()
#if DUP == 5
  RUN_P5()
#endif
  { EpiDown E; E.mod = (const float*)(P.ws + WS_MOD); E.out = P.out; E.rowss2 = (float*)(P.ws + WS_RSS2);
    gemm_phase<EpiDown>(lds, (const bf16_t*)(P.ws + WS_Z), (const bf16_t*)(P.ws + WS_WDN), 16384, DM, DFF, E); }
  { EpiDownPart E; E.mod = (const float*)(P.ws + WS_MOD); E.out = P.out; E.part = (float*)(P.ws + WS_H);
    gemm_phase<EpiDownPart, 4>(lds, (const bf16_t*)(P.ws + WS_Z), (const bf16_t*)(P.ws + WS_WDN), NTOK, DM, DFF, E); }
  GSYNC();
  phase7(P);
}

extern "C" void kernel_launch(void* const* d_in, const int* in_sizes, int n_in, void* d_out, int out_size, void* d_ws, size_t ws_size, hipStream_t stream) {
  static int grid_blocks = 0;
  if (!grid_blocks) {
    int dev = 0, cus = 0, per_cu = 0;
    hipGetDevice(&dev);
    hipDeviceGetAttribute(&cus, hipDeviceAttributeMultiprocessorCount, dev);
    hipFuncSetAttribute((const void*)fwd_megakernel, hipFuncAttributeMaxDynamicSharedMemorySize, LDS_BYTES);
    hipOccupancyMaxActiveBlocksPerMultiprocessor(&per_cu, (const void*)fwd_megakernel, 512, LDS_BYTES);
    (void)hipGetLastError();
    if (per_cu < 1) per_cu = 1;
    if (per_cu > 1) per_cu = 1;
    grid_blocks = cus * per_cu;
  }
  hipMemsetAsync(d_ws, 0, WS_ZERO_BYTES, stream);
  Params p{};
  const float** pp = (const float**)&p;
  for (int i = 0; i < 22; ++i) pp[i] = (const float*)d_in[i];
  p.out = (float*)d_out; p.ws = (unsigned char*)d_ws;
  void* args[] = {&p};
  hipError_t e = hipLaunchCooperativeKernel((const void*)fwd_megakernel, dim3(grid_blocks), dim3(512), args, LDS_BYTES, stream);
  if (e != hipSuccess) fprintf(stderr, "cooperative launch failed: %s (grid %d)\n", hipGetErrorString(e), grid_blocks);
}
```

```cpp
#include <hip/hip_runtime.h>
#include <hip/hip_cooperative_groups.h>
#include <cstdio>
namespace cg = cooperative_groups;

#ifndef DUP
#define DUP 0
#endif
#define LAS __attribute__((address_space(3)))
typedef unsigned short bf16_t;
typedef short bf16x8 __attribute__((ext_vector_type(8)));
typedef float f32x4 __attribute__((ext_vector_type(4)));
typedef unsigned u32x2 __attribute__((ext_vector_type(2)));
typedef unsigned u32x4 __attribute__((ext_vector_type(4)));

constexpr int DM = 1024, NTOK = 20480, NCTXT = 4096, DIN = 3600, NZ = 3584, DFF = 2816, NUP = 5632, NMOD = 6144;
constexpr float EPS = 1e-6f;
constexpr size_t WS_MOD = 0, WS_SB = 122880, WS_RSS1 = 235520, WS_RSS2 = 317440, WS_BAR = 399360, WS_ZERO_BYTES = 415744;
constexpr size_t WS_GATES = 415744, WS_STAT = 1726464, WS_MST = 1736704;
constexpr size_t WS_WIN = 259850240, WS_WOUT = 9437184, WS_WUP = 11534336, WS_WDN = 23068672;
constexpr int NZG = 3840;
constexpr size_t WS_H = 28835840;
constexpr size_t WS_UCAT = 71106560;
constexpr size_t WS_Z = 113049600;
constexpr int OUT_TAIL = 20971520;
constexpr int LDS_BYTES = 146432;

struct Params {
  const float *x_prompt, *x_sample, *state_C, *state_n, *state_m, *c, *c_ctx, *w_mod, *b_mod, *norm1, *w_in, *b_gate,
      *conv_sc_w, *conv_sc_b, *mh_norm, *w_out, *norm2, *w_up, *conv_ffn_w, *conv_ffn_b, *w_down, *final_norm;
  float* out; unsigned char* ws;
};

typedef __bf16 bf16x2_n __attribute__((ext_vector_type(2)));
typedef float f32x2_n __attribute__((ext_vector_type(2)));
__device__ __forceinline__ unsigned cvt_pk_bf16_c(float lo, float hi) { const f32x2_n v = {lo, hi}; return __builtin_bit_cast(unsigned, __builtin_convertvector(v, bf16x2_n)); }
__device__ __forceinline__ unsigned cvt_pk_bf16(float lo, float hi) { unsigned r; asm("v_cvt_pk_bf16_f32 %0, %1, %2" : "=v"(r) : "v"(lo), "v"(hi)); return r; }
__device__ __forceinline__ bf16_t f2bf_c(float f) { return (bf16_t)(cvt_pk_bf16_c(f, 0.f) & 0xffffu); }
__device__ __forceinline__ bf16_t f2bf(float f) { return (bf16_t)(cvt_pk_bf16(f, 0.f) & 0xffffu); }
__device__ __forceinline__ float bf2f(bf16_t b) { return __uint_as_float(((unsigned)b) << 16); }
__device__ __forceinline__ float bflo(unsigned u) { return __uint_as_float(u << 16); }
__device__ __forceinline__ float bfhi(unsigned u) { return __uint_as_float(u & 0xffff0000u); }
__device__ __forceinline__ int permtok(int T) { if (T < NCTXT) return T; const int q = T - NCTXT; return NCTXT + (q & ~4095) + ((q & 63) << 6) + ((q >> 6) & 63); }
template <int CTRL> __device__ __forceinline__ float dppf(float x) { return __builtin_bit_cast(float, __builtin_amdgcn_mov_dpp(__builtin_bit_cast(int, x), CTRL, 0xf, 0xf, true)); }
__device__ __forceinline__ float fast_sigmoid(float x) { return __builtin_amdgcn_rcpf(1.0f + __expf(-x)); }

__device__ __forceinline__ int opaque_tid() { int t = threadIdx.x; asm volatile("" : "+v"(t)); return t; }

constexpr int BM = 256, BK = 64, HALF = 128, HTB = HALF * BK * 2, NXCD = 8, WGM = 8;
__device__ __forceinline__ int lds_byte(int r, int c) { const int st = (r >> 4) * 2 + (c >> 5), rr = r & 15, cc = c & 31, ob = rr * 64 + cc * 2; return st * 1024 + (ob ^ (((ob >> 9) & 1) << 5)); }
__device__ __forceinline__ void stage_rc(int b, int& R, int& C) { const int st = b / 1024, sb = b % 1024, swz = sb ^ (((sb >> 9) & 1) << 5); R = (st >> 1) * 16 + swz / 64; C = (st & 1) * 32 + (swz % 64) / 2; }

struct Order {
  int nM, nN, nwg, G, c;
  __device__ __forceinline__ void init(int M, int N) { nM = M / BM; nN = N / BM; nwg = nM * nN; G = gridDim.x; c = blockIdx.x; }
  template <int MODE> __device__ __forceinline__ bool next_m(int i, int& pm, int& pn, int& kb, int& ntu, int nt_full) const {
    if (MODE == 0) { kb = 0; ntu = nt_full; return next(i, pm, pn); }
    const long L = (long)i * G + c; if (L >= 256) return false;
    const int x = (int)L & 7, j = (int)L >> 3, kq = j & 3;
    pm = 64 + 2 * x + (j >> 4); pn = ((j >> 2) & 3) | (kq << 8);
    kb = kq < 2 ? 12 * kq : 24 + 10 * (kq - 2); ntu = kq < 2 ? 12 : 10; return true;
  }
  __device__ __forceinline__ bool next(int i, int& pm, int& pn) const {
    const long L = (long)i * G + c; if (L >= nwg) return false;
    int wgid = (int)L; { const int q = nwg / NXCD, r = nwg % NXCD, xcd = wgid % NXCD, off = wgid / NXCD; wgid = (xcd < r ? xcd * (q + 1) : r * (q + 1) + (xcd - r) * q) + off; }
    const int nig = WGM * nN, gid = wgid / nig, fm = gid * WGM, gsz = (nM - fm) < WGM ? (nM - fm) : WGM;
    pm = fm + ((wgid % nig) % gsz); pn = (wgid % nig) / gsz; return true;
  }
};

template <class Epi, int MODE = 0>
__device__ __forceinline__ void gemm_phase(LAS unsigned char* lds, const bf16_t* gA, const bf16_t* gBt, int M, int N, int K, const Epi& E) {
  const int tid = opaque_tid(), wid = __builtin_amdgcn_readfirstlane(tid >> 6), lane = tid & 63, wr = wid >> 2, wc = wid & 3, fr = lane & 15, fq = lane >> 4;
  const int nt = K / BK;
  Order S; S.init(M, N);
  unsigned voffA[2];
#pragma unroll
  for (int i = 0; i < 2; ++i) { int R, C; stage_rc(tid * 16 + i * 8192, R, C); voffA[i] = (unsigned)(R * K + C) * 2u; }
  const size_t kstep = (size_t)(BK * 2);
  const size_t hstep = (size_t)HALF * K * 2;
  const size_t tstep = 2 * hstep;
  const unsigned ldsw = (unsigned)wid * 1024u;
  const int aoff = lds_byte(wr * 64 + fr, fq * 8), boff = lds_byte(wc * 32 + fr, fq * 8);
#define G_SA(b, h) (((b) * 2 + (h)) * HTB)
#define G_SB(b, h) ((4 + (b) * 2 + (h)) * HTB)
#define G_STAGE(bufoff, gbase) do { _Pragma("unroll") for (int _i = 0; _i < 2; ++_i) \
    __builtin_amdgcn_global_load_lds((const unsigned*)((const char*)(gbase) + voffA[_i]), (LAS unsigned*)(lds + (bufoff) + ldsw + _i * 8192), 16, 0, 0); } while (0)
#define G_LDA(dst, b, h) do { _Pragma("unroll") for (int m = 0; m < 4; ++m) _Pragma("unroll") for (int k = 0; k < 2; ++k) dst[m][k] = *(const LAS bf16x8*)(lds + G_SA(b, h) + aoff + m * 2048 + k * 1024); } while (0)
#define G_LDB(dst, b, h) do { _Pragma("unroll") for (int n = 0; n < 2; ++n) _Pragma("unroll") for (int k = 0; k < 2; ++k) dst[n][k] = *(const LAS bf16x8*)(lds + G_SB(b, h) + boff + n * 2048 + k * 1024); } while (0)
#define G_MMA(ai, bj, At, Bt) do { __builtin_amdgcn_s_setprio(1); _Pragma("unroll") for (int m = 0; m < 4; ++m) _Pragma("unroll") for (int n = 0; n < 2; ++n) _Pragma("unroll") for (int k = 0; k < 2; ++k) \
    acc[ai][bj][m][n] = __builtin_amdgcn_mfma_f32_16x16x32_bf16(Bt[n][k], At[m][k], acc[ai][bj][m][n], 0, 0, 0); __builtin_amdgcn_s_setprio(0); } while (0)
#define G_WAIT_V(n) asm volatile("s_waitcnt vmcnt(" #n ")" ::: "memory")
#define G_WAIT_L(n) asm volatile("s_waitcnt lgkmcnt(" #n ")" ::: "memory")
#define G_BAR __builtin_amdgcn_s_barrier()
#define G_SCHED __builtin_amdgcn_sched_barrier(0)
  int cpm, cpn, npm = 0, npn = 0, ui = 0, ckb = 0, cnt = nt, nkb = 0, nnt = nt;
  if (!S.template next_m<MODE>(0, cpm, cpn, ckb, cnt, nt)) return;
  f32x4 acc[2][2][4][2];
#pragma unroll
  for (int a = 0; a < 2; ++a)
#pragma unroll
    for (int b = 0; b < 2; ++b)
#pragma unroll
      for (int m = 0; m < 4; ++m)
#pragma unroll
        for (int n = 0; n < 2; ++n) acc[a][b][m][n] = (f32x4){0.f, 0.f, 0.f, 0.f};
  bf16x8 At[4][2], B0[2][2], B1[2][2];
  const char* cA = (const char*)gA + (size_t)cpm * tstep + (size_t)ckb * kstep; const char* cB = (const char*)gBt + (size_t)(cpn & 255) * tstep + (size_t)ckb * kstep;
  G_STAGE(G_SB(0, 0), cB); G_STAGE(G_SA(0, 0), cA); G_STAGE(G_SB(0, 1), cB + hstep); G_STAGE(G_SA(0, 1), cA + hstep);
  if (wr == 1) G_BAR;
  G_WAIT_V(4); G_BAR;
  G_STAGE(G_SB(1, 0), cB + kstep); G_STAGE(G_SA(1, 0), cA + kstep); G_STAGE(G_SB(1, 1), cB + hstep + kstep);
  G_WAIT_V(6); G_BAR;
  for (;;) {
    const bool has_next = S.template next_m<MODE>(ui + 1, npm, npn, nkb, nnt, nt);
    const char* nA = has_next ? (const char*)gA + (size_t)npm * tstep + (size_t)nkb * kstep : cA; const char* nB = has_next ? (const char*)gBt + (size_t)(npn & 255) * tstep + (size_t)nkb * kstep : cB;
    for (int t = 0; t < cnt; t += 2) {
      const bool last = (t == cnt - 2);
      const char* a1 = cA + (size_t)(t + 1) * kstep;
      const char* a2 = last ? nA : cA + (size_t)(t + 2) * kstep; const char* b2 = last ? nB : cB + (size_t)(t + 2) * kstep;
      const char* a3 = a2 + kstep; const char* b3 = b2 + kstep;
      G_LDB(B0, 0, 0); G_SCHED; G_LDA(At, 0, 0); G_STAGE(G_SA(1, 1), a1 + hstep);
      G_WAIT_L(8); G_BAR; G_WAIT_L(0); G_MMA(0, 0, At, B0); G_BAR; G_SCHED;
      G_LDB(B1, 0, 1); G_STAGE(G_SB(0, 0), b2);
      G_BAR; G_WAIT_L(0); G_MMA(0, 1, At, B1); G_BAR;
      G_LDA(At, 0, 1); G_STAGE(G_SA(0, 0), a2);
      G_BAR; G_WAIT_L(0); G_MMA(1, 0, At, B0); G_BAR; G_SCHED;
      G_STAGE(G_SB(0, 1), b2 + hstep);
      G_WAIT_V(6); G_BAR; G_MMA(1, 1, At, B1); G_BAR;
      G_LDB(B0, 1, 0); G_SCHED; G_LDA(At, 1, 0); G_STAGE(G_SA(0, 1), a2 + hstep);
      G_WAIT_L(8); G_BAR; G_WAIT_L(0); G_MMA(0, 0, At, B0); G_BAR; G_SCHED;
      G_LDB(B1, 1, 1); G_STAGE(G_SB(1, 0), b3);
      G_BAR; G_WAIT_L(0); G_MMA(0, 1, At, B1); G_BAR;
      G_LDA(At, 1, 1); G_STAGE(G_SA(1, 0), a3);
      G_BAR; G_WAIT_L(0); G_MMA(1, 0, At, B0); G_BAR; G_SCHED;
      G_STAGE(G_SB(1, 1), b3 + hstep);
      G_WAIT_V(6); G_BAR; G_MMA(1, 1, At, B1); G_BAR;
    }
    asm volatile("s_nop 15\n\ts_nop 15" ::: "memory");
    E(acc, cpm, cpn, wr, wc, fr, fq, lds);
    if (!has_next) break;
#pragma unroll
    for (int a = 0; a < 2; ++a)
#pragma unroll
      for (int b = 0; b < 2; ++b)
#pragma unroll
        for (int m = 0; m < 4; ++m)
#pragma unroll
          for (int n = 0; n < 2; ++n) acc[a][b][m][n] = (f32x4){0.f, 0.f, 0.f, 0.f};
    cpm = npm; cpn = npn; cA = nA; cB = nB; cnt = nnt; ++ui;
  }
  G_WAIT_V(0);
  if (wr == 0) G_BAR;
  G_BAR;
}

struct EpiZ {
  bf16_t* Z; float* gates; const float* bgate;
  __device__ __forceinline__ void operator()(f32x4 (&acc)[2][2][4][2], int pm, int pn, int wr, int wc, int fr, int fq, LAS unsigned char*) const {
    const int row0 = pm * BM + wr * 64 + fr, col0 = pn * BM + wc * 32 + 8 * fq;
    if (pn == 14) {
      if (wc == 0 && fq < 2) {
        f32x4 bg[2]; bg[0] = *(const f32x4*)(bgate + 8 * fq); bg[1] = *(const f32x4*)(bgate + 8 * fq + 4);
#pragma unroll
        for (int ai = 0; ai < 2; ++ai)
#pragma unroll
          for (int m = 0; m < 4; ++m) {
            float* gp = gates + (size_t)(row0 + ai * HALF + m * 16) * 16 + 8 * fq;
#pragma unroll
            for (int n = 0; n < 2; ++n) {
              f32x4 v = acc[ai][0][m][n] + bg[n];
              if (n == 1) {
#pragma unroll
                for (int e = 0; e < 4; ++e) v[e] = fminf(v[e], 0.f) - log1pf(__expf(-fabsf(v[e])));
              }
              *(f32x4*)(gp + 4 * n) = v;
            }
          }
      }
      return;
    }
#pragma unroll
    for (int ai = 0; ai < 2; ++ai)
#pragma unroll
      for (int m = 0; m < 4; ++m) {
        bf16_t* rowp = Z + (size_t)(row0 + ai * HALF + m * 16) * NZ + col0;
#pragma unroll
        for (int bj = 0; bj < 2; ++bj) { const f32x4 v0 = acc[ai][bj][m][0], v1 = acc[ai][bj][m][1];
          u32x4 o; o.x = cvt_pk_bf16(v0[0], v0[1]); o.y = cvt_pk_bf16(v0[2], v0[3]); o.z = cvt_pk_bf16(v1[0], v1[1]); o.w = cvt_pk_bf16(v1[2], v1[3]);
          *(u32x4*)(rowp + bj * HALF) = o; }
      }
  }
};

struct EpiNone {
  bf16_t* Z;
  __device__ __forceinline__ void operator()(f32x4 (&acc)[2][2][4][2], int pm, int pn, int wr, int wc, int fr, int fq, LAS unsigned char*) const {
    f32x4 s = (f32x4){0.f, 0.f, 0.f, 0.f};
#pragma unroll
    for (int ai = 0; ai < 2; ++ai)
#pragma unroll
      for (int bj = 0; bj < 2; ++bj)
#pragma unroll
        for (int m = 0; m < 4; ++m)
#pragma unroll
          for (int n = 0; n < 2; ++n) s += acc[ai][bj][m][n];
    if (s[0] + s[1] + s[2] + s[3] == 12345.678f) Z[pm + pn] = 1;
  }
};

struct EpiX1 {
  const float* xp; const float* xs; const float* mod; const float* norm2; float* x1out; bf16_t* x1g; float* rowss;
  __device__ __forceinline__ void operator()(f32x4 (&acc)[2][2][4][2], int pm, int pn, int wr, int wc, int fr, int fq, LAS unsigned char*) const {
    const int g = pm < 16 ? 4 : ((pm - 16) >> 4);
    const float* modg = mod + g * NMOD;
    const int col0 = pn * BM + wc * 32 + 4 * fq;
    f32x4 g1[2][2], g2[2][2];
#pragma unroll
    for (int bj = 0; bj < 2; ++bj)
#pragma unroll
      for (int n = 0; n < 2; ++n) { const int c = col0 + bj * HALF + n * 16; g1[bj][n] = *(const f32x4*)(modg + 2048 + c); const f32x4 s2 = *(const f32x4*)(modg + 4096 + c); const f32x4 nv = *(const f32x4*)(norm2 + c); g2[bj][n] = nv * (s2 + 1.0f); }
#pragma unroll
    for (int ai = 0; ai < 2; ++ai)
#pragma unroll
      for (int m = 0; m < 4; ++m) {
        const int T = pm * BM + ai * HALF + wr * 64 + m * 16 + fr;
        const float* xrow = (T < NCTXT) ? xp + (size_t)T * DM : xs + (size_t)(T - NCTXT) * DM;
        const int p = permtok(T);
        float ss = 0.f;
#pragma unroll
        for (int bj = 0; bj < 2; ++bj)
#pragma unroll
          for (int n = 0; n < 2; ++n) {
            const int c = col0 + bj * HALF + n * 16;
            const f32x4 xv = *(const f32x4*)(xrow + c);
            const f32x4 v = xv + g1[bj][n] * acc[ai][bj][m][n];
            *(f32x4*)(x1out + (size_t)T * DM + c) = v;
            ss += v[0] * v[0] + v[1] * v[1] + v[2] * v[2] + v[3] * v[3];
            const f32x4 w = v * g2[bj][n];
            u32x2 o; o.x = cvt_pk_bf16(w[0], w[1]); o.y = cvt_pk_bf16(w[2], w[3]);
            *(u32x2*)(x1g + (size_t)p * DM + c) = o;
          }
        ss += __shfl_xor(ss, 16); ss += __shfl_xor(ss, 32);
        if (fq == 0) __hip_atomic_fetch_add(rowss + p, ss, __ATOMIC_RELAXED, __HIP_MEMORY_SCOPE_AGENT);
      }
  }
};

struct EpiDown {
  const float* mod; float* out; float* rowss2;
  __device__ __forceinline__ void operator()(f32x4 (&acc)[2][2][4][2], int pm, int pn, int wr, int wc, int fr, int fq, LAS unsigned char*) const {
    const int g = pm < 16 ? 4 : ((pm - 16) >> 4);
    const float* modg = mod + g * NMOD;
    const int col0 = pn * BM + wc * 32 + 4 * fq;
    f32x4 g2[2][2];
#pragma unroll
    for (int bj = 0; bj < 2; ++bj)
#pragma unroll
      for (int n = 0; n < 2; ++n) g2[bj][n] = *(const f32x4*)(modg + 5120 + col0 + bj * HALF + n * 16);
#pragma unroll
    for (int ai = 0; ai < 2; ++ai)
#pragma unroll
      for (int m = 0; m < 4; ++m) {
        const int p = pm * BM + ai * HALF + wr * 64 + m * 16 + fr;
        const int T = permtok(p);
        float* orow = out + (size_t)T * DM;
        float ss = 0.f;
#pragma unroll
        for (int bj = 0; bj < 2; ++bj)
#pragma unroll
          for (int n = 0; n < 2; ++n) {
            const int c = col0 + bj * HALF + n * 16;
            const f32x4 xv = *(const f32x4*)(orow + c);
            const f32x4 v = xv + g2[bj][n] * acc[ai][bj][m][n];
            *(f32x4*)(orow + c) = v;
            ss += v[0] * v[0] + v[1] * v[1] + v[2] * v[2] + v[3] * v[3];
          }
        ss += __shfl_xor(ss, 16); ss += __shfl_xor(ss, 32);
        if (fq == 0) __hip_atomic_fetch_add(rowss2 + T, ss, __ATOMIC_RELAXED, __HIP_MEMORY_SCOPE_AGENT);
      }
  }
};

struct EpiDownPart {
  const float* mod; float* out; float* part;
  __device__ __forceinline__ void operator()(f32x4 (&acc)[2][2][4][2], int pm, int pnk, int wr, int wc, int fr, int fq, LAS unsigned char*) const {
    const int pn = pnk & 255, kq = pnk >> 8;
    const int g = pm < 16 ? 4 : ((pm - 16) >> 4);
    const float* modg = mod + g * NMOD;
    const int col0 = pn * BM + wc * 32 + 4 * fq;
    f32x4 g2[2][2];
#pragma unroll
    for (int bj = 0; bj < 2; ++bj)
#pragma unroll
      for (int n = 0; n < 2; ++n) g2[bj][n] = *(const f32x4*)(modg + 5120 + col0 + bj * HALF + n * 16);
#pragma unroll
    for (int ai = 0; ai < 2; ++ai)
#pragma unroll
      for (int m = 0; m < 4; ++m) {
        const int p = pm * BM + ai * HALF + wr * 64 + m * 16 + fr;
        const int T = permtok(p);
        if (kq == 0) {
          float* orow = out + (size_t)T * DM;
#pragma unroll
          for (int bj = 0; bj < 2; ++bj)
#pragma unroll
            for (int n = 0; n < 2; ++n) { const int c = col0 + bj * HALF + n * 16; const f32x4 xv = *(const f32x4*)(orow + c); *(f32x4*)(orow + c) = xv + g2[bj][n] * acc[ai][bj][m][n]; }
        } else {
          bf16_t* prow = (bf16_t*)part + ((size_t)(kq - 1) * 4096 + (T - 16384)) * DM;
#pragma unroll
          for (int bj = 0; bj < 2; ++bj)
#pragma unroll
            for (int n = 0; n < 2; ++n) { const int c = col0 + bj * HALF + n * 16; const f32x4 w = g2[bj][n] * acc[ai][bj][m][n]; u32x2 o; o.x = cvt_pk_bf16(w[0], w[1]); o.y = cvt_pk_bf16(w[2], w[3]); *(u32x2*)(prow + c) = o; }
        }
      }
  }
};

struct EpiUp {
  const float* rowss1; const float* sb; const float* cw; const float* cb; bf16_t* act;
  __device__ __forceinline__ void operator()(f32x4 (&acc)[2][2][4][2], int pm, int pn, int wr, int wc, int fr, int fq, LAS unsigned char* lds) const {
    asm volatile("" : "+v"(fr), "+v"(fq));
    const bool ctx = pm < 16;
    const int g = ctx ? 4 : ((pm - 16) >> 4);
    const float* sbg = sb + g * NUP;
    LAS float* halo = (LAS float*)(lds + 131072);
    const int prow0 = pm * BM + wr * 64 + fr;
    {
      float rs[2][4];
#pragma unroll
      for (int ai = 0; ai < 2; ++ai)
#pragma unroll
        for (int m = 0; m < 4; ++m) rs[ai][m] = __builtin_amdgcn_rsqf(rowss1[prow0 + ai * HALF + m * 16] * (1.0f / 1024.0f) + EPS);
#pragma unroll
      for (int bj = 0; bj < 2; ++bj)
#pragma unroll
        for (int n = 0; n < 2; ++n) {
          asm volatile("" ::: "memory"); __builtin_amdgcn_sched_barrier(0);
          const f32x4 sv = *(const f32x4*)(sbg + bj * DFF + pn * HALF + wc * 32 + 8 * fq + 4 * n);
#pragma unroll
          for (int ai = 0; ai < 2; ++ai)
#pragma unroll
            for (int m = 0; m < 4; ++m) { acc[ai][bj][m][n] = acc[ai][bj][m][n] * rs[ai][m] + sv; asm volatile("" : "+v"(acc[ai][bj][m][n])); }
        }
    }
    if (ctx) {
#pragma unroll
      for (int ai = 0; ai < 2; ++ai)
#pragma unroll
        for (int bj = 0; bj < 2; ++bj)
#pragma unroll
          for (int n = 0; n < 2; ++n) {
            const int rb = 2 * ai + wr, colt = bj * HALF + wc * 32 + 8 * fq + 4 * n;
            if (fr == 0) *(LAS f32x4*)(halo + (rb * 2 + 0) * 256 + colt) = acc[ai][bj][0][n];
            if (fr == 15) *(LAS f32x4*)(halo + (rb * 2 + 1) * 256 + colt) = acc[ai][bj][3][n];
          }
      asm volatile("s_waitcnt lgkmcnt(0)" ::: "memory");
      __builtin_amdgcn_s_barrier();
      __builtin_amdgcn_s_barrier();
      asm volatile("" ::: "memory");
    }
#pragma unroll
    for (int ai = 0; ai < 2; ++ai) {
      u32x2 st[4];
#pragma unroll
      for (int n = 0; n < 2; ++n) {
        f32x4 ya[4];
        const int rb = 2 * ai + wr;
#pragma unroll
        for (int bj = 0; bj < 2; ++bj) {
          const int cnat = bj * DFF + pn * HALF + wc * 32 + 8 * fq + 4 * n, colt = bj * HALF + wc * 32 + 8 * fq + 4 * n;
          const f32x4 w0 = *(const f32x4*)(cw + cnat), w1 = *(const f32x4*)(cw + NUP + cnat), w2 = *(const f32x4*)(cw + 2 * NUP + cnat), bb = *(const f32x4*)(cb + cnat);
          f32x4 hp = (f32x4){0.f, 0.f, 0.f, 0.f}, hn = hp;
          if (ctx) {
            if (rb > 0) hp = *(const LAS f32x4*)(halo + ((rb - 1) * 2 + 1) * 256 + colt);
            if (rb < 3) hn = *(const LAS f32x4*)(halo + ((rb + 1) * 2 + 0) * 256 + colt);
          }
#pragma unroll
          for (int m = 0; m < 4; ++m) {
            const f32x4 cur = acc[ai][bj][m][n];
            f32x4 prev, next;
#pragma unroll
            for (int e = 0; e < 4; ++e) {
              if (m > 0) { const float snd = (fr == 15) ? acc[ai][bj][m > 0 ? m - 1 : 0][n][e] : cur[e]; prev[e] = dppf<0x121>(snd); }
              else { const float rcv = dppf<0x121>(cur[e]); prev[e] = (fr == 0) ? hp[e] : rcv; }
              if (m < 3) { const float snd = (fr == 0) ? acc[ai][bj][m < 3 ? m + 1 : 3][n][e] : cur[e]; next[e] = dppf<0x12F>(snd); }
              else { const float rcv = dppf<0x12F>(cur[e]); next[e] = (fr == 15) ? hn[e] : rcv; }
            }
            const f32x4 y = w0 * prev + w1 * cur + w2 * next + bb;
            if (bj == 0) ya[m] = y;
            else {
              float o[4];
#pragma unroll
              for (int e = 0; e < 4; ++e) o[e] = y[e] * fast_sigmoid(y[e]) * ya[m][e];
              u32x2 ov; ov.x = cvt_pk_bf16(o[0], o[1]); ov.y = cvt_pk_bf16(o[2], o[3]);
              if (n == 0) st[m] = ov;
              else { u32x4 o4; o4.x = st[m].x; o4.y = st[m].y; o4.z = ov.x; o4.w = ov.y;
                *(u32x4*)(act + (size_t)(prow0 + ai * HALF + m * 16) * DFF + pn * HALF + wc * 32 + 8 * fq) = o4; }
            }
          }
        }
      }
    }
  }
};

template <bool SILU>
__device__ __forceinline__ void gemv5_unit(const Params& P, int unit, int ncb, const float* W, int ldw, float* outp, int ldo, const float* bias, const float* modv, float* sm) {
  const int tid = opaque_tid();
  const int cb = unit % ncb, ks = unit / ncb, n0 = cb * 256, k0 = ks * 128;
  float* sv = sm; float* red = sm + 640;
  for (int i = tid; i < 640; i += 512) {
    const int g = i >> 7, k = k0 + (i & 127);
    float v;
    if (SILU) { v = (g < 4) ? P.c[g * DM + k] : P.c_ctx[k]; v = v / (1.0f + __expf(-v)); }
    else v = modv[g * NMOD + 3072 + k];
    sv[i] = v;
  }
  __syncthreads();
  const int col = tid & 255, kh = tid >> 8;
  float a0 = 0.f, a1 = 0.f, a2 = 0.f, a3 = 0.f, a4 = 0.f;
  const float* wp = W + (size_t)(k0 + kh * 64) * ldw + n0 + col;
#pragma unroll 8
  for (int kk = 0; kk < 64; ++kk) {
    const float w = wp[(size_t)kk * ldw];
    const int ki = kh * 64 + kk;
    a0 += sv[ki] * w; a1 += sv[128 + ki] * w; a2 += sv[256 + ki] * w; a3 += sv[384 + ki] * w; a4 += sv[512 + ki] * w;
  }
  if (kh == 1) { red[col] = a0; red[256 + col] = a1; red[512 + col] = a2; red[768 + col] = a3; red[1024 + col] = a4; }
  __syncthreads();
  if (kh == 0) {
    const float bv = (bias != nullptr && ks == 0) ? bias[n0 + col] : 0.f;
    a0 += red[col] + bv; a1 += red[256 + col] + bv; a2 += red[512 + col] + bv; a3 += red[768 + col] + bv; a4 += red[1024 + col] + bv;
    float* o = outp + n0 + col;
    __hip_atomic_fetch_add(o, a0, __ATOMIC_RELAXED, __HIP_MEMORY_SCOPE_AGENT);
    __hip_atomic_fetch_add(o + ldo, a1, __ATOMIC_RELAXED, __HIP_MEMORY_SCOPE_AGENT);
    __hip_atomic_fetch_add(o + 2 * ldo, a2, __ATOMIC_RELAXED, __HIP_MEMORY_SCOPE_AGENT);
    __hip_atomic_fetch_add(o + 3 * ldo, a3, __ATOMIC_RELAXED, __HIP_MEMORY_SCOPE_AGENT);
    __hip_atomic_fetch_add(o + 4 * ldo, a4, __ATOMIC_RELAXED, __HIP_MEMORY_SCOPE_AGENT);
  }
  __syncthreads();
}

struct TrUnit { const float* src; bf16_t* dst; int ldw, ldd, perm; };
__device__ __forceinline__ void tr_decode(const Params& P, int v, TrUnit& t) {
  bf16_t* WinT = (bf16_t*)(P.ws + WS_WIN); bf16_t* WoutT = (bf16_t*)(P.ws + WS_WOUT); bf16_t* WupT = (bf16_t*)(P.ws + WS_WUP); bf16_t* WdnT = (bf16_t*)(P.ws + WS_WDN);
  if (v < 896) { const int kt = v / 56, ntl = v % 56; t.src = P.w_in + (size_t)(kt * 64) * DIN + ntl * 64; t.ldw = DIN; t.dst = WinT + (size_t)(ntl * 64) * DM + kt * 64; t.ldd = DM; t.perm = 1; }
  else if (v < 1152) { const int w = v - 896, kt = w >> 4, ntl = w & 15; t.src = P.w_out + (size_t)(kt * 64) * DM + ntl * 64; t.ldw = DM; t.dst = WoutT + (size_t)(ntl * 64) * DM + kt * 64; t.ldd = DM; t.perm = 0; }
  else if (v < 2560) { const int w = v - 1152, kt = w / 88, ntl = w % 88; const int n0 = ntl * 64, half = n0 / DFF, r = n0 % DFF, pn = r >> 7, cc = r & 127;
    t.src = P.w_up + (size_t)(kt * 64) * NUP + n0; t.ldw = NUP; t.dst = WupT + (size_t)(pn * 256 + half * 128 + cc) * DM + kt * 64; t.ldd = DM; t.perm = 1; }
  else { const int w = v - 2560, kt = w >> 4, ntl = w & 15; t.src = P.w_down + (size_t)(kt * 64) * DM + ntl * 64; t.ldw = DM; t.dst = WdnT + (size_t)(ntl * 64) * DFF + kt * 64; t.ldd = DFF; t.perm = 0; }
}
__device__ __forceinline__ void transpose_range(const Params& P, float* tile, int rank, int nrank, int vfirst, int vend) {
  const int tid = opaque_tid();
  const int r = tid >> 4, c4 = (tid & 15) * 4, nn = tid >> 3, kk8 = (tid & 7) * 8;
  int v = vfirst + rank;
  f32x4 p0 = (f32x4){0.f, 0.f, 0.f, 0.f}, p1 = p0; TrUnit cur;
  if (v < vend) { tr_decode(P, v, cur); p0 = *(const f32x4*)(cur.src + (size_t)r * cur.ldw + c4); p1 = *(const f32x4*)(cur.src + (size_t)(r + 32) * cur.ldw + c4); }
  while (v < vend) {
    { float* t = tile + r * 65 + c4; t[0] = p0[0]; t[1] = p0[1]; t[2] = p0[2]; t[3] = p0[3]; t += 32 * 65; t[0] = p1[0]; t[1] = p1[1]; t[2] = p1[2]; t[3] = p1[3]; }
    const int vn = v + nrank; TrUnit nxt = cur;
    if (vn < vend) tr_decode(P, vn, nxt);
    p0 = *(const f32x4*)(nxt.src + (size_t)r * nxt.ldw + c4); p1 = *(const f32x4*)(nxt.src + (size_t)(r + 32) * nxt.ldw + c4);
    __syncthreads();
    { float vv[8];
#pragma unroll
      for (int j = 0; j < 8; ++j) vv[j] = tile[(kk8 + j) * 65 + nn];
      u32x4 o; o.x = cvt_pk_bf16(vv[0], vv[1]); o.y = cvt_pk_bf16(vv[2], vv[3]); o.z = cvt_pk_bf16(vv[4], vv[5]); o.w = cvt_pk_bf16(vv[6], vv[7]);
      const int c5 = nn & 31, nnp = cur.perm ? ((nn & 32) + ((c5 >> 2) & 1) * 16 + (c5 >> 3) * 4 + (c5 & 3)) : nn;
      *(u32x4*)(cur.dst + (size_t)nnp * cur.ldd + kk8) = o; }
    __syncthreads();
    cur = nxt; v = vn;
  }
}
constexpr int NTR_WIN = 896, NTR_ALL = 896 + 256 + 1408 + 704;
__device__ void phase0a(const Params& P, float* sm) {
  float* mod = (float*)(P.ws + WS_MOD);
  for (int u = blockIdx.x; u < 24 * 8; u += gridDim.x) gemv5_unit<true>(P, u, 24, P.w_mod, NMOD, mod, NMOD, P.b_mod, nullptr, sm);
  transpose_range(P, sm, gridDim.x - 1 - blockIdx.x, gridDim.x, 0, NTR_WIN);
  if (blockIdx.x == gridDim.x - 1) {
    const int tid = opaque_tid();
    bf16_t* WinT = (bf16_t*)(P.ws + WS_WIN);
    for (int i0 = 0; i0 < 32; i0 += 8) {
      float wv[8];
#pragma unroll
      for (int i = 0; i < 8; ++i) { const int idx = tid + 512 * (i0 + i); wv[i] = P.w_in[(size_t)(idx >> 4) * DIN + NZ + (idx & 15)]; }
#pragma unroll
      for (int i = 0; i < 8; ++i) { const int idx = tid + 512 * (i0 + i); const int g = idx & 15, k = idx >> 4; const int slot = ((g >> 2) & 1) * 16 + (g >> 3) * 4 + (g & 3);
        WinT[(size_t)(NZ + slot) * DM + k] = f2bf(wv[i]); }
    }
  }
}

__device__ void phase0b(const Params& P, float* sm) {
  const int tid = opaque_tid(), wid = tid >> 6, lane = tid & 63;
  const float* mod = (const float*)(P.ws + WS_MOD);
  float* sbv = (float*)(P.ws + WS_SB);
  bf16_t* H = (bf16_t*)(P.ws + WS_H);
  for (int u = blockIdx.x; u < 22 * 8; u += gridDim.x) gemv5_unit<false>(P, u, 22, P.w_up, NUP, sbv, NUP, nullptr, mod, sm + 16384);
  f32x4 xnext[4];
  { const int Tn = blockIdx.x * 8 + wid; const float* xr = (Tn < NCTXT) ? P.x_prompt + (size_t)Tn * DM : P.x_sample + (size_t)(Tn - NCTXT) * DM;
#pragma unroll
    for (int i = 0; i < 4; ++i) xnext[i] = *(const f32x4*)(xr + i * 256 + lane * 4); }
  for (int T = blockIdx.x * 8 + wid; T < NTOK; T += gridDim.x * 8) {
    const int g = T < NCTXT ? 4 : ((T - NCTXT) >> 12);
    const float* modg = mod + g * NMOD;
    f32x4 xv[4]; float ss = 0.f;
#pragma unroll
    for (int i = 0; i < 4; ++i) xv[i] = xnext[i];
    { int Tn = T + gridDim.x * 8; Tn = Tn < NTOK ? Tn : T;
      const float* xr = (Tn < NCTXT) ? P.x_prompt + (size_t)Tn * DM : P.x_sample + (size_t)(Tn - NCTXT) * DM;
#pragma unroll
      for (int i = 0; i < 4; ++i) xnext[i] = *(const f32x4*)(xr + i * 256 + lane * 4); }
#pragma unroll
    for (int i = 0; i < 4; ++i) ss += xv[i][0] * xv[i][0] + xv[i][1] * xv[i][1] + xv[i][2] * xv[i][2] + xv[i][3] * xv[i][3];
#pragma unroll
    for (int o = 1; o < 64; o <<= 1) ss += __shfl_xor(ss, o);
    const float rstd = rsqrtf(ss * (1.0f / 1024.0f) + EPS);
    f32x4 hv[4];
#pragma unroll
    for (int i = 0; i < 4; ++i) {
      const int c = i * 256 + lane * 4;
      const f32x4 nv = *(const f32x4*)(P.norm1 + c), sc = *(const f32x4*)(modg + 1024 + c), sh = *(const f32x4*)(modg + c);
      hv[i] = xv[i] * rstd * nv * (sc + 1.0f) + sh;
      u32x2 o; o.x = cvt_pk_bf16(hv[i][0], hv[i][1]); o.y = cvt_pk_bf16(hv[i][2], hv[i][3]);
      *(u32x2*)(H + (size_t)T * DM + c) = o;
    }
  }
  __syncthreads();
}

__device__ __forceinline__ void unit_info(int u, int& T0, int& nc, int& b, int& h, int& c) {
  if (u < 128) { nc = 2; b = u >> 3; h = (u >> 1) & 3; c = u & 1; T0 = b * 256 + c * 128; }
  else { const int v = u - 128; nc = 32; b = v >> 7; h = (v >> 5) & 3; c = v & 31; T0 = NCTXT + b * 4096 + c * 128; }
}
struct ScanOut { float beta0, beta1, cf0, cf1, pm0, pm1, bl, cmax; int t0, t1; };
__device__ __forceinline__ void chunk_scan(const float* gates, int T0, int h, int d, int lane, ScanOut& o) {
  const int t0 = d ? 127 - 2 * lane : 2 * lane, t1 = d ? t0 - 1 : t0 + 1;
  const float* g0 = gates + (size_t)(T0 + t0) * 16 + d * 8 + h; const float* g1 = gates + (size_t)(T0 + t1) * 16 + d * 8 + h;
  const float i0 = g0[0], f0 = g0[4], i1 = g1[0], f1 = g1[4];
  const float s = f0 + f1;
  float x = s;
#pragma unroll
  for (int off = 1; off < 64; off <<= 1) { const float y = __shfl_up(x, off); if (lane >= off) x += y; }
  const float excl = x - s;
  o.beta0 = excl + f0; o.beta1 = x;
  o.cf0 = i0 - o.beta0; o.cf1 = i1 - o.beta1;
  float mx = fmaxf(o.cf0, o.cf1);
#pragma unroll
  for (int off = 1; off < 64; off <<= 1) { const float y = __shfl_up(mx, off); if (lane >= off) mx = fmaxf(mx, y); }
  const float mex = __shfl_up(mx, 1);
  o.pm0 = lane ? fmaxf(mex, o.cf0) : o.cf0; o.pm1 = mx;
  o.bl = __shfl(x, 63); o.cmax = __shfl(mx, 63);
  o.t0 = t0; o.t1 = t1;
}

constexpr int LROW = 136;
constexpr int CST_ELEMS = 129 * 128;

__device__ void shortconv_items(const Params& P) {
  const bf16_t* Z = (const bf16_t*)(P.ws + WS_Z);
  bf16_t* ucat = (bf16_t*)(P.ws + WS_UCAT);
  const int tid = opaque_tid(), wid = tid >> 6, lane = tid & 63, cgp = lane * 8;
  float w0[8], w1[8], w2[8], bb[8];
#pragma unroll
  for (int q = 0; q < 2; ++q) {
    const f32x4 a = *(const f32x4*)(P.conv_sc_w + cgp + q * 4), b = *(const f32x4*)(P.conv_sc_w + 512 + cgp + q * 4), cc = *(const f32x4*)(P.conv_sc_w + 1024 + cgp + q * 4), d = *(const f32x4*)(P.conv_sc_b + cgp + q * 4);
#pragma unroll
    for (int e = 0; e < 4; ++e) { w0[q * 4 + e] = a[e]; w1[q * 4 + e] = b[e]; w2[q * 4 + e] = cc[e]; bb[q * 4 + e] = d[e]; }
  }
  int Tb, Te;
  { const int G = gridDim.x, nhi = 640 % G == 0 ? G : 640 % G;
    const int wlo = 1, whi = (nhi < G) ? 5 : 1;
    const long tot = (long)nhi * wlo + (long)(G - nhi) * whi;
    const int b = blockIdx.x;
    const long s0 = b < nhi ? (long)b * wlo : (long)nhi * wlo + (long)(b - nhi) * whi, s1 = s0 + (b < nhi ? wlo : whi);
    const int r0 = (int)((long)NTOK * s0 / tot), r1 = (int)((long)NTOK * s1 / tot);
    const int n = r1 - r0, per = (n + 7) >> 3;
    Tb = r0 + wid * per; Te = Tb + per < r1 ? Tb + per : r1; }
  if (Tb >= Te) return;
  auto loadu = [&](int T, float (&u)[8]) {
    const int Tc = T < 0 ? 0 : (T >= NTOK ? NTOK - 1 : T);
    const bf16_t* zr = Z + (size_t)Tc * NZ + cgp;
    const u32x4 c = *(const u32x4*)(zr + 512), x = *(const u32x4*)(zr + 1024);
#pragma unroll
    for (int q = 0; q < 4; ++q) { u[2 * q] = bflo(c[q]) * bflo(x[q]); u[2 * q + 1] = bfhi(c[q]) * bfhi(x[q]); }
  };
  float up[8], uc[8], un[8];
  loadu(Tb - 1, up); loadu(Tb, uc);
  for (int T = Tb; T < Te; ++T) {
    loadu(T + 1, un);
    const u32x4 sbq = *(const u32x4*)(Z + (size_t)T * NZ + cgp);
    const int pos = (T < NCTXT) ? (T & 255) : ((T - NCTXT) & 63), lastp = (T < NCTXT) ? 255 : 63;
    const float mp = pos != 0 ? 1.f : 0.f, mn = pos != lastp ? 1.f : 0.f;
    float o[8];
#pragma unroll
    for (int q = 0; q < 4; ++q) {
      o[2 * q] = bflo(sbq[q]) * (w0[2 * q] * (mp * up[2 * q]) + w1[2 * q] * uc[2 * q] + w2[2 * q] * (mn * un[2 * q]) + bb[2 * q]);
      o[2 * q + 1] = bfhi(sbq[q]) * (w0[2 * q + 1] * (mp * up[2 * q + 1]) + w1[2 * q + 1] * uc[2 * q + 1] + w2[2 * q + 1] * (mn * un[2 * q + 1]) + bb[2 * q + 1]);
    }
    u32x4 ov; ov.x = cvt_pk_bf16(o[0], o[1]); ov.y = cvt_pk_bf16(o[2], o[3]); ov.z = cvt_pk_bf16(o[4], o[5]); ov.w = cvt_pk_bf16(o[6], o[7]);
    *(u32x4*)(ucat + (size_t)T * DM + cgp) = ov;
#pragma unroll
    for (int e = 0; e < 8; ++e) { up[e] = uc[e]; uc[e] = un[e]; }
  }
}

__device__ void phaseM1(const Params& P, LAS unsigned char* lds) {
  const int tid = opaque_tid(), wid = tid >> 6, lane = tid & 63, fr = lane & 15, fq = lane >> 4;
  const bf16_t* Z = (const bf16_t*)(P.ws + WS_Z);
  const float* gates = (const float*)(P.ws + WS_GATES);
  float* stat = (float*)(P.ws + WS_STAT);
  bf16_t* dC = (bf16_t*)P.out;
  LAS bf16_t* KT = (LAS bf16_t*)lds;
  LAS bf16_t* VT0 = (LAS bf16_t*)(lds + 34816);
  LAS bf16_t* VT1 = (LAS bf16_t*)(lds + 34816 + 36992);
  LAS float* ecs = (LAS float*)(lds + 34816 + 2 * 36992 + 4096);
  for (int u = blockIdx.x; u < 640; u += gridDim.x) {
    int T0, nc, b, h, c; unit_info(u, T0, nc, b, h, c);
    if (wid < 2) {
      ScanOut so; chunk_scan(gates, T0, h, wid, lane, so);
      ecs[wid * 128 + so.t0] = __expf(so.cf0 - so.cmax); ecs[wid * 128 + so.t1] = __expf(so.cf1 - so.cmax);
      if (lane == 0) { stat[(u * 2 + wid) * 2] = so.bl; stat[(u * 2 + wid) * 2 + 1] = so.cmax; }
    }
    __syncthreads();
    {
      const int s = 2 * (tid & 63);
#pragma unroll
      for (int i = 0; i < 2; ++i) {
        const int kg = (tid >> 6) + 8 * i;
        const bf16_t* zr = Z + (size_t)(T0 + s) * NZ + h * 128 + kg * 8;
        const u32x4 ka = *(const u32x4*)(zr + 2048), va = *(const u32x4*)(zr + 2560);
        const u32x4 kb = *(const u32x4*)(zr + NZ + 2048), vb = *(const u32x4*)(zr + NZ + 2560);
        const float e0a = ecs[s], e0b = ecs[s + 1], e1a = ecs[128 + s], e1b = ecs[128 + s + 1];
#pragma unroll
        for (int q = 0; q < 4; ++q) {
          const int r0 = (kg * 8 + 2 * q) * LROW + s, r1 = r0 + LROW;
          *(LAS unsigned*)(KT + r0) = (ka[q] & 0xffffu) | (kb[q] << 16);
          *(LAS unsigned*)(KT + r1) = (ka[q] >> 16) | (kb[q] & 0xffff0000u);
          const float al = bflo(va[q]), ah = bfhi(va[q]), bl_ = bflo(vb[q]), bh = bfhi(vb[q]);
          *(LAS unsigned*)(VT0 + r0) = cvt_pk_bf16_c(al * e0a, bl_ * e0b);
          *(LAS unsigned*)(VT0 + r1) = cvt_pk_bf16_c(ah * e0a, bh * e0b);
          *(LAS unsigned*)(VT1 + r0) = cvt_pk_bf16_c(al * e1a, bl_ * e1b);
          *(LAS unsigned*)(VT1 + r1) = cvt_pk_bf16_c(ah * e1a, bh * e1b);
        }
      }
      if (tid < 64) { *(LAS unsigned*)(VT0 + 128 * LROW + 2 * tid) = cvt_pk_bf16_c(ecs[2 * tid], ecs[2 * tid + 1]); *(LAS unsigned*)(VT1 + 128 * LROW + 2 * tid) = cvt_pk_bf16_c(ecs[128 + 2 * tid], ecs[128 + 2 * tid + 1]); }
    }
    __syncthreads();
    {
      bf16x8 Kf[4];
#pragma unroll
      for (int ks = 0; ks < 4; ++ks) Kf[ks] = *(const LAS bf16x8*)(KT + (16 * wid + fr) * LROW + 32 * ks + 8 * fq);
#pragma unroll
      for (int d = 0; d < 2; ++d) {
        LAS bf16_t* VT = d ? VT1 : VT0;
        bf16_t* dst = dC + (size_t)(u * 2 + d) * CST_ELEMS;
#pragma unroll
        for (int mt = 0; mt < 9; ++mt) {
          f32x4 a = (f32x4){0.f, 0.f, 0.f, 0.f};
#pragma unroll
          for (int ks = 0; ks < 4; ++ks) { const bf16x8 Vf = *(const LAS bf16x8*)(VT + (16 * mt + fr) * LROW + 32 * ks + 8 * fq); a = __builtin_amdgcn_mfma_f32_16x16x32_bf16(Kf[ks], Vf, a, 0, 0, 0); }
          if (mt < 8 || fr == 0) { u32x2 o; o.x = cvt_pk_bf16_c(a[0], a[1]); o.y = cvt_pk_bf16_c(a[2], a[3]); *(u32x2*)(dst + (16 * mt + fr) * 128 + 16 * wid + 4 * fq) = o; }
        }
      }
    }
    __syncthreads();
  }
}

template <int NC, int BLK, bool HASN>
__device__ __forceinline__ void m2_loop(const bf16_t* dC, bf16_t* Cst, float* mst, const float* sm, int ubase, int d, int e, int kn, bool wm, f32x4& C4, f32x4& n4, float& m) {
#pragma unroll 1
  for (int jb = 0; jb < NC; jb += BLK) {
    u32x2 dv[BLK], nv[BLK];
#pragma unroll
    for (int jj = 0; jj < BLK; ++jj) {
      const int j = jb + jj, c = d ? NC - 1 - j : j;
      const bf16_t* dp = dC + (size_t)((ubase + c) * 2 + d) * CST_ELEMS;
      dv[jj] = *(const u32x2*)(dp + e);
      if (HASN) nv[jj] = *(const u32x2*)(dp + 16384 + kn);
    }
#pragma unroll
    for (int jj = 0; jj < BLK; ++jj) {
      const int j = jb + jj, c = d ? NC - 1 - j : j;
      const int idx = (ubase + c) * 2 + d;
      bf16_t* cs = Cst + (size_t)idx * CST_ELEMS;
      { u32x2 o; o.x = cvt_pk_bf16(C4[0], C4[1]); o.y = cvt_pk_bf16(C4[2], C4[3]); *(u32x2*)(cs + e) = o; }
      if (HASN) { u32x2 o; o.x = cvt_pk_bf16(n4[0], n4[1]); o.y = cvt_pk_bf16(n4[2], n4[3]); *(u32x2*)(cs + 16384 + kn) = o; if (wm) mst[idx] = m; }
      const float bl = sm[2 * j], cmax = sm[2 * j + 1];
      const float mn = bl + fmaxf(m, cmax);
      const float decay = __expf(bl + m - mn), scale = __expf(bl + cmax - mn);
      const u32x2 dvv = dv[jj];
      C4[0] = decay * C4[0] + scale * bflo(dvv.x); C4[1] = decay * C4[1] + scale * bfhi(dvv.x); C4[2] = decay * C4[2] + scale * bflo(dvv.y); C4[3] = decay * C4[3] + scale * bfhi(dvv.y);
      if (HASN) { const u32x2 nvv = nv[jj];
        n4[0] = decay * n4[0] + scale * bflo(nvv.x); n4[1] = decay * n4[1] + scale * bfhi(nvv.x); n4[2] = decay * n4[2] + scale * bflo(nvv.y); n4[3] = decay * n4[3] + scale * bfhi(nvv.y); }
      m = mn;
    }
  }
}
template <int NC, int BLK>
__device__ __forceinline__ void m2_unit(const Params& P, bool lat, int sq, int slice, float* sm) {
  const int tid = opaque_tid();
  const bf16_t* dC = (const bf16_t*)P.out;
  bf16_t* Cst = (bf16_t*)(P.ws + WS_H);
  const float* stat = (const float*)(P.ws + WS_STAT);
  float* mst = (float*)(P.ws + WS_MST);
  const int b = sq >> 3, h = (sq >> 1) & 3, d = sq & 1;
  const int ubase = lat ? 128 + (b * 4 + h) * 32 : (b * 4 + h) * 2;
  const int e = slice * 2048 + tid * 4;
  const bool hasn = (slice == 0) && (tid < 64);
  const int kn = (tid & 31) * 4;
  if (tid < NC) { const int c = d ? NC - 1 - tid : tid; const int idx = (ubase + c) * 2 + d; sm[2 * tid] = stat[idx * 2]; sm[2 * tid + 1] = stat[idx * 2 + 1]; }
  f32x4 C4 = (f32x4){0.f, 0.f, 0.f, 0.f}, n4 = C4; float m = 0.f;
  const int sidx = (b * 2 + d) * 4 + h;
  if (lat) {
    C4 = *(const f32x4*)(P.state_C + (size_t)sidx * 16384 + e);
    n4 = *(const f32x4*)(P.state_n + sidx * 128 + kn);
    m = P.state_m[sidx];
  }
  __syncthreads();
  if (hasn) m2_loop<NC, BLK, true>(dC, Cst, mst, sm, ubase, d, e, kn, tid == 0, C4, n4, m);
  else m2_loop<NC, BLK, false>(dC, Cst, mst, sm, ubase, d, e, kn, false, C4, n4, m);
  if (!lat) {
    *(f32x4*)(P.out + OUT_TAIL + (size_t)sidx * 16384 + e) = C4;
    if (hasn) { *(f32x4*)(P.out + OUT_TAIL + 2097152 + sidx * 128 + kn) = n4; if (tid == 0) P.out[OUT_TAIL + 2097152 + 16384 + sidx] = m; }
  }
  __syncthreads();
}
__device__ void phaseM2(const Params& P, float* sm) {
  for (int unit = blockIdx.x; unit < 1280; unit += gridDim.x) {
    if (unit < 256) m2_unit<32, 16>(P, true, unit >> 3, unit & 7, sm);
    else { const int v = unit - 256; m2_unit<2, 2>(P, false, v >> 3, v & 7, sm); }
  }
}

__device__ __forceinline__ bf16x8 scale_frag(bf16x8 q, float s) {
  const u32x4 a = __builtin_bit_cast(u32x4, q); u32x4 r;
  r.x = cvt_pk_bf16_c(bflo(a.x) * s, bfhi(a.x) * s); r.y = cvt_pk_bf16_c(bflo(a.y) * s, bfhi(a.y) * s);
  r.z = cvt_pk_bf16_c(bflo(a.z) * s, bfhi(a.z) * s); r.w = cvt_pk_bf16_c(bflo(a.w) * s, bfhi(a.w) * s);
  return __builtin_bit_cast(bf16x8, r);
}

__device__ void phaseM3(const Params& P, LAS unsigned char* lds) {
  const int tid = opaque_tid(), wid = tid >> 6, lane = tid & 63, fr = lane & 15, fq = lane >> 4;
  const bf16_t* Z = (const bf16_t*)(P.ws + WS_Z);
  const float* gates = (const float*)(P.ws + WS_GATES);
  const bf16_t* Cst = (const bf16_t*)(P.ws + WS_H);
  const float* mst = (const float*)(P.ws + WS_MST);
  bf16_t* ucat = (bf16_t*)(P.ws + WS_UCAT);
  LAS bf16_t* Ks = (LAS bf16_t*)lds;
  LAS bf16_t* VT = (LAS bf16_t*)(lds + 34816);
  LAS bf16_t* Sb = (LAS bf16_t*)(lds + 34816 + 36992);
  LAS float* arr = (LAS float*)(lds + 34816 + 36992 + 34816);
  LAS float* ecA = arr; LAS float* erA = arr + 256; LAS float* wiA = arr + 512; LAS float* flA = arr + 768;
  LAS bf16_t* Cb = (LAS bf16_t*)(lds + 34816 + 36992 + 34816 + 4096);
  const float qs = 0.08838834764831845f;
  for (int u = blockIdx.x; u < 640; u += gridDim.x) {
    int T0, nc, b, h, c; unit_info(u, T0, nc, b, h, c);
    if (wid < 2) {
      const int d = wid;
      ScanOut so; chunk_scan(gates, T0, h, d, lane, so);
      const float mc = mst[u * 2 + d];
      const float mx0 = fmaxf(mc, so.pm0), mx1 = fmaxf(mc, so.pm1);
      ecA[d * 128 + so.t0] = __expf(so.cf0 - so.cmax); ecA[d * 128 + so.t1] = __expf(so.cf1 - so.cmax);
      erA[d * 128 + so.t0] = __expf(so.cmax - mx0) * qs; erA[d * 128 + so.t1] = __expf(so.cmax - mx1) * qs;
      wiA[d * 128 + so.t0] = __expf(mc - mx0) * qs; wiA[d * 128 + so.t1] = __expf(mc - mx1) * qs;
      flA[d * 128 + so.t0] = __expf(-(so.beta0 + mx0)); flA[d * 128 + so.t1] = __expf(-(so.beta1 + mx1));
    }
    {
      const int s = 2 * (tid & 63);
#pragma unroll
      for (int i = 0; i < 2; ++i) {
        const int kg = (tid >> 6) + 8 * i;
        const bf16_t* zr = Z + (size_t)(T0 + s) * NZ + h * 128 + kg * 8;
        const u32x4 ka = *(const u32x4*)(zr + 2048), va = *(const u32x4*)(zr + 2560);
        const u32x4 kb = *(const u32x4*)(zr + NZ + 2048), vb = *(const u32x4*)(zr + NZ + 2560);
        *(LAS u32x4*)(Ks + s * LROW + kg * 8) = ka;
        *(LAS u32x4*)(Ks + (s + 1) * LROW + kg * 8) = kb;
#pragma unroll
        for (int q = 0; q < 4; ++q) {
          const int r0 = (kg * 8 + 2 * q) * LROW + s, r1 = r0 + LROW;
          *(LAS unsigned*)(VT + r0) = (va[q] & 0xffffu) | (vb[q] << 16);
          *(LAS unsigned*)(VT + r1) = (va[q] >> 16) | (vb[q] & 0xffff0000u);
        }
      }
      if (tid < 64) *(LAS unsigned*)(VT + 128 * LROW + 2 * tid) = 0x3F803F80u;
    }
    u32x4 creg[5];
    {
      const bf16_t* cs0 = Cst + (size_t)(u * 2) * CST_ELEMS;
#pragma unroll
      for (int i = 0; i < 4; ++i) creg[i] = *(const u32x4*)(cs0 + (tid + 512 * i) * 8);
      creg[4] = *(const u32x4*)(cs0 + 16384 + (tid & 15) * 8);
#pragma unroll
      for (int i = 0; i < 4; ++i) { const int ci = tid + 512 * i; *(LAS u32x4*)(Cb + (ci >> 4) * LROW + (ci & 15) * 8) = creg[i]; }
      if (tid < 16) *(LAS u32x4*)(Cb + 128 * LROW + tid * 8) = creg[4];
    }
    __syncthreads();
    {
      const bf16_t* cs1 = Cst + (size_t)(u * 2 + 1) * CST_ELEMS;
#pragma unroll
      for (int i = 0; i < 4; ++i) creg[i] = *(const u32x4*)(cs1 + (tid + 512 * i) * 8);
      creg[4] = *(const u32x4*)(cs1 + 16384 + (tid & 15) * 8);
    }
    {
      const int w = wid;
      bf16x8 Qf[4];
      { const bf16_t* qr = Z + (size_t)(T0 + 16 * w + fr) * NZ + 1536 + h * 128 + 8 * fq;
#pragma unroll
        for (int ks = 0; ks < 4; ++ks) Qf[ks] = *(const bf16x8*)(qr + 32 * ks); }
      f32x4 hsum[8];
#pragma unroll
      for (int vt = 0; vt < 8; ++vt) hsum[vt] = (f32x4){0.f, 0.f, 0.f, 0.f};
      LAS bf16_t* Sw = Sb + w * 16 * LROW;
#pragma unroll
      for (int d = 0; d < 2; ++d) {
        if (d == 1) {
          __syncthreads();
#pragma unroll
          for (int i = 0; i < 4; ++i) { const int ci = tid + 512 * i; *(LAS u32x4*)(Cb + (ci >> 4) * LROW + (ci & 15) * 8) = creg[i]; }
          if (tid < 16) *(LAS u32x4*)(Cb + 128 * LROW + tid * 8) = creg[4];
          __syncthreads();
        }
        const int lo = d ? w : 0, hi = d ? 7 : w;
        const int ks_lo = lo >> 1, ks_hi = hi >> 1;
        float er4[4];
#pragma unroll
        for (int j = 0; j < 4; ++j) er4[j] = erA[d * 128 + 16 * w + 4 * fq + j];
#pragma unroll
        for (int nt = 0; nt < 8; ++nt) {
          if (nt >= 2 * ks_lo && nt <= 2 * ks_hi + 1) {
            f32x4 a = (f32x4){0.f, 0.f, 0.f, 0.f};
            if (nt >= lo && nt <= hi) {
#pragma unroll
              for (int ks = 0; ks < 4; ++ks) { const bf16x8 Kf = *(const LAS bf16x8*)(Ks + (16 * nt + fr) * LROW + 32 * ks + 8 * fq); a = __builtin_amdgcn_mfma_f32_16x16x32_bf16(Qf[ks], Kf, a, 0, 0, 0); }
              const float ecv = ecA[d * 128 + 16 * nt + fr];
#pragma unroll
              for (int j = 0; j < 4; ++j) {
                float val = a[j] * er4[j] * ecv;
                if (nt == w) { const int tl = 4 * fq + j; const bool ok = d ? (fr >= tl) : (fr <= tl); val = ok ? val : 0.f; }
                a[j] = val;
              }
            }
#pragma unroll
            for (int j = 0; j < 4; ++j) { const float nb = dppf<0x12F>(a[j]); if ((fr & 1) == 0) *(LAS unsigned*)(Sw + (4 * fq + j) * LROW + 16 * nt + fr) = cvt_pk_bf16_c(a[j], nb); }
          }
        }
        asm volatile("s_waitcnt lgkmcnt(0)" ::: "memory");
        f32x4 ao[9];
#pragma unroll
        for (int vt = 0; vt < 9; ++vt) ao[vt] = (f32x4){0.f, 0.f, 0.f, 0.f};
        const bf16x8 zf = (bf16x8){0, 0, 0, 0, 0, 0, 0, 0};
#pragma unroll
        for (int ks = 0; ks < 4; ++ks) {
          if (ks >= ks_lo && ks <= ks_hi) {
            const bf16x8 Sf = *(const LAS bf16x8*)(Sw + fr * LROW + 32 * ks + 8 * fq);
#pragma unroll
            for (int vt = 0; vt < 9; ++vt) {
              bf16x8 Vf = *(const LAS bf16x8*)(VT + (vt < 8 ? 16 * vt + fr : 128) * LROW + 32 * ks + 8 * fq);
              if (vt == 8 && fr != 0) Vf = zf;
              ao[vt] = __builtin_amdgcn_mfma_f32_16x16x32_bf16(Sf, Vf, ao[vt], 0, 0, 0);
            }
          }
        }
        {
          const float wv = wiA[d * 128 + 16 * w + fr];
#pragma unroll
          for (int ks = 0; ks < 4; ++ks) {
            const bf16x8 Qs = scale_frag(Qf[ks], wv);
#pragma unroll
            for (int vt = 0; vt < 9; ++vt) {
              bf16x8 Cf = *(const LAS bf16x8*)(Cb + (vt < 8 ? 16 * vt + fr : 128) * LROW + 32 * ks + 8 * fq);
              if (vt == 8 && fr != 0) Cf = zf;
              ao[vt] = __builtin_amdgcn_mfma_f32_16x16x32_bf16(Qs, Cf, ao[vt], 0, 0, 0);
            }
          }
        }
#pragma unroll
        for (int j = 0; j < 4; ++j) {
          const float den = __shfl(ao[8][j], lane & 48);
          const float fl = flA[d * 128 + 16 * w + 4 * fq + j];
          const float inv = 1.0f / fmaxf(fabsf(den), fl);
#pragma unroll
          for (int vt = 0; vt < 8; ++vt) hsum[vt][j] += ao[vt][j] * inv;
        }
        asm volatile("" ::: "memory");
      }
#pragma unroll
      for (int j = 0; j < 4; ++j) {
        float ms = 0.f;
#pragma unroll
        for (int vt = 0; vt < 8; ++vt) ms += hsum[vt][j] * hsum[vt][j];
        ms += __shfl_xor(ms, 1); ms += __shfl_xor(ms, 2); ms += __shfl_xor(ms, 4); ms += __shfl_xor(ms, 8);
        const float r = rsqrtf(ms * (1.0f / 128.0f) + EPS);
        const int T = T0 + 16 * w + 4 * fq + j;
#pragma unroll
        for (int vt = 0; vt < 8; ++vt) {
          const int col = h * 128 + 16 * vt + fr;
          const float og = bf2f(Z[(size_t)T * NZ + 3072 + col]);
          const float val = hsum[vt][j] * r * P.mh_norm[col] * fast_sigmoid(og);
          ucat[(size_t)T * DM + 512 + col] = f2bf_c(val);
        }
      }
    }
    __syncthreads();
  }
}

__device__ void phase7(const Params& P) {
  const int tid7 = opaque_tid(); const int wid = tid7 >> 6, lane = tid7 & 63;
  const float* rss2 = (const float*)(P.ws + WS_RSS2);
  f32x4 fn[4];
#pragma unroll
  for (int i = 0; i < 4; ++i) fn[i] = *(const f32x4*)(P.final_norm + i * 256 + lane * 4);
  const int stride = gridDim.x * 8;
  for (int T0 = blockIdx.x * 8 + wid; T0 < 16384; T0 += 5 * stride) {
    f32x4 v[5][4]; float r[5];
#pragma unroll
    for (int q = 0; q < 5; ++q) {
      int T = T0 + q * stride; T = T < 16384 ? T : 16383;
      r[q] = rss2[T];
#pragma unroll
      for (int i = 0; i < 4; ++i) v[q][i] = *(const f32x4*)(P.out + (size_t)T * DM + i * 256 + lane * 4);
    }
#pragma unroll
    for (int q = 0; q < 5; ++q) {
      const int T = T0 + q * stride;
      if (T < 16384) {
        const float rr = rsqrtf(r[q] * (1.0f / 1024.0f) + EPS);
#pragma unroll
        for (int i = 0; i < 4; ++i) *(f32x4*)(P.out + (size_t)T * DM + i * 256 + lane * 4) = v[q][i] * rr * fn[i];
      }
    }
  }
  {
    const bf16_t* part = (const bf16_t*)(P.ws + WS_H);
    for (int T = 16384 + blockIdx.x * 8 + wid; T < NTOK; T += stride) {
      f32x4 v[4], a1[4], a2[4], a3[4];
      const size_t ro = (size_t)(T - 16384) * DM;
      u32x2 b1[4], b2[4], b3[4];
#pragma unroll
      for (int i = 0; i < 4; ++i) { const int c = i * 256 + lane * 4;
        v[i] = *(const f32x4*)(P.out + (size_t)T * DM + c); b1[i] = *(const u32x2*)(part + ro + c);
        b2[i] = *(const u32x2*)(part + (size_t)4096 * DM + ro + c); b3[i] = *(const u32x2*)(part + (size_t)8192 * DM + ro + c); }
#pragma unroll
      for (int i = 0; i < 4; ++i) {
        a1[i] = (f32x4){bflo(b1[i].x), bfhi(b1[i].x), bflo(b1[i].y), bfhi(b1[i].y)};
        a2[i] = (f32x4){bflo(b2[i].x), bfhi(b2[i].x), bflo(b2[i].y), bfhi(b2[i].y)};
        a3[i] = (f32x4){bflo(b3[i].x), bfhi(b3[i].x), bflo(b3[i].y), bfhi(b3[i].y)}; }
      float ss = 0.f;
#pragma unroll
      for (int i = 0; i < 4; ++i) { v[i] = v[i] + a1[i] + a2[i] + a3[i]; ss += v[i][0] * v[i][0] + v[i][1] * v[i][1] + v[i][2] * v[i][2] + v[i][3] * v[i][3]; }
#pragma unroll
      for (int o = 1; o < 64; o <<= 1) ss += __shfl_xor(ss, o);
      const float rr = rsqrtf(ss * (1.0f / 1024.0f) + EPS);
#pragma unroll
      for (int i = 0; i < 4; ++i) *(f32x4*)(P.out + (size_t)T * DM + i * 256 + lane * 4) = v[i] * rr * fn[i];
    }
  }
}


#define XB_TMO      128
#define XB_XCNT(j)  (256  + 64 * (j))
#define XB_XSUB(j)  (1280 + 64 * (j))
#define XB_XGEN(j)  (2304 + 64 * (j))
#define XB_TOP      3328
#define XB_TOPGEN   3392
#define XCD_BAR_WORDS 3456
#define XB_SPIN_CAP (1u << 18)
__device__ __forceinline__ unsigned xb_ld(unsigned* p)              { return __hip_atomic_load(p, __ATOMIC_RELAXED, __HIP_MEMORY_SCOPE_AGENT); }
__device__ __forceinline__ unsigned xb_add(unsigned* p, unsigned v) { return __hip_atomic_fetch_add(p, v, __ATOMIC_RELAXED, __HIP_MEMORY_SCOPE_AGENT); }
__device__ __forceinline__ unsigned xb_xcc_id() { return (unsigned)__builtin_amdgcn_s_getreg((3 << 11) | 20) & 0xFu; }
#define XB_SPIN(cond, bar) do { unsigned _sp = 0; while (cond) { __builtin_amdgcn_s_sleep(1); \
    if ((++_sp & 255u) == 0u) { if (xb_ld(&(bar)[XB_TMO])) break; if (_sp > XB_SPIN_CAP) { atomicAdd(&(bar)[XB_TMO], 1u); break; } } } } while (0)
struct XcdBarrier { unsigned* bar; unsigned x; volatile LAS unsigned* st; };
__device__ __forceinline__ XcdBarrier xcd_barrier_post(unsigned* bar, volatile LAS unsigned* st) {
  XcdBarrier b; b.bar = bar; b.x = xb_xcc_id(); b.st = st;
  if (threadIdx.x == 0) (void)xb_add(&bar[XB_XCNT(b.x)], 1u);
  return b;
}
__device__ __forceinline__ void xcd_barrier_complete(unsigned* bar, unsigned x, unsigned& nloc, unsigned& nx) {
  const unsigned G = gridDim.x * gridDim.y * gridDim.z;
  unsigned sum, cnt, mine, sp = 0u;
  for (;;) {
    sum = 0u; cnt = 0u; mine = 0u;
#pragma unroll
    for (unsigned j = 0; j < 16; ++j) { const unsigned c = xb_ld(&bar[XB_XCNT(j)]); sum += c; cnt += (c > 0u) ? 1u : 0u; mine = (j == x) ? c : mine; }
    if (sum == G) break;
    __builtin_amdgcn_s_sleep(1);
    if ((++sp & 255u) == 0u) { if (xb_ld(&bar[XB_TMO])) break; if (sp > XB_SPIN_CAP) { atomicAdd(&bar[XB_TMO], 1u); break; } }
  }
  nloc = mine > 0u ? mine : 1u; nx = cnt > 0u ? cnt : 1u;
}
__device__ __forceinline__ void xcd_barrier(const XcdBarrier& b) {
  asm volatile("s_waitcnt vmcnt(0) lgkmcnt(0)" ::: "memory");
  __syncthreads();
  if (threadIdx.x == 0) {
    unsigned* bar = b.bar;
    __builtin_amdgcn_s_waitcnt(0);
    unsigned nloc = b.st[0], nx = b.st[1];
    if (nloc == 0u) { xcd_barrier_complete(bar, b.x, nloc, nx); b.st[0] = nloc; b.st[1] = nx; }
    const unsigned old = xb_add(&bar[XB_XSUB(b.x)], 1u);
    const unsigned gen = old / nloc;
    if (old + 1u == (gen + 1u) * nloc) {
      __builtin_amdgcn_fence(__ATOMIC_RELEASE, "agent");
      asm volatile("s_waitcnt vmcnt(0)" ::: "memory");
      const unsigned og = xb_add(&bar[XB_TOP], 1u);
      const unsigned tg = og / nx;
      if (og + 1u == (tg + 1u) * nx) xb_add(&bar[XB_TOPGEN], 1u);
      else XB_SPIN(xb_ld(&bar[XB_TOPGEN]) == tg, bar);
      __builtin_amdgcn_fence(__ATOMIC_ACQUIRE, "agent");
      xb_add(&bar[XB_XGEN(b.x)], 1u);
      asm volatile("s_waitcnt vmcnt(0)" ::: "memory");
    } else {
      XB_SPIN(xb_ld(&bar[XB_XGEN(b.x)]) == gen, bar);
      __builtin_amdgcn_fence(__ATOMIC_ACQUIRE, "agent");
      asm volatile("s_waitcnt vmcnt(0)" ::: "memory");
    }
  }
  __syncthreads();
}

#define GSYNC() xcd_barrier(xb)
__global__ void __launch_bounds__(512, 2) fwd_megakernel(Params P) {
  extern __shared__ __attribute__((aligned(16))) unsigned char shm[];
  cg::grid_group grid = cg::this_grid();
  LAS unsigned char* lds = (LAS unsigned char*)shm;
  float* smf = (float*)shm;
  if (P.ws == nullptr) grid.sync();
  volatile LAS unsigned* xst = (volatile LAS unsigned*)(lds + (LDS_BYTES - 16));
  if (threadIdx.x == 0) { xst[0] = 0u; xst[1] = 0u; }
  __syncthreads();
  const XcdBarrier xb = xcd_barrier_post((unsigned*)(P.ws + WS_BAR), xst);
#define RUN_P2() { EpiZ E; E.Z = (bf16_t*)(P.ws + WS_Z); E.gates = (float*)(P.ws + WS_GATES); E.bgate = P.b_gate; \
    gemm_phase<EpiZ>(lds, (const bf16_t*)(P.ws + WS_H), (const bf16_t*)(P.ws + WS_WIN), NTOK, NZG, DM, E); } \
    { const int nfull = (80 * 15) % (int)gridDim.x;     \
      if ((int)blockIdx.x >= nfull) transpose_range(P, smf, blockIdx.x - nfull, gridDim.x - nfull, NTR_WIN, NTR_WIN + 256); } GSYNC();
#define RUN_M() phaseM1(P, lds); GSYNC(); phaseM2(P, smf); GSYNC(); phaseM3(P, lds); shortconv_items(P); GSYNC();
#define RUN_P5() { EpiUp E; E.rowss1 = (const float*)(P.ws + WS_RSS1); E.sb = (const float*)(P.ws + WS_SB); E.cw = P.conv_ffn_w; E.cb = P.conv_ffn_b; E.act = (bf16_t*)(P.ws + WS_Z); \
    gemm_phase<EpiUp>(lds, (const bf16_t*)(P.ws + WS_H), (const bf16_t*)(P.ws + WS_WUP), NTOK, NUP, DM, E); } GSYNC();
  phase0a(P, smf);
  GSYNC();
  phase0b(P, smf);
  GSYNC();
  RUN_P2()
#if DUP == 2
  RUN_P2()
#endif
#if DUP == 21
  { EpiNone E; E.Z = (bf16_t*)(P.ws + WS_UCAT);
    gemm_phase<EpiNone>(lds, (const bf16_t*)(P.ws + WS_H), (const bf16_t*)(P.ws + WS_WIN), NTOK, NZ, DM, E); } GSYNC();
#endif
  RUN_M()
#if DUP == 3
  RUN_M()
#endif
#if DUP == 31
  phaseM1(P, lds); GSYNC();
#endif
#if DUP == 32
  phaseM2(P, smf); GSYNC();
#endif
#if DUP == 33
  phaseM3(P, lds); GSYNC();
#endif
#if DUP == 34
  shortconv_items(P); GSYNC();
#endif
#if DUP == 6
  RUN_P5()
#endif
  { EpiX1 E; E.xp = P.x_prompt; E.xs = P.x_sample; E.mod = (const float*)(P.ws + WS_MOD); E.norm2 = P.norm2; E.x1out = P.out; E.x1g = (bf16_t*)(P.ws + WS_H); E.rowss = (float*)(P.ws + WS_RSS1);
    gemm_phase<EpiX1>(lds, (const bf16_t*)(P.ws + WS_UCAT), (const bf16_t*)(P.ws + WS_WOUT), NTOK, DM, DM, E); }
  if (blockIdx.x >= 64) transpose_range(P, smf, blockIdx.x - 64, gridDim.x - 64, NTR_WIN + 256, NTR_ALL);
  GSYNC();
  RUN_P5()
#if DUP == 5
  RUN_P5()
#endif
  { EpiDown E; E.mod = (const float*)(P.ws + WS_MOD); E.out = P.out; E.rowss2 = (float*)(P.ws + WS_RSS2);
    gemm_phase<EpiDown>(lds, (const bf16_t*)(P.ws + WS_Z), (const bf16_t*)(P.ws + WS_WDN), 16384, DM, DFF, E); }
  { EpiDownPart E; E.mod = (const float*)(P.ws + WS_MOD); E.out = P.out; E.part = (float*)(P.ws + WS_H);
    gemm_phase<EpiDownPart, 4>(lds, (const bf16_t*)(P.ws + WS_Z), (const bf16_t*)(P.ws + WS_WDN), NTOK, DM, DFF, E); }
  GSYNC();
  phase7(P);
}

extern "C" void kernel_launch(void* const* d_in, const int* in_sizes, int n_in, void* d_out, int out_size, void* d_ws, size_t ws_size, hipStream_t stream) {
  static int grid_blocks = 0;
  if (!grid_blocks) {
    int dev = 0, cus = 0, per_cu = 0;
    hipGetDevice(&dev);
    hipDeviceGetAttribute(&cus, hipDeviceAttributeMultiprocessorCount, dev);
    hipFuncSetAttribute((const void*)fwd_megakernel, hipFuncAttributeMaxDynamicSharedMemorySize, LDS_BYTES);
    hipOccupancyMaxActiveBlocksPerMultiprocessor(&per_cu, (const void*)fwd_megakernel, 512, LDS_BYTES);
    (void)hipGetLastError();
    if (per_cu < 1) per_cu = 1;
    if (per_cu > 1) per_cu = 1;
    grid_blocks = cus * per_cu;
  }
  hipMemsetAsync(d_ws, 0, WS_ZERO_BYTES, stream);
  Params p{};
  const float** pp = (const float**)&p;
  for (int i = 0; i < 22; ++i) pp[i] = (const float*)d_in[i];
  p.out = (float*)d_out; p.ws = (unsigned char*)d_ws;
  void* args[] = {&p};
  hipError_t e = hipLaunchCooperativeKernel((const void*)fwd_megakernel, dim3(grid_blocks), dim3(512), args, LDS_BYTES, stream);
  if (e != hipSuccess) fprintf(stderr, "cooperative launch failed: %s (grid %d)\n", hipGetErrorString(e), grid_blocks);
}
```
